# Optimizing an MI355X kernel written in HIP

```python
import math
import jax, jax.numpy as jnp
from jax import lax
import numpy as np

D_MODEL = 1024
BATCH = 1
SEQ = 16384
DEPTH = 2

CHUNK = 64
HEAD_DIM = 64
N_RET = 6
N_SB = 5
N_FOX = 5
W_RET = N_RET * HEAD_DIM
W_SB = N_SB * HEAD_DIM
W_FOX = N_FOX * HEAD_DIM
MIX_WIDTH = W_RET + W_SB + W_FOX
IN_WIDTH = 4 * W_RET + 3 * W_SB + 3 * W_FOX + N_FOX
Q_BLOCK = 128
ROPE_BASE = 10000.0
EPS = 1e-6
N_GROUPS = 4
EXPERTS_PER_GROUP = 8
N_EXPERTS = N_GROUPS * EXPERTS_PER_GROUP
TOP_K = 2
D_EXPERT = 512
MOE_BLOCK = 128

kernel_name = "hybrid_retention_stickbreak_fox_hmoe"


def rmsnorm(x, g):
    xf = x.astype(jnp.float32)
    y = xf * lax.rsqrt(jnp.mean(xf * xf, axis=-1, keepdims=True) + EPS)
    return (y * g.astype(jnp.float32)).astype(x.dtype)


def to_heads(t, n):
    B, S, _ = t.shape
    return t.reshape(B, S, n, HEAD_DIM).transpose(0, 2, 1, 3)


def from_heads(t):
    B, H, S, d = t.shape
    return t.transpose(0, 2, 1, 3).reshape(B, S, H * d)


def rotary(x, pos):
    half = HEAD_DIM // 2
    inv = 1.0 / (ROPE_BASE ** (jnp.arange(half, dtype=jnp.float32) / half))
    ang = pos.astype(jnp.float32)[:, None] * inv[None, :]
    cos = jnp.cos(ang).astype(x.dtype)
    sin = jnp.sin(ang).astype(x.dtype)
    x1, x2 = x[..., :half], x[..., half:]
    return jnp.concatenate([x1 * cos - x2 * sin, x1 * sin + x2 * cos], axis=-1)


def head_group_norm(o, g):
    H, d = o.shape[1], o.shape[3]
    mu = jnp.mean(o, axis=-1, keepdims=True)
    c = o - mu
    var = jnp.mean(c * c, axis=-1, keepdims=True)
    return c * lax.rsqrt(var + EPS) * g.astype(jnp.float32).reshape(1, H, 1, d)


def head_rms_norm(o, g):
    H, d = o.shape[1], o.shape[3]
    return o * lax.rsqrt(jnp.mean(o * o, axis=-1, keepdims=True) + EPS) * g.astype(jnp.float32).reshape(1, H, 1, d)


def retention(q, k, v):
    B, H, S, d = q.shape
    N = S // CHUNK
    f32 = jnp.float32
    qc = q.astype(f32).reshape(B, H, N, CHUNK, d)
    kc = k.astype(f32).reshape(B, H, N, CHUNK, d)
    vc = v.astype(f32).reshape(B, H, N, CHUNK, d)
    log_gamma = jnp.log(1.0 - 2.0 ** (-5.0 - jnp.arange(H, dtype=f32)))
    idx = jnp.arange(CHUNK, dtype=f32)
    intra_decay = jnp.exp(log_gamma[:, None, None] * jnp.abs(idx[:, None] - idx[None, :]))
    q_decay = jnp.exp(log_gamma[:, None] * (idx + 1.0))
    k_decay = jnp.exp(log_gamma[:, None] * (CHUNK - 1.0 - idx))
    chunk_decay = jnp.exp(log_gamma * CHUNK)
    scores = jnp.einsum('bhncd,bhnkd->bhnck', qc, kc) * intra_decay[None, :, None]
    o_intra = jnp.einsum('bhnck,bhnke->bhnce', scores, vc)
    u = jnp.einsum('bhnkd,bhnke->bhnde', kc * k_decay[None, :, None, :, None], vc)

    def step(state, u_n):
        return state * chunk_decay[None, :, None, None] + u_n, state

    _, state_prev = lax.scan(step, jnp.zeros((B, H, d, d), f32), jnp.moveaxis(u, 2, 0))
    state_prev = jnp.moveaxis(state_prev, 0, 2)
    o_cross = jnp.einsum('bhncd,bhnde->bhnce', qc * q_decay[None, :, None, :, None], state_prev)
    return (o_intra + o_cross).reshape(B, H, S, d)


def causal_block_mixers(q_sb, k_sb, v_sb, q_fx, k_fx, v_fx, log_f):
    B, H, S, d = q_sb.shape
    nb = S // Q_BLOCK
    scale = d ** -0.5
    f32 = jnp.float32
    F = jnp.cumsum(log_f.astype(f32), axis=-1)
    key_pos = jnp.arange(S)

    def to_blocks(t):
        return jnp.moveaxis(t.reshape(t.shape[:2] + (nb, Q_BLOCK) + t.shape[3:]), 2, 0)

    def one_block(args):
        i, qs, qf, Fq = args
        q_pos = i * Q_BLOCK + jnp.arange(Q_BLOCK)
        z = jnp.einsum('bhqd,bhkd->bhqk', qs, k_sb).astype(f32) * scale
        strict = key_pos[None, :] < q_pos[:, None]
        log_beta = jax.nn.log_sigmoid(z)
        log_1m = jnp.where(strict, log_beta - z, 0.0)
        between = lax.cumsum(log_1m, axis=3, reverse=True) - log_1m
        a = jnp.where(strict, jnp.exp(log_beta + between), 0.0)
        o_sb = jnp.einsum('bhqk,bhkd->bhqd', a.astype(v_sb.dtype), v_sb).astype(f32)
        logits = jnp.einsum('bhqd,bhkd->bhqk', qf, k_fx).astype(f32) * scale
        logits = logits + Fq[..., :, None] - F[..., None, :]
        causal = key_pos[None, :] <= q_pos[:, None]
        p = jax.nn.softmax(jnp.where(causal, logits, -jnp.inf), axis=-1)
        o_fx = jnp.einsum('bhqk,bhkd->bhqd', p.astype(v_fx.dtype), v_fx).astype(f32)
        return o_sb, o_fx

    o_sb, o_fx = lax.map(one_block, (jnp.arange(nb), to_blocks(q_sb), to_blocks(q_fx), to_blocks(F)))
    o_sb = jnp.moveaxis(o_sb, 0, 2).reshape(B, H, S, d)
    o_fx = jnp.moveaxis(o_fx, 0, 2).reshape(B, H, S, d)
    return o_sb, o_fx


def mixer_block(h, w_in, b_forget, g_ret, g_sb, g_fox, w_out, pos):
    f32 = jnp.float32
    proj = h @ w_in
    sizes = [W_RET] * 4 + [W_SB] * 3 + [W_FOX] * 3 + [N_FOX]
    cuts, acc = [], 0
    for s in sizes[:-1]:
        acc += s
        cuts.append(acc)
    q_r, k_r, v_r, gate_r, q_s, k_s, v_s, q_f, k_f, v_f, f_logit = jnp.split(proj, cuts, axis=-1)
    qr = rotary(to_heads(q_r, N_RET), pos) * (HEAD_DIM ** -0.5)
    kr = rotary(to_heads(k_r, N_RET), pos)
    o_ret = head_group_norm(retention(qr, kr, to_heads(v_r, N_RET)), g_ret)
    o_ret = from_heads(o_ret) * jax.nn.silu(gate_r.astype(f32))
    log_f = jax.nn.log_sigmoid(f_logit.astype(f32) + b_forget.astype(f32)).transpose(0, 2, 1)
    o_sb, o_fx = causal_block_mixers(to_heads(q_s, N_SB), to_heads(k_s, N_SB), to_heads(v_s, N_SB),
                                     to_heads(q_f, N_FOX), to_heads(k_f, N_FOX), to_heads(v_f, N_FOX), log_f)
    o_sb = from_heads(head_rms_norm(o_sb, g_sb))
    o_fx = from_heads(head_rms_norm(o_fx, g_fox))
    merged = jnp.concatenate([o_ret, o_sb, o_fx], axis=-1).astype(h.dtype)
    return merged @ w_out


def hier_moe(h, w_group, b_group, w_router, b_router, w_gate, w_up, w_down):
    B, S, D = h.shape
    T = B * S
    f32 = jnp.float32
    xt = h.reshape(T, D)
    g_logits = (xt @ w_group).astype(f32) + b_group.astype(f32)
    g_prob = jax.nn.softmax(g_logits, axis=-1)
    grp = jnp.argmax(g_logits, axis=-1)
    p_grp = jnp.take_along_axis(g_prob, grp[:, None], axis=-1)
    e_logits = ((xt @ w_router).astype(f32) + b_router.astype(f32)).reshape(T, N_GROUPS, EXPERTS_PER_GROUP)
    e_logits = jnp.take_along_axis(e_logits, grp[:, None, None], axis=1)[:, 0]
    top_val, top_idx = lax.top_k(e_logits, TOP_K)
    gate = jax.nn.softmax(top_val, axis=-1) * p_grp
    expert_id = (grp[:, None] * EXPERTS_PER_GROUP + top_idx).reshape(-1)
    A = T * TOP_K
    order = jnp.argsort(expert_id)
    sorted_e = expert_id[order]
    token_of = order // TOP_K
    gate_sorted = gate.reshape(-1)[order]
    counts = jnp.bincount(expert_id, length=N_EXPERTS)
    start = jnp.cumsum(counts) - counts
    padded = ((counts + MOE_BLOCK - 1) // MOE_BLOCK) * MOE_BLOCK
    padded_end = jnp.cumsum(padded)
    padded_start = padded_end - padded
    dest = padded_start[sorted_e] + (jnp.arange(A) - start[sorted_e])
    P = ((A + MOE_BLOCK - 1) // MOE_BLOCK) * MOE_BLOCK + N_EXPERTS * MOE_BLOCK
    nblk = P // MOE_BLOCK
    buf = jnp.zeros((P, D), h.dtype).at[dest].set(xt[token_of])
    blk_start = jnp.arange(nblk) * MOE_BLOCK
    blk_expert = jnp.minimum(jnp.sum(padded_end[None, :] <= blk_start[:, None], axis=-1), N_EXPERTS - 1)

    def expert_block(args):
        xb, e = args
        hid = jax.nn.silu(xb @ w_gate[e]) * (xb @ w_up[e])
        return hid @ w_down[e]

    ybuf = lax.map(expert_block, (buf.reshape(nblk, MOE_BLOCK, D), blk_expert)).reshape(P, D)
    y = ybuf[dest] * gate_sorted[:, None].astype(ybuf.dtype)
    out = jax.ops.segment_sum(y, token_of, num_segments=T)
    return out.reshape(B, S, D)


def setup_inputs(seed: int = 0) -> dict:
    key = jax.random.key(seed)
    ks = jax.random.split(key, 18)
    L, D = DEPTH, D_MODEL

    def nrm(k, shape, scale):
        return jax.random.normal(k, shape, jnp.float32) * scale

    return {
        "x": nrm(ks[0], (BATCH, SEQ, D), 1.0),
        "norm_mix": 1.0 + nrm(ks[1], (L, D), 0.02),
        "w_in": nrm(ks[2], (L, D, IN_WIDTH), D ** -0.5),
        "b_forget": jax.random.uniform(ks[3], (L, N_FOX), jnp.float32, 1.0, 4.0),
        "g_ret": 1.0 + nrm(ks[4], (L, W_RET), 0.02),
        "g_sb": 1.0 + nrm(ks[5], (L, W_SB), 0.02),
        "g_fox": 1.0 + nrm(ks[6], (L, W_FOX), 0.02),
        "w_out": nrm(ks[7], (L, MIX_WIDTH, D), MIX_WIDTH ** -0.5),
        "norm_ffn": 1.0 + nrm(ks[8], (L, D), 0.02),
        "w_group": nrm(ks[9], (L, D, N_GROUPS), D ** -0.5),
        "b_group": nrm(ks[10], (L, N_GROUPS), 0.01),
        "w_router": nrm(ks[11], (L, D, N_EXPERTS), D ** -0.5),
        "b_router": nrm(ks[12], (L, N_EXPERTS), 0.01),
        "w_gate": nrm(ks[13], (L, N_EXPERTS, D, D_EXPERT), D ** -0.5),
        "w_up": nrm(ks[14], (L, N_EXPERTS, D, D_EXPERT), D ** -0.5),
        "w_down": nrm(ks[15], (L, N_EXPERTS, D_EXPERT, D), D_EXPERT ** -0.5),
        "norm_final": 1.0 + nrm(ks[16], (D,), 0.02),
    }


def reference(x, norm_mix, w_in, b_forget, g_ret, g_sb, g_fox, w_out, norm_ffn, w_group, b_group,
              w_router, b_router, w_gate, w_up, w_down, norm_final):
    S = x.shape[1]
    pos = jnp.arange(S)
    for l in range(DEPTH):
        mix = mixer_block(rmsnorm(x, norm_mix[l]), w_in[l], b_forget[l], g_ret[l], g_sb[l], g_fox[l],
                          w_out[l], pos)
        x = x + mix.astype(x.dtype)
        ffn = hier_moe(rmsnorm(x, norm_ffn[l]), w_group[l], b_group[l], w_router[l], b_router[l],
                       w_gate[l], w_up[l], w_down[l])
        x = x + ffn.astype(x.dtype)
    return rmsnorm(x, norm_final)
```

```cpp
#ifndef CPU_EMU
#include <hip/hip_runtime.h>
#include <hip/hip_cooperative_groups.h>
#include <cstdio>
#include <cstdint>
#include <cmath>
namespace cg = cooperative_groups;
#define VEC(T, N) T __attribute__((ext_vector_type(N)))
__device__ __forceinline__ void wave_barrier() { __builtin_amdgcn_wave_barrier(); }
__device__ __forceinline__ float sin2pi(float x) { return __builtin_amdgcn_sinf(x); }
__device__ __forceinline__ float cos2pi(float x) { return __builtin_amdgcn_cosf(x); }
__device__ __forceinline__ unsigned long long ballot64(bool p) { return __ballot(p); }
#else
#define VEC(T, N) T __attribute__((vector_size(sizeof(T) * N)))
inline float sin2pi(float x) { return (float)sin(6.283185307179586 * (double)x); }
inline float cos2pi(float x) { return (float)cos(6.283185307179586 * (double)x); }
inline unsigned long long ballot64(bool p) { return emu_ballot(p); }
#endif

typedef unsigned short bf16_t;
typedef VEC(float, 4) f32x4;
typedef VEC(float, 2) f32x2;
typedef VEC(unsigned, 2) u32x2;
typedef VEC(unsigned, 4) u32x4;

#ifdef SMALL_CFG
constexpr int D = 256, S = 512, DEPTH = 2, NRET = 2, NSB = 1, NFOX = 1, NG = 2, EPG = 4, DE = 128;
#else
constexpr int D = 1024, S = 16384, DEPTH = 2, NRET = 6, NSB = 5, NFOX = 5, NG = 4, EPG = 8, DE = 512;
#endif
constexpr int CH = 64, HD = 64, NE = NG * EPG;
constexpr int WRET = NRET * HD, WSB = NSB * HD, WFOX = NFOX * HD, MIXW = WRET + WSB + WFOX;
constexpr int IN_W = 4 * WRET + 3 * WSB + 3 * WFOX + NFOX;
constexpr int PW = (IN_W + 255) / 256 * 256;
constexpr int OQR = 0, OKR = WRET, OVR = 2 * WRET, OGR = 3 * WRET, OQS = 4 * WRET, OKS = OQS + WSB, OVS = OKS + WSB;
constexpr int OQF = OVS + WSB, OKF = OQF + WFOX, OVF = OKF + WFOX, OFL = OVF + WFOX;
constexpr int NCHUNK = S / CH;
constexpr float EPS = 1e-6f;
constexpr int NT = 512, NW = NT / 64;
constexpr int NROUTE = NG + NE;
constexpr float EXIT_T = 30.0f;

constexpr size_t al256(size_t x) { return (x + 255) / 256 * 256; }
constexpr size_t WS_CTL = 0;
constexpr int CTL_CNT = 0;
constexpr int CTL_KMAX = 256;
constexpr int CTL_WORDS = 512;
constexpr size_t WS_ROT = 4096;
constexpr size_t WS_X = al256(WS_ROT + (size_t)S * 32 * 8);
constexpr size_t WS_H = al256(WS_X + (size_t)S * D * 4);
constexpr size_t WS_PROJ = al256(WS_H + (size_t)S * D * 2);
constexpr size_t WS_LOGF = al256(WS_PROJ + (size_t)S * PW * 2);
constexpr size_t WS_MERGED = al256(WS_LOGF + (size_t)S * 8 * 4);
constexpr size_t WS_U = al256(WS_MERGED + (size_t)S * MIXW * 2);
constexpr size_t WS_SP = al256(WS_U + (size_t)NRET * NCHUNK * 4096 * 4);
constexpr size_t WS_LIST = al256(WS_SP + (size_t)NRET * NCHUNK * 4096 * 4);
constexpr size_t WS_GATE = al256(WS_LIST + (size_t)NE * S * 4);
constexpr size_t WS_HID = al256(WS_GATE + (size_t)S * 2 * 4);
constexpr size_t WS_Y = al256(WS_HID + (size_t)2 * S * DE * 2);
constexpr size_t WS_END = al256(WS_Y + (size_t)2 * S * D * 2);

struct Params {
    const float* x; const float* norm_mix; const float* w_in; const float* b_forget; const float* g_ret; const float* g_sb; const float* g_fox;
    const float* w_out; const float* norm_ffn; const float* w_group; const float* b_group; const float* w_router; const float* b_router;
    const float* w_gate; const float* w_up; const float* w_down; const float* norm_final;
    float* out; unsigned char* ws;
};

__device__ __forceinline__ int imin(int a, int b) { return a < b ? a : b; }
__device__ __forceinline__ float u2f(unsigned u) { return __builtin_bit_cast(float, u); }
__device__ __forceinline__ unsigned f2u(float f) { return __builtin_bit_cast(unsigned, f); }
__device__ __forceinline__ float bf2f(bf16_t b) { return u2f((unsigned)b << 16); }
__device__ __forceinline__ bf16_t f2bf(float f) { unsigned u = f2u(f); return (bf16_t)((u + 0x7fffu + ((u >> 16) & 1u)) >> 16); }
__device__ __forceinline__ unsigned pk2(float lo, float hi) { return (unsigned)f2bf(lo) | ((unsigned)f2bf(hi) << 16); }
__device__ __forceinline__ float log_sigmoid(float x) { return fminf(x, 0.f) - log1pf(expf(-fabsf(x))); }
__device__ __forceinline__ float silu(float x) { return x / (1.f + expf(-x)); }
__device__ __forceinline__ float wave_sum(float v) {
#pragma unroll
    for (int o = 1; o < 64; o <<= 1) v += __shfl_xor(v, o);
    return v;
}
__device__ __forceinline__ float wave_max(float v) {
#pragma unroll
    for (int o = 1; o < 64; o <<= 1) v = fmaxf(v, __shfl_xor(v, o));
    return v;
}
__device__ __forceinline__ bool block_all(bool pred, volatile unsigned* red) {
    const unsigned long long b = ballot64(pred);
    __syncthreads();
    if ((threadIdx.x & 63) == 0) red[threadIdx.x >> 6] = (b == ~0ull) ? 1u : 0u;
    __syncthreads();
    bool all = true;
    for (int w = 0; w < NW; ++w) all = all && (red[w] != 0u);
    return all;
}
__device__ __forceinline__ double inv_turns(int j) {
    static constexpr double T[32] = {
        1.59154943091895346e-01, 1.19349370211248862e-01, 8.94994016088910133e-02, 6.71150830052272551e-02, 5.03292121044870353e-02, 3.77415847174197711e-02, 2.83021958306233987e-02, 2.12236527647776604e-02,
        1.59154943091895339e-02, 1.19349370211248862e-02, 8.94994016088910237e-03, 6.71150830052272534e-03, 5.03292121044870370e-03, 3.77415847174197719e-03, 2.83021958306233987e-03, 2.12236527647776622e-03,
        1.59154943091895356e-03, 1.19349370211248849e-03, 8.94994016088910237e-04, 6.71150830052272599e-04, 5.03292121044870326e-04, 3.77415847174197741e-04, 2.83021958306233954e-04, 2.12236527647776605e-04,
        1.59154943091895351e-04, 1.19349370211248862e-04, 8.94994016088910182e-05, 6.71150830052272545e-05, 5.03292121044870354e-05, 3.77415847174197768e-05, 2.83021958306233961e-05, 2.12236527647776592e-05};
    return T[j];
}

constexpr int RJ = D / 256;
__device__ __forceinline__ void row_load(const float* row, f32x4* v, int lane) {
#pragma unroll
    for (int j = 0; j < RJ; ++j) v[j] = *(const f32x4*)(row + 256 * j + lane * 4);
}
__device__ __forceinline__ float row_rinv(const f32x4* v) {
    float s = 0.f;
#pragma unroll
    for (int j = 0; j < RJ; ++j) s += (v[j][0] * v[j][0] + v[j][1] * v[j][1]) + (v[j][2] * v[j][2] + v[j][3] * v[j][3]);
    s = wave_sum(s);
    return 1.0f / sqrtf(s * (1.0f / D) + EPS);
}

__device__ __forceinline__ void phase_init(const Params& p) {
    unsigned* ctl = (unsigned*)(p.ws + WS_CTL);
    if (blockIdx.x == 0) for (int i = threadIdx.x; i < CTL_WORDS; i += NT) ctl[i] = 0u;
    f32x2* rot = (f32x2*)(p.ws + WS_ROT);
    for (int i = blockIdx.x * NT + threadIdx.x; i < S * 32; i += gridDim.x * NT) {
        const int pos = i >> 5, j = i & 31;
        const double turns = (double)pos * inv_turns(j);
        const double fr = turns - floor(turns);
        f32x2 cs; cs[0] = cos2pi((float)fr); cs[1] = sin2pi((float)fr);
        rot[i] = cs;
    }
    const int lane = threadIdx.x & 63, wave = threadIdx.x >> 6;
    bf16_t* H = (bf16_t*)(p.ws + WS_H);
    for (int r = blockIdx.x * NW + wave; r < S; r += gridDim.x * NW) {
        f32x4 v[RJ]; row_load(p.x + (size_t)r * D, v, lane);
        const float ri = row_rinv(v);
#pragma unroll
        for (int j = 0; j < RJ; ++j) {
            const f32x4 g = *(const f32x4*)(p.norm_mix + 256 * j + lane * 4);
            u32x2 o; o[0] = pk2(v[j][0] * ri * g[0], v[j][1] * ri * g[1]); o[1] = pk2(v[j][2] * ri * g[2], v[j][3] * ri * g[3]);
            *(u32x2*)(H + (size_t)r * D + 256 * j + lane * 4) = o;
        }
    }
}

constexpr int GTM = 64, GTN = 128, GKC = 32, CTP = GTN + 4;
constexpr int GEMM_LDS_FLOATS = GTM * (GKC + 1) + 2 * GKC * GTN + 2 * GTM * CTP;
struct RowSrc { const bf16_t* A; int lda; const int* map; int shift; int m0; int mvalid; };
template <int NB>
__device__ __forceinline__ void gemm_tile_naive(const RowSrc rs, const float* B0, const float* B1, int ldb, int nvalid, int K, int n0, float* lds) {
    float* As = lds; float* Bs = As + GTM * (GKC + 1); float* Ct = Bs + 2 * GKC * GTN;
    const int tid = threadIdx.x, ty = tid >> 5, tx = tid & 31;
    float acc[NB][4][4];
#pragma unroll
    for (int b = 0; b < NB; ++b)
#pragma unroll
        for (int i = 0; i < 4; ++i)
#pragma unroll
            for (int j = 0; j < 4; ++j) acc[b][i][j] = 0.f;
    for (int k0 = 0; k0 < K; k0 += GKC) {
        __syncthreads();
#pragma unroll
        for (int i = 0; i < GTM * GKC / NT; ++i) {
            const int idx = tid + i * NT, r = idx / GKC, kk = idx % GKC;
            float v = 0.f;
            if (r < rs.mvalid) { const int sr = rs.map ? (rs.map[r] >> rs.shift) : (rs.m0 + r); v = bf2f(rs.A[(size_t)sr * rs.lda + k0 + kk]); }
            As[r * (GKC + 1) + kk] = v;
        }
#pragma unroll
        for (int b = 0; b < NB; ++b) {
            const float* B = b ? B1 : B0;
#pragma unroll
            for (int i = 0; i < GKC * GTN / NT; ++i) {
                const int idx = tid + i * NT, kk = idx / GTN, c = idx % GTN;
                Bs[b * GKC * GTN + kk * GTN + c] = (n0 + c < nvalid) ? B[(size_t)(k0 + kk) * ldb + n0 + c] : 0.f;
            }
        }
        __syncthreads();
#pragma unroll 4
        for (int kk = 0; kk < GKC; ++kk) {
            float a[4];
#pragma unroll
            for (int i = 0; i < 4; ++i) a[i] = As[(ty * 4 + i) * (GKC + 1) + kk];
#pragma unroll
            for (int b = 0; b < NB; ++b) {
                const f32x4 bv = *(const f32x4*)(Bs + b * GKC * GTN + kk * GTN + tx * 4);
#pragma unroll
                for (int i = 0; i < 4; ++i)
#pragma unroll
                    for (int j = 0; j < 4; ++j) acc[b][i][j] += a[i] * bv[j];
            }
        }
    }
#pragma unroll
    for (int b = 0; b < NB; ++b)
#pragma unroll
        for (int i = 0; i < 4; ++i)
#pragma unroll
            for (int j = 0; j < 4; ++j) Ct[b * GTM * CTP + (ty * 4 + i) * CTP + tx * 4 + j] = acc[b][i][j];
    __syncthreads();
}

__device__ __forceinline__ void phase_inproj(const Params& p, int l, float* lds) {
    const bf16_t* H = (const bf16_t*)(p.ws + WS_H);
    bf16_t* P = (bf16_t*)(p.ws + WS_PROJ);
    float* LOGF = (float*)(p.ws + WS_LOGF);
    const f32x2* rot = (const f32x2*)(p.ws + WS_ROT);
    const float* W = p.w_in + (size_t)l * D * IN_W;
    const float* bfg = p.b_forget + l * NFOX;
    constexpr int NTM = S / GTM, NTN = PW / GTN;
    const float* Ct = lds + GTM * (GKC + 1) + 2 * GKC * GTN;
    for (int it = blockIdx.x; it < NTM * NTN; it += gridDim.x) {
        const int tm = it / NTN, tn = it % NTN, m0 = tm * GTM, n0 = tn * GTN;
        RowSrc rs{H, D, nullptr, 0, m0, GTM};
        gemm_tile_naive<1>(rs, W, nullptr, IN_W, IN_W, D, n0, lds);
        for (int idx = threadIdx.x; idx < GTM * GTN; idx += NT) {
            const int r = idx / GTN, c = idx % GTN, gc = n0 + c, row = m0 + r;
            float v = Ct[r * CTP + c];
            if (gc >= IN_W) continue;
            if (gc >= OFL) { LOGF[(size_t)row * 8 + (gc - OFL)] = log_sigmoid(v + bfg[gc - OFL]); continue; }
            if (gc < OVR) {
                const int d = gc & 63, j = d & 31;
                const float partner = Ct[r * CTP + (c ^ 32)];
                const f32x2 cs = rot[(size_t)row * 32 + j];
                v = (d < 32) ? (v * cs[0] - partner * cs[1]) : (partner * cs[1] + v * cs[0]);
                if (gc < OKR) v *= 0.125f;
            } else if (gc >= OGR && gc < OQS) v = silu(v);
            else if ((gc >= OQS && gc < OKS) || (gc >= OQF && gc < OKF)) v *= 0.125f;
            P[(size_t)row * PW + gc] = f2bf(v);
        }
    }
}

__device__ __forceinline__ float ret_log_gamma(int h) { return logf(1.0f - exp2f(-5.0f - (float)h)); }
__device__ __forceinline__ void phase_prep(const Params& p, int l, float* lds) {
    const bf16_t* P = (const bf16_t*)(p.ws + WS_PROJ);
    float* U = (float*)(p.ws + WS_U);
    unsigned* ctl = (unsigned*)(p.ws + WS_CTL);
    float* Ks = lds; float* Vs = lds + 4096;
    const int tid = threadIdx.x;
    constexpr int NU = NRET * NCHUNK;
    constexpr int NKM = S * NFOX / NT;
    for (int it = blockIdx.x; it < NU + NKM; it += gridDim.x) {
        if (it < NU) {
            const int h = it / NCHUNK, n = it % NCHUNK;
            const float lg = ret_log_gamma(h);
            __syncthreads();
            for (int idx = tid; idx < 4096; idx += NT) {
                const int k = idx >> 6, d = idx & 63; const size_t row = (size_t)(n * CH + k) * PW;
                Ks[idx] = bf2f(P[row + OKR + h * HD + d]) * expf(lg * (float)(CH - 1 - k));
                Vs[idx] = bf2f(P[row + OVR + h * HD + d]);
            }
            __syncthreads();
            const int d = tid >> 3, e0 = (tid & 7) * 8;
            float acc[8];
#pragma unroll
            for (int j = 0; j < 8; ++j) acc[j] = 0.f;
            for (int k = 0; k < CH; ++k) {
                const float kv = Ks[k * 64 + d];
#pragma unroll
                for (int j = 0; j < 8; ++j) acc[j] += kv * Vs[k * 64 + e0 + j];
            }
            float* dst = U + ((size_t)(h * NCHUNK + n) * 64 + d) * 64 + e0;
#pragma unroll
            for (int j = 0; j < 8; ++j) dst[j] = acc[j];
        } else {
            const int pi = (it - NU) * NT + tid, row = pi / NFOX, h = pi % NFOX;
            const bf16_t* kp = P + (size_t)row * PW + OKF + h * HD;
            float s = 0.f;
            for (int d = 0; d < HD; ++d) { const float v = bf2f(kp[d]); s += v * v; }
            atomicMax(ctl + CTL_KMAX + l * 8 + h, f2u(s));
        }
    }
}

constexpr int QB = 128, NQB = S / QB;
__device__ __forceinline__ void ret_scan_item(const Params& p, int item) {
    const float* U = (const float*)(p.ws + WS_U);
    float* SP = (float*)(p.ws + WS_SP);
    const int e = item * NT + threadIdx.x;
    const int h = e >> 12, de = e & 4095;
    const float c = expf(ret_log_gamma(h) * (float)CH);
    float st = 0.f;
    const size_t base = (size_t)h * NCHUNK * 4096 + de;
#pragma unroll 8
    for (int n = 0; n < NCHUNK; ++n) { const float u = U[base + (size_t)n * 4096]; SP[base + (size_t)n * 4096] = st; st = st * c + u; }
}
__device__ __forceinline__ void sb_item(const Params& p, int l, int h, int qb, float* lds) {
    const bf16_t* P = (const bf16_t*)(p.ws + WS_PROJ);
    bf16_t* MG = (bf16_t*)(p.ws + WS_MERGED);
    float* Ks = lds; float* Vs = lds + 4096; volatile unsigned* red = (volatile unsigned*)(lds + 8192);
    const int tid = threadIdx.x, r = tid >> 2, part = tid & 3, t = qb * QB + r;
    float q[16], o[16];
    { const bf16_t* qp = P + (size_t)t * PW + OQS + h * HD + part * 16;
#pragma unroll
      for (int j = 0; j < 16; ++j) { q[j] = bf2f(qp[j]); o[j] = 0.f; } }
    float carry = 0.f;
    for (int kt = (qb * QB + QB - 1) / 64; kt >= 0; --kt) {
        __syncthreads();
        for (int idx = tid; idx < 4096; idx += NT) {
            const int k = idx >> 6, d = idx & 63; const size_t row = (size_t)(kt * 64 + k) * PW;
            Ks[idx] = bf2f(P[row + OKS + h * HD + d]); Vs[idx] = bf2f(P[row + OVS + h * HD + d]);
        }
        __syncthreads();
        for (int sl = 63; sl >= 0; --sl) {
            const int s = kt * 64 + sl;
            float z = 0.f;
#pragma unroll
            for (int j = 0; j < 16; ++j) z += q[j] * Ks[sl * 64 + part * 16 + j];
            z += __shfl_xor(z, 1); z += __shfl_xor(z, 2);
            if (s < t) {
                const float lb = log_sigmoid(z);
                const float a = expf(lb + carry);
                carry += lb - z;
#pragma unroll
                for (int j = 0; j < 16; ++j) o[j] += a * Vs[sl * 64 + part * 16 + j];
            }
        }
        if (block_all(carry < -EXIT_T, red)) break;
    }
    float ss = 0.f;
#pragma unroll
    for (int j = 0; j < 16; ++j) ss += o[j] * o[j];
    ss += __shfl_xor(ss, 1); ss += __shfl_xor(ss, 2);
    const float ri = 1.0f / sqrtf(ss * (1.0f / HD) + EPS);
    const float* g = p.g_sb + l * WSB + h * HD + part * 16;
    bf16_t* dst = MG + (size_t)t * MIXW + WRET + h * HD + part * 16;
#pragma unroll
    for (int j = 0; j < 16; ++j) dst[j] = f2bf(o[j] * ri * g[j]);
}
__device__ __forceinline__ void fox_item(const Params& p, int l, int h, int qb, float* lds) {
    const bf16_t* P = (const bf16_t*)(p.ws + WS_PROJ);
    const float* LOGF = (const float*)(p.ws + WS_LOGF);
    const unsigned* ctl = (const unsigned*)(p.ws + WS_CTL);
    bf16_t* MG = (bf16_t*)(p.ws + WS_MERGED);
    float* Ks = lds; float* Vs = lds + 4096; volatile unsigned* red = (volatile unsigned*)(lds + 8192);
    float* Fr = lds + 8192 + 64;
    float* Lf = Fr + 64;
    float* Fq = Lf + 64;
    const int tid = threadIdx.x, r = tid >> 2, part = tid & 3, t = qb * QB + r;
    const int tlast = qb * QB + QB - 1;
    float q[16], o[16];
    float qq = 0.f;
    { const bf16_t* qp = P + (size_t)t * PW + OQF + h * HD + part * 16;
#pragma unroll
      for (int j = 0; j < 16; ++j) { q[j] = bf2f(qp[j]); o[j] = 0.f; qq += q[j] * q[j]; } }
    qq += __shfl_xor(qq, 1); qq += __shfl_xor(qq, 2);
    const float kmax = sqrtf(u2f(ctl[CTL_KMAX + l * 8 + h]));
    const float Bt = sqrtf(qq) * kmax * 1.0001f + 1e-6f;
    float m = -1e30f, lsum = 0.f;
    float Fc = 0.f;
    float fq = 0.f;
    for (int kt = tlast / 64; kt >= 0; --kt) {
        __syncthreads();
        for (int idx = tid; idx < 4096; idx += NT) {
            const int k = idx >> 6, d = idx & 63; const size_t row = (size_t)(kt * 64 + k) * PW;
            Ks[idx] = bf2f(P[row + OKF + h * HD + d]); Vs[idx] = bf2f(P[row + OVF + h * HD + d]);
        }
        if (tid < 64) Lf[tid] = -LOGF[(size_t)(kt * 64 + tid) * 8 + h];
        __syncthreads();
        if (tid < 64) { float a = Fc; for (int j = 63; j > tid; --j) a += Lf[j]; Fr[tid] = a; }
        __syncthreads();
        if (kt * 64 + 63 >= qb * QB) {
            if (part == 0 && (t >> 6) == kt) Fq[r] = Fr[t & 63];
            __syncthreads();
            if ((t >> 6) == kt) fq = Fq[r];
        }
        for (int sl = 63; sl >= 0; --sl) {
            const int s = kt * 64 + sl;
            float z = 0.f;
#pragma unroll
            for (int j = 0; j < 16; ++j) z += q[j] * Ks[sl * 64 + part * 16 + j];
            z += __shfl_xor(z, 1); z += __shfl_xor(z, 2);
            if (s <= t) {
                const float lg = z + fq - Fr[sl];
                if (lg > m) { const float f = expf(m - lg); lsum *= f;
#pragma unroll
                    for (int j = 0; j < 16; ++j) o[j] *= f;
                    m = lg; }
                const float pr = expf(lg - m);
                lsum += pr;
#pragma unroll
                for (int j = 0; j < 16; ++j) o[j] += pr * Vs[sl * 64 + part * 16 + j];
            }
        }
        const float Fnext = Fr[0] + Lf[0];
        __syncthreads();
        Fc = Fnext;
        const bool done = (kt * 64 <= t) && (Bt + fq - Fnext - m + logf((float)(kt * 64 + 1)) < -EXIT_T);
        if (block_all(done, red)) break;
    }
    const float il = 1.0f / lsum;
    float ss = 0.f;
#pragma unroll
    for (int j = 0; j < 16; ++j) { o[j] *= il; ss += o[j] * o[j]; }
    ss += __shfl_xor(ss, 1); ss += __shfl_xor(ss, 2);
    const float ri = 1.0f / sqrtf(ss * (1.0f / HD) + EPS);
    const float* g = p.g_fox + l * WFOX + h * HD + part * 16;
    bf16_t* dst = MG + (size_t)t * MIXW + WRET + WSB + h * HD + part * 16;
#pragma unroll
    for (int j = 0; j < 16; ++j) dst[j] = f2bf(o[j] * ri * g[j]);
}
__device__ __forceinline__ void phase_mix(const Params& p, int l, float* lds) {
    constexpr int NSCAN = NRET * 4096 / NT, NSBI = NSB * NQB, NFXI = NFOX * NQB;
    for (int it = blockIdx.x; it < NSCAN + NSBI + NFXI; it += gridDim.x) {
        if (it < NSCAN) ret_scan_item(p, it);
        else if (it < NSCAN + NSBI) { const int j = it - NSCAN; sb_item(p, l, j / NQB, NQB - 1 - (j % NQB), lds); }
        else { const int j = it - NSCAN - NSBI; fox_item(p, l, j / NQB, NQB - 1 - (j % NQB), lds); }
    }
}

__device__ __forceinline__ void phase_retout(const Params& p, int l, float* lds) {
    const bf16_t* P = (const bf16_t*)(p.ws + WS_PROJ);
    const float* SP = (const float*)(p.ws + WS_SP);
    bf16_t* MG = (bf16_t*)(p.ws + WS_MERGED);
    float* Qs = lds; float* Ks = lds + 4096; float* Vs = lds + 8192; float* Ss = lds + 12288; float* Sc = lds + 16384;
    const int tid = threadIdx.x, c = tid >> 3, part = tid & 7;
    for (int it = blockIdx.x; it < NRET * NCHUNK; it += gridDim.x) {
        const int h = it / NCHUNK, n = it % NCHUNK;
        const float lg = ret_log_gamma(h);
        __syncthreads();
        for (int idx = tid; idx < 4096; idx += NT) {
            const int k = idx >> 6, d = idx & 63; const size_t row = (size_t)(n * CH + k) * PW;
            Qs[idx] = bf2f(P[row + OQR + h * HD + d]); Ks[idx] = bf2f(P[row + OKR + h * HD + d]); Vs[idx] = bf2f(P[row + OVR + h * HD + d]);
            Ss[idx] = SP[(size_t)(h * NCHUNK + n) * 4096 + idx];
        }
        __syncthreads();
        float o[8];
#pragma unroll
        for (int j = 0; j < 8; ++j) o[j] = 0.f;
#pragma unroll 2
        for (int d = 0; d < 64; ++d) { const float qv = Qs[c * 64 + d];
#pragma unroll
            for (int j = 0; j < 8; ++j) o[j] += qv * Ks[(part * 8 + j) * 64 + d]; }
#pragma unroll
        for (int j = 0; j < 8; ++j) { const int k = part * 8 + j; Sc[c * 64 + k] = o[j] * expf(lg * fabsf((float)(c - k))); o[j] = 0.f; }
        __syncthreads();
#pragma unroll 2
        for (int k = 0; k < 64; ++k) { const float s = Sc[c * 64 + k];
#pragma unroll
            for (int j = 0; j < 8; ++j) o[j] += s * Vs[k * 64 + part * 8 + j]; }
        const float qd = expf(lg * (float)(c + 1));
#pragma unroll 2
        for (int d = 0; d < 64; ++d) { const float qv = Qs[c * 64 + d] * qd;
#pragma unroll
            for (int j = 0; j < 8; ++j) o[j] += qv * Ss[d * 64 + part * 8 + j]; }
        float sm = 0.f;
#pragma unroll
        for (int j = 0; j < 8; ++j) sm += o[j];
        sm += __shfl_xor(sm, 1); sm += __shfl_xor(sm, 2); sm += __shfl_xor(sm, 4);
        const float mu = sm * (1.0f / HD);
        float vs = 0.f;
#pragma unroll
        for (int j = 0; j < 8; ++j) { o[j] -= mu; vs += o[j] * o[j]; }
        vs += __shfl_xor(vs, 1); vs += __shfl_xor(vs, 2); vs += __shfl_xor(vs, 4);
        const float ri = 1.0f / sqrtf(vs * (1.0f / HD) + EPS);
        const int row = n * CH + c;
        const float* g = p.g_ret + l * WRET + h * HD + part * 8;
        const bf16_t* gate = P + (size_t)row * PW + OGR + h * HD + part * 8;
        bf16_t* dst = MG + (size_t)row * MIXW + h * HD + part * 8;
#pragma unroll
        for (int j = 0; j < 8; ++j) dst[j] = f2bf(o[j] * ri * g[j] * bf2f(gate[j]));
    }
}

__device__ __forceinline__ void phase_outproj(const Params& p, int l, float* lds) {
    const bf16_t* MG = (const bf16_t*)(p.ws + WS_MERGED);
    float* X = (float*)(p.ws + WS_X);
    const float* xin = l == 0 ? p.x : X;
    const float* W = p.w_out + (size_t)l * MIXW * D;
    constexpr int NTM = S / GTM, NTN = D / GTN;
    const float* Ct = lds + GTM * (GKC + 1) + 2 * GKC * GTN;
    for (int it = blockIdx.x; it < NTM * NTN; it += gridDim.x) {
        const int tm = it / NTN, tn = it % NTN, m0 = tm * GTM, n0 = tn * GTN;
        RowSrc rs{MG, MIXW, nullptr, 0, m0, GTM};
        gemm_tile_naive<1>(rs, W, nullptr, D, D, MIXW, n0, lds);
        for (int idx = threadIdx.x; idx < GTM * GTN; idx += NT) {
            const int r = idx / GTN, c = idx % GTN; const size_t o = (size_t)(m0 + r) * D + n0 + c;
            X[o] = xin[o] + Ct[r * CTP + c];
        }
    }
}

__device__ __forceinline__ void phase_route(const Params& p, int l, float* lds) {
    const float* X = (const float*)(p.ws + WS_X);
    bf16_t* H = (bf16_t*)(p.ws + WS_H);
    unsigned* ctl = (unsigned*)(p.ws + WS_CTL);
    int* LIST = (int*)(p.ws + WS_LIST);
    float* GATE = (float*)(p.ws + WS_GATE);
    const float* gn = p.norm_ffn + l * D;
    const float* wg = p.w_group + (size_t)l * D * NG; const float* wr = p.w_router + (size_t)l * D * NE;
    const float* bg = p.b_group + l * NG; const float* br = p.b_router + l * NE;
    const int lane = threadIdx.x & 63, wave = threadIdx.x >> 6;
    for (int r = blockIdx.x * NW + wave; r < S; r += gridDim.x * NW) {
        f32x4 v[RJ]; row_load(X + (size_t)r * D, v, lane);
        const float ri = row_rinv(v);
#pragma unroll
        for (int j = 0; j < RJ; ++j) {
            const f32x4 g = *(const f32x4*)(gn + 256 * j + lane * 4);
            v[j] = v[j] * ri * g;
            u32x2 o; o[0] = pk2(v[j][0], v[j][1]); o[1] = pk2(v[j][2], v[j][3]);
            *(u32x2*)(H + (size_t)r * D + 256 * j + lane * 4) = o;
        }
        float* lgt = lds + wave * 64;
#pragma unroll 1
        for (int e = 0; e < NROUTE; ++e) {
            const float* wcol = e < NG ? wg + e : wr + (e - NG); const int ldw = e < NG ? NG : NE;
            float s = 0.f;
#pragma unroll
            for (int j = 0; j < RJ; ++j)
#pragma unroll
                for (int i = 0; i < 4; ++i) { const int c = 256 * j + lane * 4 + i; s += v[j][i] * wcol[(size_t)c * ldw]; }
            s = wave_sum(s);
            if (lane == 0) lgt[e] = s + (e < NG ? bg[e] : br[e - NG]);
        }
        if (lane == 0) {
            int grp = 0; float gm = lgt[0];
#pragma unroll
            for (int g = 1; g < NG; ++g) if (lgt[g] > gm) { gm = lgt[g]; grp = g; }
            float den = 0.f;
#pragma unroll
            for (int g = 0; g < NG; ++g) den += expf(lgt[g] - gm);
            const float pg = 1.0f / den;
            int i1 = 0; float v1 = -INFINITY; int i2 = 0; float v2 = -INFINITY;
#pragma unroll
            for (int g = 0; g < NG; ++g)
#pragma unroll
                for (int e = 0; e < EPG; ++e) if (g == grp) { const float x = lgt[NG + g * EPG + e];
                    if (x > v1) { v2 = v1; i2 = i1; v1 = x; i1 = e; } else if (x > v2) { v2 = x; i2 = e; } }
            const float e2 = expf(v2 - v1), g1 = pg / (1.f + e2), g2 = pg * e2 / (1.f + e2);
            const int ea = grp * EPG + i1, eb = grp * EPG + i2;
            GATE[(size_t)r * 2] = g1; GATE[(size_t)r * 2 + 1] = g2;
            const unsigned sa = atomicAdd(ctl + CTL_CNT + l * NE + ea, 1u); LIST[(size_t)ea * S + sa] = r * 2;
            const unsigned sb = atomicAdd(ctl + CTL_CNT + l * NE + eb, 1u); LIST[(size_t)eb * S + sb] = r * 2 + 1;
        }
    }
}

__device__ __forceinline__ bool moe_item(const unsigned* cnt, int it, int ntn, int& e, int& rt, int& tn) {
    int tile = it / ntn; tn = it % ntn;
    for (e = 0; e < NE; ++e) { const int nt = ((int)cnt[e] + GTM - 1) / GTM; if (tile < nt) { rt = tile; return true; } tile -= nt; }
    return false;
}
__device__ __forceinline__ void phase_moe1(const Params& p, int l, float* lds) {
    const bf16_t* H = (const bf16_t*)(p.ws + WS_H);
    bf16_t* HID = (bf16_t*)(p.ws + WS_HID);
    const unsigned* cnt = (const unsigned*)(p.ws + WS_CTL) + CTL_CNT + l * NE;
    const int* LIST = (const int*)(p.ws + WS_LIST);
    const float* Ct = lds + GTM * (GKC + 1) + 2 * GKC * GTN;
    constexpr int NTN = DE / GTN;
    for (int it = blockIdx.x;; it += gridDim.x) {
        int e, rt, tn; if (!moe_item(cnt, it, NTN, e, rt, tn)) break;
        const int mvalid = imin(GTM, (int)cnt[e] - rt * GTM), n0 = tn * GTN;
        const int* map = LIST + (size_t)e * S + rt * GTM;
        RowSrc rs{H, D, map, 1, 0, mvalid};
        gemm_tile_naive<2>(rs, p.w_gate + ((size_t)l * NE + e) * D * DE, p.w_up + ((size_t)l * NE + e) * D * DE, DE, DE, D, n0, lds);
        for (int idx = threadIdx.x; idx < GTM * GTN; idx += NT) {
            const int r = idx / GTN, c = idx % GTN; if (r >= mvalid) continue;
            HID[(size_t)map[r] * DE + n0 + c] = f2bf(silu(Ct[r * CTP + c]) * Ct[GTM * CTP + r * CTP + c]);
        }
    }
}
__device__ __forceinline__ void phase_moe2(const Params& p, int l, float* lds) {
    const bf16_t* HID = (const bf16_t*)(p.ws + WS_HID);
    bf16_t* Y = (bf16_t*)(p.ws + WS_Y);
    const unsigned* cnt = (const unsigned*)(p.ws + WS_CTL) + CTL_CNT + l * NE;
    const int* LIST = (const int*)(p.ws + WS_LIST);
    const float* GATE = (const float*)(p.ws + WS_GATE);
    const float* Ct = lds + GTM * (GKC + 1) + 2 * GKC * GTN;
    constexpr int NTN = D / GTN;
    for (int it = blockIdx.x;; it += gridDim.x) {
        int e, rt, tn; if (!moe_item(cnt, it, NTN, e, rt, tn)) break;
        const int mvalid = imin(GTM, (int)cnt[e] - rt * GTM), n0 = tn * GTN;
        const int* map = LIST + (size_t)e * S + rt * GTM;
        RowSrc rs{HID, DE, map, 0, 0, mvalid};
        gemm_tile_naive<1>(rs, p.w_down + ((size_t)l * NE + e) * DE * D, nullptr, D, D, DE, n0, lds);
        for (int idx = threadIdx.x; idx < GTM * GTN; idx += NT) {
            const int r = idx / GTN, c = idx % GTN; if (r >= mvalid) continue;
            const int a = map[r];
            Y[(size_t)a * D + n0 + c] = f2bf(Ct[r * CTP + c] * GATE[a]);
        }
    }
}

__device__ __forceinline__ void phase_combine(const Params& p, int l) {
    float* X = (float*)(p.ws + WS_X);
    const bf16_t* Y = (const bf16_t*)(p.ws + WS_Y);
    bf16_t* H = (bf16_t*)(p.ws + WS_H);
    const bool last = (l == DEPTH - 1);
    const float* gn = last ? p.norm_final : p.norm_mix + (l + 1) * D;
    const int lane = threadIdx.x & 63, wave = threadIdx.x >> 6;
    for (int r = blockIdx.x * NW + wave; r < S; r += gridDim.x * NW) {
        f32x4 v[RJ]; row_load(X + (size_t)r * D, v, lane);
#pragma unroll
        for (int j = 0; j < RJ; ++j) {
            const u32x2 a = *(const u32x2*)(Y + (size_t)(2 * r) * D + 256 * j + lane * 4), b = *(const u32x2*)(Y + (size_t)(2 * r + 1) * D + 256 * j + lane * 4);
            v[j][0] += u2f(a[0] << 16) + u2f(b[0] << 16); v[j][1] += u2f(a[0] & 0xffff0000u) + u2f(b[0] & 0xffff0000u);
            v[j][2] += u2f(a[1] << 16) + u2f(b[1] << 16); v[j][3] += u2f(a[1] & 0xffff0000u) + u2f(b[1] & 0xffff0000u);
        }
        const float ri = row_rinv(v);
#pragma unroll
        for (int j = 0; j < RJ; ++j) {
            const f32x4 g = *(const f32x4*)(gn + 256 * j + lane * 4);
            if (last) *(f32x4*)(p.out + (size_t)r * D + 256 * j + lane * 4) = v[j] * ri * g;
            else {
                *(f32x4*)(X + (size_t)r * D + 256 * j + lane * 4) = v[j];
                u32x2 o; o[0] = pk2(v[j][0] * ri * g[0], v[j][1] * ri * g[1]); o[1] = pk2(v[j][2] * ri * g[2], v[j][3] * ri * g[3]);
                *(u32x2*)(H + (size_t)r * D + 256 * j + lane * 4) = o;
            }
        }
    }
}

constexpr int PH_PER_LAYER = 9, NPHASE = 1 + DEPTH * PH_PER_LAYER;
constexpr int LDS_FLOATS = GEMM_LDS_FLOATS > 20480 ? GEMM_LDS_FLOATS : 20480;
constexpr int LDS_BYTES = LDS_FLOATS * 4;

__device__ __forceinline__ void run_phase(const Params& p, int ph, float* lds) {
    if (ph == 0) { phase_init(p); return; }
    const int l = (ph - 1) / PH_PER_LAYER, q = (ph - 1) % PH_PER_LAYER;
    switch (q) {
        case 0: phase_inproj(p, l, lds); break;
        case 1: phase_prep(p, l, lds); break;
        case 2: phase_mix(p, l, lds); break;
        case 3: phase_retout(p, l, lds); break;
        case 4: phase_outproj(p, l, lds); break;
        case 5: phase_route(p, l, lds); break;
        case 6: phase_moe1(p, l, lds); break;
        case 7: phase_moe2(p, l, lds); break;
        default: phase_combine(p, l); break;
    }
}

#ifndef CPU_EMU
__global__ void __launch_bounds__(NT) fwd_kernel(Params p, int ph_lo, int ph_hi) {
    extern __shared__ __attribute__((aligned(16))) float lds[];
    cg::grid_group grid = cg::this_grid();
#define PHASE(k, call) do { if (ph_lo <= (k) && (k) < ph_hi) { call; if ((k) + 1 < ph_hi) grid.sync(); } } while (0)
#define LAYER(l) do { const int b_ = 1 + (l) * PH_PER_LAYER; \
        PHASE(b_ + 0, phase_inproj(p, l, lds)); PHASE(b_ + 1, phase_prep(p, l, lds)); PHASE(b_ + 2, phase_mix(p, l, lds)); \
        PHASE(b_ + 3, phase_retout(p, l, lds)); PHASE(b_ + 4, phase_outproj(p, l, lds)); PHASE(b_ + 5, phase_route(p, l, lds)); \
        PHASE(b_ + 6, phase_moe1(p, l, lds)); PHASE(b_ + 7, phase_moe2(p, l, lds)); PHASE(b_ + 8, phase_combine(p, l)); } while (0)
    PHASE(0, phase_init(p));
    LAYER(0);
    LAYER(1);
    static_assert(DEPTH == 2, "phase program written for two layers");
#undef LAYER
#undef PHASE
}

#ifndef N_LAUNCH_PER_PHASE
#define N_LAUNCH_PER_PHASE 0
#endif
extern "C" void kernel_launch(void* const* d_in, const int* in_sizes, int n_in, void* d_out, int out_size, void* d_ws, size_t ws_size, hipStream_t stream) {
    static int grid = 0;
    if (grid == 0) {
        if (ws_size < WS_END) { fprintf(stderr, "kernel_launch: workspace too small (%zu < %zu)\n", ws_size, (size_t)WS_END); grid = -1; return; }
        int dev = 0, cus = 0, per_cu = 0;
        hipGetDevice(&dev);
        hipDeviceGetAttribute(&cus, hipDeviceAttributeMultiprocessorCount, dev);
        hipFuncSetAttribute((const void*)fwd_kernel, hipFuncAttributeMaxDynamicSharedMemorySize, LDS_BYTES);
        hipOccupancyMaxActiveBlocksPerMultiprocessor(&per_cu, (const void*)fwd_kernel, NT, LDS_BYTES);
        if (per_cu < 1) { fprintf(stderr, "kernel_launch: occupancy query says %d blocks per CU\n", per_cu); grid = -1; return; }
        grid = cus;
    }
    if (grid < 0) return;
    Params p{};
    p.x = (const float*)d_in[0]; p.norm_mix = (const float*)d_in[1]; p.w_in = (const float*)d_in[2]; p.b_forget = (const float*)d_in[3];
    p.g_ret = (const float*)d_in[4]; p.g_sb = (const float*)d_in[5]; p.g_fox = (const float*)d_in[6]; p.w_out = (const float*)d_in[7];
    p.norm_ffn = (const float*)d_in[8]; p.w_group = (const float*)d_in[9]; p.b_group = (const float*)d_in[10]; p.w_router = (const float*)d_in[11];
    p.b_router = (const float*)d_in[12]; p.w_gate = (const float*)d_in[13]; p.w_up = (const float*)d_in[14]; p.w_down = (const float*)d_in[15];
    p.norm_final = (const float*)d_in[16]; p.out = (float*)d_out; p.ws = (unsigned char*)d_ws;
#if N_LAUNCH_PER_PHASE
    for (int ph = 0; ph < NPHASE; ++ph) {
        int lo = ph, hi = ph + 1; void* args[] = {&p, &lo, &hi};
        hipLaunchCooperativeKernel((const void*)fwd_kernel, dim3(grid), dim3(NT), args, LDS_BYTES, stream);
    }
#else
    int lo = 0, hi = NPHASE; void* args[] = {&p, &lo, &hi};
    hipError_t e = hipLaunchCooperativeKernel((const void*)fwd_kernel, dim3(grid), dim3(NT), args, LDS_BYTES, stream);
    if (e != hipSuccess) fprintf(stderr, "cooperative launch failed: %s (grid %d)\n", hipGetErrorString(e), grid);
#endif
}
#endif
```

```cpp
#ifndef CPU_EMU
#include <hip/hip_runtime.h>
#include <hip/hip_cooperative_groups.h>
#include <cstdio>
#include <cstdint>
#include <cmath>
namespace cg = cooperative_groups;
#define VEC(T, N) T __attribute__((ext_vector_type(N)))
__device__ __forceinline__ void wave_barrier() { __builtin_amdgcn_wave_barrier(); }
__device__ __forceinline__ float sin2pi(float x) { return __builtin_amdgcn_sinf(x); }
__device__ __forceinline__ float cos2pi(float x) { return __builtin_amdgcn_cosf(x); }
__device__ __forceinline__ unsigned long long ballot64(bool p) { return __ballot(p); }
#define LAS __attribute__((address_space(3)))
typedef VEC(short, 8) bf16x8;
typedef VEC(float, 4) f32x4_;
__device__ __forceinline__ void glds16(const void* g, LAS unsigned char* l) { __builtin_amdgcn_global_load_lds((const unsigned*)g, (LAS unsigned*)l, 16, 0, 0); }
__device__ __forceinline__ void vm_wait0() { asm volatile("s_waitcnt vmcnt(0)" ::: "memory"); }
__device__ __forceinline__ void lds_wait0() { asm volatile("s_waitcnt lgkmcnt(0)" ::: "memory"); }
__device__ __forceinline__ void sched_fence() { __builtin_amdgcn_sched_barrier(0); }
__device__ __forceinline__ f32x4_ mfma16(bf16x8 a, bf16x8 b, f32x4_ c) { return __builtin_amdgcn_mfma_f32_16x16x32_bf16(a, b, c, 0, 0, 0); }
#else
#define VEC(T, N) T __attribute__((vector_size(sizeof(T) * N)))
inline float sin2pi(float x) { return (float)sin(6.283185307179586 * (double)x); }
inline float cos2pi(float x) { return (float)cos(6.283185307179586 * (double)x); }
inline unsigned long long ballot64(bool p) { return emu_ballot(p); }
#define LAS
typedef VEC(short, 8) bf16x8;
inline void glds16(const void* g, unsigned char* l) { memcpy(l + (threadIdx.x & 63) * 16, g, 16); }
inline void vm_wait0() {}
inline void lds_wait0() {}
inline void sched_fence() {}
inline emu_f32x4 mfma16(bf16x8 a, bf16x8 b, emu_f32x4 c) { return emu_mfma16(a, b, c); }
#endif

typedef unsigned short bf16_t;
typedef VEC(float, 4) f32x4;
typedef VEC(float, 2) f32x2;
typedef VEC(unsigned, 2) u32x2;
typedef VEC(unsigned, 4) u32x4;
typedef LAS unsigned char lds_u8;

#ifdef SMALL_CFG
constexpr int D = 256, S = 512, DEPTH = 2, NRET = 2, NSB = 1, NFOX = 1, NG = 2, EPG = 4, DE = 128;
#else
constexpr int D = 1024, S = 16384, DEPTH = 2, NRET = 6, NSB = 5, NFOX = 5, NG = 4, EPG = 8, DE = 512;
#endif
constexpr int CH = 64, HD = 64, NE = NG * EPG;
constexpr int WRET = NRET * HD, WSB = NSB * HD, WFOX = NFOX * HD, MIXW = WRET + WSB + WFOX;
constexpr int IN_W = 4 * WRET + 3 * WSB + 3 * WFOX + NFOX;
constexpr int PW = (IN_W + 255) / 256 * 256;
constexpr int OQR = 0, OKR = WRET, OVR = 2 * WRET, OGR = 3 * WRET, OQS = 4 * WRET, OKS = OQS + WSB, OVS = OKS + WSB;
constexpr int OQF = OVS + WSB, OKF = OQF + WFOX, OVF = OKF + WFOX, OFL = OVF + WFOX;
constexpr int NCHUNK = S / CH;
constexpr float EPS = 1e-6f;
constexpr int NT = 512, NW = NT / 64;
constexpr int NROUTE = NG + NE;
constexpr float EXIT_T = 30.0f;

constexpr size_t al256(size_t x) { return (x + 255) / 256 * 256; }
constexpr size_t WS_CTL = 0;
constexpr int CTL_CNT = 0;
constexpr int CTL_KMAX = 256;
constexpr int CTL_BAR = 1024;
constexpr int CTL_WORDS = 8192;
constexpr size_t WS_ROT = 32768;
constexpr size_t WS_X = al256(WS_ROT + (size_t)S * 32 * 8);
constexpr size_t WS_H = al256(WS_X + (size_t)S * D * 4);
constexpr size_t WS_LOGF = al256(WS_H + (size_t)S * D * 2);
constexpr size_t WS_MERGED = al256(WS_LOGF + (size_t)S * 8 * 4);
constexpr size_t WS_U = al256(WS_MERGED + (size_t)S * MIXW * 2);
constexpr size_t WS_SP = al256(WS_U + (size_t)NRET * NCHUNK * 4096 * 4);
constexpr size_t WS_LIST = al256(WS_SP + (size_t)NRET * NCHUNK * 4096 * 4);
constexpr size_t WS_GATE = al256(WS_LIST + (size_t)NE * S * 4);
constexpr size_t WS_WIN = al256(WS_GATE + (size_t)S * 2 * 4);
constexpr size_t WS_WOUT = al256(WS_WIN + (size_t)DEPTH * PW * D * 2);
constexpr size_t WS_WGU = al256(WS_WOUT + (size_t)DEPTH * D * MIXW * 2);
constexpr size_t WS_WDN = al256(WS_WGU + (size_t)DEPTH * NE * 2 * DE * D * 2);
constexpr size_t WS_PROJ = al256(WS_WDN + (size_t)DEPTH * NE * D * DE * 2);
constexpr int HID_ROWS = 2 * S + NE * 256;
constexpr size_t WS_HID = WS_PROJ;
constexpr size_t WS_Y = al256(WS_HID + (size_t)HID_ROWS * DE * 2);
constexpr size_t WS_END0 = al256(WS_PROJ + (size_t)S * PW * 2), WS_END1 = al256(WS_Y + (size_t)2 * S * D * 2);
constexpr size_t WS_END = WS_END0 > WS_END1 ? WS_END0 : WS_END1;
#ifndef SMALL_CFG
static_assert(WS_END <= (size_t)512 * 1024 * 1024, "workspace map exceeds the guaranteed 512 MiB");
#endif

struct Params {
    const float* x; const float* norm_mix; const float* w_in; const float* b_forget; const float* g_ret; const float* g_sb; const float* g_fox;
    const float* w_out; const float* norm_ffn; const float* w_group; const float* b_group; const float* w_router; const float* b_router;
    const float* w_gate; const float* w_up; const float* w_down; const float* norm_final;
    float* out; unsigned char* ws;
};

__device__ __forceinline__ int imin(int a, int b) { return a < b ? a : b; }
__device__ __forceinline__ float u2f(unsigned u) { return __builtin_bit_cast(float, u); }
__device__ __forceinline__ unsigned f2u(float f) { return __builtin_bit_cast(unsigned, f); }
__device__ __forceinline__ float bf2f(bf16_t b) { return u2f((unsigned)b << 16); }
__device__ __forceinline__ bf16_t f2bf(float f) { unsigned u = f2u(f); return (bf16_t)((u + 0x7fffu + ((u >> 16) & 1u)) >> 16); }
__device__ __forceinline__ unsigned pk2(float lo, float hi) { return (unsigned)f2bf(lo) | ((unsigned)f2bf(hi) << 16); }
__device__ __forceinline__ float log_sigmoid(float x) { return fminf(x, 0.f) - log1pf(expf(-fabsf(x))); }
__device__ __forceinline__ float silu(float x) { return x / (1.f + expf(-x)); }
__device__ __forceinline__ float wave_sum(float v) {
#pragma unroll
    for (int o = 1; o < 64; o <<= 1) v += __shfl_xor(v, o);
    return v;
}
__device__ __forceinline__ float wave_max(float v) {
#pragma unroll
    for (int o = 1; o < 64; o <<= 1) v = fmaxf(v, __shfl_xor(v, o));
    return v;
}
__device__ __forceinline__ bool block_all(bool pred, volatile unsigned* red) {
    const unsigned long long b = ballot64(pred);
    __syncthreads();
    if ((threadIdx.x & 63) == 0) red[threadIdx.x >> 6] = (b == ~0ull) ? 1u : 0u;
    __syncthreads();
    bool all = true;
    for (int w = 0; w < NW; ++w) all = all && (red[w] != 0u);
    return all;
}
__device__ __forceinline__ double inv_turns(int j) {
    static constexpr double T[32] = {
        1.59154943091895346e-01, 1.19349370211248862e-01, 8.94994016088910133e-02, 6.71150830052272551e-02, 5.03292121044870353e-02, 3.77415847174197711e-02, 2.83021958306233987e-02, 2.12236527647776604e-02,
        1.59154943091895339e-02, 1.19349370211248862e-02, 8.94994016088910237e-03, 6.71150830052272534e-03, 5.03292121044870370e-03, 3.77415847174197719e-03, 2.83021958306233987e-03, 2.12236527647776622e-03,
        1.59154943091895356e-03, 1.19349370211248849e-03, 8.94994016088910237e-04, 6.71150830052272599e-04, 5.03292121044870326e-04, 3.77415847174197741e-04, 2.83021958306233954e-04, 2.12236527647776605e-04,
        1.59154943091895351e-04, 1.19349370211248862e-04, 8.94994016088910182e-05, 6.71150830052272545e-05, 5.03292121044870354e-05, 3.77415847174197768e-05, 2.83021958306233961e-05, 2.12236527647776592e-05};
    return T[j];
}

constexpr int RJ = D / 256;
__device__ __forceinline__ void row_load(const float* row, f32x4* v, int lane) {
#pragma unroll
    for (int j = 0; j < RJ; ++j) v[j] = *(const f32x4*)(row + 256 * j + lane * 4);
}
__device__ __forceinline__ float row_rinv(const f32x4* v) {
    float s = 0.f;
#pragma unroll
    for (int j = 0; j < RJ; ++j) s += (v[j][0] * v[j][0] + v[j][1] * v[j][1]) + (v[j][2] * v[j][2] + v[j][3] * v[j][3]);
    s = wave_sum(s);
    return 1.0f / sqrtf(s * (1.0f / D) + EPS);
}

__device__ __forceinline__ void transpose_item(const float* W, int ldw, int ncols, int c0, int k0, bf16_t* WT, int ldt, int r0, float* scr, int lane) {
#pragma unroll 8
    for (int i = 0; i < 32; ++i) { const int kk = 2 * i + (lane >> 5), c = c0 + (lane & 31); scr[kk * 33 + (lane & 31)] = c < ncols ? W[(size_t)(k0 + kk) * ldw + c] : 0.f; }
    wave_barrier();
    const int ch = lane & 7;
#pragma unroll
    for (int j = 0; j < 4; ++j) { const int n = (lane >> 3) + 8 * j; const float* s = scr + (8 * ch) * 33 + n;
        u32x4 o; o[0] = pk2(s[0], s[33]); o[1] = pk2(s[2 * 33], s[3 * 33]); o[2] = pk2(s[4 * 33], s[5 * 33]); o[3] = pk2(s[6 * 33], s[7 * 33]);
        *(u32x4*)(WT + (size_t)(r0 + n) * ldt + k0 + 8 * ch) = o; }
    wave_barrier();
}
__device__ __forceinline__ void phase_init(const Params& p, float* lds) {
    unsigned* ctl = (unsigned*)(p.ws + WS_CTL);
    if (blockIdx.x == 0) for (int i = threadIdx.x; i < CTL_WORDS; i += NT) ctl[i] = 0u;
    f32x2* rot = (f32x2*)(p.ws + WS_ROT);
    for (int i = blockIdx.x * NT + threadIdx.x; i < S * 32; i += gridDim.x * NT) {
        const int pos = i >> 5, j = i & 31;
        const double turns = (double)pos * inv_turns(j);
        const double fr = turns - floor(turns);
        f32x2 cs; cs[0] = cos2pi((float)fr); cs[1] = sin2pi((float)fr);
        rot[i] = cs;
    }
    const int lane = threadIdx.x & 63, wave = threadIdx.x >> 6;
    {
        float* scr = lds + wave * (64 * 33);
        constexpr int IT_IN = (D / 64) * ((IN_W + 31) / 32), IT_OUT = (MIXW / 64) * (D / 32), IT_GU = (D / 64) * (2 * DE / 32), IT_DN = (DE / 64) * (D / 32);
        constexpr int IT_LAYER = IT_IN + IT_OUT + NE * (IT_GU + IT_DN);
        for (int it = blockIdx.x * NW + wave; it < DEPTH * IT_LAYER; it += gridDim.x * NW) {
            const int l = it / IT_LAYER; int r = it % IT_LAYER;
            if (r < IT_IN) { const int nb = (IN_W + 31) / 32;
                transpose_item(p.w_in + (size_t)l * D * IN_W, IN_W, IN_W, (r % nb) * 32, (r / nb) * 64, (bf16_t*)(p.ws + WS_WIN) + (size_t)l * PW * D, D, (r % nb) * 32, scr, lane); continue; }
            r -= IT_IN;
            if (r < IT_OUT) { const int nb = D / 32;
                transpose_item(p.w_out + (size_t)l * MIXW * D, D, D, (r % nb) * 32, (r / nb) * 64, (bf16_t*)(p.ws + WS_WOUT) + (size_t)l * D * MIXW, MIXW, (r % nb) * 32, scr, lane); continue; }
            r -= IT_OUT;
            const int e = r / (IT_GU + IT_DN); r %= (IT_GU + IT_DN);
            if (r < IT_GU) { const int nb = 2 * DE / 32, blk = r % nb, r0 = blk * 32;
                const int pn = r0 / 256, wc = (r0 % 256) / 64, up = (r0 % 64) / 32, c0 = pn * 128 + wc * 32;
                transpose_item((up ? p.w_up : p.w_gate) + (size_t)(l * NE + e) * D * DE, DE, DE, c0, (r / nb) * 64, (bf16_t*)(p.ws + WS_WGU) + (size_t)(l * NE + e) * 2 * DE * D, D, r0, scr, lane); continue; }
            r -= IT_GU;
            { const int nb = D / 32;
                transpose_item(p.w_down + (size_t)(l * NE + e) * DE * D, D, D, (r % nb) * 32, (r / nb) * 64, (bf16_t*)(p.ws + WS_WDN) + (size_t)(l * NE + e) * D * DE, DE, (r % nb) * 32, scr, lane); }
        }
    }
    bf16_t* H = (bf16_t*)(p.ws + WS_H);
    for (int r = blockIdx.x * NW + wave; r < S; r += gridDim.x * NW) {
        f32x4 v[RJ]; row_load(p.x + (size_t)r * D, v, lane);
        const float ri = row_rinv(v);
#pragma unroll
        for (int j = 0; j < RJ; ++j) {
            const f32x4 g = *(const f32x4*)(p.norm_mix + 256 * j + lane * 4);
            u32x2 o; o[0] = pk2(v[j][0] * ri * g[0], v[j][1] * ri * g[1]); o[1] = pk2(v[j][2] * ri * g[2], v[j][3] * ri * g[3]);
            *(u32x2*)(H + (size_t)r * D + 256 * j + lane * 4) = o;
        }
    }
}

constexpr int GBM = 256, GBK = 64, TILE_B = GBM * GBK * 2, STAGE_B = 2 * TILE_B, GEMM_LDS = 2 * STAGE_B;
__device__ __forceinline__ int lds_byte(int r, int c) { const int st = (r >> 4) * 2 + (c >> 5), ob = (r & 15) * 64 + (c & 31) * 2; return st * 1024 + (ob ^ (((ob >> 9) & 1) << 5)); }
__device__ __forceinline__ void stage_rc(int b, int& R, int& C) { const int st = b >> 10, sb = b & 1023, swz = sb ^ (((sb >> 9) & 1) << 5); R = (st >> 1) * 16 + swz / 64; C = (st & 1) * 32 + (swz % 64) / 2; }
__device__ __forceinline__ void stage_coords(int& sR, int& sC) { stage_rc((threadIdx.x >> 6) * 1024 + (threadIdx.x & 63) * 16, sR, sC); }
__device__ __forceinline__ void gemm256(f32x4 (&acc)[8][4], lds_u8* lds, const bf16_t* Ab, const unsigned (&ao)[4], const bf16_t* Bb, unsigned bo0, unsigned bstep, int K) {
    const int tid = threadIdx.x, wid = tid >> 6, lane = tid & 63, wr = wid >> 2, wc = wid & 3, fr = lane & 15, fq = lane >> 4;
    lds_u8* ldsw = lds + wid * 1024;
    const int aoff = lds_byte(wr * 128 + fr, fq * 8), boff = TILE_B + lds_byte(wc * 64 + fr, fq * 8);
#pragma unroll
    for (int m = 0; m < 8; ++m)
#pragma unroll
        for (int n = 0; n < 4; ++n) acc[m][n] = (f32x4){0.f, 0.f, 0.f, 0.f};
#define GEMM_STAGE(buf, kt) do { _Pragma("unroll") for (int i_ = 0; i_ < 4; ++i_) { \
        glds16((const char*)Ab + (size_t)((kt) * (GBK * 2)) + ao[i_], ldsw + (buf) * STAGE_B + i_ * 8192); \
        glds16((const char*)Bb + ((size_t)((kt) * (GBK * 2)) + (size_t)i_ * bstep) + bo0, ldsw + (buf) * STAGE_B + TILE_B + i_ * 8192); } } while (0)
    const int nt = K / GBK;
    GEMM_STAGE(0, 0); vm_wait0(); __syncthreads();
    for (int t = 0; t < nt; ++t) {
        const int cur = t & 1;
        if (t + 1 < nt) GEMM_STAGE(cur ^ 1, t + 1);
        const lds_u8* base = lds + cur * STAGE_B;
#pragma unroll
        for (int ks = 0; ks < 2; ++ks) {
            bf16x8 At[8], Bf[4];
#pragma unroll
            for (int m = 0; m < 8; ++m) At[m] = *(const LAS bf16x8*)(base + aoff + m * 2048 + ks * 1024);
#pragma unroll
            for (int n = 0; n < 4; ++n) Bf[n] = *(const LAS bf16x8*)(base + boff + n * 2048 + ks * 1024);
#pragma unroll
            for (int m = 0; m < 8; ++m)
#pragma unroll
                for (int n = 0; n < 4; ++n) acc[m][n] = mfma16(Bf[n], At[m], acc[m][n]);
            sched_fence();
        }
        vm_wait0(); __syncthreads();
    }
#undef GEMM_STAGE
}
__device__ __forceinline__ int vcu_id() { const int G = gridDim.x, b = blockIdx.x; return (G % 8 == 0) ? (b % 8) * (G / 8) + b / 8 : b; }

__device__ __forceinline__ void phase_inproj(const Params& p, int l, float* ldsf) {
    lds_u8* lds = (lds_u8*)ldsf;
    const bf16_t* H = (const bf16_t*)(p.ws + WS_H);
    const bf16_t* WT = (const bf16_t*)(p.ws + WS_WIN) + (size_t)l * PW * D;
    bf16_t* P = (bf16_t*)(p.ws + WS_PROJ);
    float* LOGF = (float*)(p.ws + WS_LOGF);
    unsigned* ctl = (unsigned*)(p.ws + WS_CTL);
    const f32x2* rot = (const f32x2*)(p.ws + WS_ROT);
    const float* bfg = p.b_forget + l * NFOX;
    constexpr int NPM = S / GBM, NPN = PW / GBM;
    const int tid = threadIdx.x, wid = tid >> 6, lane = tid & 63, wr = wid >> 2, wc = wid & 3, fr = lane & 15, fq = lane >> 4;
    int sR, sC; stage_coords(sR, sC);
    for (int u = vcu_id(); u < NPM * NPN; u += gridDim.x) {
        const int pm = u / NPN, pn = u % NPN;
        unsigned ao[4];
#pragma unroll
        for (int i = 0; i < 4; ++i) ao[i] = (unsigned)(((sR + 64 * i) * D + sC) * 2);
        f32x4 acc[8][4];
        gemm256(acc, lds, H + (size_t)pm * GBM * D, ao, WT + (size_t)pn * GBM * D, (unsigned)((sR * D + sC) * 2), (unsigned)(64 * D * 2), D);
        const int gc0 = pn * GBM + wc * 64;
        if (gc0 >= IN_W) continue;
        const int row0 = pm * GBM + wr * 128 + fr;
        if (gc0 >= OFL) {
#pragma unroll
            for (int m = 0; m < 8; ++m)
#pragma unroll
                for (int j = 0; j < 4; ++j) { const int h = 4 * fq + j; if (h < NFOX) LOGF[(size_t)(row0 + m * 16) * 8 + h] = log_sigmoid(acc[m][0][j] + bfg[h]); }
            continue;
        }
        const bool rotary = gc0 < OVR, is_gate = (gc0 >= OGR && gc0 < OQS), is_kf = (gc0 >= OKF && gc0 < OVF);
        const float scale = (gc0 < OKR || (gc0 >= OQS && gc0 < OKS) || (gc0 >= OQF && gc0 < OKF)) ? 0.125f : 1.0f;
        float kmx = 0.f;
#pragma unroll
        for (int m = 0; m < 8; ++m) {
            const int row = row0 + m * 16;
            if (rotary) {
#pragma unroll
                for (int n = 0; n < 2; ++n) {
                    const f32x4 c01 = *(const f32x4*)(rot + (size_t)row * 32 + n * 16 + 4 * fq), c23 = *(const f32x4*)(rot + (size_t)row * 32 + n * 16 + 4 * fq + 2);
                    const float cs[4] = {c01[0], c01[2], c23[0], c23[2]}, sn[4] = {c01[1], c01[3], c23[1], c23[3]};
#pragma unroll
                    for (int j = 0; j < 4; ++j) { const float x1 = acc[m][n][j], x2 = acc[m][n + 2][j]; acc[m][n][j] = x1 * cs[j] - x2 * sn[j]; acc[m][n + 2][j] = x1 * sn[j] + x2 * cs[j]; }
                }
            }
            float ss = 0.f;
#pragma unroll
            for (int n = 0; n < 4; ++n) {
                f32x4 v = acc[m][n] * scale;
                if (is_gate) {
#pragma unroll
                    for (int j = 0; j < 4; ++j) v[j] = silu(v[j]);
                }
                u32x2 o; o[0] = pk2(v[0], v[1]); o[1] = pk2(v[2], v[3]);
                if (is_kf) {
#pragma unroll
                    for (int j = 0; j < 4; ++j) { const float r = bf2f(f2bf(v[j])); ss += r * r; }
                }
                *(u32x2*)(P + (size_t)row * PW + gc0 + n * 16 + 4 * fq) = o;
            }
            if (is_kf) { ss += __shfl_xor(ss, 16); ss += __shfl_xor(ss, 32); kmx = fmaxf(kmx, ss); }
        }
        if (is_kf) { kmx = wave_max(kmx); if (lane == 0) atomicMax(ctl + CTL_KMAX + l * 8 + (gc0 - OKF) / HD, f2u(kmx)); }
    }
}

__device__ __forceinline__ float ret_log_gamma(int h) { return logf(1.0f - exp2f(-5.0f - (float)h)); }
__device__ __forceinline__ void phase_prep(const Params& p, int l, float* lds) {
    const bf16_t* P = (const bf16_t*)(p.ws + WS_PROJ);
    float* U = (float*)(p.ws + WS_U);
    float* Ks = lds; float* Vs = lds + 4096;
    const int tid = threadIdx.x;
    constexpr int NU = NRET * NCHUNK;
    for (int it = blockIdx.x; it < NU; it += gridDim.x) {
        {
            const int h = it / NCHUNK, n = it % NCHUNK;
            const float lg = ret_log_gamma(h);
            __syncthreads();
            for (int idx = tid; idx < 4096; idx += NT) {
                const int k = idx >> 6, d = idx & 63; const size_t row = (size_t)(n * CH + k) * PW;
                Ks[idx] = bf2f(P[row + OKR + h * HD + d]) * expf(lg * (float)(CH - 1 - k));
                Vs[idx] = bf2f(P[row + OVR + h * HD + d]);
            }
            __syncthreads();
            const int d = tid >> 3, e0 = (tid & 7) * 8;
            float acc[8];
#pragma unroll
            for (int j = 0; j < 8; ++j) acc[j] = 0.f;
            for (int k = 0; k < CH; ++k) {
                const float kv = Ks[k * 64 + d];
#pragma unroll
                for (int j = 0; j < 8; ++j) acc[j] += kv * Vs[k * 64 + e0 + j];
            }
            float* dst = U + ((size_t)(h * NCHUNK + n) * 64 + d) * 64 + e0;
#pragma unroll
            for (int j = 0; j < 8; ++j) dst[j] = acc[j];
        }
    }
}

constexpr int QB = 128, NQB = S / QB;
__device__ __forceinline__ void ret_scan_item(const Params& p, int item) {
    const float* U = (const float*)(p.ws + WS_U);
    float* SP = (float*)(p.ws + WS_SP);
    const int e = item * NT + threadIdx.x;
    const int h = e >> 12, de = e & 4095;
    const float c = expf(ret_log_gamma(h) * (float)CH);
    float st = 0.f;
    const size_t base = (size_t)h * NCHUNK * 4096 + de;
#pragma unroll 8
    for (int n = 0; n < NCHUNK; ++n) { const float u = U[base + (size_t)n * 4096]; SP[base + (size_t)n * 4096] = st; st = st * c + u; }
}
__device__ __forceinline__ void sb_item(const Params& p, int l, int h, int qb, float* lds) {
    const bf16_t* P = (const bf16_t*)(p.ws + WS_PROJ);
    bf16_t* MG = (bf16_t*)(p.ws + WS_MERGED);
    float* Ks = lds; float* Vs = lds + 4096; volatile unsigned* red = (volatile unsigned*)(lds + 8192);
    const int tid = threadIdx.x, r = tid >> 2, part = tid & 3, t = qb * QB + r;
    float q[16], o[16];
    { const bf16_t* qp = P + (size_t)t * PW + OQS + h * HD + part * 16;
#pragma unroll
      for (int j = 0; j < 16; ++j) { q[j] = bf2f(qp[j]); o[j] = 0.f; } }
    float carry = 0.f;
    for (int kt = (qb * QB + QB - 1) / 64; kt >= 0; --kt) {
        __syncthreads();
        for (int idx = tid; idx < 4096; idx += NT) {
            const int k = idx >> 6, d = idx & 63; const size_t row = (size_t)(kt * 64 + k) * PW;
            Ks[idx] = bf2f(P[row + OKS + h * HD + d]); Vs[idx] = bf2f(P[row + OVS + h * HD + d]);
        }
        __syncthreads();
        for (int sl = 63; sl >= 0; --sl) {
            const int s = kt * 64 + sl;
            float z = 0.f;
#pragma unroll
            for (int j = 0; j < 16; ++j) z += q[j] * Ks[sl * 64 + part * 16 + j];
            z += __shfl_xor(z, 1); z += __shfl_xor(z, 2);
            if (s < t) {
                const float lb = log_sigmoid(z);
                const float a = expf(lb + carry);
                carry += lb - z;
#pragma unroll
                for (int j = 0; j < 16; ++j) o[j] += a * Vs[sl * 64 + part * 16 + j];
            }
        }
        if (block_all(carry < -EXIT_T, red)) break;
    }
    float ss = 0.f;
#pragma unroll
    for (int j = 0; j < 16; ++j) ss += o[j] * o[j];
    ss += __shfl_xor(ss, 1); ss += __shfl_xor(ss, 2);
    const float ri = 1.0f / sqrtf(ss * (1.0f / HD) + EPS);
    const float* g = p.g_sb + l * WSB + h * HD + part * 16;
    bf16_t* dst = MG + (size_t)t * MIXW + WRET + h * HD + part * 16;
#pragma unroll
    for (int j = 0; j < 16; ++j) dst[j] = f2bf(o[j] * ri * g[j]);
}
__device__ __forceinline__ void fox_item(const Params& p, int l, int h, int qb, float* lds) {
    const bf16_t* P = (const bf16_t*)(p.ws + WS_PROJ);
    const float* LOGF = (const float*)(p.ws + WS_LOGF);
    const unsigned* ctl = (const unsigned*)(p.ws + WS_CTL);
    bf16_t* MG = (bf16_t*)(p.ws + WS_MERGED);
    float* Ks = lds; float* Vs = lds + 4096; volatile unsigned* red = (volatile unsigned*)(lds + 8192);
    float* Fr = lds + 8192 + 64;
    float* Lf = Fr + 64;
    float* Fq = Lf + 64;
    const int tid = threadIdx.x, r = tid >> 2, part = tid & 3, t = qb * QB + r;
    const int tlast = qb * QB + QB - 1;
    float q[16], o[16];
    float qq = 0.f;
    { const bf16_t* qp = P + (size_t)t * PW + OQF + h * HD + part * 16;
#pragma unroll
      for (int j = 0; j < 16; ++j) { q[j] = bf2f(qp[j]); o[j] = 0.f; qq += q[j] * q[j]; } }
    qq += __shfl_xor(qq, 1); qq += __shfl_xor(qq, 2);
    const float kmax = sqrtf(u2f(ctl[CTL_KMAX + l * 8 + h]));
    const float Bt = sqrtf(qq) * kmax * 1.0001f + 1e-6f;
    float m = -1e30f, lsum = 0.f;
    float Fc = 0.f;
    float fq = 0.f;
    for (int kt = tlast / 64; kt >= 0; --kt) {
        __syncthreads();
        for (int idx = tid; idx < 4096; idx += NT) {
            const int k = idx >> 6, d = idx & 63; const size_t row = (size_t)(kt * 64 + k) * PW;
            Ks[idx] = bf2f(P[row + OKF + h * HD + d]); Vs[idx] = bf2f(P[row + OVF + h * HD + d]);
        }
        if (tid < 64) Lf[tid] = -LOGF[(size_t)(kt * 64 + tid) * 8 + h];
        __syncthreads();
        if (tid < 64) { float a = Fc; for (int j = 63; j > tid; --j) a += Lf[j]; Fr[tid] = a; }
        __syncthreads();
        if (kt * 64 + 63 >= qb * QB) {
            if (part == 0 && (t >> 6) == kt) Fq[r] = Fr[t & 63];
            __syncthreads();
            if ((t >> 6) == kt) fq = Fq[r];
        }
        for (int sl = 63; sl >= 0; --sl) {
            const int s = kt * 64 + sl;
            float z = 0.f;
#pragma unroll
            for (int j = 0; j < 16; ++j) z += q[j] * Ks[sl * 64 + part * 16 + j];
            z += __shfl_xor(z, 1); z += __shfl_xor(z, 2);
            if (s <= t) {
                const float lg = z + fq - Fr[sl];
                if (lg > m) { const float f = expf(m - lg); lsum *= f;
#pragma unroll
                    for (int j = 0; j < 16; ++j) o[j] *= f;
                    m = lg; }
                const float pr = expf(lg - m);
                lsum += pr;
#pragma unroll
                for (int j = 0; j < 16; ++j) o[j] += pr * Vs[sl * 64 + part * 16 + j];
            }
        }
        const float Fnext = Fr[0] + Lf[0];
        __syncthreads();
        Fc = Fnext;
        const bool done = (kt * 64 <= t) && (Bt + fq - Fnext - m + logf((float)(kt * 64 + 1)) < -EXIT_T);
        if (block_all(done, red)) break;
    }
    const float il = 1.0f / lsum;
    float ss = 0.f;
#pragma unroll
    for (int j = 0; j < 16; ++j) { o[j] *= il; ss += o[j] * o[j]; }
    ss += __shfl_xor(ss, 1); ss += __shfl_xor(ss, 2);
    const float ri = 1.0f / sqrtf(ss * (1.0f / HD) + EPS);
    const float* g = p.g_fox + l * WFOX + h * HD + part * 16;
    bf16_t* dst = MG + (size_t)t * MIXW + WRET + WSB + h * HD + part * 16;
#pragma unroll
    for (int j = 0; j < 16; ++j) dst[j] = f2bf(o[j] * ri * g[j]);
}
__device__ __forceinline__ void phase_mix(const Params& p, int l, float* lds) {
    constexpr int NSCAN = NRET * 4096 / NT, NSBI = NSB * NQB, NFXI = NFOX * NQB;
    for (int it = blockIdx.x; it < NSCAN + NSBI + NFXI; it += gridDim.x) {
        if (it < NSCAN) ret_scan_item(p, it);
        else if (it < NSCAN + NSBI) { const int j = it - NSCAN; sb_item(p, l, j / NQB, NQB - 1 - (j % NQB), lds); }
        else { const int j = it - NSCAN - NSBI; fox_item(p, l, j / NQB, NQB - 1 - (j % NQB), lds); }
    }
}

__device__ __forceinline__ void phase_retout(const Params& p, int l, float* lds) {
    const bf16_t* P = (const bf16_t*)(p.ws + WS_PROJ);
    const float* SP = (const float*)(p.ws + WS_SP);
    bf16_t* MG = (bf16_t*)(p.ws + WS_MERGED);
    float* Qs = lds; float* Ks = lds + 4096; float* Vs = lds + 8192; float* Ss = lds + 12288; float* Sc = lds + 16384;
    const int tid = threadIdx.x, c = tid >> 3, part = tid & 7;
    for (int it = blockIdx.x; it < NRET * NCHUNK; it += gridDim.x) {
        const int h = it / NCHUNK, n = it % NCHUNK;
        const float lg = ret_log_gamma(h);
        __syncthreads();
        for (int idx = tid; idx < 4096; idx += NT) {
            const int k = idx >> 6, d = idx & 63; const size_t row = (size_t)(n * CH + k) * PW;
            Qs[idx] = bf2f(P[row + OQR + h * HD + d]); Ks[idx] = bf2f(P[row + OKR + h * HD + d]); Vs[idx] = bf2f(P[row + OVR + h * HD + d]);
            Ss[idx] = SP[(size_t)(h * NCHUNK + n) * 4096 + idx];
        }
        __syncthreads();
        float o[8];
#pragma unroll
        for (int j = 0; j < 8; ++j) o[j] = 0.f;
#pragma unroll 2
        for (int d = 0; d < 64; ++d) { const float qv = Qs[c * 64 + d];
#pragma unroll
            for (int j = 0; j < 8; ++j) o[j] += qv * Ks[(part * 8 + j) * 64 + d]; }
#pragma unroll
        for (int j = 0; j < 8; ++j) { const int k = part * 8 + j; Sc[c * 64 + k] = o[j] * expf(lg * fabsf((float)(c - k))); o[j] = 0.f; }
        __syncthreads();
#pragma unroll 2
        for (int k = 0; k < 64; ++k) { const float s = Sc[c * 64 + k];
#pragma unroll
            for (int j = 0; j < 8; ++j) o[j] += s * Vs[k * 64 + part * 8 + j]; }
        const float qd = expf(lg * (float)(c + 1));
#pragma unroll 2
        for (int d = 0; d < 64; ++d) { const float qv = Qs[c * 64 + d] * qd;
#pragma unroll
            for (int j = 0; j < 8; ++j) o[j] += qv * Ss[d * 64 + part * 8 + j]; }
        float sm = 0.f;
#pragma unroll
        for (int j = 0; j < 8; ++j) sm += o[j];
        sm += __shfl_xor(sm, 1); sm += __shfl_xor(sm, 2); sm += __shfl_xor(sm, 4);
        const float mu = sm * (1.0f / HD);
        float vs = 0.f;
#pragma unroll
        for (int j = 0; j < 8; ++j) { o[j] -= mu; vs += o[j] * o[j]; }
        vs += __shfl_xor(vs, 1); vs += __shfl_xor(vs, 2); vs += __shfl_xor(vs, 4);
        const float ri = 1.0f / sqrtf(vs * (1.0f / HD) + EPS);
        const int row = n * CH + c;
        const float* g = p.g_ret + l * WRET + h * HD + part * 8;
        const bf16_t* gate = P + (size_t)row * PW + OGR + h * HD + part * 8;
        bf16_t* dst = MG + (size_t)row * MIXW + h * HD + part * 8;
#pragma unroll
        for (int j = 0; j < 8; ++j) dst[j] = f2bf(o[j] * ri * g[j] * bf2f(gate[j]));
    }
}

__device__ __forceinline__ void phase_outproj(const Params& p, int l, float* ldsf) {
    lds_u8* lds = (lds_u8*)ldsf;
    const bf16_t* MG = (const bf16_t*)(p.ws + WS_MERGED);
    const bf16_t* WT = (const bf16_t*)(p.ws + WS_WOUT) + (size_t)l * D * MIXW;
    float* X = (float*)(p.ws + WS_X);
    const float* xin = l == 0 ? p.x : X;
    constexpr int NPM = S / GBM, NPN = D / GBM;
    const int tid = threadIdx.x, wid = tid >> 6, lane = tid & 63, wr = wid >> 2, wc = wid & 3, fr = lane & 15, fq = lane >> 4;
    int sR, sC; stage_coords(sR, sC);
    for (int u = vcu_id(); u < NPM * NPN; u += gridDim.x) {
        const int pm = u / NPN, pn = u % NPN;
        unsigned ao[4];
#pragma unroll
        for (int i = 0; i < 4; ++i) ao[i] = (unsigned)(((sR + 64 * i) * MIXW + sC) * 2);
        f32x4 acc[8][4];
        gemm256(acc, lds, MG + (size_t)pm * GBM * MIXW, ao, WT + (size_t)pn * GBM * MIXW, (unsigned)((sR * MIXW + sC) * 2), (unsigned)(64 * MIXW * 2), MIXW);
#pragma unroll
        for (int m = 0; m < 8; ++m)
#pragma unroll
            for (int n = 0; n < 4; ++n) { const size_t o = (size_t)(pm * GBM + wr * 128 + m * 16 + fr) * D + pn * GBM + wc * 64 + n * 16 + 4 * fq;
                *(f32x4*)(X + o) = *(const f32x4*)(xin + o) + acc[m][n]; }
    }
}

constexpr int RW = D + 4;
constexpr int ROUTE_LDS = NROUTE * RW * 4;
__device__ __forceinline__ void phase_route(const Params& p, int l, float* lds) {
    const float* X = (const float*)(p.ws + WS_X);
    bf16_t* H = (bf16_t*)(p.ws + WS_H);
    unsigned* ctl = (unsigned*)(p.ws + WS_CTL);
    int* LIST = (int*)(p.ws + WS_LIST);
    float* GATE = (float*)(p.ws + WS_GATE);
    const float* gn = p.norm_ffn + l * D;
    const float* wg = p.w_group + (size_t)l * D * NG; const float* wr = p.w_router + (size_t)l * D * NE;
    const float* bg = p.b_group + l * NG; const float* br = p.b_router + l * NE;
    const int lane = threadIdx.x & 63, wave = threadIdx.x >> 6;
    __syncthreads();
    for (int i = threadIdx.x; i < D * NG; i += NT) lds[(i % NG) * RW + i / NG] = wg[i];
    for (int i = threadIdx.x; i < D * NE; i += NT) lds[(NG + i % NE) * RW + i / NE] = wr[i];
    __syncthreads();
    for (int r = blockIdx.x * NW + wave; r < S; r += gridDim.x * NW) {
        f32x4 v[RJ]; row_load(X + (size_t)r * D, v, lane);
        const float ri = row_rinv(v);
#pragma unroll
        for (int j = 0; j < RJ; ++j) {
            const f32x4 g = *(const f32x4*)(gn + 256 * j + lane * 4);
            v[j] = v[j] * ri * g;
            u32x2 o; o[0] = pk2(v[j][0], v[j][1]); o[1] = pk2(v[j][2], v[j][3]);
            *(u32x2*)(H + (size_t)r * D + 256 * j + lane * 4) = o;
        }
        float gl[NG];
#pragma unroll
        for (int g = 0; g < NG; ++g) { float s = 0.f;
#pragma unroll
            for (int j = 0; j < RJ; ++j) { const f32x4 w = *(const f32x4*)(lds + g * RW + 256 * j + lane * 4); s += (v[j][0] * w[0] + v[j][1] * w[1]) + (v[j][2] * w[2] + v[j][3] * w[3]); }
            gl[g] = s; }
#pragma unroll
        for (int g = 0; g < NG; ++g) gl[g] = wave_sum(gl[g]) + bg[g];
        int grp = 0; float gm = gl[0];
#pragma unroll
        for (int g = 1; g < NG; ++g) if (gl[g] > gm) { gm = gl[g]; grp = g; }
        float den = 0.f;
#pragma unroll
        for (int g = 0; g < NG; ++g) den += expf(gl[g] - gm);
        const float pg = 1.0f / den;
        float el[EPG];
        const float* wl = lds + (NG + grp * EPG) * RW + lane * 4;
#pragma unroll
        for (int e = 0; e < EPG; ++e) { float s = 0.f;
#pragma unroll
            for (int j = 0; j < RJ; ++j) { const f32x4 w = *(const f32x4*)(wl + e * RW + 256 * j); s += (v[j][0] * w[0] + v[j][1] * w[1]) + (v[j][2] * w[2] + v[j][3] * w[3]); }
            el[e] = s; }
#pragma unroll
        for (int e = 0; e < EPG; ++e) el[e] = wave_sum(el[e]) + br[grp * EPG + e];
        if (lane == 0) {
            int i1 = 0; float v1 = -INFINITY; int i2 = 0; float v2 = -INFINITY;
#pragma unroll
            for (int e = 0; e < EPG; ++e) { const float x = el[e];
                if (x > v1) { v2 = v1; i2 = i1; v1 = x; i1 = e; } else if (x > v2) { v2 = x; i2 = e; } }
            const float e2 = expf(v2 - v1), g1 = pg / (1.f + e2), g2 = pg * e2 / (1.f + e2);
            const int ea = grp * EPG + i1, eb = grp * EPG + i2;
            GATE[(size_t)r * 2] = g1; GATE[(size_t)r * 2 + 1] = g2;
            const unsigned sa = atomicAdd(ctl + CTL_CNT + l * NE + ea, 1u); LIST[(size_t)ea * S + sa] = r * 2;
            const unsigned sb = atomicAdd(ctl + CTL_CNT + l * NE + eb, 1u); LIST[(size_t)eb * S + sb] = r * 2 + 1;
        }
    }
}

__device__ __forceinline__ bool moe_unit(const unsigned* cnt, int u, int npn, int& e, int& rt, int& pn, int& base) {
    int tile = u / npn; pn = u % npn; base = 0;
    for (e = 0; e < NE; ++e) { const int nt = ((int)cnt[e] + GBM - 1) / GBM; if (tile < nt) { rt = tile; return true; } tile -= nt; base += nt * GBM; }
    return false;
}
__device__ __forceinline__ void phase_moe1(const Params& p, int l, float* ldsf) {
    lds_u8* lds = (lds_u8*)ldsf;
    const bf16_t* H = (const bf16_t*)(p.ws + WS_H);
    bf16_t* HID = (bf16_t*)(p.ws + WS_HID);
    const unsigned* cnt = (const unsigned*)(p.ws + WS_CTL) + CTL_CNT + l * NE;
    const int* LIST = (const int*)(p.ws + WS_LIST);
    constexpr int NPN = 2 * DE / GBM;
    const int tid = threadIdx.x, wid = tid >> 6, lane = tid & 63, wr = wid >> 2, wc = wid & 3, fr = lane & 15, fq = lane >> 4;
    int sR, sC; stage_coords(sR, sC);
    for (int u = vcu_id();; u += gridDim.x) {
        int e, rt, pn, base; if (!moe_unit(cnt, u, NPN, e, rt, pn, base)) break;
        const int nvalid = (int)cnt[e] - rt * GBM;
        const bf16_t* WT = (const bf16_t*)(p.ws + WS_WGU) + ((size_t)(l * NE + e) * 2 * DE + pn * GBM) * D;
        unsigned ao[4];
#pragma unroll
        for (int i = 0; i < 4; ++i) { const int r = sR + 64 * i; const int tok = r < nvalid ? (LIST[(size_t)e * S + rt * GBM + r] >> 1) : 0; ao[i] = (unsigned)((tok * D + sC) * 2); }
        f32x4 acc[8][4];
        gemm256(acc, lds, H, ao, WT, (unsigned)((sR * D + sC) * 2), (unsigned)(64 * D * 2), D);
#pragma unroll
        for (int m = 0; m < 8; ++m)
#pragma unroll
            for (int n = 0; n < 2; ++n) { f32x4 v;
#pragma unroll
                for (int j = 0; j < 4; ++j) v[j] = silu(acc[m][n][j]) * acc[m][n + 2][j];
                u32x2 o; o[0] = pk2(v[0], v[1]); o[1] = pk2(v[2], v[3]);
                *(u32x2*)(HID + (size_t)(base + rt * GBM + wr * 128 + m * 16 + fr) * DE + pn * 128 + wc * 32 + n * 16 + 4 * fq) = o; }
    }
}
__device__ __forceinline__ void phase_moe2(const Params& p, int l, float* ldsf) {
    lds_u8* lds = (lds_u8*)ldsf;
    const bf16_t* HID = (const bf16_t*)(p.ws + WS_HID);
    bf16_t* Y = (bf16_t*)(p.ws + WS_Y);
    const unsigned* cnt = (const unsigned*)(p.ws + WS_CTL) + CTL_CNT + l * NE;
    const int* LIST = (const int*)(p.ws + WS_LIST);
    const float* GATE = (const float*)(p.ws + WS_GATE);
    constexpr int NPN = D / GBM;
    const int tid = threadIdx.x, wid = tid >> 6, lane = tid & 63, wr = wid >> 2, wc = wid & 3, fr = lane & 15, fq = lane >> 4;
    int sR, sC; stage_coords(sR, sC);
    for (int u = vcu_id();; u += gridDim.x) {
        int e, rt, pn, base; if (!moe_unit(cnt, u, NPN, e, rt, pn, base)) break;
        const int nvalid = (int)cnt[e] - rt * GBM;
        const bf16_t* WT = (const bf16_t*)(p.ws + WS_WDN) + ((size_t)(l * NE + e) * D + pn * GBM) * DE;
        unsigned ao[4];
#pragma unroll
        for (int i = 0; i < 4; ++i) ao[i] = (unsigned)(((sR + 64 * i) * DE + sC) * 2);
        f32x4 acc[8][4];
        gemm256(acc, lds, HID + (size_t)(base + rt * GBM) * DE, ao, WT, (unsigned)((sR * DE + sC) * 2), (unsigned)(64 * DE * 2), DE);
#pragma unroll
        for (int m = 0; m < 8; ++m) {
            const int r = wr * 128 + m * 16 + fr;
            if (r < nvalid) {
                const int a = LIST[(size_t)e * S + rt * GBM + r]; const float g = GATE[a];
#pragma unroll
                for (int n = 0; n < 4; ++n) { const f32x4 v = acc[m][n] * g; u32x2 o; o[0] = pk2(v[0], v[1]); o[1] = pk2(v[2], v[3]);
                    *(u32x2*)(Y + (size_t)a * D + pn * GBM + wc * 64 + n * 16 + 4 * fq) = o; }
            }
        }
    }
}

__device__ __forceinline__ void phase_combine(const Params& p, int l) {
    float* X = (float*)(p.ws + WS_X);
    const bf16_t* Y = (const bf16_t*)(p.ws + WS_Y);
    bf16_t* H = (bf16_t*)(p.ws + WS_H);
    const bool last = (l == DEPTH - 1);
    const float* gn = last ? p.norm_final : p.norm_mix + (l + 1) * D;
    const int lane = threadIdx.x & 63, wave = threadIdx.x >> 6;
    for (int r = blockIdx.x * NW + wave; r < S; r += gridDim.x * NW) {
        f32x4 v[RJ]; row_load(X + (size_t)r * D, v, lane);
#pragma unroll
        for (int j = 0; j < RJ; ++j) {
            const u32x2 a = *(const u32x2*)(Y + (size_t)(2 * r) * D + 256 * j + lane * 4), b = *(const u32x2*)(Y + (size_t)(2 * r + 1) * D + 256 * j + lane * 4);
            v[j][0] += u2f(a[0] << 16) + u2f(b[0] << 16); v[j][1] += u2f(a[0] & 0xffff0000u) + u2f(b[0] & 0xffff0000u);
            v[j][2] += u2f(a[1] << 16) + u2f(b[1] << 16); v[j][3] += u2f(a[1] & 0xffff0000u) + u2f(b[1] & 0xffff0000u);
        }
        const float ri = row_rinv(v);
#pragma unroll
        for (int j = 0; j < RJ; ++j) {
            const f32x4 g = *(const f32x4*)(gn + 256 * j + lane * 4);
            if (last) *(f32x4*)(p.out + (size_t)r * D + 256 * j + lane * 4) = v[j] * ri * g;
            else {
                *(f32x4*)(X + (size_t)r * D + 256 * j + lane * 4) = v[j];
                u32x2 o; o[0] = pk2(v[j][0] * ri * g[0], v[j][1] * ri * g[1]); o[1] = pk2(v[j][2] * ri * g[2], v[j][3] * ri * g[3]);
                *(u32x2*)(H + (size_t)r * D + 256 * j + lane * 4) = o;
            }
        }
    }
}

constexpr int PH_PER_LAYER = 9, NPHASE = 1 + DEPTH * PH_PER_LAYER;
constexpr int LDS_MAIN = (GEMM_LDS > ROUTE_LDS ? GEMM_LDS : ROUTE_LDS);
constexpr int LDS_MISC = (LDS_MAIN + 255) / 256 * 256;
constexpr int LDS_BYTES = LDS_MISC + 256;

__device__ __forceinline__ void run_phase(const Params& p, int ph, float* lds) {
    if (ph == 0) { phase_init(p, lds); return; }
    const int l = (ph - 1) / PH_PER_LAYER, q = (ph - 1) % PH_PER_LAYER;
    switch (q) {
        case 0: phase_inproj(p, l, lds); break;
        case 1: phase_prep(p, l, lds); break;
        case 2: phase_mix(p, l, lds); break;
        case 3: phase_retout(p, l, lds); break;
        case 4: phase_outproj(p, l, lds); break;
        case 5: phase_route(p, l, lds); break;
        case 6: phase_moe1(p, l, lds); break;
        case 7: phase_moe2(p, l, lds); break;
        default: phase_combine(p, l); break;
    }
}

#ifndef CPU_EMU
#define XB_TMO      128
#define XB_XCNT(j)  (256  + 64 * (j))
#define XB_XSUB(j)  (1280 + 64 * (j))
#define XB_XGEN(j)  (2304 + 64 * (j))
#define XB_TOP      3328
#define XB_TOPGEN   3392
#define XCD_BAR_WORDS 3456
#define XB_SPIN_CAP (1u << 22)
__device__ __forceinline__ unsigned xb_ld(unsigned* p)              { return __hip_atomic_load(p, __ATOMIC_RELAXED, __HIP_MEMORY_SCOPE_AGENT); }
__device__ __forceinline__ unsigned xb_add(unsigned* p, unsigned v) { return __hip_atomic_fetch_add(p, v, __ATOMIC_RELAXED, __HIP_MEMORY_SCOPE_AGENT); }
__device__ __forceinline__ unsigned xb_xcc_id() { return (unsigned)__builtin_amdgcn_s_getreg((3 << 11) | 20) & 0xFu; }
#define XB_SPIN(cond, bar) do { unsigned _sp = 0; while (cond) { __builtin_amdgcn_s_sleep(1); \
    if ((++_sp & 255u) == 0u) { if (xb_ld(&(bar)[XB_TMO])) break; if (_sp > XB_SPIN_CAP) { atomicAdd(&(bar)[XB_TMO], 1u); break; } } } } while (0)
struct XcdBarrier { unsigned* bar; unsigned x; volatile LAS unsigned* st; };
__device__ __forceinline__ XcdBarrier xcd_barrier_post(unsigned* bar, volatile LAS unsigned* st) {
    XcdBarrier b; b.bar = bar; b.x = xb_xcc_id(); b.st = st;
    if (threadIdx.x == 0) (void)xb_add(&bar[XB_XCNT(b.x)], 1u);
    return b;
}
__device__ __forceinline__ void xcd_barrier_complete(unsigned* bar, unsigned x, unsigned& nloc, unsigned& nx) {
    const unsigned G = gridDim.x * gridDim.y * gridDim.z;
    unsigned sum, cnt, mine, sp = 0u;
    for (;;) {
        sum = 0u; cnt = 0u; mine = 0u;
#pragma unroll
        for (unsigned j = 0; j < 16; ++j) { const unsigned c = xb_ld(&bar[XB_XCNT(j)]); sum += c; cnt += (c > 0u) ? 1u : 0u; mine = (j == x) ? c : mine; }
        if (sum == G) break;
        __builtin_amdgcn_s_sleep(1);
        if ((++sp & 255u) == 0u) { if (xb_ld(&bar[XB_TMO])) break; if (sp > XB_SPIN_CAP) { atomicAdd(&bar[XB_TMO], 1u); break; } }
    }
    nloc = mine > 0u ? mine : 1u; nx = cnt > 0u ? cnt : 1u;
}
__device__ __forceinline__ void xcd_barrier(const XcdBarrier& b) {
    asm volatile("s_waitcnt vmcnt(0)" ::: "memory");
    __syncthreads();
    if (threadIdx.x == 0) {
        unsigned* bar = b.bar;
        __builtin_amdgcn_s_waitcnt(0);
        unsigned nloc = b.st[0], nx = b.st[1];
        if (nloc == 0u) { xcd_barrier_complete(bar, b.x, nloc, nx); b.st[0] = nloc; b.st[1] = nx; }
        const unsigned old = xb_add(&bar[XB_XSUB(b.x)], 1u);
        const unsigned gen = old / nloc;
        if (old + 1u == (gen + 1u) * nloc) {
            __builtin_amdgcn_fence(__ATOMIC_RELEASE, "agent");
            asm volatile("s_waitcnt vmcnt(0)" ::: "memory");
            const unsigned og = xb_add(&bar[XB_TOP], 1u);
            const unsigned tg = og / nx;
            if (og + 1u == (tg + 1u) * nx) xb_add(&bar[XB_TOPGEN], 1u);
            else XB_SPIN(xb_ld(&bar[XB_TOPGEN]) == tg, bar);
            __builtin_amdgcn_fence(__ATOMIC_ACQUIRE, "agent");
            xb_add(&bar[XB_XGEN(b.x)], 1u);
            asm volatile("s_waitcnt vmcnt(0)" ::: "memory");
        } else {
            XB_SPIN(xb_ld(&bar[XB_XGEN(b.x)]) == gen, bar);
            __builtin_amdgcn_fence(__ATOMIC_ACQUIRE, "agent");
            asm volatile("s_waitcnt vmcnt(0)" ::: "memory");
        }
    }
    __syncthreads();
}
#endif
#ifndef CPU_EMU
__global__ void __launch_bounds__(NT) fwd_kernel(Params p, int ph_lo, int ph_hi) {
    extern __shared__ __attribute__((aligned(16))) float lds[];
    cg::grid_group grid = cg::this_grid();
    volatile LAS unsigned* misc = (volatile LAS unsigned*)((LAS unsigned char*)lds + LDS_MISC);
    if (threadIdx.x < 64) misc[threadIdx.x] = 0u;
    __syncthreads();
    XcdBarrier xb; xb.bar = (unsigned*)(p.ws + WS_CTL) + CTL_BAR; xb.x = 0; xb.st = misc;
    const bool use_xb = (ph_lo == 0);
#define SEAM(k) do { if ((k) == 0 || !use_xb) { grid.sync(); if ((k) == 0 && use_xb) xb = xcd_barrier_post((unsigned*)(p.ws + WS_CTL) + CTL_BAR, misc); } else xcd_barrier(xb); } while (0)
#define PHASE(k, call) do { if (ph_lo <= (k) && (k) < ph_hi) { call; if ((k) + 1 < ph_hi) SEAM(k); } } while (0)
#define LAYER(l) do { const int b_ = 1 + (l) * PH_PER_LAYER; \
        PHASE(b_ + 0, phase_inproj(p, l, lds)); PHASE(b_ + 1, phase_prep(p, l, lds)); PHASE(b_ + 2, phase_mix(p, l, lds)); \
        PHASE(b_ + 3, phase_retout(p, l, lds)); PHASE(b_ + 4, phase_outproj(p, l, lds)); PHASE(b_ + 5, phase_route(p, l, lds)); \
        PHASE(b_ + 6, phase_moe1(p, l, lds)); PHASE(b_ + 7, phase_moe2(p, l, lds)); PHASE(b_ + 8, phase_combine(p, l)); } while (0)
    PHASE(0, phase_init(p, lds));
    LAYER(0);
    LAYER(1);
    static_assert(DEPTH == 2, "phase program written for two layers");
#undef LAYER
#undef PHASE
#undef SEAM
}

#ifndef N_LAUNCH_PER_PHASE
#define N_LAUNCH_PER_PHASE 0
#endif
extern "C" void kernel_launch(void* const* d_in, const int* in_sizes, int n_in, void* d_out, int out_size, void* d_ws, size_t ws_size, hipStream_t stream) {
    static int grid = 0;
    if (grid == 0) {
        if (ws_size < WS_END) { fprintf(stderr, "kernel_launch: workspace too small (%zu < %zu)\n", ws_size, (size_t)WS_END); grid = -1; return; }
        int dev = 0, cus = 0, per_cu = 0;
        hipGetDevice(&dev);
        hipDeviceGetAttribute(&cus, hipDeviceAttributeMultiprocessorCount, dev);
        hipFuncSetAttribute((const void*)fwd_kernel, hipFuncAttributeMaxDynamicSharedMemorySize, LDS_BYTES);
        hipOccupancyMaxActiveBlocksPerMultiprocessor(&per_cu, (const void*)fwd_kernel, NT, LDS_BYTES);
        if (per_cu < 1) { fprintf(stderr, "kernel_launch: occupancy query says %d blocks per CU\n", per_cu); grid = -1; return; }
        grid = cus;
    }
    if (grid < 0) return;
    Params p{};
    p.x = (const float*)d_in[0]; p.norm_mix = (const float*)d_in[1]; p.w_in = (const float*)d_in[2]; p.b_forget = (const float*)d_in[3];
    p.g_ret = (const float*)d_in[4]; p.g_sb = (const float*)d_in[5]; p.g_fox = (const float*)d_in[6]; p.w_out = (const float*)d_in[7];
    p.norm_ffn = (const float*)d_in[8]; p.w_group = (const float*)d_in[9]; p.b_group = (const float*)d_in[10]; p.w_router = (const float*)d_in[11];
    p.b_router = (const float*)d_in[12]; p.w_gate = (const float*)d_in[13]; p.w_up = (const float*)d_in[14]; p.w_down = (const float*)d_in[15];
    p.norm_final = (const float*)d_in[16]; p.out = (float*)d_out; p.ws = (unsigned char*)d_ws;
#if N_LAUNCH_PER_PHASE
    for (int ph = 0; ph < NPHASE; ++ph) {
        int lo = ph, hi = ph + 1; void* args[] = {&p, &lo, &hi};
        hipLaunchCooperativeKernel((const void*)fwd_kernel, dim3(grid), dim3(NT), args, LDS_BYTES, stream);
    }
#else
    int lo = 0, hi = NPHASE; void* args[] = {&p, &lo, &hi};
    hipError_t e = hipLaunchCooperativeKernel((const void*)fwd_kernel, dim3(grid), dim3(NT), args, LDS_BYTES, stream);
    if (e != hipSuccess) fprintf(stderr, "cooperative launch failed: %s (grid %d)\n", hipGetErrorString(e), grid);
#endif
}
#endif
```

```cpp
#ifndef CPU_EMU
#include <hip/hip_runtime.h>
#include <hip/hip_cooperative_groups.h>
#include <cstdio>
#include <cstdint>
#include <cmath>
namespace cg = cooperative_groups;
#define VEC(T, N) T __attribute__((ext_vector_type(N)))
__device__ __forceinline__ void wave_barrier() { __builtin_amdgcn_wave_barrier(); }
__device__ __forceinline__ float sin2pi(float x) { return __builtin_amdgcn_sinf(x); }
__device__ __forceinline__ float cos2pi(float x) { return __builtin_amdgcn_cosf(x); }
__device__ __forceinline__ unsigned long long ballot64(bool p) { return __ballot(p); }
#define LAS __attribute__((address_space(3)))
typedef VEC(short, 8) bf16x8;
typedef VEC(float, 4) f32x4_;
__device__ __forceinline__ void glds16(const void* g, LAS unsigned char* l) { __builtin_amdgcn_global_load_lds((const unsigned*)g, (LAS unsigned*)l, 16, 0, 0); }
__device__ __forceinline__ void vm_wait0() { asm volatile("s_waitcnt vmcnt(0)" ::: "memory"); }
__device__ __forceinline__ void lds_wait0() { asm volatile("s_waitcnt lgkmcnt(0)" ::: "memory"); }
__device__ __forceinline__ void sched_fence() { __builtin_amdgcn_sched_barrier(0); }
__device__ __forceinline__ f32x4_ mfma16(bf16x8 a, bf16x8 b, f32x4_ c) { return __builtin_amdgcn_mfma_f32_16x16x32_bf16(a, b, c, 0, 0, 0); }
typedef VEC(float, 16) f32x16;
typedef VEC(short, 4) s16x4;
__device__ __forceinline__ f32x16 mfma32(bf16x8 a, bf16x8 b, f32x16 c) { return __builtin_amdgcn_mfma_f32_32x32x16_bf16(a, b, c, 0, 0, 0); }
__device__ __forceinline__ s16x4 tr16(const LAS unsigned char* p) { return __builtin_amdgcn_ds_read_tr16_b64_v4i16((LAS s16x4*)p); }
__device__ __forceinline__ float fast_exp(float x) { return __expf(x); }
__device__ __forceinline__ float fast_log(float x) { return __logf(x); }
#else
#define VEC(T, N) T __attribute__((vector_size(sizeof(T) * N)))
inline float sin2pi(float x) { return (float)sin(6.283185307179586 * (double)x); }
inline float cos2pi(float x) { return (float)cos(6.283185307179586 * (double)x); }
inline unsigned long long ballot64(bool p) { return emu_ballot(p); }
#define LAS
typedef VEC(short, 8) bf16x8;
inline void glds16(const void* g, unsigned char* l) { memcpy(l + (threadIdx.x & 63) * 16, g, 16); }
inline void vm_wait0() {}
inline void lds_wait0() {}
inline void sched_fence() {}
inline emu_f32x4 mfma16(bf16x8 a, bf16x8 b, emu_f32x4 c) { return emu_mfma16(a, b, c); }
typedef VEC(float, 16) f32x16;
typedef VEC(short, 4) s16x4;
inline f32x16 mfma32(bf16x8 a, bf16x8 b, f32x16 c) { return emu_mfma32(a, b, c); }
inline s16x4 tr16(const unsigned char* p) { return emu_tr16(p); }
inline float fast_exp(float x) { return expf(x); }
inline float fast_log(float x) { return logf(x); }
#endif

typedef unsigned short bf16_t;
typedef VEC(float, 4) f32x4;
typedef VEC(float, 2) f32x2;
typedef VEC(unsigned, 2) u32x2;
typedef VEC(unsigned, 4) u32x4;
typedef LAS unsigned char lds_u8;

#ifdef SMALL_CFG
constexpr int D = 256, S = 512, DEPTH = 2, NRET = 2, NSB = 1, NFOX = 1, NG = 2, EPG = 4, DE = 128;
#else
constexpr int D = 1024, S = 16384, DEPTH = 2, NRET = 6, NSB = 5, NFOX = 5, NG = 4, EPG = 8, DE = 512;
#endif
constexpr int CH = 64, HD = 64, NE = NG * EPG;
constexpr int WRET = NRET * HD, WSB = NSB * HD, WFOX = NFOX * HD, MIXW = WRET + WSB + WFOX;
constexpr int IN_W = 4 * WRET + 3 * WSB + 3 * WFOX + NFOX;
constexpr int PW = (IN_W + 255) / 256 * 256;
constexpr int OQR = 0, OKR = WRET, OVR = 2 * WRET, OGR = 3 * WRET, OQS = 4 * WRET, OKS = OQS + WSB, OVS = OKS + WSB;
constexpr int OQF = OVS + WSB, OKF = OQF + WFOX, OVF = OKF + WFOX, OFL = OVF + WFOX;
constexpr int NCHUNK = S / CH;
constexpr float EPS = 1e-6f;
constexpr int NT = 512, NW = NT / 64;
constexpr int NROUTE = NG + NE;
constexpr float EXIT_T = 30.0f;

constexpr size_t al256(size_t x) { return (x + 255) / 256 * 256; }
constexpr size_t WS_CTL = 0;
constexpr int CTL_CNT = 0;
constexpr int CTL_KMAX = 256;
constexpr int CTL_WQ = 320;
constexpr int CTL_BAR = 1024;
constexpr int CTL_WORDS = 8192;
constexpr size_t WS_ROT = 32768;
constexpr size_t WS_X = al256(WS_ROT + (size_t)S * 32 * 8);
constexpr size_t WS_H = al256(WS_X + (size_t)S * D * 4);
constexpr size_t WS_LOGF = al256(WS_H + (size_t)S * D * 2);
constexpr size_t WS_MERGED = al256(WS_LOGF + (size_t)S * 8 * 4);
constexpr size_t WS_U = al256(WS_MERGED + (size_t)S * MIXW * 2);
constexpr size_t WS_SP = al256(WS_U + (size_t)NRET * NCHUNK * 4096 * 4);
constexpr size_t WS_LIST = al256(WS_SP + (size_t)NRET * NCHUNK * 4096 * 4);
constexpr size_t WS_GATE = al256(WS_LIST + (size_t)NE * S * 4);
constexpr size_t WS_WIN = al256(WS_GATE + (size_t)S * 2 * 4);
constexpr size_t WS_WOUT = al256(WS_WIN + (size_t)DEPTH * PW * D * 2);
constexpr size_t WS_WGU = al256(WS_WOUT + (size_t)DEPTH * D * MIXW * 2);
constexpr size_t WS_WDN = al256(WS_WGU + (size_t)DEPTH * NE * 2 * DE * D * 2);
constexpr size_t WS_PROJ = al256(WS_WDN + (size_t)DEPTH * NE * D * DE * 2);
constexpr int HID_ROWS = 2 * S + NE * 256;
constexpr size_t WS_HID = WS_PROJ;
constexpr size_t WS_Y = al256(WS_HID + (size_t)HID_ROWS * DE * 2);
constexpr size_t WS_END0 = al256(WS_PROJ + (size_t)S * PW * 2), WS_END1 = al256(WS_Y + (size_t)2 * S * D * 2);
constexpr size_t WS_END = WS_END0 > WS_END1 ? WS_END0 : WS_END1;
#ifndef SMALL_CFG
static_assert(WS_END <= (size_t)512 * 1024 * 1024, "workspace map exceeds the guaranteed 512 MiB");
#endif

struct Params {
    const float* x; const float* norm_mix; const float* w_in; const float* b_forget; const float* g_ret; const float* g_sb; const float* g_fox;
    const float* w_out; const float* norm_ffn; const float* w_group; const float* b_group; const float* w_router; const float* b_router;
    const float* w_gate; const float* w_up; const float* w_down; const float* norm_final;
    float* out; unsigned char* ws;
};

__device__ __forceinline__ int imin(int a, int b) { return a < b ? a : b; }
__device__ __forceinline__ float u2f(unsigned u) { return __builtin_bit_cast(float, u); }
__device__ __forceinline__ unsigned f2u(float f) { return __builtin_bit_cast(unsigned, f); }
__device__ __forceinline__ float bf2f(bf16_t b) { return u2f((unsigned)b << 16); }
__device__ __forceinline__ bf16_t f2bf(float f) { unsigned u = f2u(f); return (bf16_t)((u + 0x7fffu + ((u >> 16) & 1u)) >> 16); }
__device__ __forceinline__ unsigned pk2(float lo, float hi) { return (unsigned)f2bf(lo) | ((unsigned)f2bf(hi) << 16); }
__device__ __forceinline__ float log_sigmoid(float x) { return fminf(x, 0.f) - log1pf(expf(-fabsf(x))); }
__device__ __forceinline__ float silu(float x) { return x / (1.f + expf(-x)); }
__device__ __forceinline__ float wave_sum(float v) {
#pragma unroll
    for (int o = 1; o < 64; o <<= 1) v += __shfl_xor(v, o);
    return v;
}
__device__ __forceinline__ float wave_max(float v) {
#pragma unroll
    for (int o = 1; o < 64; o <<= 1) v = fmaxf(v, __shfl_xor(v, o));
    return v;
}
__device__ __forceinline__ bool block_all(bool pred, volatile unsigned* red) {
    const unsigned long long b = ballot64(pred);
    __syncthreads();
    if ((threadIdx.x & 63) == 0) red[threadIdx.x >> 6] = (b == ~0ull) ? 1u : 0u;
    __syncthreads();
    bool all = true;
    for (int w = 0; w < NW; ++w) all = all && (red[w] != 0u);
    return all;
}
__device__ __forceinline__ double inv_turns(int j) {
    static constexpr double T[32] = {
        1.59154943091895346e-01, 1.19349370211248862e-01, 8.94994016088910133e-02, 6.71150830052272551e-02, 5.03292121044870353e-02, 3.77415847174197711e-02, 2.83021958306233987e-02, 2.12236527647776604e-02,
        1.59154943091895339e-02, 1.19349370211248862e-02, 8.94994016088910237e-03, 6.71150830052272534e-03, 5.03292121044870370e-03, 3.77415847174197719e-03, 2.83021958306233987e-03, 2.12236527647776622e-03,
        1.59154943091895356e-03, 1.19349370211248849e-03, 8.94994016088910237e-04, 6.71150830052272599e-04, 5.03292121044870326e-04, 3.77415847174197741e-04, 2.83021958306233954e-04, 2.12236527647776605e-04,
        1.59154943091895351e-04, 1.19349370211248862e-04, 8.94994016088910182e-05, 6.71150830052272545e-05, 5.03292121044870354e-05, 3.77415847174197768e-05, 2.83021958306233961e-05, 2.12236527647776592e-05};
    return T[j];
}

constexpr int VROWB = 144;
constexpr int IMG64 = 64 * VROWB;
constexpr int RET_WAVE_LDS = 2 * IMG64;
__device__ __forceinline__ int crow(int reg, int hi) { return (reg & 3) + 8 * (reg >> 2) + 4 * hi; }
__device__ __forceinline__ bf16x8 tr_frag(const lds_u8* base, int rowoff0, int rowoff1, int coloff) {
    const s16x4 lo = tr16(base + rowoff0 * VROWB + coloff), hi4 = tr16(base + rowoff1 * VROWB + coloff);
    bf16x8 f; f[0] = lo[0]; f[1] = lo[1]; f[2] = lo[2]; f[3] = lo[3]; f[4] = hi4[0]; f[5] = hi4[1]; f[6] = hi4[2]; f[7] = hi4[3]; return f;
}

constexpr int RJ = D / 256;
__device__ __forceinline__ void row_load(const float* row, f32x4* v, int lane) {
#pragma unroll
    for (int j = 0; j < RJ; ++j) v[j] = *(const f32x4*)(row + 256 * j + lane * 4);
}
__device__ __forceinline__ float row_rinv(const f32x4* v) {
    float s = 0.f;
#pragma unroll
    for (int j = 0; j < RJ; ++j) s += (v[j][0] * v[j][0] + v[j][1] * v[j][1]) + (v[j][2] * v[j][2] + v[j][3] * v[j][3]);
    s = wave_sum(s);
    return 1.0f / sqrtf(s * (1.0f / D) + EPS);
}

#ifndef CPU_EMU
typedef float f32x4_u __attribute__((ext_vector_type(4), aligned(4)));
#else
typedef float f32x4_u __attribute__((vector_size(16), aligned(4)));
#endif
__device__ __forceinline__ void transpose_item64(const float* Wa, const float* Wb, int ldw, int ncols, int c0, int cb0, int k0, bf16_t* WT, int ldt, int r0, lds_u8* img, int lane) {
    const int n = 4 * (lane & 15), kr = lane >> 4;
    const float* src = (n < 32 ? Wa + c0 + n : Wb + cb0 + (n - 32)) + (size_t)(k0 + kr) * ldw;
    const int col = (n < 32 ? c0 + n : cb0 + n - 32);
    f32x4 v[16];
    if (col + 3 < ncols) {
#pragma unroll
        for (int i = 0; i < 16; ++i) { const f32x4_u t = *(const f32x4_u*)(src + (size_t)(4 * i) * ldw); v[i][0] = t[0]; v[i][1] = t[1]; v[i][2] = t[2]; v[i][3] = t[3]; }
    } else {
#pragma unroll
        for (int i = 0; i < 16; ++i)
#pragma unroll
            for (int j = 0; j < 4; ++j) v[i][j] = (col + j < ncols) ? src[(size_t)(4 * i) * ldw + j] : 0.f;
    }
    wave_barrier();
#pragma unroll
    for (int i = 0; i < 16; ++i) { u32x2 o; o[0] = pk2(v[i][0], v[i][1]); o[1] = pk2(v[i][2], v[i][3]); *(LAS u32x2*)(img + (4 * i + kr) * VROWB + n * 2) = o; }
    wave_barrier();
    const lds_u8* tb = img + ((lane & 15) >> 2) * VROWB + (16 * (lane >> 4) + 4 * (lane & 3)) * 2;
    bf16_t* dst = WT + (size_t)(r0 + lane) * ldt + k0;
#pragma unroll
    for (int kc = 0; kc < 8; ++kc) {
        const s16x4 lo = tr16(tb + (8 * kc) * VROWB), hi4 = tr16(tb + (8 * kc + 4) * VROWB);
        u32x4 o; o[0] = (unsigned)(unsigned short)lo[0] | ((unsigned)(unsigned short)lo[1] << 16); o[1] = (unsigned)(unsigned short)lo[2] | ((unsigned)(unsigned short)lo[3] << 16);
        o[2] = (unsigned)(unsigned short)hi4[0] | ((unsigned)(unsigned short)hi4[1] << 16); o[3] = (unsigned)(unsigned short)hi4[2] | ((unsigned)(unsigned short)hi4[3] << 16);
        *(u32x4*)(dst + 8 * kc) = o;
    }
}
constexpr int WI_IN = (D / 64) * ((IN_W + 63) / 64), WI_OUT = (MIXW / 64) * (D / 64), WI_GU = (D / 64) * (2 * DE / 64), WI_DN = (DE / 64) * (D / 64);
constexpr int WI_DENSE = WI_IN + WI_OUT, WI_EXPERT = WI_GU + WI_DN, WI_LAYER = WI_DENSE + NE * WI_EXPERT;
__device__ __forceinline__ void weight_item(const Params& p, int l, int r, lds_u8* img, int lane) {
    if (r < WI_IN) { const int nb = (IN_W + 63) / 64, c0 = (r % nb) * 64; const float* W = p.w_in + (size_t)l * D * IN_W;
        transpose_item64(W, W, IN_W, IN_W, c0, c0 + 32, (r / nb) * 64, (bf16_t*)(p.ws + WS_WIN) + (size_t)l * PW * D, D, c0, img, lane); return; }
    r -= WI_IN;
    if (r < WI_OUT) { const int nb = D / 64, c0 = (r % nb) * 64; const float* W = p.w_out + (size_t)l * MIXW * D;
        transpose_item64(W, W, D, D, c0, c0 + 32, (r / nb) * 64, (bf16_t*)(p.ws + WS_WOUT) + (size_t)l * D * MIXW, MIXW, c0, img, lane); return; }
    r -= WI_OUT;
    const int e = r / WI_EXPERT; r %= WI_EXPERT;
    if (r < WI_GU) { const int nb = 2 * DE / 64, r0 = (r % nb) * 64;
        const int c0 = (r0 / 256) * 128 + ((r0 % 256) / 64) * 32;
        transpose_item64(p.w_gate + (size_t)(l * NE + e) * D * DE, p.w_up + (size_t)(l * NE + e) * D * DE, DE, DE, c0, c0, (r / nb) * 64, (bf16_t*)(p.ws + WS_WGU) + (size_t)(l * NE + e) * 2 * DE * D, D, r0, img, lane); return; }
    r -= WI_GU;
    { const int nb = D / 64, c0 = (r % nb) * 64; const float* W = p.w_down + (size_t)(l * NE + e) * DE * D;
        transpose_item64(W, W, D, D, c0, c0 + 32, (r / nb) * 64, (bf16_t*)(p.ws + WS_WDN) + (size_t)(l * NE + e) * D * DE, DE, c0, img, lane); }
}
__device__ __forceinline__ void phase_init(const Params& p, float* lds) {
    unsigned* ctl = (unsigned*)(p.ws + WS_CTL);
    if (blockIdx.x == 0) for (int i = threadIdx.x; i < CTL_WORDS; i += NT) ctl[i] = 0u;
    f32x2* rot = (f32x2*)(p.ws + WS_ROT);
    for (int i = blockIdx.x * NT + threadIdx.x; i < S * 32; i += gridDim.x * NT) {
        const int pos = i >> 5, j = i & 31;
        const double turns = (double)pos * inv_turns(j);
        const double fr = turns - floor(turns);
        f32x2 cs; cs[0] = cos2pi((float)fr); cs[1] = sin2pi((float)fr);
        rot[i] = cs;
    }
    const int lane = threadIdx.x & 63, wave = threadIdx.x >> 6;
    {
        lds_u8* img = (lds_u8*)lds + wave * RET_WAVE_LDS;
        for (int it = blockIdx.x * NW + wave; it < DEPTH * WI_DENSE; it += gridDim.x * NW) weight_item(p, it / WI_DENSE, it % WI_DENSE, img, lane);
    }
    bf16_t* H = (bf16_t*)(p.ws + WS_H);
    for (int r = blockIdx.x * NW + wave; r < S; r += gridDim.x * NW) {
        f32x4 v[RJ]; row_load(p.x + (size_t)r * D, v, lane);
        const float ri = row_rinv(v);
#pragma unroll
        for (int j = 0; j < RJ; ++j) {
            const f32x4 g = *(const f32x4*)(p.norm_mix + 256 * j + lane * 4);
            u32x2 o; o[0] = pk2(v[j][0] * ri * g[0], v[j][1] * ri * g[1]); o[1] = pk2(v[j][2] * ri * g[2], v[j][3] * ri * g[3]);
            *(u32x2*)(H + (size_t)r * D + 256 * j + lane * 4) = o;
        }
    }
}

constexpr int GBM = 256, GBK = 64, TILE_B = GBM * GBK * 2, STAGE_B = 2 * TILE_B, GEMM_LDS = 2 * STAGE_B;
__device__ __forceinline__ int lds_byte(int r, int c) { const int st = (r >> 4) * 2 + (c >> 5), ob = (r & 15) * 64 + (c & 31) * 2; return st * 1024 + (ob ^ (((ob >> 9) & 1) << 5)); }
__device__ __forceinline__ void stage_rc(int b, int& R, int& C) { const int st = b >> 10, sb = b & 1023, swz = sb ^ (((sb >> 9) & 1) << 5); R = (st >> 1) * 16 + swz / 64; C = (st & 1) * 32 + (swz % 64) / 2; }
__device__ __forceinline__ void stage_coords(int& sR, int& sC) { stage_rc((threadIdx.x >> 6) * 1024 + (threadIdx.x & 63) * 16, sR, sC); }
__device__ __forceinline__ void gemm256(f32x4 (&acc)[8][4], lds_u8* lds, const bf16_t* Ab, const unsigned (&ao)[4], const bf16_t* Bb, unsigned bo0, unsigned bstep, int K) {
    const int tid = threadIdx.x, wid = tid >> 6, lane = tid & 63, wr = wid >> 2, wc = wid & 3, fr = lane & 15, fq = lane >> 4;
    lds_u8* ldsw = lds + wid * 1024;
    const int aoff = lds_byte(wr * 128 + fr, fq * 8), boff = TILE_B + lds_byte(wc * 64 + fr, fq * 8);
#pragma unroll
    for (int m = 0; m < 8; ++m)
#pragma unroll
        for (int n = 0; n < 4; ++n) acc[m][n] = (f32x4){0.f, 0.f, 0.f, 0.f};
#define GEMM_STAGE(buf, kt) do { _Pragma("unroll") for (int i_ = 0; i_ < 4; ++i_) { \
        glds16((const char*)Ab + (size_t)((kt) * (GBK * 2)) + ao[i_], ldsw + (buf) * STAGE_B + i_ * 8192); \
        glds16((const char*)Bb + ((size_t)((kt) * (GBK * 2)) + (size_t)i_ * bstep) + bo0, ldsw + (buf) * STAGE_B + TILE_B + i_ * 8192); } } while (0)
    const int nt = K / GBK;
    GEMM_STAGE(0, 0); vm_wait0(); __syncthreads();
    for (int t = 0; t < nt; ++t) {
        const int cur = t & 1;
        if (t + 1 < nt) GEMM_STAGE(cur ^ 1, t + 1);
        const lds_u8* base = lds + cur * STAGE_B;
#pragma unroll
        for (int ks = 0; ks < 2; ++ks) {
            bf16x8 At[8], Bf[4];
#pragma unroll
            for (int m = 0; m < 8; ++m) At[m] = *(const LAS bf16x8*)(base + aoff + m * 2048 + ks * 1024);
#pragma unroll
            for (int n = 0; n < 4; ++n) Bf[n] = *(const LAS bf16x8*)(base + boff + n * 2048 + ks * 1024);
#pragma unroll
            for (int m = 0; m < 8; ++m)
#pragma unroll
                for (int n = 0; n < 4; ++n) acc[m][n] = mfma16(Bf[n], At[m], acc[m][n]);
            sched_fence();
        }
        vm_wait0(); __syncthreads();
    }
#undef GEMM_STAGE
}
__device__ __forceinline__ int vcu_id() { const int G = gridDim.x, b = blockIdx.x; return (G % 8 == 0) ? (b % 8) * (G / 8) + b / 8 : b; }

__device__ __forceinline__ void phase_inproj(const Params& p, int l, float* ldsf) {
    lds_u8* lds = (lds_u8*)ldsf;
    const bf16_t* H = (const bf16_t*)(p.ws + WS_H);
    const bf16_t* WT = (const bf16_t*)(p.ws + WS_WIN) + (size_t)l * PW * D;
    bf16_t* P = (bf16_t*)(p.ws + WS_PROJ);
    float* LOGF = (float*)(p.ws + WS_LOGF);
    unsigned* ctl = (unsigned*)(p.ws + WS_CTL);
    const f32x2* rot = (const f32x2*)(p.ws + WS_ROT);
    const float* bfg = p.b_forget + l * NFOX;
    constexpr int NPM = S / GBM, NPN = PW / GBM;
    const int tid = threadIdx.x, wid = tid >> 6, lane = tid & 63, wr = wid >> 2, wc = wid & 3, fr = lane & 15, fq = lane >> 4;
    int sR, sC; stage_coords(sR, sC);
    for (int u = vcu_id(); u < NPM * NPN; u += gridDim.x) {
        const int pm = u / NPN, pn = u % NPN;
        unsigned ao[4];
#pragma unroll
        for (int i = 0; i < 4; ++i) ao[i] = (unsigned)(((sR + 64 * i) * D + sC) * 2);
        f32x4 acc[8][4];
        gemm256(acc, lds, H + (size_t)pm * GBM * D, ao, WT + (size_t)pn * GBM * D, (unsigned)((sR * D + sC) * 2), (unsigned)(64 * D * 2), D);
        const int gc0 = pn * GBM + wc * 64;
        if (gc0 >= IN_W) continue;
        const int row0 = pm * GBM + wr * 128 + fr;
        if (gc0 >= OFL) {
#pragma unroll
            for (int m = 0; m < 8; ++m)
#pragma unroll
                for (int j = 0; j < 4; ++j) { const int h = 4 * fq + j; if (h < NFOX) LOGF[(size_t)(row0 + m * 16) * 8 + h] = log_sigmoid(acc[m][0][j] + bfg[h]); }
            continue;
        }
        const bool rotary = gc0 < OVR, is_gate = (gc0 >= OGR && gc0 < OQS), is_kf = (gc0 >= OKF && gc0 < OVF);
        const float scale = (gc0 < OKR || (gc0 >= OQS && gc0 < OKS) || (gc0 >= OQF && gc0 < OKF)) ? 0.125f : 1.0f;
        float kmx = 0.f;
#pragma unroll
        for (int m = 0; m < 8; ++m) {
            const int row = row0 + m * 16;
            if (rotary) {
#pragma unroll
                for (int n = 0; n < 2; ++n) {
                    const f32x4 c01 = *(const f32x4*)(rot + (size_t)row * 32 + n * 16 + 4 * fq), c23 = *(const f32x4*)(rot + (size_t)row * 32 + n * 16 + 4 * fq + 2);
                    const float cs[4] = {c01[0], c01[2], c23[0], c23[2]}, sn[4] = {c01[1], c01[3], c23[1], c23[3]};
#pragma unroll
                    for (int j = 0; j < 4; ++j) { const float x1 = acc[m][n][j], x2 = acc[m][n + 2][j]; acc[m][n][j] = x1 * cs[j] - x2 * sn[j]; acc[m][n + 2][j] = x1 * sn[j] + x2 * cs[j]; }
                }
            }
            float ss = 0.f;
#pragma unroll
            for (int n = 0; n < 4; ++n) {
                f32x4 v = acc[m][n] * scale;
                if (is_gate) {
#pragma unroll
                    for (int j = 0; j < 4; ++j) v[j] = silu(v[j]);
                }
                u32x2 o; o[0] = pk2(v[0], v[1]); o[1] = pk2(v[2], v[3]);
                if (is_kf) {
#pragma unroll
                    for (int j = 0; j < 4; ++j) { const float r = bf2f(f2bf(v[j])); ss += r * r; }
                }
                *(u32x2*)(P + (size_t)row * PW + gc0 + n * 16 + 4 * fq) = o;
            }
            if (is_kf) { ss += __shfl_xor(ss, 16); ss += __shfl_xor(ss, 32); kmx = fmaxf(kmx, ss); }
        }
        if (is_kf) { kmx = wave_max(kmx); if (lane == 0) atomicMax(ctl + CTL_KMAX + l * 8 + (gc0 - OKF) / HD, f2u(kmx)); }
    }
}

__device__ __forceinline__ float ret_log_gamma(int h) { return logf(1.0f - exp2f(-5.0f - (float)h)); }
__device__ __forceinline__ void ret_prep_item(const Params& p, int h, int n, lds_u8* wl) {
    const bf16_t* P = (const bf16_t*)(p.ws + WS_PROJ);
    float* UT = (float*)(p.ws + WS_U);
    const int lane = threadIdx.x & 63, r32 = lane & 31, hi = lane >> 5;
    const float lg = ret_log_gamma(h);
    wave_barrier();
#pragma unroll
    for (int i = 0; i < 8; ++i) {
        const int c = lane + 64 * i, row = c >> 3, ch = c & 7;
        const bf16_t* src = P + (size_t)(n * CH + row) * PW + h * HD + 8 * ch;
        const u32x4 kv = *(const u32x4*)(src + OKR), vv = *(const u32x4*)(src + OVR);
        const float dk = fast_exp(lg * (float)(CH - 1 - row));
        u32x4 ko;
#pragma unroll
        for (int w = 0; w < 4; ++w) ko[w] = pk2(u2f(kv[w] << 16) * dk, u2f(kv[w] & 0xffff0000u) * dk);
        *(LAS u32x4*)(wl + row * VROWB + ch * 16) = ko;
        *(LAS u32x4*)(wl + IMG64 + row * VROWB + ch * 16) = vv;
    }
    wave_barrier();
    const lds_u8* tb = wl + (8 * hi + ((lane & 15) >> 2)) * VROWB + (16 * ((lane >> 4) & 1) + 4 * (lane & 3)) * 2;
    f32x16 acc[2][2];
#pragma unroll
    for (int a = 0; a < 2; ++a)
#pragma unroll
        for (int b = 0; b < 2; ++b)
#pragma unroll
            for (int r = 0; r < 16; ++r) acc[a][b][r] = 0.f;
#pragma unroll
    for (int s = 0; s < 4; ++s) {
        bf16x8 vf[2], kf[2];
#pragma unroll
        for (int x = 0; x < 2; ++x) { kf[x] = tr_frag(tb, 16 * s, 16 * s + 4, x * 64); vf[x] = tr_frag(tb + IMG64, 16 * s, 16 * s + 4, x * 64); }
#pragma unroll
        for (int eb = 0; eb < 2; ++eb)
#pragma unroll
            for (int db = 0; db < 2; ++db) acc[eb][db] = mfma32(vf[eb], kf[db], acc[eb][db]);
    }
    float* dst = UT + (size_t)(h * NCHUNK + n) * 4096;
#pragma unroll
    for (int eb = 0; eb < 2; ++eb)
#pragma unroll
        for (int db = 0; db < 2; ++db)
#pragma unroll
            for (int r = 0; r < 16; ++r) dst[(32 * eb + crow(r, hi)) * 64 + 32 * db + r32] = acc[eb][db][r];
}
__device__ __forceinline__ void phase_prep(const Params& p, int l, float* ldsf) {
    const int wave = threadIdx.x >> 6;
    lds_u8* wl = (lds_u8*)ldsf + wave * RET_WAVE_LDS;
    for (int it = blockIdx.x * NW + wave; it < NRET * NCHUNK; it += gridDim.x * NW) ret_prep_item(p, it / NCHUNK, it % NCHUNK, wl);
}

constexpr int NQ32 = S / 32;
constexpr int MIX_WAVE_LDS = 32 * VROWB + 256;
__device__ __forceinline__ void ret_scan_wave(const Params& p, int item) {
    const float* U = (const float*)(p.ws + WS_U);
    bf16_t* SP = (bf16_t*)(p.ws + WS_SP);
    const int e = item * 64 + (threadIdx.x & 63);
    const int h = e >> 12, de = e & 4095;
    const float c = expf(ret_log_gamma(h) * (float)CH);
    float st = 0.f;
    const size_t base = (size_t)h * NCHUNK * 4096 + de;
#pragma unroll 8
    for (int n = 0; n < NCHUNK; ++n) { const float u = U[base + (size_t)n * 4096]; SP[base + (size_t)n * 4096] = f2bf(st); st = st * c + u; }
}
template <bool FOX>
__device__ __forceinline__ void attn_item(const Params& p, int l, int h, int qb, lds_u8* wl) {
    const bf16_t* P = (const bf16_t*)(p.ws + WS_PROJ);
    const float* LOGF = (const float*)(p.ws + WS_LOGF);
    bf16_t* MG = (bf16_t*)(p.ws + WS_MERGED);
    const int lane = threadIdx.x & 63, r32 = lane & 31, hi = lane >> 5;
    const int q0 = qb * 32, t = q0 + r32;
    constexpr int oq = FOX ? OQF : OQS, ok = FOX ? OKF : OKS, ov = FOX ? OVF : OVS;
    bf16x8 qf[4];
    { const bf16_t* qp = P + (size_t)t * PW + oq + h * HD + 8 * hi;
#pragma unroll
      for (int ks = 0; ks < 4; ++ks) qf[ks] = *(const bf16x8*)(qp + 16 * ks); }
    float Bt = 0.f;
    if (FOX) {
        float qq = 0.f;
#pragma unroll
        for (int ks = 0; ks < 4; ++ks)
#pragma unroll
            for (int j = 0; j < 8; ++j) { const float v = bf2f((bf16_t)qf[ks][j]); qq += v * v; }
        qq += __shfl_xor(qq, 32);
        const float kmax = sqrtf(u2f(((const unsigned*)(p.ws + WS_CTL))[CTL_KMAX + l * 8 + h]));
        Bt = sqrtf(qq) * kmax * 1.0001f + 1e-6f;
    }
    float fq = 0.f, m = -1e30f, lsum = 0.f, carry = 0.f, Fc = 0.f;
    f32x16 o0, o1;
#pragma unroll
    for (int r = 0; r < 16; ++r) { o0[r] = 0.f; o1[r] = 0.f; }
    LAS float* frl = (LAS float*)(wl + 32 * VROWB);
    const lds_u8* vb = wl + (4 * hi + ((lane & 15) >> 2)) * VROWB + (16 * ((lane >> 4) & 1) + 4 * (lane & 3)) * 2;
    for (int kt = qb; kt >= 0; --kt) {
        const int key0 = kt * 32;
        const bool diag = (kt == qb);
        bf16x8 kf[4];
        { const bf16_t* kp = P + (size_t)(key0 + r32) * PW + ok + h * HD + 8 * hi;
#pragma unroll
          for (int ks = 0; ks < 4; ++ks) kf[ks] = *(const bf16x8*)(kp + 16 * ks); }
        u32x4 vr[4];
#pragma unroll
        for (int i = 0; i < 4; ++i) { const int c = lane + 64 * i; vr[i] = *(const u32x4*)(P + (size_t)(key0 + (c >> 3)) * PW + ov + h * HD + 8 * (c & 7)); }
        float lf = 0.f;
        if (FOX) lf = -LOGF[(size_t)(key0 + r32) * 8 + h];
        f32x16 st;
#pragma unroll
        for (int r = 0; r < 16; ++r) st[r] = 0.f;
#pragma unroll
        for (int ks = 0; ks < 4; ++ks) st = mfma32(kf[ks], qf[ks], st);
        wave_barrier();
#pragma unroll
        for (int i = 0; i < 4; ++i) { const int c = lane + 64 * i; *(LAS u32x4*)(wl + (c >> 3) * VROWB + (c & 7) * 16) = vr[i]; }
        if (FOX) {
            float inc = lf;
#pragma unroll
            for (int d = 1; d < 32; d <<= 1) { const float o_ = __shfl_down(inc, d); if (r32 + d < 32) inc += o_; }
            const float exc = Fc + inc - lf;
            const float tot = __shfl(inc, 0);
            if (diag) fq = exc;
            if (lane < 32) frl[lane] = exc;
            wave_barrier();
            float tmax = -1e30f;
#pragma unroll
            for (int g4 = 0; g4 < 4; ++g4) {
                const f32x4 fr4 = *(const LAS f32x4*)(frl + 8 * g4 + 4 * hi);
#pragma unroll
                for (int i = 0; i < 4; ++i) { const int r = 4 * g4 + i; float lg = st[r] + fq - fr4[i]; if (diag && crow(r, hi) > r32) lg = -1e30f; st[r] = lg; tmax = fmaxf(tmax, lg); }
            }
            Fc += tot;
            tmax = fmaxf(tmax, __shfl_xor(tmax, 32));
            const float mn = fmaxf(m, tmax), f = fast_exp(m - mn);
            m = mn; lsum *= f;
#pragma unroll
            for (int r = 0; r < 16; ++r) { o0[r] *= f; o1[r] *= f; }
            float ps = 0.f;
#pragma unroll
            for (int r = 0; r < 16; ++r) { const float pr = fast_exp(st[r] - mn); st[r] = pr; ps += pr; }
            lsum += ps;
        } else {
            float l1m[16];
#pragma unroll
            for (int r = 0; r < 16; ++r) {
                const float z = st[r], sp = fast_log(1.0f + fast_exp(-fabsf(z)));
                const float lb = fminf(z, 0.f) - sp;
                const bool masked = diag && crow(r, hi) >= r32;
                l1m[r] = masked ? 0.f : lb - z;
                st[r] = masked ? -1e30f : lb;
            }
            float gs[4], pg[4], T[4];
#pragma unroll
            for (int k = 0; k < 4; ++k) { gs[k] = (l1m[4 * k] + l1m[4 * k + 1]) + (l1m[4 * k + 2] + l1m[4 * k + 3]); pg[k] = __shfl_xor(gs[k], 32); }
            float run = 0.f;
#pragma unroll
            for (int k = 3; k >= 0; --k) { T[k] = run + (hi == 0 ? pg[k] : 0.f); run += gs[k] + pg[k]; }
#pragma unroll
            for (int k = 0; k < 4; ++k) {
                float w = T[k] + carry;
#pragma unroll
                for (int i = 3; i >= 0; --i) { const int r = 4 * k + i; st[r] = fast_exp(st[r] + w); w += l1m[r]; }
            }
            carry += run;
        }
        bf16x8 pf0, pf1;
#pragma unroll
        for (int j = 0; j < 8; ++j) { pf0[j] = (short)f2bf(st[j]); pf1[j] = (short)f2bf(st[8 + j]); }
        wave_barrier();
#pragma unroll
        for (int s = 0; s < 2; ++s) {
#pragma unroll
            for (int db = 0; db < 2; ++db) {
                const s16x4 lo = tr16(vb + (16 * s) * VROWB + db * 64), hi4 = tr16(vb + (16 * s + 8) * VROWB + db * 64);
                bf16x8 vf; vf[0] = lo[0]; vf[1] = lo[1]; vf[2] = lo[2]; vf[3] = lo[3]; vf[4] = hi4[0]; vf[5] = hi4[1]; vf[6] = hi4[2]; vf[7] = hi4[3];
                if (db == 0) o0 = mfma32(vf, s == 0 ? pf0 : pf1, o0); else o1 = mfma32(vf, s == 0 ? pf0 : pf1, o1);
            }
        }
        const bool done = FOX ? (Bt + fq - Fc - m + logf((float)(key0 + 1)) < -EXIT_T) : (carry < -EXIT_T);
        if (ballot64(done) == ~0ull) break;
    }
    if (FOX) { lsum += __shfl_xor(lsum, 32); const float il = 1.0f / lsum;
#pragma unroll
        for (int r = 0; r < 16; ++r) { o0[r] *= il; o1[r] *= il; } }
    float ss = 0.f;
#pragma unroll
    for (int r = 0; r < 16; ++r) ss += o0[r] * o0[r] + o1[r] * o1[r];
    ss += __shfl_xor(ss, 32);
    const float ri = 1.0f / sqrtf(ss * (1.0f / HD) + EPS);
    const float* g = (FOX ? p.g_fox + l * WFOX : p.g_sb + l * WSB) + h * HD;
    bf16_t* dst = MG + (size_t)t * MIXW + (FOX ? WRET + WSB : WRET) + h * HD;
#pragma unroll
    for (int db = 0; db < 2; ++db)
#pragma unroll
        for (int g4 = 0; g4 < 4; ++g4) {
            const int d0 = db * 32 + 8 * g4 + 4 * hi;
            const f32x4 gg = *(const f32x4*)(g + d0);
            float v[4];
#pragma unroll
            for (int i = 0; i < 4; ++i) v[i] = (db == 0 ? o0[4 * g4 + i] : o1[4 * g4 + i]) * ri * gg[i];
            u32x2 o; o[0] = pk2(v[0], v[1]); o[1] = pk2(v[2], v[3]);
            *(u32x2*)(dst + d0) = o;
        }
}
__device__ __forceinline__ void phase_mix(const Params& p, int l, float* ldsf) {
    constexpr int NSCANW = NRET * 4096 / 64, NFXI = NFOX * NQ32, NSBI = NSB * NQ32;
    const int wave = threadIdx.x >> 6;
    lds_u8* wl = (lds_u8*)ldsf + wave * RET_WAVE_LDS;
    static_assert(MIX_WAVE_LDS <= RET_WAVE_LDS, "per-wave LDS region");
    for (int it = blockIdx.x * NW + wave; it < NSCANW + NFXI + NSBI; it += gridDim.x * NW) {
        if (it < NSCANW) ret_scan_wave(p, it);
        else if (it < NSCANW + NFXI) { const int j = it - NSCANW; attn_item<true>(p, l, j % NFOX, NQ32 - 1 - j / NFOX, wl); }
        else { const int j = it - NSCANW - NFXI; attn_item<false>(p, l, j % NSB, NQ32 - 1 - j / NSB, wl); }
    }
    unsigned* head = (unsigned*)(p.ws + WS_CTL) + CTL_WQ + 64 * l;
    const int lane = threadIdx.x & 63;
    lds_u8* img = (lds_u8*)ldsf + wave * RET_WAVE_LDS;
    for (;;) {
        unsigned it = 0;
        if (lane == 0) it = atomicAdd(head, 1u);
        it = __shfl(it, 0);
        if (it >= (unsigned)(NE * WI_EXPERT)) break;
        weight_item(p, l, WI_DENSE + (int)it, img, lane);
    }
}

__device__ __forceinline__ void ret_out_item(const Params& p, int l, int h, int n, int cb, lds_u8* wl) {
    const bf16_t* P = (const bf16_t*)(p.ws + WS_PROJ);
    const bf16_t* SPT = (const bf16_t*)(p.ws + WS_SP) + (size_t)(h * NCHUNK + n) * 4096;
    bf16_t* MG = (bf16_t*)(p.ws + WS_MERGED);
    const int lane = threadIdx.x & 63, r32 = lane & 31, hi = lane >> 5;
    const float lg = ret_log_gamma(h);
    const size_t rowb = (size_t)(n * CH) * PW + h * HD;
    const int c = 32 * cb + r32;
    wave_barrier();
    {
        u32x4 vv[8];
#pragma unroll
        for (int i = 0; i < 8; ++i) { const int q = lane + 64 * i; vv[i] = *(const u32x4*)(P + rowb + (size_t)(q >> 3) * PW + OVR + 8 * (q & 7)); }
#pragma unroll
        for (int i = 0; i < 8; ++i) { const int q = lane + 64 * i; *(LAS u32x4*)(wl + (q >> 3) * VROWB + (q & 7) * 16) = vv[i]; }
    }
    sched_fence();
    bf16x8 qf[4];
#pragma unroll
    for (int ks = 0; ks < 4; ++ks) qf[ks] = *(const bf16x8*)(P + rowb + (size_t)c * PW + OQR + 16 * ks + 8 * hi);
    f32x16 o[2];
#pragma unroll
    for (int a = 0; a < 2; ++a)
#pragma unroll
        for (int r = 0; r < 16; ++r) o[a][r] = 0.f;
#pragma unroll
    for (int ks = 0; ks < 4; ++ks)
#pragma unroll
        for (int eb = 0; eb < 2; ++eb) { const bf16x8 sf = *(const bf16x8*)(SPT + (32 * eb + r32) * 64 + 16 * ks + 8 * hi); o[eb] = mfma32(sf, qf[ks], o[eb]); }
    { const float qd = fast_exp(lg * (float)(c + 1));
#pragma unroll
      for (int eb = 0; eb < 2; ++eb)
#pragma unroll
          for (int r = 0; r < 16; ++r) o[eb][r] *= qd; }
    wave_barrier();
    const lds_u8* vb = wl + (4 * hi + ((lane & 15) >> 2)) * VROWB + (16 * ((lane >> 4) & 1) + 4 * (lane & 3)) * 2;
#pragma unroll
    for (int kb = 0; kb < 2; ++kb) {
        f32x16 st;
#pragma unroll
        for (int r = 0; r < 16; ++r) st[r] = 0.f;
#pragma unroll
        for (int ks = 0; ks < 4; ++ks) { const bf16x8 kf = *(const bf16x8*)(P + rowb + (size_t)(32 * kb + r32) * PW + OKR + 16 * ks + 8 * hi); st = mfma32(kf, qf[ks], st); }
        bf16x8 pf[2];
#pragma unroll
        for (int r = 0; r < 16; ++r) { const int dist = c - (32 * kb + crow(r, hi)); pf[r >> 3][r & 7] = (short)f2bf(st[r] * fast_exp(lg * fabsf((float)dist))); }
#pragma unroll
        for (int s = 0; s < 2; ++s)
#pragma unroll
            for (int eb = 0; eb < 2; ++eb) o[eb] = mfma32(tr_frag(vb, 32 * kb + 16 * s, 32 * kb + 16 * s + 8, eb * 64), pf[s], o[eb]);
    }
    float sm = 0.f;
#pragma unroll
    for (int eb = 0; eb < 2; ++eb)
#pragma unroll
        for (int r = 0; r < 16; ++r) sm += o[eb][r];
    sm += __shfl_xor(sm, 32);
    const float mu = sm * (1.0f / HD);
    float vs = 0.f;
#pragma unroll
    for (int eb = 0; eb < 2; ++eb)
#pragma unroll
        for (int r = 0; r < 16; ++r) { const float dlt = o[eb][r] - mu; o[eb][r] = dlt; vs += dlt * dlt; }
    vs += __shfl_xor(vs, 32);
    const float ri = 1.0f / sqrtf(vs * (1.0f / HD) + EPS);
    const int row = n * CH + c;
#pragma unroll
    for (int eb = 0; eb < 2; ++eb)
#pragma unroll
        for (int g4 = 0; g4 < 4; ++g4) {
            const int e0 = 32 * eb + 8 * g4 + 4 * hi;
            const f32x4 gg = *(const f32x4*)(p.g_ret + l * WRET + h * HD + e0);
            const u32x2 gt = *(const u32x2*)(P + (size_t)row * PW + OGR + h * HD + e0);
            const float ga[4] = {u2f(gt[0] << 16), u2f(gt[0] & 0xffff0000u), u2f(gt[1] << 16), u2f(gt[1] & 0xffff0000u)};
            float v[4];
#pragma unroll
            for (int i = 0; i < 4; ++i) v[i] = o[eb][4 * g4 + i] * ri * gg[i] * ga[i];
            u32x2 ov; ov[0] = pk2(v[0], v[1]); ov[1] = pk2(v[2], v[3]);
            *(u32x2*)(MG + (size_t)row * MIXW + h * HD + e0) = ov;
        }
}
__device__ __forceinline__ void phase_retout(const Params& p, int l, float* ldsf) {
    const int wave = threadIdx.x >> 6;
    lds_u8* wl = (lds_u8*)ldsf + wave * RET_WAVE_LDS;
    for (int it = blockIdx.x * NW + wave; it < NRET * NCHUNK * 2; it += gridDim.x * NW) ret_out_item(p, l, (it >> 1) / NCHUNK, (it >> 1) % NCHUNK, it & 1, wl);
}

__device__ __forceinline__ void phase_outproj(const Params& p, int l, float* ldsf) {
    lds_u8* lds = (lds_u8*)ldsf;
    const bf16_t* MG = (const bf16_t*)(p.ws + WS_MERGED);
    const bf16_t* WT = (const bf16_t*)(p.ws + WS_WOUT) + (size_t)l * D * MIXW;
    float* X = (float*)(p.ws + WS_X);
    const float* xin = l == 0 ? p.x : X;
    constexpr int NPM = S / GBM, NPN = D / GBM;
    const int tid = threadIdx.x, wid = tid >> 6, lane = tid & 63, wr = wid >> 2, wc = wid & 3, fr = lane & 15, fq = lane >> 4;
    int sR, sC; stage_coords(sR, sC);
    for (int u = vcu_id(); u < NPM * NPN; u += gridDim.x) {
        const int pm = u / NPN, pn = u % NPN;
        unsigned ao[4];
#pragma unroll
        for (int i = 0; i < 4; ++i) ao[i] = (unsigned)(((sR + 64 * i) * MIXW + sC) * 2);
        f32x4 acc[8][4];
        gemm256(acc, lds, MG + (size_t)pm * GBM * MIXW, ao, WT + (size_t)pn * GBM * MIXW, (unsigned)((sR * MIXW + sC) * 2), (unsigned)(64 * MIXW * 2), MIXW);
#pragma unroll
        for (int m = 0; m < 8; ++m)
#pragma unroll
            for (int n = 0; n < 4; ++n) { const size_t o = (size_t)(pm * GBM + wr * 128 + m * 16 + fr) * D + pn * GBM + wc * 64 + n * 16 + 4 * fq;
                *(f32x4*)(X + o) = *(const f32x4*)(xin + o) + acc[m][n]; }
    }
}

constexpr int RW = D + 4;
constexpr int ROUTE_LDS = NROUTE * RW * 4 + 2 * NE * 4 + 2 * 256 * 4;
template <bool DRY = false>
__device__ __forceinline__ void phase_route(const Params& p, int l, float* lds) {
    const float* X = (const float*)(p.ws + WS_X);
    bf16_t* H = (bf16_t*)(p.ws + WS_H);
    unsigned* ctl = (unsigned*)(p.ws + WS_CTL);
    int* LIST = (int*)(p.ws + WS_LIST);
    float* GATE = (float*)(p.ws + WS_GATE);
    const float* gn = p.norm_ffn + l * D;
    const float* wg = p.w_group + (size_t)l * D * NG; const float* wr = p.w_router + (size_t)l * D * NE;
    const float* bg = p.b_group + l * NG; const float* br = p.b_router + l * NE;
    const int lane = threadIdx.x & 63, wave = threadIdx.x >> 6;
    unsigned* lcnt = (unsigned*)(lds + NROUTE * RW); unsigned* lbase = lcnt + NE; unsigned* lrec = lbase + NE;
    __syncthreads();
    if (threadIdx.x < NE) lcnt[threadIdx.x] = 0u;
    for (int i = threadIdx.x; i < D * NG; i += NT) lds[(i % NG) * RW + i / NG] = wg[i];
    for (int i = threadIdx.x; i < D * NE; i += NT) lds[(NG + i % NE) * RW + i / NE] = wr[i];
    __syncthreads();
    for (int r = blockIdx.x * NW + wave; r < S; r += gridDim.x * NW) {
        f32x4 v[RJ]; row_load(X + (size_t)r * D, v, lane);
        const float ri = row_rinv(v);
#pragma unroll
        for (int j = 0; j < RJ; ++j) {
            const f32x4 g = *(const f32x4*)(gn + 256 * j + lane * 4);
            v[j] = v[j] * ri * g;
            u32x2 o; o[0] = pk2(v[j][0], v[j][1]); o[1] = pk2(v[j][2], v[j][3]);
            *(u32x2*)(H + (size_t)r * D + 256 * j + lane * 4) = o;
        }
        float gl[NG];
#pragma unroll
        for (int g = 0; g < NG; ++g) { float s = 0.f;
#pragma unroll
            for (int j = 0; j < RJ; ++j) { const f32x4 w = *(const f32x4*)(lds + g * RW + 256 * j + lane * 4); s += (v[j][0] * w[0] + v[j][1] * w[1]) + (v[j][2] * w[2] + v[j][3] * w[3]); }
            gl[g] = s; }
#pragma unroll
        for (int g = 0; g < NG; ++g) gl[g] = wave_sum(gl[g]) + bg[g];
        int grp = 0; float gm = gl[0];
#pragma unroll
        for (int g = 1; g < NG; ++g) if (gl[g] > gm) { gm = gl[g]; grp = g; }
        float den = 0.f;
#pragma unroll
        for (int g = 0; g < NG; ++g) den += expf(gl[g] - gm);
        const float pg = 1.0f / den;
        float el[EPG];
        const float* wl = lds + (NG + grp * EPG) * RW + lane * 4;
#pragma unroll
        for (int e = 0; e < EPG; ++e) { float s = 0.f;
#pragma unroll
            for (int j = 0; j < RJ; ++j) { const f32x4 w = *(const f32x4*)(wl + e * RW + 256 * j); s += (v[j][0] * w[0] + v[j][1] * w[1]) + (v[j][2] * w[2] + v[j][3] * w[3]); }
            el[e] = s; }
#pragma unroll
        for (int e = 0; e < EPG; ++e) el[e] = wave_sum(el[e]) + br[grp * EPG + e];
        if (lane == 0 && !(DRY && el[0] != 12345.f)) {
            int i1 = 0; float v1 = -INFINITY; int i2 = 0; float v2 = -INFINITY;
#pragma unroll
            for (int e = 0; e < EPG; ++e) { const float x = el[e];
                if (x > v1) { v2 = v1; i2 = i1; v1 = x; i1 = e; } else if (x > v2) { v2 = x; i2 = e; } }
            const float e2 = expf(v2 - v1), g1 = pg / (1.f + e2), g2 = pg * e2 / (1.f + e2);
            const int ea = grp * EPG + i1, eb = grp * EPG + i2;
            GATE[(size_t)r * 2] = g1; GATE[(size_t)r * 2 + 1] = g2;
            const int li = (r - blockIdx.x * NW) / (gridDim.x * NW) * NW + wave;
            const unsigned ra = atomicAdd(lcnt + ea, 1u), rb = atomicAdd(lcnt + eb, 1u);
            lrec[2 * li] = (unsigned)ea | (ra << 8); lrec[2 * li + 1] = (unsigned)eb | (rb << 8);
        }
    }
    if (!DRY) {
        __syncthreads();
        if (threadIdx.x < NE) lbase[threadIdx.x] = atomicAdd(ctl + CTL_CNT + l * NE + threadIdx.x, lcnt[threadIdx.x]);
        __syncthreads();
        const int nrows = (S - blockIdx.x * NW + gridDim.x * NW - 1) / (gridDim.x * NW) * NW;
        for (int i = threadIdx.x; i < 2 * nrows; i += NT) {
            const int li = i >> 1, r = blockIdx.x * NW + (li / NW) * (gridDim.x * NW) + (li % NW);
            if (r < S) { const unsigned rec = lrec[i]; const int e = rec & 255u; LIST[(size_t)e * S + lbase[e] + (rec >> 8)] = r * 2 + (i & 1); }
        }
    }
}

__device__ __forceinline__ bool moe_unit(const unsigned* cnt, int u, int npn, int& e, int& rt, int& pn, int& base) {
    int tile = u / npn; pn = u % npn; base = 0;
    for (e = 0; e < NE; ++e) { const int nt = ((int)cnt[e] + GBM - 1) / GBM; if (tile < nt) { rt = tile; return true; } tile -= nt; base += nt * GBM; }
    return false;
}
__device__ __forceinline__ void phase_moe1(const Params& p, int l, float* ldsf) {
    lds_u8* lds = (lds_u8*)ldsf;
    const bf16_t* H = (const bf16_t*)(p.ws + WS_H);
    bf16_t* HID = (bf16_t*)(p.ws + WS_HID);
    const unsigned* cnt = (const unsigned*)(p.ws + WS_CTL) + CTL_CNT + l * NE;
    const int* LIST = (const int*)(p.ws + WS_LIST);
    constexpr int NPN = 2 * DE / GBM;
    const int tid = threadIdx.x, wid = tid >> 6, lane = tid & 63, wr = wid >> 2, wc = wid & 3, fr = lane & 15, fq = lane >> 4;
    int sR, sC; stage_coords(sR, sC);
    for (int u = vcu_id();; u += gridDim.x) {
        int e, rt, pn, base; if (!moe_unit(cnt, u, NPN, e, rt, pn, base)) break;
        const int nvalid = (int)cnt[e] - rt * GBM;
        const bf16_t* WT = (const bf16_t*)(p.ws + WS_WGU) + ((size_t)(l * NE + e) * 2 * DE + pn * GBM) * D;
        unsigned ao[4];
#pragma unroll
        for (int i = 0; i < 4; ++i) { const int r = sR + 64 * i; const int tok = r < nvalid ? (LIST[(size_t)e * S + rt * GBM + r] >> 1) : 0; ao[i] = (unsigned)((tok * D + sC) * 2); }
        f32x4 acc[8][4];
        gemm256(acc, lds, H, ao, WT, (unsigned)((sR * D + sC) * 2), (unsigned)(64 * D * 2), D);
#pragma unroll
        for (int m = 0; m < 8; ++m)
#pragma unroll
            for (int n = 0; n < 2; ++n) { f32x4 v;
#pragma unroll
                for (int j = 0; j < 4; ++j) v[j] = silu(acc[m][n][j]) * acc[m][n + 2][j];
                u32x2 o; o[0] = pk2(v[0], v[1]); o[1] = pk2(v[2], v[3]);
                *(u32x2*)(HID + (size_t)(base + rt * GBM + wr * 128 + m * 16 + fr) * DE + pn * 128 + wc * 32 + n * 16 + 4 * fq) = o; }
    }
}
__device__ __forceinline__ void phase_moe2(const Params& p, int l, float* ldsf) {
    lds_u8* lds = (lds_u8*)ldsf;
    const bf16_t* HID = (const bf16_t*)(p.ws + WS_HID);
    bf16_t* Y = (bf16_t*)(p.ws + WS_Y);
    const unsigned* cnt = (const unsigned*)(p.ws + WS_CTL) + CTL_CNT + l * NE;
    const int* LIST = (const int*)(p.ws + WS_LIST);
    const float* GATE = (const float*)(p.ws + WS_GATE);
    constexpr int NPN = D / GBM;
    const int tid = threadIdx.x, wid = tid >> 6, lane = tid & 63, wr = wid >> 2, wc = wid & 3, fr = lane & 15, fq = lane >> 4;
    int sR, sC; stage_coords(sR, sC);
    for (int u = vcu_id();; u += gridDim.x) {
        int e, rt, pn, base; if (!moe_unit(cnt, u, NPN, e, rt, pn, base)) break;
        const int nvalid = (int)cnt[e] - rt * GBM;
        const bf16_t* WT = (const bf16_t*)(p.ws + WS_WDN) + ((size_t)(l * NE + e) * D + pn * GBM) * DE;
        unsigned ao[4];
#pragma unroll
        for (int i = 0; i < 4; ++i) ao[i] = (unsigned)(((sR + 64 * i) * DE + sC) * 2);
        f32x4 acc[8][4];
        gemm256(acc, lds, HID + (size_t)(base + rt * GBM) * DE, ao, WT, (unsigned)((sR * DE + sC) * 2), (unsigned)(64 * DE * 2), DE);
#pragma unroll
        for (int m = 0; m < 8; ++m) {
            const int r = wr * 128 + m * 16 + fr;
            if (r < nvalid) {
                const int a = LIST[(size_t)e * S + rt * GBM + r]; const float g = GATE[a];
#pragma unroll
                for (int n = 0; n < 4; ++n) { const f32x4 v = acc[m][n] * g; u32x2 o; o[0] = pk2(v[0], v[1]); o[1] = pk2(v[2], v[3]);
                    *(u32x2*)(Y + (size_t)a * D + pn * GBM + wc * 64 + n * 16 + 4 * fq) = o; }
            }
        }
    }
}

__device__ __forceinline__ void phase_combine(const Params& p, int l) {
    float* X = (float*)(p.ws + WS_X);
    const bf16_t* Y = (const bf16_t*)(p.ws + WS_Y);
    bf16_t* H = (bf16_t*)(p.ws + WS_H);
    const bool last = (l == DEPTH - 1);
    const float* gn = last ? p.norm_final : p.norm_mix + (l + 1) * D;
    const int lane = threadIdx.x & 63, wave = threadIdx.x >> 6;
    for (int r = blockIdx.x * NW + wave; r < S; r += gridDim.x * NW) {
        f32x4 v[RJ]; row_load(X + (size_t)r * D, v, lane);
#pragma unroll
        for (int j = 0; j < RJ; ++j) {
            const u32x2 a = *(const u32x2*)(Y + (size_t)(2 * r) * D + 256 * j + lane * 4), b = *(const u32x2*)(Y + (size_t)(2 * r + 1) * D + 256 * j + lane * 4);
            v[j][0] += u2f(a[0] << 16) + u2f(b[0] << 16); v[j][1] += u2f(a[0] & 0xffff0000u) + u2f(b[0] & 0xffff0000u);
            v[j][2] += u2f(a[1] << 16) + u2f(b[1] << 16); v[j][3] += u2f(a[1] & 0xffff0000u) + u2f(b[1] & 0xffff0000u);
        }
        const float ri = row_rinv(v);
#pragma unroll
        for (int j = 0; j < RJ; ++j) {
            const f32x4 g = *(const f32x4*)(gn + 256 * j + lane * 4);
            if (last) *(f32x4*)(p.out + (size_t)r * D + 256 * j + lane * 4) = v[j] * ri * g;
            else {
                *(f32x4*)(X + (size_t)r * D + 256 * j + lane * 4) = v[j];
                u32x2 o; o[0] = pk2(v[j][0] * ri * g[0], v[j][1] * ri * g[1]); o[1] = pk2(v[j][2] * ri * g[2], v[j][3] * ri * g[3]);
                *(u32x2*)(H + (size_t)r * D + 256 * j + lane * 4) = o;
            }
        }
    }
}

constexpr int PH_PER_LAYER = 9, NPHASE = 1 + DEPTH * PH_PER_LAYER;
constexpr int imax_c(int a, int b) { return a > b ? a : b; }
constexpr int LDS_MAIN = imax_c(imax_c(GEMM_LDS, ROUTE_LDS), imax_c(NW * RET_WAVE_LDS, NW * MIX_WAVE_LDS));
constexpr int LDS_MISC = (LDS_MAIN + 255) / 256 * 256;
constexpr int LDS_BYTES = LDS_MISC + 256;

__device__ __forceinline__ void run_phase(const Params& p, int ph, float* lds) {
    if (ph == 0) { phase_init(p, lds); return; }
    const int l = (ph - 1) / PH_PER_LAYER, q = (ph - 1) % PH_PER_LAYER;
    switch (q) {
        case 0: phase_inproj(p, l, lds); break;
        case 1: phase_prep(p, l, lds); break;
        case 2: phase_mix(p, l, lds); break;
        case 3: phase_retout(p, l, lds); break;
        case 4: phase_outproj(p, l, lds); break;
        case 5: phase_route(p, l, lds); break;
        case 6: phase_moe1(p, l, lds); break;
        case 7: phase_moe2(p, l, lds); break;
        default: phase_combine(p, l); break;
    }
}

#ifndef CPU_EMU
#define XB_TMO      128
#define XB_XCNT(j)  (256  + 64 * (j))
#define XB_XSUB(j)  (1280 + 64 * (j))
#define XB_XGEN(j)  (2304 + 64 * (j))
#define XB_TOP      3328
#define XB_TOPGEN   3392
#define XCD_BAR_WORDS 3456
#define XB_SPIN_CAP (1u << 22)
__device__ __forceinline__ unsigned xb_ld(unsigned* p)              { return __hip_atomic_load(p, __ATOMIC_RELAXED, __HIP_MEMORY_SCOPE_AGENT); }
__device__ __forceinline__ unsigned xb_add(unsigned* p, unsigned v) { return __hip_atomic_fetch_add(p, v, __ATOMIC_RELAXED, __HIP_MEMORY_SCOPE_AGENT); }
__device__ __forceinline__ unsigned xb_xcc_id() { return (unsigned)__builtin_amdgcn_s_getreg((3 << 11) | 20) & 0xFu; }
#define XB_SPIN(cond, bar) do { unsigned _sp = 0; while (cond) { __builtin_amdgcn_s_sleep(1); \
    if ((++_sp & 255u) == 0u) { if (xb_ld(&(bar)[XB_TMO])) break; if (_sp > XB_SPIN_CAP) { atomicAdd(&(bar)[XB_TMO], 1u); break; } } } } while (0)
struct XcdBarrier { unsigned* bar; unsigned x; volatile LAS unsigned* st; };
__device__ __forceinline__ XcdBarrier xcd_barrier_post(unsigned* bar, volatile LAS unsigned* st) {
    XcdBarrier b; b.bar = bar; b.x = xb_xcc_id(); b.st = st;
    if (threadIdx.x == 0) (void)xb_add(&bar[XB_XCNT(b.x)], 1u);
    return b;
}
__device__ __forceinline__ void xcd_barrier_complete(unsigned* bar, unsigned x, unsigned& nloc, unsigned& nx) {
    const unsigned G = gridDim.x * gridDim.y * gridDim.z;
    unsigned sum, cnt, mine, sp = 0u;
    for (;;) {
        sum = 0u; cnt = 0u; mine = 0u;
#pragma unroll
        for (unsigned j = 0; j < 16; ++j) { const unsigned c = xb_ld(&bar[XB_XCNT(j)]); sum += c; cnt += (c > 0u) ? 1u : 0u; mine = (j == x) ? c : mine; }
        if (sum == G) break;
        __builtin_amdgcn_s_sleep(1);
        if ((++sp & 255u) == 0u) { if (xb_ld(&bar[XB_TMO])) break; if (sp > XB_SPIN_CAP) { atomicAdd(&bar[XB_TMO], 1u); break; } }
    }
    nloc = mine > 0u ? mine : 1u; nx = cnt > 0u ? cnt : 1u;
}
__device__ __forceinline__ void xcd_barrier(const XcdBarrier& b) {
    asm volatile("s_waitcnt vmcnt(0)" ::: "memory");
    __syncthreads();
    if (threadIdx.x == 0) {
        unsigned* bar = b.bar;
        __builtin_amdgcn_s_waitcnt(0);
        unsigned nloc = b.st[0], nx = b.st[1];
        if (nloc == 0u) { xcd_barrier_complete(bar, b.x, nloc, nx); b.st[0] = nloc; b.st[1] = nx; }
        const unsigned old = xb_add(&bar[XB_XSUB(b.x)], 1u);
        const unsigned gen = old / nloc;
        if (old + 1u == (gen + 1u) * nloc) {
            __builtin_amdgcn_fence(__ATOMIC_RELEASE, "agent");
            asm volatile("s_waitcnt vmcnt(0)" ::: "memory");
            const unsigned og = xb_add(&bar[XB_TOP], 1u);
            const unsigned tg = og / nx;
            if (og + 1u == (tg + 1u) * nx) xb_add(&bar[XB_TOPGEN], 1u);
            else XB_SPIN(xb_ld(&bar[XB_TOPGEN]) == tg, bar);
            __builtin_amdgcn_fence(__ATOMIC_ACQUIRE, "agent");
            xb_add(&bar[XB_XGEN(b.x)], 1u);
            asm volatile("s_waitcnt vmcnt(0)" ::: "memory");
        } else {
            XB_SPIN(xb_ld(&bar[XB_XGEN(b.x)]) == gen, bar);
            __builtin_amdgcn_fence(__ATOMIC_ACQUIRE, "agent");
            asm volatile("s_waitcnt vmcnt(0)" ::: "memory");
        }
    }
    __syncthreads();
}
#endif
#ifndef CPU_EMU
__global__ void __launch_bounds__(NT) fwd_kernel(Params p, int ph_lo, int ph_hi) {
    extern __shared__ __attribute__((aligned(16))) float lds[];
    cg::grid_group grid = cg::this_grid();
    volatile LAS unsigned* misc = (volatile LAS unsigned*)((LAS unsigned char*)lds + LDS_MISC);
    if (threadIdx.x < 64) misc[threadIdx.x] = 0u;
    __syncthreads();
    XcdBarrier xb; xb.bar = (unsigned*)(p.ws + WS_CTL) + CTL_BAR; xb.x = 0; xb.st = misc;
    const bool use_xb = (ph_lo == 0);
#define SEAM(k) do { if ((k) == 0 || !use_xb) { grid.sync(); if ((k) == 0 && use_xb) xb = xcd_barrier_post((unsigned*)(p.ws + WS_CTL) + CTL_BAR, misc); } else xcd_barrier(xb); } while (0)
#define PHASE(k, call) do { if (ph_lo <= (k) && (k) < ph_hi) { call; if ((k) + 1 < ph_hi) SEAM(k); } } while (0)
#ifndef PROBE_DUP
#define PROBE_DUP 0
#endif
#define DUP(bit, call) do { if ((PROBE_DUP & (bit)) && l_ == 0) { __syncthreads(); call; } } while (0)
#define LAYER(l) do { const int b_ = 1 + (l) * PH_PER_LAYER; const int l_ = (l); \
        PHASE(b_ + 0, phase_inproj(p, l, lds); DUP(1, phase_inproj(p, l, lds))); PHASE(b_ + 1, phase_prep(p, l, lds); DUP(2, phase_prep(p, l, lds))); PHASE(b_ + 2, phase_mix(p, l, lds); DUP(4, phase_mix(p, l, lds))); \
        PHASE(b_ + 3, phase_retout(p, l, lds); DUP(8, phase_retout(p, l, lds))); PHASE(b_ + 4, phase_outproj(p, l, lds); DUP(16, phase_outproj(p, l, lds))); PHASE(b_ + 5, phase_route(p, l, lds); DUP(128, phase_route<true>(p, l, lds))); \
        PHASE(b_ + 6, phase_moe1(p, l, lds); DUP(32, phase_moe1(p, l, lds))); PHASE(b_ + 7, phase_moe2(p, l, lds); DUP(64, phase_moe2(p, l, lds))); PHASE(b_ + 8, phase_combine(p, l); if ((PROBE_DUP & 256) && l_ == 1) phase_combine(p, l)); } while (0)
    PHASE(0, phase_init(p, lds); if (PROBE_DUP & 512) { __syncthreads(); phase_init(p, lds); });
    LAYER(0);
    LAYER(1);
    static_assert(DEPTH == 2, "phase program written for two layers");
#undef LAYER
#undef PHASE
#undef SEAM
}

#ifndef N_LAUNCH_PER_PHASE
#define N_LAUNCH_PER_PHASE 0
#endif
extern "C" void kernel_launch(void* const* d_in, const int* in_sizes, int n_in, void* d_out, int out_size, void* d_ws, size_t ws_size, hipStream_t stream) {
    static int grid = 0;
    if (grid == 0) {
        if (ws_size < WS_END) { fprintf(stderr, "kernel_launch: workspace too small (%zu < %zu)\n", ws_size, (size_t)WS_END); grid = -1; return; }
        int dev = 0, cus = 0, per_cu = 0;
        hipGetDevice(&dev);
        hipDeviceGetAttribute(&cus, hipDeviceAttributeMultiprocessorCount, dev);
        hipFuncSetAttribute((const void*)fwd_kernel, hipFuncAttributeMaxDynamicSharedMemorySize, LDS_BYTES);
        hipOccupancyMaxActiveBlocksPerMultiprocessor(&per_cu, (const void*)fwd_kernel, NT, LDS_BYTES);
        if (per_cu < 1) { fprintf(stderr, "kernel_launch: occupancy query says %d blocks per CU\n", per_cu); grid = -1; return; }
        grid = cus;
    }
    if (grid < 0) return;
    Params p{};
    p.x = (const float*)d_in[0]; p.norm_mix = (const float*)d_in[1]; p.w_in = (const float*)d_in[2]; p.b_forget = (const float*)d_in[3];
    p.g_ret = (const float*)d_in[4]; p.g_sb = (const float*)d_in[5]; p.g_fox = (const float*)d_in[6]; p.w_out = (const float*)d_in[7];
    p.norm_ffn = (const float*)d_in[8]; p.w_group = (const float*)d_in[9]; p.b_group = (const float*)d_in[10]; p.w_router = (const float*)d_in[11];
    p.b_router = (const float*)d_in[12]; p.w_gate = (const float*)d_in[13]; p.w_up = (const float*)d_in[14]; p.w_down = (const float*)d_in[15];
    p.norm_final = (const float*)d_in[16]; p.out = (float*)d_out; p.ws = (unsigned char*)d_ws;
#if N_LAUNCH_PER_PHASE
    for (int ph = 0; ph < NPHASE; ++ph) {
        int lo = ph, hi = ph + 1; void* args[] = {&p, &lo, &hi};
        hipLaunchCooperativeKernel((const void*)fwd_kernel, dim3(grid), dim3(NT), args, LDS_BYTES, stream);
    }
#else
    int lo = 0, hi = NPHASE; void* args[] = {&p, &lo, &hi};
    hipError_t e = hipLaunchCooperativeKernel((const void*)fwd_kernel, dim3(grid), dim3(NT), args, LDS_BYTES, stream);
    if (e != hipSuccess) fprintf(stderr, "cooperative launch failed: %s (grid %d)\n", hipGetErrorString(e), grid);
#endif
}
#endif
```

```cpp
#ifndef CPU_EMU
#include <hip/hip_runtime.h>
#include <hip/hip_cooperative_groups.h>
#include <cstdio>
#include <cstdint>
#include <cmath>
namespace cg = cooperative_groups;
#define VEC(T, N) T __attribute__((ext_vector_type(N)))
__device__ __forceinline__ void wave_barrier() { __builtin_amdgcn_wave_barrier(); }
__device__ __forceinline__ float sin2pi(float x) { return __builtin_amdgcn_sinf(x); }
__device__ __forceinline__ float cos2pi(float x) { return __builtin_amdgcn_cosf(x); }
__device__ __forceinline__ unsigned long long ballot64(bool p) { return __ballot(p); }
#define LAS __attribute__((address_space(3)))
typedef VEC(short, 8) bf16x8;
typedef VEC(float, 4) f32x4_;
__device__ __forceinline__ void glds16(const void* g, LAS unsigned char* l) { __builtin_amdgcn_global_load_lds((const unsigned*)g, (LAS unsigned*)l, 16, 0, 0); }
__device__ __forceinline__ void vm_wait0() { asm volatile("s_waitcnt vmcnt(0)" ::: "memory"); }
__device__ __forceinline__ void lds_wait0() { asm volatile("s_waitcnt lgkmcnt(0)" ::: "memory"); }
__device__ __forceinline__ void sched_fence() { __builtin_amdgcn_sched_barrier(0); }
__device__ __forceinline__ int uni(int x) { return __builtin_amdgcn_readfirstlane(x); }
__device__ __forceinline__ unsigned ld_relaxed(const unsigned* p) { return __hip_atomic_load(p, __ATOMIC_RELAXED, __HIP_MEMORY_SCOPE_AGENT); }
__device__ __forceinline__ int xcc_shard() { return (int)(__builtin_amdgcn_s_getreg((3 << 11) | 20) & 7u); }
__device__ __forceinline__ int lane_id() { int l; asm volatile("v_mbcnt_lo_u32_b32 %0, -1, 0\n\tv_mbcnt_hi_u32_b32 %0, -1, %0" : "=v"(l)); return l; }
__device__ __forceinline__ f32x4_ mfma16(bf16x8 a, bf16x8 b, f32x4_ c) { return __builtin_amdgcn_mfma_f32_16x16x32_bf16(a, b, c, 0, 0, 0); }
typedef VEC(float, 16) f32x16;
typedef VEC(short, 4) s16x4;
__device__ __forceinline__ f32x16 mfma32(bf16x8 a, bf16x8 b, f32x16 c) { return __builtin_amdgcn_mfma_f32_32x32x16_bf16(a, b, c, 0, 0, 0); }
__device__ __forceinline__ s16x4 tr16(const LAS unsigned char* p) { return __builtin_amdgcn_ds_read_tr16_b64_v4i16((LAS s16x4*)p); }
__device__ __forceinline__ float fast_exp(float x) { return __expf(x); }
__device__ __forceinline__ float fast_log(float x) { return __logf(x); }
__device__ __forceinline__ float partner32(float x, int hi) { const auto rr = __builtin_amdgcn_permlane32_swap(__builtin_bit_cast(unsigned, x), __builtin_bit_cast(unsigned, x), false, false); return __builtin_bit_cast(float, hi ? rr[0] : rr[1]); }
template <int N> __device__ __forceinline__ float row_shl_add(float x) { return x + __builtin_bit_cast(float, __builtin_amdgcn_update_dpp(0, __builtin_bit_cast(int, x), 0x100 + N, 0xf, 0xf, true)); }
__device__ __forceinline__ float read_lane(float x, int l) { return __builtin_bit_cast(float, __builtin_amdgcn_readlane(__builtin_bit_cast(int, x), l)); }
#else
#define VEC(T, N) T __attribute__((vector_size(sizeof(T) * N)))
inline float sin2pi(float x) { return (float)sin(6.283185307179586 * (double)x); }
inline float cos2pi(float x) { return (float)cos(6.283185307179586 * (double)x); }
inline unsigned long long ballot64(bool p) { return emu_ballot(p); }
#define LAS
typedef VEC(short, 8) bf16x8;
inline void glds16(const void* g, unsigned char* l) { memcpy(l + (threadIdx.x & 63) * 16, g, 16); }
inline void vm_wait0() {}
inline void lds_wait0() {}
inline void sched_fence() {}
inline int uni(int x) { return x; }
inline int xcc_shard() { return (int)(blockIdx.x & 7u); }
inline unsigned ld_relaxed(const unsigned* p) { return __atomic_load_n(p, __ATOMIC_RELAXED); }
inline int lane_id() { return threadIdx.x & 63; }
inline emu_f32x4 mfma16(bf16x8 a, bf16x8 b, emu_f32x4 c) { return emu_mfma16(a, b, c); }
typedef VEC(float, 16) f32x16;
typedef VEC(short, 4) s16x4;
inline f32x16 mfma32(bf16x8 a, bf16x8 b, f32x16 c) { return emu_mfma32(a, b, c); }
inline s16x4 tr16(const unsigned char* p) { return emu_tr16(p); }
inline float fast_exp(float x) { return expf(x); }
inline float fast_log(float x) { return logf(x); }
inline float partner32(float x, int hi) { return __shfl_xor(x, 32); }
template <int N> inline float row_shl_add(float x) { const int l = threadIdx.x & 63; const float o = emu_shfl_idx(x, (l + N) & 63); return x + (((l & 15) + N < 16) ? o : 0.f); }
inline float read_lane(float x, int l) { return emu_shfl_idx(x, l); }
#endif

typedef unsigned short bf16_t;
typedef VEC(float, 4) f32x4;
typedef VEC(float, 2) f32x2;
typedef VEC(unsigned, 2) u32x2;
typedef VEC(unsigned, 4) u32x4;
typedef LAS unsigned char lds_u8;

#ifdef SMALL_CFG
constexpr int D = 256, S = 512, DEPTH = 2, NRET = 2, NSB = 1, NFOX = 1, NG = 2, EPG = 4, DE = 128;
#else
constexpr int D = 1024, S = 16384, DEPTH = 2, NRET = 6, NSB = 5, NFOX = 5, NG = 4, EPG = 8, DE = 512;
#endif
constexpr int CH = 64, HD = 64, NE = NG * EPG;
constexpr int WRET = NRET * HD, WSB = NSB * HD, WFOX = NFOX * HD, MIXW = WRET + WSB + WFOX;
constexpr int IN_W = 4 * WRET + 3 * WSB + 3 * WFOX + NFOX;
constexpr int PW = (IN_W + 255) / 256 * 256;
constexpr int OQR = 0, OKR = WRET, OVR = 2 * WRET, OGR = 3 * WRET, OQS = 4 * WRET, OKS = OQS + WSB, OVS = OKS + WSB;
constexpr int OQF = OVS + WSB, OKF = OQF + WFOX, OVF = OKF + WFOX, OFL = OVF + WFOX;
constexpr int NCHUNK = S / CH;
constexpr float EPS = 1e-6f;
constexpr int NT = 512, NW = NT / 64;
constexpr int NROUTE = NG + NE;
constexpr float EXIT_T = 20.0f;

constexpr size_t al256(size_t x) { return (x + 255) / 256 * 256; }
constexpr size_t WS_CTL = 0;
constexpr int CTL_CNT = 0;
constexpr int CTL_KMAX = 256;
constexpr int CTL_MQ = 4608, CTL_WQ = 4608 + DEPTH * 8 * 64;
constexpr int CTL_BAR = 1024;
constexpr int CTL_WORDS = 8192;
static_assert(CTL_BAR + 3456 <= CTL_MQ && CTL_WQ + DEPTH * 8 * 64 <= CTL_WORDS, "control-word map");
constexpr size_t WS_ROT = 32768;
constexpr size_t WS_X = al256(WS_ROT + (size_t)S * 32 * 8);
constexpr size_t WS_H = al256(WS_X + (size_t)S * D * 4);
constexpr size_t WS_LOGF = al256(WS_H + (size_t)S * D * 2);
constexpr size_t WS_MERGED = al256(WS_LOGF + (size_t)S * 8 * 4);
constexpr size_t WS_U = al256(WS_MERGED + (size_t)S * MIXW * 2);
constexpr size_t WS_SP = al256(WS_U + (size_t)NRET * NCHUNK * 4096 * 4);
constexpr size_t WS_LIST = al256(WS_SP + (size_t)NRET * NCHUNK * 4096 * 4);
constexpr size_t WS_GATE = al256(WS_LIST + (size_t)NE * S * 4);
constexpr size_t WS_WIN = al256(WS_GATE + (size_t)S * 2 * 4);
constexpr size_t WS_WOUT = al256(WS_WIN + (size_t)DEPTH * PW * D * 2);
constexpr size_t WS_WGU = al256(WS_WOUT + (size_t)DEPTH * D * MIXW * 2);
constexpr size_t WS_WDN = al256(WS_WGU + (size_t)DEPTH * NE * 2 * DE * D * 2);
constexpr size_t WS_PROJ = al256(WS_WDN + (size_t)DEPTH * NE * D * DE * 2);
constexpr int HID_ROWS = 2 * S + NE * 256;
constexpr size_t WS_HID = WS_PROJ;
constexpr size_t WS_Y = al256(WS_HID + (size_t)HID_ROWS * DE * 2);
constexpr size_t WS_END0 = al256(WS_PROJ + (size_t)S * PW * 2), WS_END1 = al256(WS_Y + (size_t)2 * S * D * 2);
constexpr size_t WS_END = WS_END0 > WS_END1 ? WS_END0 : WS_END1;
#ifndef SMALL_CFG
static_assert(WS_END <= (size_t)512 * 1024 * 1024, "workspace map exceeds the guaranteed 512 MiB");
#endif

struct Params {
    const float* x; const float* norm_mix; const float* w_in; const float* b_forget; const float* g_ret; const float* g_sb; const float* g_fox;
    const float* w_out; const float* norm_ffn; const float* w_group; const float* b_group; const float* w_router; const float* b_router;
    const float* w_gate; const float* w_up; const float* w_down; const float* norm_final;
    float* out; unsigned char* ws;
    int wid, pad;
};

#define TIDX(p) (((p).wid << 6) | lane_id())
__device__ __forceinline__ int imin(int a, int b) { return a < b ? a : b; }
__device__ __forceinline__ float u2f(unsigned u) { return __builtin_bit_cast(float, u); }
__device__ __forceinline__ unsigned f2u(float f) { return __builtin_bit_cast(unsigned, f); }
__device__ __forceinline__ float bf2f(bf16_t b) { return u2f((unsigned)b << 16); }
__device__ __forceinline__ bf16_t f2bf(float f) { unsigned u = f2u(f); return (bf16_t)((u + 0x7fffu + ((u >> 16) & 1u)) >> 16); }
__device__ __forceinline__ unsigned pk2(float lo, float hi) { return (unsigned)f2bf(lo) | ((unsigned)f2bf(hi) << 16); }
__device__ __forceinline__ float log_sigmoid(float x) { return fminf(x, 0.f) - log1pf(expf(-fabsf(x))); }
__device__ __forceinline__ float silu(float x) { return x / (1.f + expf(-x)); }
__device__ __forceinline__ float wave_sum(float v) {
#pragma unroll
    for (int o = 1; o < 64; o <<= 1) v += __shfl_xor(v, o);
    return v;
}
__device__ __forceinline__ float wave_max(float v) {
#pragma unroll
    for (int o = 1; o < 64; o <<= 1) v = fmaxf(v, __shfl_xor(v, o));
    return v;
}
__device__ __forceinline__ double inv_turns(int j) {
    static constexpr double T[32] = {
        1.59154943091895346e-01, 1.19349370211248862e-01, 8.94994016088910133e-02, 6.71150830052272551e-02, 5.03292121044870353e-02, 3.77415847174197711e-02, 2.83021958306233987e-02, 2.12236527647776604e-02,
        1.59154943091895339e-02, 1.19349370211248862e-02, 8.94994016088910237e-03, 6.71150830052272534e-03, 5.03292121044870370e-03, 3.77415847174197719e-03, 2.83021958306233987e-03, 2.12236527647776622e-03,
        1.59154943091895356e-03, 1.19349370211248849e-03, 8.94994016088910237e-04, 6.71150830052272599e-04, 5.03292121044870326e-04, 3.77415847174197741e-04, 2.83021958306233954e-04, 2.12236527647776605e-04,
        1.59154943091895351e-04, 1.19349370211248862e-04, 8.94994016088910182e-05, 6.71150830052272545e-05, 5.03292121044870354e-05, 3.77415847174197768e-05, 2.83021958306233961e-05, 2.12236527647776592e-05};
    return T[j];
}

constexpr int VROWB = 144;
constexpr int IMG64 = 64 * VROWB;
constexpr int RET_WAVE_LDS = 2 * IMG64;
__device__ __forceinline__ int crow(int reg, int hi) { return (reg & 3) + 8 * (reg >> 2) + 4 * hi; }
__device__ __forceinline__ bf16x8 tr_frag(const lds_u8* base, int rowoff0, int rowoff1, int coloff) {
    const s16x4 lo = tr16(base + rowoff0 * VROWB + coloff), hi4 = tr16(base + rowoff1 * VROWB + coloff);
    bf16x8 f; f[0] = lo[0]; f[1] = lo[1]; f[2] = lo[2]; f[3] = lo[3]; f[4] = hi4[0]; f[5] = hi4[1]; f[6] = hi4[2]; f[7] = hi4[3]; return f;
}

constexpr int RJ = D / 256;
__device__ __forceinline__ void row_load(const float* row, f32x4* v, int lane) {
#pragma unroll
    for (int j = 0; j < RJ; ++j) v[j] = *(const f32x4*)(row + 256 * j + lane * 4);
}
__device__ __forceinline__ float row_rinv(const f32x4* v) {
    float s = 0.f;
#pragma unroll
    for (int j = 0; j < RJ; ++j) s += (v[j][0] * v[j][0] + v[j][1] * v[j][1]) + (v[j][2] * v[j][2] + v[j][3] * v[j][3]);
    s = wave_sum(s);
    return 1.0f / sqrtf(s * (1.0f / D) + EPS);
}

#ifndef CPU_EMU
typedef float f32x4_u __attribute__((ext_vector_type(4), aligned(4)));
#else
typedef float f32x4_u __attribute__((vector_size(16), aligned(4)));
#endif
#ifndef CPU_EMU
__device__ __forceinline__ f32x4_u nt_load4(const f32x4_u* p) { return __builtin_nontemporal_load(p); }
#else
inline f32x4_u nt_load4(const f32x4_u* p) { return *p; }
#endif
__device__ __forceinline__ void transpose_item64(const float* Wa, const float* Wb, int ldw, int ncols, int c0, int cb0, int k0, bf16_t* WT, int ldt, int r0, int r1, lds_u8* img, int lane) {
    const int n = 4 * (lane & 15), kr = lane >> 4;
    const float* src = (n < 32 ? Wa + c0 + n : Wb + cb0 + (n - 32)) + (size_t)(k0 + kr) * ldw;
    const int col = (n < 32 ? c0 + n : cb0 + n - 32);
    f32x4 v[16];
    if (col + 3 < ncols) {
#pragma unroll
        for (int i = 0; i < 16; ++i) { const f32x4_u t = nt_load4((const f32x4_u*)(src + (size_t)(4 * i) * ldw)); v[i][0] = t[0]; v[i][1] = t[1]; v[i][2] = t[2]; v[i][3] = t[3]; }
    } else {
#pragma unroll
        for (int i = 0; i < 16; ++i)
#pragma unroll
            for (int j = 0; j < 4; ++j) v[i][j] = (col + j < ncols) ? src[(size_t)(4 * i) * ldw + j] : 0.f;
    }
    wave_barrier();
#pragma unroll
    for (int i = 0; i < 16; ++i) { u32x2 o; o[0] = pk2(v[i][0], v[i][1]); o[1] = pk2(v[i][2], v[i][3]); *(LAS u32x2*)(img + (4 * i + kr) * VROWB + n * 2) = o; }
    wave_barrier();
    const lds_u8* tb = img + ((lane & 15) >> 2) * VROWB + (16 * (lane >> 4) + 4 * (lane & 3)) * 2;
    bf16_t* dst = WT + (size_t)(lane < 32 ? r0 + lane : r1 + lane - 32) * ldt + k0;
#pragma unroll
    for (int kc = 0; kc < 8; ++kc) {
        const s16x4 lo = tr16(tb + (8 * kc) * VROWB), hi4 = tr16(tb + (8 * kc + 4) * VROWB);
        u32x4 o; o[0] = (unsigned)(unsigned short)lo[0] | ((unsigned)(unsigned short)lo[1] << 16); o[1] = (unsigned)(unsigned short)lo[2] | ((unsigned)(unsigned short)lo[3] << 16);
        o[2] = (unsigned)(unsigned short)hi4[0] | ((unsigned)(unsigned short)hi4[1] << 16); o[3] = (unsigned)(unsigned short)hi4[2] | ((unsigned)(unsigned short)hi4[3] << 16);
        *(u32x4*)(dst + 8 * kc) = o;
    }
}
constexpr int WI_IN = (D / 64) * ((IN_W + 63) / 64), WI_OUT = (MIXW / 64) * (D / 64), WI_GU = (D / 64) * (DE / 32), WI_DN = (DE / 64) * (D / 64);
constexpr int WI_DENSE = WI_IN + WI_OUT, WI_EXPERT = WI_GU + WI_DN, WI_LAYER = WI_DENSE + NE * WI_EXPERT;
__device__ __forceinline__ void weight_item(const Params& p, int l, int r, lds_u8* img, int lane) {
    if (r < WI_IN) { const int nb = (IN_W + 63) / 64, c0 = (r % nb) * 64; const float* W = p.w_in + (size_t)l * D * IN_W;
        const int r0 = (c0 / 256) * 256 + ((c0 % 256) / 64) * 32;
        transpose_item64(W, W, IN_W, IN_W, c0, c0 + 32, (r / nb) * 64, (bf16_t*)(p.ws + WS_WIN) + (size_t)l * PW * D, D, r0, r0 + 128, img, lane); return; }
    r -= WI_IN;
    if (r < WI_OUT) { const int nb = D / 64, c0 = (r % nb) * 64; const float* W = p.w_out + (size_t)l * MIXW * D;
        transpose_item64(W, W, D, D, c0, c0 + 32, (r / nb) * 64, (bf16_t*)(p.ws + WS_WOUT) + (size_t)l * D * MIXW, MIXW, c0, c0 + 32, img, lane); return; }
    r -= WI_OUT;
    const int e = r / WI_EXPERT; r %= WI_EXPERT;
    if (r < WI_GU) { const int nb = DE / 32, c0 = (r % nb) * 32;
        const int r0 = (c0 / 128) * 256 + (c0 % 128);
        transpose_item64(p.w_gate + (size_t)(l * NE + e) * D * DE, p.w_up + (size_t)(l * NE + e) * D * DE, DE, DE, c0, c0, (r / nb) * 64, (bf16_t*)(p.ws + WS_WGU) + (size_t)(l * NE + e) * 2 * DE * D, D, r0, r0 + 128, img, lane); return; }
    r -= WI_GU;
    { const int nb = D / 64, c0 = (r % nb) * 64; const float* W = p.w_down + (size_t)(l * NE + e) * DE * D;
        transpose_item64(W, W, D, D, c0, c0 + 32, (r / nb) * 64, (bf16_t*)(p.ws + WS_WDN) + (size_t)(l * NE + e) * D * DE, DE, c0, c0 + 32, img, lane); }
}
__device__ __forceinline__ void phase_init(const Params& p, float* lds) {
    unsigned* ctl = (unsigned*)(p.ws + WS_CTL);
    if (blockIdx.x == 0) for (int i = TIDX(p); i < CTL_WORDS; i += NT) ctl[i] = 0u;
    f32x2* rot = (f32x2*)(p.ws + WS_ROT);
    for (int i = blockIdx.x * NT + TIDX(p); i < S * 32; i += gridDim.x * NT) {
        const int pos = i >> 5, j = i & 31;
        const double turns = (double)pos * inv_turns(j);
        const double fr = turns - floor(turns);
        f32x2 cs; cs[0] = cos2pi((float)fr); cs[1] = sin2pi((float)fr);
        rot[i] = cs;
    }
    const int lane = lane_id(), wave = p.wid;
    {
        lds_u8* img = (lds_u8*)lds + wave * RET_WAVE_LDS;
        for (int it = blockIdx.x * NW + wave; it < DEPTH * WI_DENSE; it += gridDim.x * NW) weight_item(p, it / WI_DENSE, it % WI_DENSE, img, lane);
    }
    bf16_t* H = (bf16_t*)(p.ws + WS_H);
    for (int r = blockIdx.x * NW + wave; r < S; r += gridDim.x * NW) {
        f32x4 v[RJ]; row_load(p.x + (size_t)r * D, v, lane);
        const float ri = row_rinv(v);
#pragma unroll
        for (int j = 0; j < RJ; ++j) {
            const f32x4 g = *(const f32x4*)(p.norm_mix + 256 * j + lane * 4);
            u32x2 o; o[0] = pk2(v[j][0] * ri * g[0], v[j][1] * ri * g[1]); o[1] = pk2(v[j][2] * ri * g[2], v[j][3] * ri * g[3]);
            *(u32x2*)(H + (size_t)r * D + 256 * j + lane * 4) = o;
        }
    }
}

constexpr int GBM = 256, GBK = 64, TILE_B = GBM * GBK * 2, STAGE_B = 2 * TILE_B, GEMM_LDS = 2 * STAGE_B;
__device__ __forceinline__ int lds_byte(int r, int c) { const int st = (r >> 4) * 2 + (c >> 5), ob = (r & 15) * 64 + (c & 31) * 2; return st * 1024 + (ob ^ (((ob >> 9) & 1) << 5)); }
__device__ __forceinline__ void stage_rc(int b, int& R, int& C) { const int st = b >> 10, sb = b & 1023, swz = sb ^ (((sb >> 9) & 1) << 5); R = (st >> 1) * 16 + swz / 64; C = (st & 1) * 32 + (swz % 64) / 2; }
__device__ __forceinline__ int vcu_id() { const int G = gridDim.x, b = blockIdx.x; return (G % 8 == 0) ? (b % 8) * (G / 8) + b / 8 : b; }

constexpr int HTB = 128 * GBK * 2;
struct GUnit { unsigned A, B; unsigned ao[4]; int i0, i1, i2, i3; };
#ifndef CPU_EMU
#define G8_WAIT_V(n) asm volatile("s_waitcnt vmcnt(" #n ")" ::: "memory")
#define G8_WAIT_L0() asm volatile("s_waitcnt lgkmcnt(0)" ::: "memory")
#define G8_BAR() __builtin_amdgcn_s_barrier()
#define G8_PRIO(x) __builtin_amdgcn_s_setprio(x)
#else
#define G8_WAIT_V(n) do {} while (0)
#define G8_WAIT_L0() do {} while (0)
#define G8_BAR() __syncthreads()
#define G8_PRIO(x) do {} while (0)
#endif
template <class Sched, class Epi>
__device__ __forceinline__ void gemm_stream(lds_u8* lds, const char* Abase, const char* Bbase, const int K, Sched& S, const Epi& E) {
    const int wid = S.wid, lane = lane_id(), tid = (wid << 6) | lane, wr = wid >> 2, wc = wid & 3, fr = lane & 15, fq = lane >> 4;
    const int nt = K / GBK;
    unsigned voffB[2];
    { int R, C; stage_rc(tid * 16, R, C); voffB[0] = (unsigned)((R * K + C) * 2); stage_rc(tid * 16 + 8192, R, C); voffB[1] = (unsigned)((R * K + C) * 2); }
    const unsigned hstepB = (unsigned)(128 * K * 2);
    lds_u8* ldsw = lds + wid * 1024;
    const int aoff = lds_byte(wr * 64 + fr, fq * 8), boff = lds_byte(wc * 32 + fr, fq * 8);
#define G8_SA(b, h) (((b) * 2 + (h)) * HTB)
#define G8_SB(b, h) ((4 + (b) * 2 + (h)) * HTB)
#define G8_STAGE_A(b, h, U, kt) do { _Pragma("unroll") for (int i_ = 0; i_ < 2; ++i_) glds16(Abase + ((size_t)(U).A + (size_t)((kt) * (GBK * 2))) + (Sched::GATHER ? (U).ao[2 * (h) + i_] : S.ao[2 * (h) + i_]), ldsw + G8_SA(b, h) + i_ * 8192); } while (0)
#define G8_STAGE_B(b, h, U, kt) do { _Pragma("unroll") for (int i_ = 0; i_ < 2; ++i_) glds16(Bbase + ((size_t)(U).B + (size_t)((kt) * (GBK * 2)) + (size_t)(h) * hstepB) + voffB[i_], ldsw + G8_SB(b, h) + i_ * 8192); } while (0)
#define G8_LDA(dst, b, h) do { _Pragma("unroll") for (int m = 0; m < 4; ++m) _Pragma("unroll") for (int k = 0; k < 2; ++k) dst[m][k] = *(const LAS bf16x8*)(lds + G8_SA(b, h) + aoff + m * 2048 + k * 1024); } while (0)
#define G8_LDB(dst, b, h) do { _Pragma("unroll") for (int n = 0; n < 2; ++n) _Pragma("unroll") for (int k = 0; k < 2; ++k) dst[n][k] = *(const LAS bf16x8*)(lds + G8_SB(b, h) + boff + n * 2048 + k * 1024); } while (0)
#define G8_MMA(ai, bj, At_, Bt_) do { G8_PRIO(1); _Pragma("unroll") for (int m = 0; m < 4; ++m) _Pragma("unroll") for (int n = 0; n < 2; ++n) _Pragma("unroll") for (int k = 0; k < 2; ++k) \
        acc[ai][bj][m][n] = mfma16(Bt_[n][k], At_[m][k], acc[ai][bj][m][n]); G8_PRIO(0); } while (0)
    GUnit cur, nxt; int ui = 0;
    if (!S.next(0, cur)) return;
    f32x4 acc[2][2][4][2];
#pragma unroll
    for (int a = 0; a < 2; ++a)
#pragma unroll
        for (int b = 0; b < 2; ++b)
#pragma unroll
            for (int m = 0; m < 4; ++m)
#pragma unroll
                for (int n = 0; n < 2; ++n) acc[a][b][m][n] = (f32x4){0.f, 0.f, 0.f, 0.f};
    bf16x8 At[4][2], B0[2][2], B1[2][2];
    G8_STAGE_B(0, 0, cur, 0); G8_STAGE_B(0, 1, cur, 0); G8_STAGE_A(0, 0, cur, 0); G8_STAGE_A(0, 1, cur, 0);
    if (wr == 1) G8_BAR();
    G8_WAIT_V(2); G8_BAR();
    G8_STAGE_B(1, 0, cur, 1); G8_STAGE_A(1, 0, cur, 1); G8_STAGE_B(1, 1, cur, 1);
    G8_WAIT_V(6); G8_BAR();
    for (;;) {
        const bool has_next = S.next(ui + 1, nxt);
        if (!has_next) nxt = cur;
        for (int t = 0; t < nt; t += 2) {
            const bool last = (t == nt - 2);
            const GUnit& U2 = last ? nxt : cur;
            const int k2 = last ? 0 : t + 2, k3 = k2 + 1;
            G8_LDB(B0, 0, 0); G8_LDB(B1, 0, 1); sched_fence(); G8_LDA(At, 0, 0); G8_STAGE_A(1, 1, cur, t + 1);
            G8_WAIT_V(8); G8_WAIT_L0(); G8_BAR(); G8_MMA(0, 0, At, B0); G8_MMA(0, 1, At, B1); G8_BAR(); sched_fence();
            G8_LDA(At, 0, 1); G8_STAGE_B(0, 0, U2, k2); G8_STAGE_B(0, 1, U2, k2); G8_STAGE_A(0, 0, U2, k2);
            G8_WAIT_V(8); G8_WAIT_L0(); G8_BAR(); G8_MMA(1, 0, At, B0); G8_MMA(1, 1, At, B1); G8_BAR(); sched_fence();
            G8_LDB(B0, 1, 0); G8_LDB(B1, 1, 1); sched_fence(); G8_LDA(At, 1, 0); G8_STAGE_A(0, 1, U2, k2);
            G8_WAIT_V(8); G8_WAIT_L0(); G8_BAR(); G8_MMA(0, 0, At, B0); G8_MMA(0, 1, At, B1); G8_BAR(); sched_fence();
            G8_LDA(At, 1, 1); G8_STAGE_B(1, 0, U2, k3); G8_STAGE_B(1, 1, U2, k3); G8_STAGE_A(1, 0, U2, k3);
            G8_WAIT_V(8); G8_WAIT_L0(); G8_BAR(); G8_MMA(1, 0, At, B0); G8_MMA(1, 1, At, B1); G8_BAR(); sched_fence();
        }
        E(acc, cur, wr, wc, fr, fq);
        if (!has_next) break;
#pragma unroll
        for (int a = 0; a < 2; ++a)
#pragma unroll
            for (int b = 0; b < 2; ++b)
#pragma unroll
                for (int m = 0; m < 4; ++m)
#pragma unroll
                    for (int n = 0; n < 2; ++n) acc[a][b][m][n] = (f32x4){0.f, 0.f, 0.f, 0.f};
        cur = nxt; ++ui;
    }
    G8_WAIT_V(0);
    if (wr == 0) G8_BAR();
    G8_BAR();
#undef G8_SA
#undef G8_SB
#undef G8_STAGE_A
#undef G8_STAGE_B
#undef G8_LDA
#undef G8_LDB
#undef G8_MMA
}
__device__ __forceinline__ void plain_ao(unsigned (&ao)[4], int K, int tid) {
    int R, C; stage_rc(tid * 16, R, C); ao[0] = (unsigned)((R * K + C) * 2); ao[2] = ao[0] + (unsigned)(128 * K * 2);
    stage_rc(tid * 16 + 8192, R, C); ao[1] = (unsigned)((R * K + C) * 2); ao[3] = ao[1] + (unsigned)(128 * K * 2);
}

struct InprojSched {
    static constexpr bool GATHER = false;
    int wid;
    unsigned ao[4]; int vcu, G;
    static constexpr int NPM = S / GBM, NPN = PW / GBM;
    __device__ __forceinline__ bool next(int i, GUnit& u) const {
        const int L = uni(i * G + vcu); if (L >= NPM * NPN) return false;
        const int pm = L / NPN, pn = L % NPN;
        u.A = (unsigned)(pm * GBM * D * 2); u.B = (unsigned)(pn * GBM * D * 2); u.ao[0] = u.ao[1] = u.ao[2] = u.ao[3] = 0u;
        u.i0 = pm; u.i1 = pn; u.i2 = 0; u.i3 = 0; return true;
    }
};
struct InprojEpi {
    bf16_t* P; float* LOGF; unsigned* kmaxw; const f32x2* rot; const float* bfg;
    __device__ __forceinline__ void operator()(f32x4 (&acc)[2][2][4][2], const GUnit& u, int wr, int wc, int fr, int fq) const {
        const int gc0 = u.i1 * GBM + wc * 64;
        if (gc0 >= IN_W) return;
        const int row0 = u.i0 * GBM + wr * 64 + fr;
        if (gc0 >= OFL) {
#pragma unroll
            for (int ai = 0; ai < 2; ++ai)
#pragma unroll
                for (int m = 0; m < 4; ++m)
#pragma unroll
                    for (int j = 0; j < 4; ++j) { const int h = 4 * fq + j; if (h < NFOX) LOGF[(size_t)(row0 + ai * 128 + m * 16) * 8 + h] = log_sigmoid(acc[ai][0][m][0][j] + bfg[h]); }
            return;
        }
        const bool rotary = gc0 < OVR, is_gate = (gc0 >= OGR && gc0 < OQS), is_kf = (gc0 >= OKF && gc0 < OVF);
        const float scale = (gc0 < OKR || (gc0 >= OQS && gc0 < OKS) || (gc0 >= OQF && gc0 < OKF)) ? 0.125f : 1.0f;
        float kmx = 0.f;
#pragma unroll
        for (int ai = 0; ai < 2; ++ai)
#pragma unroll
            for (int m = 0; m < 4; ++m) {
                const int row = row0 + ai * 128 + m * 16;
                if (rotary) {
#pragma unroll
                    for (int n = 0; n < 2; ++n) {
                        const f32x4 c01 = *(const f32x4*)(rot + (size_t)row * 32 + n * 16 + 4 * fq), c23 = *(const f32x4*)(rot + (size_t)row * 32 + n * 16 + 4 * fq + 2);
                        const float cs[4] = {c01[0], c01[2], c23[0], c23[2]}, sn[4] = {c01[1], c01[3], c23[1], c23[3]};
#pragma unroll
                        for (int j = 0; j < 4; ++j) { const float x1 = acc[ai][0][m][n][j], x2 = acc[ai][1][m][n][j]; acc[ai][0][m][n][j] = x1 * cs[j] - x2 * sn[j]; acc[ai][1][m][n][j] = x1 * sn[j] + x2 * cs[j]; }
                    }
                }
                float ss = 0.f;
#pragma unroll
                for (int bj = 0; bj < 2; ++bj)
#pragma unroll
                    for (int n = 0; n < 2; ++n) {
                        f32x4 v = acc[ai][bj][m][n] * scale;
                        if (is_gate) {
#pragma unroll
                            for (int j = 0; j < 4; ++j) v[j] = silu(v[j]);
                        }
                        u32x2 o; o[0] = pk2(v[0], v[1]); o[1] = pk2(v[2], v[3]);
                        if (is_kf) {
#pragma unroll
                            for (int j = 0; j < 4; ++j) { const float r = bf2f(f2bf(v[j])); ss += r * r; }
                        }
                        *(u32x2*)(P + (size_t)row * PW + gc0 + 32 * bj + 16 * n + 4 * fq) = o;
                    }
                if (is_kf) { ss += __shfl_xor(ss, 16); ss += __shfl_xor(ss, 32); kmx = fmaxf(kmx, ss); }
            }
        if (is_kf) { kmx = wave_max(kmx); if (lane_id() == 0) atomicMax(kmaxw + (gc0 - OKF) / HD, f2u(kmx)); }
    }
};
__device__ __forceinline__ void phase_inproj(const Params& p, int l, float* ldsf) {
    InprojSched S; S.wid = p.wid; plain_ao(S.ao, D, TIDX(p)); S.vcu = vcu_id(); S.G = gridDim.x;
    InprojEpi E; E.P = (bf16_t*)(p.ws + WS_PROJ); E.LOGF = (float*)(p.ws + WS_LOGF); E.kmaxw = (unsigned*)(p.ws + WS_CTL) + CTL_KMAX + l * 8; E.rot = (const f32x2*)(p.ws + WS_ROT); E.bfg = p.b_forget + l * NFOX;
    gemm_stream((lds_u8*)ldsf, (const char*)(p.ws + WS_H), (const char*)(p.ws + WS_WIN) + (size_t)l * PW * D * 2, D, S, E);
}

__device__ __forceinline__ float ret_log_gamma(int h) { return logf(1.0f - exp2f(-5.0f - (float)h)); }
__device__ __forceinline__ void ret_prep_item(const Params& p, int h, int n, lds_u8* wl) {
    const bf16_t* P = (const bf16_t*)(p.ws + WS_PROJ);
    float* UT = (float*)(p.ws + WS_U);
    const int lane = lane_id(), r32 = lane & 31, hi = lane >> 5;
    const float lg = ret_log_gamma(h);
    wave_barrier();
#pragma unroll
    for (int i = 0; i < 8; ++i) {
        const int c = lane + 64 * i, row = c >> 3, ch = c & 7;
        const bf16_t* src = P + (size_t)(n * CH + row) * PW + h * HD + 8 * ch;
        const u32x4 kv = *(const u32x4*)(src + OKR), vv = *(const u32x4*)(src + OVR);
        const float dk = fast_exp(lg * (float)(CH - 1 - row));
        u32x4 ko;
#pragma unroll
        for (int w = 0; w < 4; ++w) ko[w] = pk2(u2f(kv[w] << 16) * dk, u2f(kv[w] & 0xffff0000u) * dk);
        *(LAS u32x4*)(wl + row * VROWB + ch * 16) = ko;
        *(LAS u32x4*)(wl + IMG64 + row * VROWB + ch * 16) = vv;
    }
    wave_barrier();
    const lds_u8* tb = wl + (8 * hi + ((lane & 15) >> 2)) * VROWB + (16 * ((lane >> 4) & 1) + 4 * (lane & 3)) * 2;
    f32x16 acc[2][2];
#pragma unroll
    for (int a = 0; a < 2; ++a)
#pragma unroll
        for (int b = 0; b < 2; ++b)
#pragma unroll
            for (int r = 0; r < 16; ++r) acc[a][b][r] = 0.f;
#pragma unroll
    for (int s = 0; s < 4; ++s) {
        bf16x8 vf[2], kf[2];
#pragma unroll
        for (int x = 0; x < 2; ++x) { kf[x] = tr_frag(tb, 16 * s, 16 * s + 4, x * 64); vf[x] = tr_frag(tb + IMG64, 16 * s, 16 * s + 4, x * 64); }
#pragma unroll
        for (int eb = 0; eb < 2; ++eb)
#pragma unroll
            for (int db = 0; db < 2; ++db) acc[eb][db] = mfma32(vf[eb], kf[db], acc[eb][db]);
    }
    float* dst = UT + (size_t)(h * NCHUNK + n) * 4096;
#pragma unroll
    for (int eb = 0; eb < 2; ++eb)
#pragma unroll
        for (int db = 0; db < 2; ++db)
#pragma unroll
            for (int r = 0; r < 16; ++r) dst[(32 * eb + crow(r, hi)) * 64 + 32 * db + r32] = acc[eb][db][r];
}
__device__ __forceinline__ void phase_prep(const Params& p, int l, float* ldsf) {
    const int wave = p.wid;
    lds_u8* wl = (lds_u8*)ldsf + wave * RET_WAVE_LDS;
    for (int it = blockIdx.x * NW + wave; it < NRET * NCHUNK; it += gridDim.x * NW) ret_prep_item(p, it / NCHUNK, it % NCHUNK, wl);
}

constexpr int NQ32 = S / 32;
constexpr int MIX_WAVE_LDS = 32 * VROWB + 256;
__device__ __forceinline__ void ret_scan_wave(const Params& p, int item) {
    const float* U = (const float*)(p.ws + WS_U);
    bf16_t* SP = (bf16_t*)(p.ws + WS_SP);
    const int e = item * 64 + lane_id();
    const int h = e >> 12, de = e & 4095;
    const float c = expf(ret_log_gamma(h) * (float)CH);
    float st = 0.f;
    const size_t base = (size_t)h * NCHUNK * 4096 + de;
#pragma unroll 1
    for (int n0 = 0; n0 < NCHUNK; n0 += 32) {
        float u[32];
#pragma unroll
        for (int i = 0; i < 32; ++i) u[i] = (n0 + i < NCHUNK) ? U[base + (size_t)(n0 + i) * 4096] : 0.f;
#pragma unroll
        for (int i = 0; i < 32; ++i) if (n0 + i < NCHUNK) { SP[base + (size_t)(n0 + i) * 4096] = f2bf(st); st = st * c + u[i]; }
    }
}
template <bool FOX>
__device__ __forceinline__ void attn_item(const Params& p, int l, int h, int qb, lds_u8* wl) {
    const bf16_t* P = (const bf16_t*)(p.ws + WS_PROJ);
    const float* LOGF = (const float*)(p.ws + WS_LOGF);
    bf16_t* MG = (bf16_t*)(p.ws + WS_MERGED);
    const int lane = lane_id(), r32 = lane & 31, hi = lane >> 5;
    const int q0 = qb * 32, t = q0 + r32;
    constexpr int oq = FOX ? OQF : OQS, ok = FOX ? OKF : OKS, ov = FOX ? OVF : OVS;
    bf16x8 qf[4];
    { const bf16_t* qp = P + (size_t)t * PW + oq + h * HD + 8 * hi;
#pragma unroll
      for (int ks = 0; ks < 4; ++ks) qf[ks] = *(const bf16x8*)(qp + 16 * ks); }
    float Bt = 0.f;
    if (FOX) {
        float qq = 0.f;
#pragma unroll
        for (int ks = 0; ks < 4; ++ks)
#pragma unroll
            for (int j = 0; j < 8; ++j) { const float v = bf2f((bf16_t)qf[ks][j]); qq += v * v; }
        qq += __shfl_xor(qq, 32);
        const float kmax = sqrtf(u2f(((const unsigned*)(p.ws + WS_CTL))[CTL_KMAX + l * 8 + h]));
        Bt = sqrtf(qq) * kmax * 1.0001f + 1e-6f;
    }
    float fq = 0.f, m = -1e30f, lsum = 0.f, carry = 0.f, Fc = 0.f;
    f32x16 o0, o1;
#pragma unroll
    for (int r = 0; r < 16; ++r) { o0[r] = 0.f; o1[r] = 0.f; }
    LAS float* frl = (LAS float*)(wl + 32 * VROWB);
    const lds_u8* vb = wl + (4 * hi + ((lane & 15) >> 2)) * VROWB + (16 * ((lane >> 4) & 1) + 4 * (lane & 3)) * 2;
    bf16x8 kf1[4], kf2[4]; u32x4 vr1[4], vr2[4]; float lf1 = 0.f, lf2 = 0.f;
#define ATTN_LOAD(KF, VR, LF, kt_) do { const int k0_ = (kt_) * 32; const bf16_t* kp_ = P + (size_t)(k0_ + r32) * PW + ok + h * HD + 8 * hi; \
        _Pragma("unroll") for (int ks = 0; ks < 4; ++ks) KF[ks] = *(const bf16x8*)(kp_ + 16 * ks); \
        _Pragma("unroll") for (int i = 0; i < 4; ++i) { const int c = lane + 64 * i; VR[i] = *(const u32x4*)(P + (size_t)(k0_ + (c >> 3)) * PW + ov + h * HD + 8 * (c & 7)); } \
        if (FOX) LF = -LOGF[(size_t)(k0_ + r32) * 8 + h]; } while (0)
    ATTN_LOAD(kf1, vr1, lf1, qb);
    ATTN_LOAD(kf2, vr2, lf2, qb > 0 ? qb - 1 : 0);
    for (int kt = qb; kt >= 0; --kt) {
        const int key0 = kt * 32;
        const bool diag = (kt == qb);
        bf16x8 kf[4]; u32x4 vr[4];
#pragma unroll
        for (int ks = 0; ks < 4; ++ks) { kf[ks] = kf1[ks]; kf1[ks] = kf2[ks]; }
#pragma unroll
        for (int i = 0; i < 4; ++i) { vr[i] = vr1[i]; vr1[i] = vr2[i]; }
        const float lf = lf1; lf1 = lf2;
        ATTN_LOAD(kf2, vr2, lf2, kt > 1 ? kt - 2 : 0);
        f32x16 st;
#pragma unroll
        for (int r = 0; r < 16; ++r) st[r] = 0.f;
#pragma unroll
        for (int ks = 0; ks < 4; ++ks) st = mfma32(kf[ks], qf[ks], st);
        wave_barrier();
#pragma unroll
        for (int i = 0; i < 4; ++i) { const int c = lane + 64 * i; *(LAS u32x4*)(wl + (c >> 3) * VROWB + (c & 7) * 16) = vr[i]; }
        if (FOX) {
            float inc = row_shl_add<1>(lf); inc = row_shl_add<2>(inc); inc = row_shl_add<4>(inc); inc = row_shl_add<8>(inc);
            { const float up0 = read_lane(inc, 16), up1 = read_lane(inc, 48); if ((lane & 16) == 0) inc += (hi ? up1 : up0); }
            const float exc = Fc + inc - lf;
            const float tot = read_lane(inc, 0);
            if (diag) fq = exc;
            if (lane < 32) frl[lane] = exc;
            wave_barrier();
            float tmax = -1e30f;
#pragma unroll
            for (int g4 = 0; g4 < 4; ++g4) {
                const f32x4 fr4 = *(const LAS f32x4*)(frl + 8 * g4 + 4 * hi);
#pragma unroll
                for (int i = 0; i < 4; ++i) { const int r = 4 * g4 + i; float lg = st[r] + fq - fr4[i]; if (diag && crow(r, hi) > r32) lg = -1e30f; st[r] = lg; tmax = fmaxf(tmax, lg); }
            }
            Fc += tot;
            tmax = fmaxf(tmax, partner32(tmax, hi));
            const float mn = fmaxf(m, tmax), f = fast_exp(m - mn);
            m = mn; lsum *= f;
#pragma unroll
            for (int r = 0; r < 16; ++r) { o0[r] *= f; o1[r] *= f; }
            float ps = 0.f;
#pragma unroll
            for (int r = 0; r < 16; ++r) { const float pr = fast_exp(st[r] - mn); st[r] = pr; ps += pr; }
            lsum += ps;
        } else {
            float l1m[16];
#pragma unroll
            for (int r = 0; r < 16; ++r) {
                const float z = st[r], sp = fast_log(1.0f + fast_exp(-fabsf(z)));
                const float lb = fminf(z, 0.f) - sp;
                const bool masked = diag && crow(r, hi) >= r32;
                l1m[r] = masked ? 0.f : lb - z;
                st[r] = masked ? -1e30f : lb;
            }
            float gs[4], pg[4], T[4];
#pragma unroll
            for (int k = 0; k < 4; ++k) { gs[k] = (l1m[4 * k] + l1m[4 * k + 1]) + (l1m[4 * k + 2] + l1m[4 * k + 3]); pg[k] = partner32(gs[k], hi); }
            float run = 0.f;
#pragma unroll
            for (int k = 3; k >= 0; --k) { T[k] = run + (hi == 0 ? pg[k] : 0.f); run += gs[k] + pg[k]; }
#pragma unroll
            for (int k = 0; k < 4; ++k) {
                float w = T[k] + carry;
#pragma unroll
                for (int i = 3; i >= 0; --i) { const int r = 4 * k + i; st[r] = fast_exp(st[r] + w); w += l1m[r]; }
            }
            carry += run;
        }
        bf16x8 pf0, pf1;
#pragma unroll
        for (int j = 0; j < 8; ++j) { pf0[j] = (short)f2bf(st[j]); pf1[j] = (short)f2bf(st[8 + j]); }
        wave_barrier();
#pragma unroll
        for (int s = 0; s < 2; ++s) {
#pragma unroll
            for (int db = 0; db < 2; ++db) {
                const s16x4 lo = tr16(vb + (16 * s) * VROWB + db * 64), hi4 = tr16(vb + (16 * s + 8) * VROWB + db * 64);
                bf16x8 vf; vf[0] = lo[0]; vf[1] = lo[1]; vf[2] = lo[2]; vf[3] = lo[3]; vf[4] = hi4[0]; vf[5] = hi4[1]; vf[6] = hi4[2]; vf[7] = hi4[3];
                if (db == 0) o0 = mfma32(vf, s == 0 ? pf0 : pf1, o0); else o1 = mfma32(vf, s == 0 ? pf0 : pf1, o1);
            }
        }
        const bool done = FOX ? (Bt + fq - Fc - m + logf((float)(key0 + 1)) < -EXIT_T) : (carry < -EXIT_T);
        if (ballot64(done) == ~0ull) break;
    }
#undef ATTN_LOAD
    if (FOX) { lsum += __shfl_xor(lsum, 32); const float il = 1.0f / lsum;
#pragma unroll
        for (int r = 0; r < 16; ++r) { o0[r] *= il; o1[r] *= il; } }
    float ss = 0.f;
#pragma unroll
    for (int r = 0; r < 16; ++r) ss += o0[r] * o0[r] + o1[r] * o1[r];
    ss += __shfl_xor(ss, 32);
    const float ri = 1.0f / sqrtf(ss * (1.0f / HD) + EPS);
    const float* g = (FOX ? p.g_fox + l * WFOX : p.g_sb + l * WSB) + h * HD;
    bf16_t* dst = MG + (size_t)t * MIXW + (FOX ? WRET + WSB : WRET) + h * HD;
#pragma unroll
    for (int db = 0; db < 2; ++db)
#pragma unroll
        for (int g4 = 0; g4 < 4; ++g4) {
            const int d0 = db * 32 + 8 * g4 + 4 * hi;
            const f32x4 gg = *(const f32x4*)(g + d0);
            float v[4];
#pragma unroll
            for (int i = 0; i < 4; ++i) v[i] = (db == 0 ? o0[4 * g4 + i] : o1[4 * g4 + i]) * ri * gg[i];
            u32x2 o; o[0] = pk2(v[0], v[1]); o[1] = pk2(v[2], v[3]);
            *(u32x2*)(dst + d0) = o;
        }
}
constexpr int WCH = 2, NWCH = (NE * WI_EXPERT + WCH - 1) / WCH;
__device__ __forceinline__ bool mix_weight_step(const Params& p, int l, lds_u8* wl, int shard0, int& wsk) {
    unsigned* wbase = (unsigned*)(p.ws + WS_CTL) + CTL_WQ + 64 * (l * 8);
    const int lane = lane_id();
#pragma unroll 1
    while (wsk < 8) {
        const int shard = (shard0 + wsk) & 7;
        unsigned* head = wbase + 64 * shard;
        unsigned c = 0x0fffffffu;
        if (lane == 0) { if (!(wsk > 0 && (int)ld_relaxed(head) * 8 + shard >= NWCH)) c = atomicAdd(head, 1u); }
        const int chunk = uni((int)__shfl(c, 0)) * 8 + shard;
        if (chunk >= NWCH) { ++wsk; continue; }
#pragma unroll 1
        for (int k = 0; k < WCH; ++k) { const int it = chunk * WCH + k; if (it < NE * WI_EXPERT) weight_item(p, l, WI_DENSE + it, wl, lane); }
        return true;
    }
    return false;
}
__device__ __forceinline__ void phase_mix(const Params& p, int l, float* ldsf) {
    constexpr int NSCANW = NRET * 4096 / 64, NFXI = NFOX * NQ32, NSBI = NSB * NQ32;
    const int wave = p.wid;
    lds_u8* wl = (lds_u8*)ldsf + wave * RET_WAVE_LDS;
    static_assert(MIX_WAVE_LDS <= RET_WAVE_LDS, "per-wave LDS region");
    const int shard0 = xcc_shard();
    int wsk = 0;
    unsigned* qbase = (unsigned*)(p.ws + WS_CTL) + CTL_MQ + 64 * (l * 8);
    const float* bfg = p.b_forget + l * NFOX;
    constexpr int NMIX = NSCANW + NFXI + NSBI;
#pragma unroll 1
    for (int sk = 0; sk < 8; ++sk) {
      const int shard = (shard0 + sk) & 7;
      unsigned* qhead = qbase + 64 * shard;
#pragma unroll 1
      for (;;) {
        unsigned itu = 0;
        if (lane_id() == 0) { if (sk > 0 && (int)ld_relaxed(qhead) * 8 + shard >= NMIX) itu = 0x0fffffffu; else itu = atomicAdd(qhead, 1u); }
        const int it = uni((int)__shfl(itu, 0)) * 8 + shard;
        if (it >= NMIX) break;
        if (it < NSCANW) ret_scan_wave(p, it);
        else if (it < NSCANW + NFXI) {
            const int j = it - NSCANW, rank = j / NQ32;
            int h = 0;
#pragma unroll
            for (int c = 0; c < NFOX; ++c) { int rk = 0;
#pragma unroll
                for (int o = 0; o < NFOX; ++o) rk += (bfg[o] > bfg[c] || (bfg[o] == bfg[c] && o < c)) ? 1 : 0;
                if (rk == rank) h = c; }
            attn_item<true>(p, l, h, NQ32 - 1 - j % NQ32, wl);
        }
        else { const int j = it - NSCANW - NFXI; attn_item<false>(p, l, j % NSB, NQ32 - 1 - j / NSB, wl); }
        (void)mix_weight_step(p, l, wl, shard0, wsk);
      }
    }
    while (mix_weight_step(p, l, wl, shard0, wsk)) {}
}

__device__ __forceinline__ void ret_out_item(const Params& p, int l, int h, int n, int cb, lds_u8* wl) {
    const bf16_t* P = (const bf16_t*)(p.ws + WS_PROJ);
    const bf16_t* SPT = (const bf16_t*)(p.ws + WS_SP) + (size_t)(h * NCHUNK + n) * 4096;
    bf16_t* MG = (bf16_t*)(p.ws + WS_MERGED);
    const int lane = lane_id(), r32 = lane & 31, hi = lane >> 5;
    const float lg = ret_log_gamma(h);
    const size_t rowb = (size_t)(n * CH) * PW + h * HD;
    const int c = 32 * cb + r32;
    wave_barrier();
    {
        u32x4 vv[8];
#pragma unroll
        for (int i = 0; i < 8; ++i) { const int q = lane + 64 * i; vv[i] = *(const u32x4*)(P + rowb + (size_t)(q >> 3) * PW + OVR + 8 * (q & 7)); }
#pragma unroll
        for (int i = 0; i < 8; ++i) { const int q = lane + 64 * i; *(LAS u32x4*)(wl + (q >> 3) * VROWB + (q & 7) * 16) = vv[i]; }
    }
    sched_fence();
    bf16x8 qf[4];
#pragma unroll
    for (int ks = 0; ks < 4; ++ks) qf[ks] = *(const bf16x8*)(P + rowb + (size_t)c * PW + OQR + 16 * ks + 8 * hi);
    f32x16 o[2];
#pragma unroll
    for (int a = 0; a < 2; ++a)
#pragma unroll
        for (int r = 0; r < 16; ++r) o[a][r] = 0.f;
#pragma unroll
    for (int ks = 0; ks < 4; ++ks)
#pragma unroll
        for (int eb = 0; eb < 2; ++eb) { const bf16x8 sf = *(const bf16x8*)(SPT + (32 * eb + r32) * 64 + 16 * ks + 8 * hi); o[eb] = mfma32(sf, qf[ks], o[eb]); }
    { const float qd = fast_exp(lg * (float)(c + 1));
#pragma unroll
      for (int eb = 0; eb < 2; ++eb)
#pragma unroll
          for (int r = 0; r < 16; ++r) o[eb][r] *= qd; }
    wave_barrier();
    const lds_u8* vb = wl + (4 * hi + ((lane & 15) >> 2)) * VROWB + (16 * ((lane >> 4) & 1) + 4 * (lane & 3)) * 2;
#pragma unroll
    for (int kb = 0; kb < 2; ++kb) {
        f32x16 st;
#pragma unroll
        for (int r = 0; r < 16; ++r) st[r] = 0.f;
#pragma unroll
        for (int ks = 0; ks < 4; ++ks) { const bf16x8 kf = *(const bf16x8*)(P + rowb + (size_t)(32 * kb + r32) * PW + OKR + 16 * ks + 8 * hi); st = mfma32(kf, qf[ks], st); }
        bf16x8 pf[2];
#pragma unroll
        for (int r = 0; r < 16; ++r) { const int dist = c - (32 * kb + crow(r, hi)); pf[r >> 3][r & 7] = (short)f2bf(st[r] * fast_exp(lg * fabsf((float)dist))); }
#pragma unroll
        for (int s = 0; s < 2; ++s)
#pragma unroll
            for (int eb = 0; eb < 2; ++eb) o[eb] = mfma32(tr_frag(vb, 32 * kb + 16 * s, 32 * kb + 16 * s + 8, eb * 64), pf[s], o[eb]);
    }
    float sm = 0.f;
#pragma unroll
    for (int eb = 0; eb < 2; ++eb)
#pragma unroll
        for (int r = 0; r < 16; ++r) sm += o[eb][r];
    sm += __shfl_xor(sm, 32);
    const float mu = sm * (1.0f / HD);
    float vs = 0.f;
#pragma unroll
    for (int eb = 0; eb < 2; ++eb)
#pragma unroll
        for (int r = 0; r < 16; ++r) { const float dlt = o[eb][r] - mu; o[eb][r] = dlt; vs += dlt * dlt; }
    vs += __shfl_xor(vs, 32);
    const float ri = 1.0f / sqrtf(vs * (1.0f / HD) + EPS);
    const int row = n * CH + c;
#pragma unroll
    for (int eb = 0; eb < 2; ++eb)
#pragma unroll
        for (int g4 = 0; g4 < 4; ++g4) {
            const int e0 = 32 * eb + 8 * g4 + 4 * hi;
            const f32x4 gg = *(const f32x4*)(p.g_ret + l * WRET + h * HD + e0);
            const u32x2 gt = *(const u32x2*)(P + (size_t)row * PW + OGR + h * HD + e0);
            const float ga[4] = {u2f(gt[0] << 16), u2f(gt[0] & 0xffff0000u), u2f(gt[1] << 16), u2f(gt[1] & 0xffff0000u)};
            float v[4];
#pragma unroll
            for (int i = 0; i < 4; ++i) v[i] = o[eb][4 * g4 + i] * ri * gg[i] * ga[i];
            u32x2 ov; ov[0] = pk2(v[0], v[1]); ov[1] = pk2(v[2], v[3]);
            *(u32x2*)(MG + (size_t)row * MIXW + h * HD + e0) = ov;
        }
}
__device__ __forceinline__ void phase_retout(const Params& p, int l, float* ldsf) {
    const int wave = p.wid;
    lds_u8* wl = (lds_u8*)ldsf + wave * RET_WAVE_LDS;
    for (int it = blockIdx.x * NW + wave; it < NRET * NCHUNK * 2; it += gridDim.x * NW) ret_out_item(p, l, (it >> 1) / NCHUNK, (it >> 1) % NCHUNK, it & 1, wl);
}

struct OutprojSched {
    static constexpr bool GATHER = false;
    int wid;
    unsigned ao[4]; int vcu, G;
    static constexpr int NPM = S / GBM, NPN = D / GBM;
    __device__ __forceinline__ bool next(int i, GUnit& u) const {
        const int L = uni(i * G + vcu); if (L >= NPM * NPN) return false;
        const int pm = L / NPN, pn = L % NPN;
        u.A = (unsigned)(pm * GBM * MIXW * 2); u.B = (unsigned)(pn * GBM * MIXW * 2); u.ao[0] = u.ao[1] = u.ao[2] = u.ao[3] = 0u;
        u.i0 = pm; u.i1 = pn; u.i2 = 0; u.i3 = 0; return true;
    }
};
struct OutprojEpi {
    const float* xin; float* X;
    __device__ __forceinline__ void operator()(f32x4 (&acc)[2][2][4][2], const GUnit& u, int wr, int wc, int fr, int fq) const {
#pragma unroll
        for (int ai = 0; ai < 2; ++ai)
#pragma unroll
            for (int m = 0; m < 4; ++m)
#pragma unroll
                for (int bj = 0; bj < 2; ++bj)
#pragma unroll
                    for (int n = 0; n < 2; ++n) { const size_t o = (size_t)(u.i0 * GBM + ai * 128 + wr * 64 + m * 16 + fr) * D + u.i1 * GBM + bj * 128 + wc * 32 + n * 16 + 4 * fq;
                        *(f32x4*)(X + o) = *(const f32x4*)(xin + o) + acc[ai][bj][m][n]; }
    }
};
__device__ __forceinline__ void phase_outproj(const Params& p, int l, float* ldsf) {
    OutprojSched S; S.wid = p.wid; plain_ao(S.ao, MIXW, TIDX(p)); S.vcu = vcu_id(); S.G = gridDim.x;
    OutprojEpi E; E.X = (float*)(p.ws + WS_X); E.xin = l == 0 ? p.x : E.X;
    gemm_stream((lds_u8*)ldsf, (const char*)(p.ws + WS_MERGED), (const char*)(p.ws + WS_WOUT) + (size_t)l * D * MIXW * 2, MIXW, S, E);
}

constexpr int RW = D + 4;
constexpr int ROUTE_LDS = NROUTE * RW * 4 + 2 * NE * 4 + 2 * 256 * 4;
template <bool DRY = false>
__device__ __forceinline__ void phase_route(const Params& p, int l, float* lds) {
    const float* X = (const float*)(p.ws + WS_X);
    bf16_t* H = (bf16_t*)(p.ws + WS_H);
    unsigned* ctl = (unsigned*)(p.ws + WS_CTL);
    int* LIST = (int*)(p.ws + WS_LIST);
    float* GATE = (float*)(p.ws + WS_GATE);
    const float* gn = p.norm_ffn + l * D;
    const float* wg = p.w_group + (size_t)l * D * NG; const float* wr = p.w_router + (size_t)l * D * NE;
    const float* bg = p.b_group + l * NG; const float* br = p.b_router + l * NE;
    const int lane = lane_id(), wave = p.wid;
    const int tidx = TIDX(p);
    unsigned* lcnt = (unsigned*)(lds + NROUTE * RW); unsigned* lbase = lcnt + NE; unsigned* lrec = lbase + NE;
    __syncthreads();
    if (tidx < NE) lcnt[tidx] = 0u;
    for (int i = tidx; i < D * NG; i += NT) lds[(i % NG) * RW + i / NG] = wg[i];
    for (int i = tidx; i < D * NE; i += NT) lds[(NG + i % NE) * RW + i / NE] = wr[i];
    __syncthreads();
    for (int r = blockIdx.x * NW + wave; r < S; r += gridDim.x * NW) {
        f32x4 v[RJ]; row_load(X + (size_t)r * D, v, lane);
        const float ri = row_rinv(v);
#pragma unroll
        for (int j = 0; j < RJ; ++j) {
            const f32x4 g = *(const f32x4*)(gn + 256 * j + lane * 4);
            v[j] = v[j] * ri * g;
            u32x2 o; o[0] = pk2(v[j][0], v[j][1]); o[1] = pk2(v[j][2], v[j][3]);
            *(u32x2*)(H + (size_t)r * D + 256 * j + lane * 4) = o;
        }
        float gl[NG];
#pragma unroll
        for (int g = 0; g < NG; ++g) { float s = 0.f;
#pragma unroll
            for (int j = 0; j < RJ; ++j) { const f32x4 w = *(const f32x4*)(lds + g * RW + 256 * j + lane * 4); s += (v[j][0] * w[0] + v[j][1] * w[1]) + (v[j][2] * w[2] + v[j][3] * w[3]); }
            gl[g] = s; }
#pragma unroll
        for (int g = 0; g < NG; ++g) gl[g] = wave_sum(gl[g]) + bg[g];
        int grp = 0; float gm = gl[0];
#pragma unroll
        for (int g = 1; g < NG; ++g) if (gl[g] > gm) { gm = gl[g]; grp = g; }
        float den = 0.f;
#pragma unroll
        for (int g = 0; g < NG; ++g) den += expf(gl[g] - gm);
        const float pg = 1.0f / den;
        float el[EPG];
        const float* wl = lds + (NG + grp * EPG) * RW + lane * 4;
#pragma unroll
        for (int e = 0; e < EPG; ++e) { float s = 0.f;
#pragma unroll
            for (int j = 0; j < RJ; ++j) { const f32x4 w = *(const f32x4*)(wl + e * RW + 256 * j); s += (v[j][0] * w[0] + v[j][1] * w[1]) + (v[j][2] * w[2] + v[j][3] * w[3]); }
            el[e] = s; }
#pragma unroll
        for (int e = 0; e < EPG; ++e) el[e] = wave_sum(el[e]) + br[grp * EPG + e];
        if (lane == 0 && !(DRY && el[0] != 12345.f)) {
            int i1 = 0; float v1 = -INFINITY; int i2 = 0; float v2 = -INFINITY;
#pragma unroll
            for (int e = 0; e < EPG; ++e) { const float x = el[e];
                if (x > v1) { v2 = v1; i2 = i1; v1 = x; i1 = e; } else if (x > v2) { v2 = x; i2 = e; } }
            const float e2 = expf(v2 - v1), g1 = pg / (1.f + e2), g2 = pg * e2 / (1.f + e2);
            const int ea = grp * EPG + i1, eb = grp * EPG + i2;
            GATE[(size_t)r * 2] = g1; GATE[(size_t)r * 2 + 1] = g2;
            const int li = (r - blockIdx.x * NW) / (gridDim.x * NW) * NW + wave;
            const unsigned ra = atomicAdd(lcnt + ea, 1u), rb = atomicAdd(lcnt + eb, 1u);
            lrec[2 * li] = (unsigned)ea | (ra << 8); lrec[2 * li + 1] = (unsigned)eb | (rb << 8);
        }
    }
    if (!DRY) {
        __syncthreads();
        if (tidx < NE) lbase[tidx] = atomicAdd(ctl + CTL_CNT + l * NE + tidx, lcnt[tidx]);
        __syncthreads();
        const int nrows = (S - blockIdx.x * NW + gridDim.x * NW - 1) / (gridDim.x * NW) * NW;
        for (int i = tidx; i < 2 * nrows; i += NT) {
            const int li = i >> 1, r = blockIdx.x * NW + (li / NW) * (gridDim.x * NW) + (li % NW);
            if (r < S) { const unsigned rec = lrec[i]; const int e = rec & 255u; LIST[(size_t)e * S + lbase[e] + (rec >> 8)] = r * 2 + (i & 1); }
        }
    }
}

__device__ __forceinline__ bool moe_unit(const unsigned* cnt, int u, int npn, int& e, int& rt, int& pn, int& base) {
    int tile = uni(u / npn); pn = uni(u % npn); base = 0;
    for (e = 0; e < NE; ++e) { const int nt = uni(((int)cnt[e] + GBM - 1) / GBM); if (tile < nt) { rt = tile; return true; } tile -= nt; base += nt * GBM; }
    return false;
}
struct Moe1Sched {
    static constexpr bool GATHER = true;
    int wid;
    unsigned ao[4];
    const unsigned* cnt; const int* LIST; int vcu, G;
    static constexpr int NPN = 2 * DE / GBM;
    __device__ __forceinline__ bool next(int i, GUnit& u) const {
        int e, rt, pn, base; if (!moe_unit(cnt, i * G + vcu, NPN, e, rt, pn, base)) return false;
        const int nvalid = uni((int)cnt[e]) - rt * GBM;
        u.A = 0u; u.B = (unsigned)((e * 2 * DE + pn * GBM) * D * 2);
#pragma unroll
        for (int k = 0; k < 4; ++k) { int R, C; stage_rc(((wid << 6) | lane_id()) * 16 + (k & 1) * 8192, R, C); const int r = R + 128 * (k >> 1);
            const int tok = r < nvalid ? (LIST[(size_t)e * S + rt * GBM + r] >> 1) : 0; u.ao[k] = (unsigned)((tok * D + C) * 2); }
        u.i0 = base + rt * GBM; u.i1 = pn; u.i2 = nvalid; u.i3 = e * S + rt * GBM; return true;
    }
};
struct Moe1Epi {
    bf16_t* HID;
    __device__ __forceinline__ void operator()(f32x4 (&acc)[2][2][4][2], const GUnit& u, int wr, int wc, int fr, int fq) const {
#pragma unroll
        for (int ai = 0; ai < 2; ++ai)
#pragma unroll
            for (int m = 0; m < 4; ++m)
#pragma unroll
                for (int n = 0; n < 2; ++n) { f32x4 v;
#pragma unroll
                    for (int j = 0; j < 4; ++j) v[j] = silu(acc[ai][0][m][n][j]) * acc[ai][1][m][n][j];
                    u32x2 o; o[0] = pk2(v[0], v[1]); o[1] = pk2(v[2], v[3]);
                    *(u32x2*)(HID + (size_t)(u.i0 + ai * 128 + wr * 64 + m * 16 + fr) * DE + u.i1 * 128 + wc * 32 + n * 16 + 4 * fq) = o; }
    }
};
__device__ __forceinline__ void phase_moe1(const Params& p, int l, float* ldsf) {
    Moe1Sched S; S.wid = p.wid; S.cnt = (const unsigned*)(p.ws + WS_CTL) + CTL_CNT + l * NE;
    S.LIST = (const int*)(p.ws + WS_LIST); S.vcu = vcu_id(); S.G = gridDim.x;
    Moe1Epi E; E.HID = (bf16_t*)(p.ws + WS_HID);
    gemm_stream((lds_u8*)ldsf, (const char*)(p.ws + WS_H), (const char*)(p.ws + WS_WGU) + (size_t)l * NE * 2 * DE * D * 2, D, S, E);
}
struct Moe2Sched {
    static constexpr bool GATHER = false;
    int wid;
    const unsigned* cnt; unsigned ao[4]; int vcu, G;
    static constexpr int NPN = D / GBM;
    __device__ __forceinline__ bool next(int i, GUnit& u) const {
        int e, rt, pn, base; if (!moe_unit(cnt, i * G + vcu, NPN, e, rt, pn, base)) return false;
        u.A = (unsigned)((base + rt * GBM) * DE * 2); u.B = (unsigned)((e * D + pn * GBM) * DE * 2); u.ao[0] = u.ao[1] = u.ao[2] = u.ao[3] = 0u;
        u.i0 = 0; u.i1 = pn; u.i2 = uni((int)cnt[e]) - rt * GBM; u.i3 = e * S + rt * GBM; return true;
    }
};
struct Moe2Epi {
    bf16_t* Y; const int* LIST; const float* GATE;
    __device__ __forceinline__ void operator()(f32x4 (&acc)[2][2][4][2], const GUnit& u, int wr, int wc, int fr, int fq) const {
        int a[2][4]; float g[2][4];
#pragma unroll
        for (int ai = 0; ai < 2; ++ai)
#pragma unroll
            for (int m = 0; m < 4; ++m) { const int r = ai * 128 + wr * 64 + m * 16 + fr; a[ai][m] = r < u.i2 ? LIST[(size_t)u.i3 + r] : -1; }
#pragma unroll
        for (int ai = 0; ai < 2; ++ai)
#pragma unroll
            for (int m = 0; m < 4; ++m) g[ai][m] = a[ai][m] >= 0 ? GATE[a[ai][m]] : 0.f;
#pragma unroll
        for (int ai = 0; ai < 2; ++ai)
#pragma unroll
            for (int m = 0; m < 4; ++m) {
                if (a[ai][m] >= 0) {
#pragma unroll
                    for (int bj = 0; bj < 2; ++bj)
#pragma unroll
                        for (int n = 0; n < 2; ++n) { const f32x4 v = acc[ai][bj][m][n] * g[ai][m]; u32x2 o; o[0] = pk2(v[0], v[1]); o[1] = pk2(v[2], v[3]);
                            *(u32x2*)(Y + (size_t)a[ai][m] * D + u.i1 * GBM + bj * 128 + wc * 32 + n * 16 + 4 * fq) = o; }
                }
            }
    }
};
__device__ __forceinline__ void phase_moe2(const Params& p, int l, float* ldsf) {
    Moe2Sched S; S.wid = p.wid; S.cnt = (const unsigned*)(p.ws + WS_CTL) + CTL_CNT + l * NE;
    plain_ao(S.ao, DE, TIDX(p)); S.vcu = vcu_id(); S.G = gridDim.x;
    Moe2Epi E; E.Y = (bf16_t*)(p.ws + WS_Y); E.LIST = (const int*)(p.ws + WS_LIST); E.GATE = (const float*)(p.ws + WS_GATE);
    gemm_stream((lds_u8*)ldsf, (const char*)(p.ws + WS_HID), (const char*)(p.ws + WS_WDN) + (size_t)l * NE * D * DE * 2, DE, S, E);
}

__device__ __forceinline__ void phase_combine(const Params& p, int l) {
    float* X = (float*)(p.ws + WS_X);
    const bf16_t* Y = (const bf16_t*)(p.ws + WS_Y);
    bf16_t* H = (bf16_t*)(p.ws + WS_H);
    const bool last = (l == DEPTH - 1);
    const float* gn = last ? p.norm_final : p.norm_mix + (l + 1) * D;
    const int lane = lane_id(), wave = p.wid;
    for (int r = blockIdx.x * NW + wave; r < S; r += gridDim.x * NW) {
        f32x4 v[RJ]; row_load(X + (size_t)r * D, v, lane);
#pragma unroll
        for (int j = 0; j < RJ; ++j) {
            const u32x2 a = *(const u32x2*)(Y + (size_t)(2 * r) * D + 256 * j + lane * 4), b = *(const u32x2*)(Y + (size_t)(2 * r + 1) * D + 256 * j + lane * 4);
            v[j][0] += u2f(a[0] << 16) + u2f(b[0] << 16); v[j][1] += u2f(a[0] & 0xffff0000u) + u2f(b[0] & 0xffff0000u);
            v[j][2] += u2f(a[1] << 16) + u2f(b[1] << 16); v[j][3] += u2f(a[1] & 0xffff0000u) + u2f(b[1] & 0xffff0000u);
        }
        const float ri = row_rinv(v);
#pragma unroll
        for (int j = 0; j < RJ; ++j) {
            const f32x4 g = *(const f32x4*)(gn + 256 * j + lane * 4);
            if (last) *(f32x4*)(p.out + (size_t)r * D + 256 * j + lane * 4) = v[j] * ri * g;
            else {
                *(f32x4*)(X + (size_t)r * D + 256 * j + lane * 4) = v[j];
                u32x2 o; o[0] = pk2(v[j][0] * ri * g[0], v[j][1] * ri * g[1]); o[1] = pk2(v[j][2] * ri * g[2], v[j][3] * ri * g[3]);
                *(u32x2*)(H + (size_t)r * D + 256 * j + lane * 4) = o;
            }
        }
    }
}

constexpr int PH_PER_LAYER = 9, NPHASE = 1 + DEPTH * PH_PER_LAYER;
constexpr int imax_c(int a, int b) { return a > b ? a : b; }
constexpr int LDS_MAIN = imax_c(imax_c(GEMM_LDS, ROUTE_LDS), imax_c(NW * RET_WAVE_LDS, NW * MIX_WAVE_LDS));
constexpr int LDS_MISC = (LDS_MAIN + 255) / 256 * 256;
constexpr int LDS_BYTES = LDS_MISC + 256;

__device__ __forceinline__ void run_phase(const Params& p, int ph, float* lds) {
    if (ph == 0) { phase_init(p, lds); return; }
    const int l = (ph - 1) / PH_PER_LAYER, q = (ph - 1) % PH_PER_LAYER;
    switch (q) {
        case 0: phase_inproj(p, l, lds); break;
        case 1: phase_prep(p, l, lds); break;
        case 2: phase_mix(p, l, lds); break;
        case 3: phase_retout(p, l, lds); break;
        case 4: phase_outproj(p, l, lds); break;
        case 5: phase_route(p, l, lds); break;
        case 6: phase_moe1(p, l, lds); break;
        case 7: phase_moe2(p, l, lds); break;
        default: phase_combine(p, l); break;
    }
}

#ifndef CPU_EMU
#define XB_TMO      128
#define XB_XCNT(j)  (256  + 64 * (j))
#define XB_XSUB(j)  (1280 + 64 * (j))
#define XB_XGEN(j)  (2304 + 64 * (j))
#define XB_TOP      3328
#define XB_TOPGEN   3392
#define XCD_BAR_WORDS 3456
#define XB_SPIN_CAP (1u << 22)
__device__ __forceinline__ unsigned xb_ld(unsigned* p)              { return __hip_atomic_load(p, __ATOMIC_RELAXED, __HIP_MEMORY_SCOPE_AGENT); }
__device__ __forceinline__ unsigned xb_add(unsigned* p, unsigned v) { return __hip_atomic_fetch_add(p, v, __ATOMIC_RELAXED, __HIP_MEMORY_SCOPE_AGENT); }
__device__ __forceinline__ unsigned xb_xcc_id() { return (unsigned)__builtin_amdgcn_s_getreg((3 << 11) | 20) & 0xFu; }
#define XB_SPIN(cond, bar) do { unsigned _sp = 0; while (cond) { __builtin_amdgcn_s_sleep(1); \
    if ((++_sp & 255u) == 0u) { if (xb_ld(&(bar)[XB_TMO])) break; if (_sp > XB_SPIN_CAP) { atomicAdd(&(bar)[XB_TMO], 1u); break; } } } } while (0)
struct XcdBarrier { unsigned* bar; unsigned x; volatile LAS unsigned* st; };
__device__ __forceinline__ XcdBarrier xcd_barrier_post(unsigned* bar, volatile LAS unsigned* st, bool t0) {
    XcdBarrier b; b.bar = bar; b.x = xb_xcc_id(); b.st = st;
    if (t0) (void)xb_add(&bar[XB_XCNT(b.x)], 1u);
    return b;
}
__device__ __forceinline__ void xcd_barrier_complete(unsigned* bar, unsigned x, unsigned& nloc, unsigned& nx) {
    const unsigned G = gridDim.x * gridDim.y * gridDim.z;
    unsigned sum, cnt, mine, sp = 0u;
    for (;;) {
        sum = 0u; cnt = 0u; mine = 0u;
#pragma unroll
        for (unsigned j = 0; j < 16; ++j) { const unsigned c = xb_ld(&bar[XB_XCNT(j)]); sum += c; cnt += (c > 0u) ? 1u : 0u; mine = (j == x) ? c : mine; }
        if (sum == G) break;
        __builtin_amdgcn_s_sleep(1);
        if ((++sp & 255u) == 0u) { if (xb_ld(&bar[XB_TMO])) break; if (sp > XB_SPIN_CAP) { atomicAdd(&bar[XB_TMO], 1u); break; } }
    }
    nloc = mine > 0u ? mine : 1u; nx = cnt > 0u ? cnt : 1u;
}
__device__ __forceinline__ void xcd_barrier(const XcdBarrier& b, bool t0) {
    asm volatile("s_waitcnt vmcnt(0)" ::: "memory");
    __syncthreads();
    if (t0) {
        unsigned* bar = b.bar;
        __builtin_amdgcn_s_waitcnt(0);
        unsigned nloc = b.st[0], nx = b.st[1];
        if (nloc == 0u) { xcd_barrier_complete(bar, b.x, nloc, nx); b.st[0] = nloc; b.st[1] = nx; }
        const unsigned old = xb_add(&bar[XB_XSUB(b.x)], 1u);
        const unsigned gen = old / nloc;
        if (old + 1u == (gen + 1u) * nloc) {
            __builtin_amdgcn_fence(__ATOMIC_RELEASE, "agent");
            asm volatile("s_waitcnt vmcnt(0)" ::: "memory");
            const unsigned og = xb_add(&bar[XB_TOP], 1u);
            const unsigned tg = og / nx;
            if (og + 1u == (tg + 1u) * nx) xb_add(&bar[XB_TOPGEN], 1u);
            else XB_SPIN(xb_ld(&bar[XB_TOPGEN]) == tg, bar);
            __builtin_amdgcn_fence(__ATOMIC_ACQUIRE, "agent");
            xb_add(&bar[XB_XGEN(b.x)], 1u);
            asm volatile("s_waitcnt vmcnt(0)" ::: "memory");
        } else {
            XB_SPIN(xb_ld(&bar[XB_XGEN(b.x)]) == gen, bar);
            __builtin_amdgcn_fence(__ATOMIC_ACQUIRE, "agent");
            asm volatile("s_waitcnt vmcnt(0)" ::: "memory");
        }
    }
    __syncthreads();
}
#endif
#ifndef CPU_EMU
__global__ void __launch_bounds__(NT) fwd_kernel(Params pin, int ph_lo, int ph_hi) {
    extern __shared__ __attribute__((aligned(16))) float lds[];
    cg::grid_group grid = cg::this_grid();
    Params p = pin; p.wid = uni((int)(threadIdx.x >> 6));
    volatile LAS unsigned* misc = (volatile LAS unsigned*)((LAS unsigned char*)lds + LDS_MISC);
    if (p.wid == 0) misc[lane_id()] = 0u;
    __syncthreads();
    XcdBarrier xb; xb.bar = (unsigned*)(p.ws + WS_CTL) + CTL_BAR; xb.x = 0; xb.st = misc;
    const bool use_xb = (ph_lo == 0);
#define T0() (p.wid == 0 && lane_id() == 0)
#define SEAM(k) do { if ((k) == 0 || !use_xb) { grid.sync(); if ((k) == 0 && use_xb) xb = xcd_barrier_post((unsigned*)(p.ws + WS_CTL) + CTL_BAR, misc, T0()); } else xcd_barrier(xb, T0()); } while (0)
#define PHASE(k, call) do { if (ph_lo <= (k) && (k) < ph_hi) { call; if ((k) + 1 < ph_hi) SEAM(k); } } while (0)
#ifndef PROBE_DUP
#define PROBE_DUP 0
#endif
#define DUP(bit, call) do { if ((PROBE_DUP & (bit)) && l_ == 0) { __syncthreads(); call; } } while (0)
#define LAYER(l) do { const int b_ = 1 + (l) * PH_PER_LAYER; const int l_ = (l); \
        PHASE(b_ + 0, phase_inproj(p, l, lds); DUP(1, phase_inproj(p, l, lds))); PHASE(b_ + 1, phase_prep(p, l, lds); DUP(2, phase_prep(p, l, lds))); PHASE(b_ + 2, phase_mix(p, l, lds); DUP(4, phase_mix(p, l, lds))); \
        PHASE(b_ + 3, phase_retout(p, l, lds); DUP(8, phase_retout(p, l, lds))); PHASE(b_ + 4, phase_outproj(p, l, lds); DUP(16, phase_outproj(p, l, lds))); PHASE(b_ + 5, phase_route(p, l, lds); DUP(128, phase_route<true>(p, l, lds))); \
        PHASE(b_ + 6, phase_moe1(p, l, lds); DUP(32, phase_moe1(p, l, lds))); PHASE(b_ + 7, phase_moe2(p, l, lds); DUP(64, phase_moe2(p, l, lds))); PHASE(b_ + 8, phase_combine(p, l); if ((PROBE_DUP & 256) && l_ == 1) phase_combine(p, l)); } while (0)
    PHASE(0, phase_init(p, lds); if (PROBE_DUP & 512) { __syncthreads(); phase_init(p, lds); });
    LAYER(0);
    LAYER(1);
    static_assert(DEPTH == 2, "phase program written for two layers");
#undef LAYER
#undef PHASE
#undef SEAM
}

#ifndef N_LAUNCH_PER_PHASE
#define N_LAUNCH_PER_PHASE 0
#endif
extern "C" void kernel_launch(void* const* d_in, const int* in_sizes, int n_in, void* d_out, int out_size, void* d_ws, size_t ws_size, hipStream_t stream) {
    static int grid = 0;
    if (grid == 0) {
        if (ws_size < WS_END) { fprintf(stderr, "kernel_launch: workspace too small (%zu < %zu)\n", ws_size, (size_t)WS_END); grid = -1; return; }
        int dev = 0, cus = 0, per_cu = 0;
        hipGetDevice(&dev);
        hipDeviceGetAttribute(&cus, hipDeviceAttributeMultiprocessorCount, dev);
        hipFuncSetAttribute((const void*)fwd_kernel, hipFuncAttributeMaxDynamicSharedMemorySize, LDS_BYTES);
        hipOccupancyMaxActiveBlocksPerMultiprocessor(&per_cu, (const void*)fwd_kernel, NT, LDS_BYTES);
        if (per_cu < 1) { fprintf(stderr, "kernel_launch: occupancy query says %d blocks per CU\n", per_cu); grid = -1; return; }
        grid = cus;
    }
    if (grid < 0) return;
    Params p{};
    p.x = (const float*)d_in[0]; p.norm_mix = (const float*)d_in[1]; p.w_in = (const float*)d_in[2]; p.b_forget = (const float*)d_in[3];
    p.g_ret = (const float*)d_in[4]; p.g_sb = (const float*)d_in[5]; p.g_fox = (const float*)d_in[6]; p.w_out = (const float*)d_in[7];
    p.norm_ffn = (const float*)d_in[8]; p.w_group = (const float*)d_in[9]; p.b_group = (const float*)d_in[10]; p.w_router = (const float*)d_in[11];
    p.b_router = (const float*)d_in[12]; p.w_gate = (const float*)d_in[13]; p.w_up = (const float*)d_in[14]; p.w_down = (const float*)d_in[15];
    p.norm_final = (const float*)d_in[16]; p.out = (float*)d_out; p.ws = (unsigned char*)d_ws;
#if N_LAUNCH_PER_PHASE
    for (int ph = 0; ph < NPHASE; ++ph) {
        int lo = ph, hi = ph + 1; void* args[] = {&p, &lo, &hi};
        hipLaunchCooperativeKernel((const void*)fwd_kernel, dim3(grid), dim3(NT), args, LDS_BYTES, stream);
    }
#else
    int lo = 0, hi = NPHASE; void* args[] = {&p, &lo, &hi};
    hipError_t e = hipLaunchCooperativeKernel((const void*)fwd_kernel, dim3(grid), dim3(NT), args, LDS_BYTES, stream);
    if (e != hipSuccess) fprintf(stderr, "cooperative launch failed: %s (grid %d)\n", hipGetErrorString(e), grid);
#endif
}
#endif
```

```cpp
#ifndef CPU_EMU
#include <hip/hip_runtime.h>
#include <hip/hip_cooperative_groups.h>
#include <cstdio>
#include <cstdint>
#include <cmath>
namespace cg = cooperative_groups;
#define VEC(T, N) T __attribute__((ext_vector_type(N)))
__device__ __forceinline__ void wave_barrier() { __builtin_amdgcn_wave_barrier(); }
__device__ __forceinline__ float sin2pi(float x) { return __builtin_amdgcn_sinf(x); }
__device__ __forceinline__ float cos2pi(float x) { return __builtin_amdgcn_cosf(x); }
__device__ __forceinline__ unsigned long long ballot64(bool p) { return __ballot(p); }
#define LAS __attribute__((address_space(3)))
typedef VEC(short, 8) bf16x8;
typedef VEC(float, 4) f32x4_;
__device__ __forceinline__ void glds16(const void* g, LAS unsigned char* l) { __builtin_amdgcn_global_load_lds((const unsigned*)g, (LAS unsigned*)l, 16, 0, 0); }
__device__ __forceinline__ void vm_wait0() { asm volatile("s_waitcnt vmcnt(0)" ::: "memory"); }
__device__ __forceinline__ void lds_wait0() { asm volatile("s_waitcnt lgkmcnt(0)" ::: "memory"); }
__device__ __forceinline__ void sched_fence() { __builtin_amdgcn_sched_barrier(0); }
__device__ __forceinline__ int uni(int x) { return __builtin_amdgcn_readfirstlane(x); }
__device__ __forceinline__ unsigned ld_relaxed(const unsigned* p) { return __hip_atomic_load(p, __ATOMIC_RELAXED, __HIP_MEMORY_SCOPE_AGENT); }
__device__ __forceinline__ int xcc_shard() { return (int)(__builtin_amdgcn_s_getreg((3 << 11) | 20) & 7u); }
__device__ __forceinline__ int lane_id() { int l; asm volatile("v_mbcnt_lo_u32_b32 %0, -1, 0\n\tv_mbcnt_hi_u32_b32 %0, -1, %0" : "=v"(l)); return l; }
__device__ __forceinline__ f32x4_ mfma16(bf16x8 a, bf16x8 b, f32x4_ c) { return __builtin_amdgcn_mfma_f32_16x16x32_bf16(a, b, c, 0, 0, 0); }
typedef VEC(float, 16) f32x16;
typedef VEC(short, 4) s16x4;
__device__ __forceinline__ f32x16 mfma32(bf16x8 a, bf16x8 b, f32x16 c) { return __builtin_amdgcn_mfma_f32_32x32x16_bf16(a, b, c, 0, 0, 0); }
__device__ __forceinline__ s16x4 tr16(const LAS unsigned char* p) { return __builtin_amdgcn_ds_read_tr16_b64_v4i16((LAS s16x4*)p); }
__device__ __forceinline__ float fast_exp(float x) { return __expf(x); }
__device__ __forceinline__ float fast_log(float x) { return __logf(x); }
__device__ __forceinline__ float partner32(float x, int hi) { const auto rr = __builtin_amdgcn_permlane32_swap(__builtin_bit_cast(unsigned, x), __builtin_bit_cast(unsigned, x), false, false); return __builtin_bit_cast(float, hi ? rr[0] : rr[1]); }
template <int N> __device__ __forceinline__ float row_shl_add(float x) { return x + __builtin_bit_cast(float, __builtin_amdgcn_update_dpp(0, __builtin_bit_cast(int, x), 0x100 + N, 0xf, 0xf, true)); }
__device__ __forceinline__ float read_lane(float x, int l) { return __builtin_bit_cast(float, __builtin_amdgcn_readlane(__builtin_bit_cast(int, x), l)); }
#else
#define VEC(T, N) T __attribute__((vector_size(sizeof(T) * N)))
inline float sin2pi(float x) { return (float)sin(6.283185307179586 * (double)x); }
inline float cos2pi(float x) { return (float)cos(6.283185307179586 * (double)x); }
inline unsigned long long ballot64(bool p) { return emu_ballot(p); }
#define LAS
typedef VEC(short, 8) bf16x8;
inline void glds16(const void* g, unsigned char* l) { memcpy(l + (threadIdx.x & 63) * 16, g, 16); }
inline void vm_wait0() {}
inline void lds_wait0() {}
inline void sched_fence() {}
inline int uni(int x) { return x; }
inline int xcc_shard() { return (int)(blockIdx.x & 7u); }
inline unsigned ld_relaxed(const unsigned* p) { return __atomic_load_n(p, __ATOMIC_RELAXED); }
inline int lane_id() { return threadIdx.x & 63; }
inline emu_f32x4 mfma16(bf16x8 a, bf16x8 b, emu_f32x4 c) { return emu_mfma16(a, b, c); }
typedef VEC(float, 16) f32x16;
typedef VEC(short, 4) s16x4;
inline f32x16 mfma32(bf16x8 a, bf16x8 b, f32x16 c) { return emu_mfma32(a, b, c); }
inline s16x4 tr16(const unsigned char* p) { return emu_tr16(p); }
inline float fast_exp(float x) { return expf(x); }
inline float fast_log(float x) { return logf(x); }
inline float partner32(float x, int hi) { return __shfl_xor(x, 32); }
template <int N> inline float row_shl_add(float x) { const int l = threadIdx.x & 63; const float o = emu_shfl_idx(x, (l + N) & 63); return x + (((l & 15) + N < 16) ? o : 0.f); }
inline float read_lane(float x, int l) { return emu_shfl_idx(x, l); }
#endif

typedef unsigned short bf16_t;
typedef VEC(float, 4) f32x4;
typedef VEC(float, 2) f32x2;
typedef VEC(unsigned, 2) u32x2;
typedef VEC(unsigned, 4) u32x4;
typedef LAS unsigned char lds_u8;

#ifndef PROBE_T
#define PROBE_T -1
#endif
#ifdef SMALL_CFG
constexpr int D = 256, S = 512, DEPTH = 2, NRET = 2, NSB = 1, NFOX = 1, NG = 2, EPG = 4, DE = 128;
#else
constexpr int D = 1024, S = 16384, DEPTH = 2, NRET = 6, NSB = 5, NFOX = 5, NG = 4, EPG = 8, DE = 512;
#endif
constexpr int CH = 64, HD = 64, NE = NG * EPG;
constexpr int WRET = NRET * HD, WSB = NSB * HD, WFOX = NFOX * HD, MIXW = WRET + WSB + WFOX;
constexpr int IN_W = 4 * WRET + 3 * WSB + 3 * WFOX + NFOX;
constexpr int PW = (IN_W + 255) / 256 * 256;
constexpr int OQR = 0, OKR = WRET, OVR = 2 * WRET, OGR = 3 * WRET, OQS = 4 * WRET, OKS = OQS + WSB, OVS = OKS + WSB;
constexpr int OQF = OVS + WSB, OKF = OQF + WFOX, OVF = OKF + WFOX, OFL = OVF + WFOX;
constexpr int NCHUNK = S / CH;
constexpr float EPS = 1e-6f;
constexpr int NT = 512, NW = NT / 64;
constexpr int NROUTE = NG + NE;
constexpr float EXIT_T = 20.0f;

constexpr size_t al256(size_t x) { return (x + 255) / 256 * 256; }
constexpr size_t WS_CTL = 0;
constexpr int CTL_CNT = 0;
constexpr int CTL_KMAX = 256;
constexpr int CTL_MQ = 4608, CTL_WQ = 4608 + DEPTH * 8 * 64;
constexpr int CTL_BAR = 1024;
constexpr int CTL_WORDS = 8192;
static_assert(CTL_BAR + 3456 <= CTL_MQ && CTL_WQ + DEPTH * 8 * 64 <= CTL_WORDS, "control-word map");
constexpr size_t WS_ROT = 32768;
constexpr size_t WS_X = al256(WS_ROT + (size_t)S * 32 * 8);
constexpr size_t WS_H = al256(WS_X + (size_t)S * D * 4);
constexpr size_t WS_LOGF = al256(WS_H + (size_t)S * D * 2);
constexpr size_t WS_MERGED = al256(WS_LOGF + (size_t)S * 8 * 4);
constexpr size_t WS_U = al256(WS_MERGED + (size_t)S * MIXW * 2);
constexpr size_t WS_SP = al256(WS_U + (size_t)NRET * NCHUNK * 4096 * 4);
constexpr size_t WS_LIST = al256(WS_SP + (size_t)NRET * NCHUNK * 4096 * 4);
constexpr size_t WS_GATE = al256(WS_LIST + (size_t)NE * S * 4);
constexpr size_t WS_WIN = al256(WS_GATE + (size_t)S * 2 * 4);
constexpr size_t WS_WOUT = al256(WS_WIN + (size_t)DEPTH * PW * D * 2);
constexpr size_t WS_WGU = al256(WS_WOUT + (size_t)DEPTH * D * MIXW * 2);
constexpr size_t WS_WDN = al256(WS_WGU + (size_t)DEPTH * NE * 2 * DE * D * 2);
constexpr size_t WS_PROJ = al256(WS_WDN + (size_t)DEPTH * NE * D * DE * 2);
constexpr int HID_ROWS = 2 * S + NE * 256;
constexpr size_t WS_HID = WS_PROJ;
constexpr size_t WS_Y = al256(WS_HID + (size_t)HID_ROWS * DE * 2);
constexpr size_t WS_END0 = al256(WS_PROJ + (size_t)S * PW * 2), WS_END1 = al256(WS_Y + (size_t)2 * S * D * 2);
constexpr size_t WS_END = WS_END0 > WS_END1 ? WS_END0 : WS_END1;
#ifndef SMALL_CFG
static_assert(WS_END <= (size_t)512 * 1024 * 1024, "workspace map exceeds the guaranteed 512 MiB");
#endif

struct Params {
    const float* x; const float* norm_mix; const float* w_in; const float* b_forget; const float* g_ret; const float* g_sb; const float* g_fox;
    const float* w_out; const float* norm_ffn; const float* w_group; const float* b_group; const float* w_router; const float* b_router;
    const float* w_gate; const float* w_up; const float* w_down; const float* norm_final;
    float* out; unsigned char* ws;
    int wid, pad;
};

#define TIDX(p) (((p).wid << 6) | lane_id())
__device__ __forceinline__ int imin(int a, int b) { return a < b ? a : b; }
__device__ __forceinline__ float u2f(unsigned u) { return __builtin_bit_cast(float, u); }
__device__ __forceinline__ unsigned f2u(float f) { return __builtin_bit_cast(unsigned, f); }
__device__ __forceinline__ float bf2f(bf16_t b) { return u2f((unsigned)b << 16); }
__device__ __forceinline__ bf16_t f2bf(float f) { unsigned u = f2u(f); return (bf16_t)((u + 0x7fffu + ((u >> 16) & 1u)) >> 16); }
#ifndef CPU_EMU
typedef float pk_f32x2 __attribute__((ext_vector_type(2))); typedef __bf16 pk_bf16x2 __attribute__((ext_vector_type(2)));
__device__ __forceinline__ unsigned pk2(float lo, float hi) { const pk_f32x2 v = {lo, hi}; return __builtin_bit_cast(unsigned, __builtin_convertvector(v, pk_bf16x2)); }
#else
__device__ __forceinline__ unsigned pk2(float lo, float hi) { return (unsigned)f2bf(lo) | ((unsigned)f2bf(hi) << 16); }
#endif
__device__ __forceinline__ float log_sigmoid(float x) { return fminf(x, 0.f) - log1pf(expf(-fabsf(x))); }
__device__ __forceinline__ float silu(float x) { return x / (1.f + expf(-x)); }
#ifndef CPU_EMU
template <int CTRL> __device__ __forceinline__ float dpp_mov(float x) { return __builtin_bit_cast(float, __builtin_amdgcn_update_dpp(0, __builtin_bit_cast(int, x), CTRL, 0xf, 0xf, false)); }
__device__ __forceinline__ float wave_sum(float v) {
    v += dpp_mov<0xB1>(v); v += dpp_mov<0x4E>(v); v += dpp_mov<0x141>(v); v += dpp_mov<0x140>(v);
    return (read_lane(v, 0) + read_lane(v, 16)) + (read_lane(v, 32) + read_lane(v, 48));
}
__device__ __forceinline__ float wave_max(float v) {
    v = fmaxf(v, dpp_mov<0xB1>(v)); v = fmaxf(v, dpp_mov<0x4E>(v)); v = fmaxf(v, dpp_mov<0x141>(v)); v = fmaxf(v, dpp_mov<0x140>(v));
    return fmaxf(fmaxf(read_lane(v, 0), read_lane(v, 16)), fmaxf(read_lane(v, 32), read_lane(v, 48)));
}
#else
__device__ __forceinline__ float wave_sum(float v) {
#pragma unroll
    for (int o = 1; o < 64; o <<= 1) v += __shfl_xor(v, o);
    return v;
}
__device__ __forceinline__ float wave_max(float v) {
#pragma unroll
    for (int o = 1; o < 64; o <<= 1) v = fmaxf(v, __shfl_xor(v, o));
    return v;
}
#endif
__device__ __forceinline__ double inv_turns(int j) {
    static constexpr double T[32] = {
        1.59154943091895346e-01, 1.19349370211248862e-01, 8.94994016088910133e-02, 6.71150830052272551e-02, 5.03292121044870353e-02, 3.77415847174197711e-02, 2.83021958306233987e-02, 2.12236527647776604e-02,
        1.59154943091895339e-02, 1.19349370211248862e-02, 8.94994016088910237e-03, 6.71150830052272534e-03, 5.03292121044870370e-03, 3.77415847174197719e-03, 2.83021958306233987e-03, 2.12236527647776622e-03,
        1.59154943091895356e-03, 1.19349370211248849e-03, 8.94994016088910237e-04, 6.71150830052272599e-04, 5.03292121044870326e-04, 3.77415847174197741e-04, 2.83021958306233954e-04, 2.12236527647776605e-04,
        1.59154943091895351e-04, 1.19349370211248862e-04, 8.94994016088910182e-05, 6.71150830052272545e-05, 5.03292121044870354e-05, 3.77415847174197768e-05, 2.83021958306233961e-05, 2.12236527647776592e-05};
    return T[j];
}

constexpr int VROWB = 144;
constexpr int IMG64 = 64 * VROWB;
constexpr int RET_WAVE_LDS = 2 * IMG64;
__device__ __forceinline__ int crow(int reg, int hi) { return (reg & 3) + 8 * (reg >> 2) + 4 * hi; }
__device__ __forceinline__ bf16x8 tr_frag(const lds_u8* base, int rowoff0, int rowoff1, int coloff) {
    const s16x4 lo = tr16(base + rowoff0 * VROWB + coloff), hi4 = tr16(base + rowoff1 * VROWB + coloff);
    bf16x8 f; f[0] = lo[0]; f[1] = lo[1]; f[2] = lo[2]; f[3] = lo[3]; f[4] = hi4[0]; f[5] = hi4[1]; f[6] = hi4[2]; f[7] = hi4[3]; return f;
}

constexpr int RJ = D / 256;
__device__ __forceinline__ void row_load(const float* row, f32x4* v, int lane) {
#pragma unroll
    for (int j = 0; j < RJ; ++j) v[j] = *(const f32x4*)(row + 256 * j + lane * 4);
}
__device__ __forceinline__ float row_rinv(const f32x4* v) {
    float s = 0.f;
#pragma unroll
    for (int j = 0; j < RJ; ++j) s += (v[j][0] * v[j][0] + v[j][1] * v[j][1]) + (v[j][2] * v[j][2] + v[j][3] * v[j][3]);
    s = wave_sum(s);
    return 1.0f / sqrtf(s * (1.0f / D) + EPS);
}

#ifndef CPU_EMU
typedef float f32x4_u __attribute__((ext_vector_type(4), aligned(4)));
#else
typedef float f32x4_u __attribute__((vector_size(16), aligned(4)));
#endif
#ifndef CPU_EMU
__device__ __forceinline__ f32x4_u nt_load4(const f32x4_u* p) { return __builtin_nontemporal_load(p); }
#else
inline f32x4_u nt_load4(const f32x4_u* p) { return *p; }
#endif
__device__ __forceinline__ void transpose_item64(const float* Wa, const float* Wb, int ldw, int ncols, int c0, int cb0, int k0, bf16_t* WT, int ldt, int r0, int r1, lds_u8* img, int lane) {
    const int n = 4 * (lane & 15), kr = lane >> 4;
    const float* src = (n < 32 ? Wa + c0 + n : Wb + cb0 + (n - 32)) + (size_t)(k0 + kr) * ldw;
    const int col = (n < 32 ? c0 + n : cb0 + n - 32);
    f32x4 v[16];
    if (col + 3 < ncols) {
#pragma unroll
        for (int i = 0; i < 16; ++i) { const f32x4_u t = nt_load4((const f32x4_u*)(src + (size_t)(4 * i) * ldw)); v[i][0] = t[0]; v[i][1] = t[1]; v[i][2] = t[2]; v[i][3] = t[3]; }
    } else {
#pragma unroll
        for (int i = 0; i < 16; ++i)
#pragma unroll
            for (int j = 0; j < 4; ++j) v[i][j] = (col + j < ncols) ? src[(size_t)(4 * i) * ldw + j] : 0.f;
    }
    wave_barrier();
#pragma unroll
    for (int i = 0; i < 16; ++i) { u32x2 o; o[0] = pk2(v[i][0], v[i][1]); o[1] = pk2(v[i][2], v[i][3]); *(LAS u32x2*)(img + (4 * i + kr) * VROWB + n * 2) = o; }
    wave_barrier();
    const lds_u8* tb = img + ((lane & 15) >> 2) * VROWB + (16 * (lane >> 4) + 4 * (lane & 3)) * 2;
    bf16_t* dst = WT + (size_t)(lane < 32 ? r0 + lane : r1 + lane - 32) * ldt + k0;
#pragma unroll
    for (int kc = 0; kc < 8; ++kc) {
        const s16x4 lo = tr16(tb + (8 * kc) * VROWB), hi4 = tr16(tb + (8 * kc + 4) * VROWB);
        u32x4 o; o[0] = (unsigned)(unsigned short)lo[0] | ((unsigned)(unsigned short)lo[1] << 16); o[1] = (unsigned)(unsigned short)lo[2] | ((unsigned)(unsigned short)lo[3] << 16);
        o[2] = (unsigned)(unsigned short)hi4[0] | ((unsigned)(unsigned short)hi4[1] << 16); o[3] = (unsigned)(unsigned short)hi4[2] | ((unsigned)(unsigned short)hi4[3] << 16);
        *(u32x4*)(dst + 8 * kc) = o;
    }
}
constexpr int WI_IN = (D / 64) * ((IN_W + 63) / 64), WI_OUT = (MIXW / 64) * (D / 64), WI_GU = (D / 64) * (DE / 32), WI_DN = (DE / 64) * (D / 64);
constexpr int WI_DENSE = WI_IN + WI_OUT, WI_EXPERT = WI_GU + WI_DN, WI_LAYER = WI_DENSE + NE * WI_EXPERT;
__device__ __forceinline__ void weight_item(const Params& p, int l, int r, lds_u8* img, int lane) {
    if (r < WI_IN) { const int nb = (IN_W + 63) / 64, c0 = (r % nb) * 64; const float* W = p.w_in + (size_t)l * D * IN_W;
        const int r0 = (c0 / 256) * 256 + ((c0 % 256) / 64) * 32;
        transpose_item64(W, W, IN_W, IN_W, c0, c0 + 32, (r / nb) * 64, (bf16_t*)(p.ws + WS_WIN) + (size_t)l * PW * D, D, r0, r0 + 128, img, lane); return; }
    r -= WI_IN;
    if (r < WI_OUT) { const int nb = D / 64, c0 = (r % nb) * 64; const float* W = p.w_out + (size_t)l * MIXW * D;
        transpose_item64(W, W, D, D, c0, c0 + 32, (r / nb) * 64, (bf16_t*)(p.ws + WS_WOUT) + (size_t)l * D * MIXW, MIXW, c0, c0 + 32, img, lane); return; }
    r -= WI_OUT;
    const int e = r / WI_EXPERT; r %= WI_EXPERT;
    if (r < WI_GU) { const int nb = DE / 32, c0 = (r % nb) * 32;
        const int r0 = (c0 / 128) * 256 + (c0 % 128);
        transpose_item64(p.w_gate + (size_t)(l * NE + e) * D * DE, p.w_up + (size_t)(l * NE + e) * D * DE, DE, DE, c0, c0, (r / nb) * 64, (bf16_t*)(p.ws + WS_WGU) + (size_t)(l * NE + e) * 2 * DE * D, D, r0, r0 + 128, img, lane); return; }
    r -= WI_GU;
    { const int nb = D / 64, c0 = (r % nb) * 64; const float* W = p.w_down + (size_t)(l * NE + e) * DE * D;
        transpose_item64(W, W, D, D, c0, c0 + 32, (r / nb) * 64, (bf16_t*)(p.ws + WS_WDN) + (size_t)(l * NE + e) * D * DE, DE, c0, c0 + 32, img, lane); }
}
__device__ __forceinline__ void phase_init(const Params& p, float* lds) {
    unsigned* ctl = (unsigned*)(p.ws + WS_CTL);
    if (blockIdx.x == 0) for (int i = TIDX(p); i < 8000; i += NT) ctl[i] = 0u;
    f32x2* rot = (f32x2*)(p.ws + WS_ROT);
    for (int i = blockIdx.x * NT + TIDX(p); i < S * 32; i += gridDim.x * NT) {
        const int pos = i >> 5, j = i & 31;
        const double turns = (double)pos * inv_turns(j);
        const double fr = turns - floor(turns);
        f32x2 cs; cs[0] = cos2pi((float)fr); cs[1] = sin2pi((float)fr);
        rot[i] = cs;
    }
    const int lane = lane_id(), wave = p.wid;
    {
        lds_u8* img = (lds_u8*)lds + wave * RET_WAVE_LDS;
        for (int it = blockIdx.x * NW + wave; it < DEPTH * WI_DENSE; it += gridDim.x * NW) weight_item(p, it / WI_DENSE, it % WI_DENSE, img, lane);
    }
    bf16_t* H = (bf16_t*)(p.ws + WS_H);
    for (int r = blockIdx.x * NW + wave; r < S; r += gridDim.x * NW) {
        f32x4 v[RJ]; row_load(p.x + (size_t)r * D, v, lane);
        const float ri = row_rinv(v);
#pragma unroll
        for (int j = 0; j < RJ; ++j) {
            const f32x4 g = *(const f32x4*)(p.norm_mix + 256 * j + lane * 4);
            u32x2 o; o[0] = pk2(v[j][0] * ri * g[0], v[j][1] * ri * g[1]); o[1] = pk2(v[j][2] * ri * g[2], v[j][3] * ri * g[3]);
            *(u32x2*)(H + (size_t)r * D + 256 * j + lane * 4) = o;
        }
    }
}

constexpr int GBM = 256, GBK = 64, TILE_B = GBM * GBK * 2, STAGE_B = 2 * TILE_B, GEMM_LDS = 2 * STAGE_B;
__device__ __forceinline__ int lds_byte(int r, int c) { const int st = (r >> 4) * 2 + (c >> 5), ob = (r & 15) * 64 + (c & 31) * 2; return st * 1024 + (ob ^ (((ob >> 9) & 1) << 5)); }
__device__ __forceinline__ void stage_rc(int b, int& R, int& C) { const int st = b >> 10, sb = b & 1023, swz = sb ^ (((sb >> 9) & 1) << 5); R = (st >> 1) * 16 + swz / 64; C = (st & 1) * 32 + (swz % 64) / 2; }
__device__ __forceinline__ int vcu_id() { const int G = gridDim.x, b = blockIdx.x; return (G % 8 == 0) ? (b % 8) * (G / 8) + b / 8 : b; }

constexpr int HTB = 128 * GBK * 2;
struct GUnit { unsigned A, B; unsigned ao[4]; int i0, i1, i2, i3; };
#ifndef CPU_EMU
#define G8_WAIT_V(n) asm volatile("s_waitcnt vmcnt(" #n ")" ::: "memory")
#define G8_WAIT_L0() asm volatile("s_waitcnt lgkmcnt(0)" ::: "memory")
#define G8_BAR() __builtin_amdgcn_s_barrier()
#define G8_PRIO(x) __builtin_amdgcn_s_setprio(x)
#else
#define G8_WAIT_V(n) do {} while (0)
#define G8_WAIT_L0() do {} while (0)
#define G8_BAR() __syncthreads()
#define G8_PRIO(x) do {} while (0)
#endif
template <class Sched, class Epi>
__device__ __forceinline__ void gemm_stream(lds_u8* lds, const char* Abase, const char* Bbase, const int K, Sched& S, const Epi& E) {
    const int wid = S.wid, lane = lane_id(), tid = (wid << 6) | lane, wr = wid >> 2, wc = wid & 3, fr = lane & 15, fq = lane >> 4;
    const int nt = K / GBK;
    unsigned voffB[2];
    { int R, C; stage_rc(tid * 16, R, C); voffB[0] = (unsigned)((R * K + C) * 2); stage_rc(tid * 16 + 8192, R, C); voffB[1] = (unsigned)((R * K + C) * 2); }
    const unsigned hstepB = (unsigned)(128 * K * 2);
    lds_u8* ldsw = lds + wid * 1024;
    const int aoff = lds_byte(wr * 64 + fr, fq * 8), boff = lds_byte(wc * 32 + fr, fq * 8);
#define G8_SA(b, h) (((b) * 2 + (h)) * HTB)
#define G8_SB(b, h) ((4 + (b) * 2 + (h)) * HTB)
#define G8_STAGE_A(b, h, U, kt) do { _Pragma("unroll") for (int i_ = 0; i_ < 2; ++i_) glds16(Abase + ((size_t)(U).A + (size_t)((kt) * (GBK * 2))) + (Sched::GATHER ? (U).ao[2 * (h) + i_] : S.ao[2 * (h) + i_]), ldsw + G8_SA(b, h) + i_ * 8192); } while (0)
#define G8_STAGE_B(b, h, U, kt) do { _Pragma("unroll") for (int i_ = 0; i_ < 2; ++i_) glds16(Bbase + ((size_t)(U).B + (size_t)((kt) * (GBK * 2)) + (size_t)(h) * hstepB) + voffB[i_], ldsw + G8_SB(b, h) + i_ * 8192); } while (0)
#define G8_LDA(dst, b, h) do { _Pragma("unroll") for (int m = 0; m < 4; ++m) _Pragma("unroll") for (int k = 0; k < 2; ++k) dst[m][k] = *(const LAS bf16x8*)(lds + G8_SA(b, h) + aoff + m * 2048 + k * 1024); } while (0)
#define G8_LDB(dst, b, h) do { _Pragma("unroll") for (int n = 0; n < 2; ++n) _Pragma("unroll") for (int k = 0; k < 2; ++k) dst[n][k] = *(const LAS bf16x8*)(lds + G8_SB(b, h) + boff + n * 2048 + k * 1024); } while (0)
#define G8_MMA(ai, bj, At_, Bt_) do { G8_PRIO(1); _Pragma("unroll") for (int m = 0; m < 4; ++m) _Pragma("unroll") for (int n = 0; n < 2; ++n) _Pragma("unroll") for (int k = 0; k < 2; ++k) \
        acc[ai][bj][m][n] = mfma16(Bt_[n][k], At_[m][k], acc[ai][bj][m][n]); G8_PRIO(0); } while (0)
    GUnit cur, nxt; int ui = 0;
    if (!S.next(0, cur)) return;
    f32x4 acc[2][2][4][2];
#pragma unroll
    for (int a = 0; a < 2; ++a)
#pragma unroll
        for (int b = 0; b < 2; ++b)
#pragma unroll
            for (int m = 0; m < 4; ++m)
#pragma unroll
                for (int n = 0; n < 2; ++n) acc[a][b][m][n] = (f32x4){0.f, 0.f, 0.f, 0.f};
    bf16x8 At[4][2], B0[2][2], B1[2][2];
    G8_STAGE_B(0, 0, cur, 0); G8_STAGE_B(0, 1, cur, 0); G8_STAGE_A(0, 0, cur, 0); G8_STAGE_A(0, 1, cur, 0);
    if (wr == 1) G8_BAR();
    G8_WAIT_V(2); G8_BAR();
    G8_STAGE_B(1, 0, cur, 1); G8_STAGE_A(1, 0, cur, 1); G8_STAGE_B(1, 1, cur, 1);
    G8_WAIT_V(6); G8_BAR();
    for (;;) {
        const bool has_next = S.next(ui + 1, nxt);
        if (!has_next) nxt = cur;
        for (int t = 0; t < nt; t += 2) {
            const bool last = (t == nt - 2);
            const GUnit& U2 = last ? nxt : cur;
            const int k2 = last ? 0 : t + 2, k3 = k2 + 1;
            G8_LDB(B0, 0, 0); G8_LDB(B1, 0, 1); sched_fence(); G8_LDA(At, 0, 0); G8_STAGE_A(1, 1, cur, t + 1);
            G8_WAIT_V(8); G8_WAIT_L0(); G8_BAR(); G8_MMA(0, 0, At, B0); G8_MMA(0, 1, At, B1); G8_BAR(); sched_fence();
            G8_LDA(At, 0, 1); G8_STAGE_B(0, 0, U2, k2); G8_STAGE_B(0, 1, U2, k2); G8_STAGE_A(0, 0, U2, k2);
            G8_WAIT_V(8); G8_WAIT_L0(); G8_BAR(); G8_MMA(1, 0, At, B0); G8_MMA(1, 1, At, B1); G8_BAR(); sched_fence();
            G8_LDB(B0, 1, 0); G8_LDB(B1, 1, 1); sched_fence(); G8_LDA(At, 1, 0); G8_STAGE_A(0, 1, U2, k2);
            G8_WAIT_V(8); G8_WAIT_L0(); G8_BAR(); G8_MMA(0, 0, At, B0); G8_MMA(0, 1, At, B1); G8_BAR(); sched_fence();
            G8_LDA(At, 1, 1); G8_STAGE_B(1, 0, U2, k3); G8_STAGE_B(1, 1, U2, k3); G8_STAGE_A(1, 0, U2, k3);
            G8_WAIT_V(8); G8_WAIT_L0(); G8_BAR(); G8_MMA(1, 0, At, B0); G8_MMA(1, 1, At, B1); G8_BAR(); sched_fence();
        }
        if (wr == 0) G8_BAR();
        E(acc, cur, wr, wc, fr, fq);
        if (!has_next) break;
#pragma unroll
        for (int a = 0; a < 2; ++a)
#pragma unroll
            for (int b = 0; b < 2; ++b)
#pragma unroll
                for (int m = 0; m < 4; ++m)
#pragma unroll
                    for (int n = 0; n < 2; ++n) acc[a][b][m][n] = (f32x4){0.f, 0.f, 0.f, 0.f};
        cur = nxt; ++ui;
        if (wr == 1) G8_BAR();
    }
    G8_WAIT_V(0);
    G8_BAR();
#undef G8_SA
#undef G8_SB
#undef G8_STAGE_A
#undef G8_STAGE_B
#undef G8_LDA
#undef G8_LDB
#undef G8_MMA
}
__device__ __forceinline__ void plain_ao(unsigned (&ao)[4], int K, int tid) {
    int R, C; stage_rc(tid * 16, R, C); ao[0] = (unsigned)((R * K + C) * 2); ao[2] = ao[0] + (unsigned)(128 * K * 2);
    stage_rc(tid * 16 + 8192, R, C); ao[1] = (unsigned)((R * K + C) * 2); ao[3] = ao[1] + (unsigned)(128 * K * 2);
}

struct InprojSched {
    static constexpr bool GATHER = false;
    int wid;
    unsigned ao[4]; int vcu, G;
    static constexpr int NPM = S / GBM, NPN = PW / GBM;
    __device__ __forceinline__ bool next(int i, GUnit& u) const {
        const int L = uni(i * G + vcu); if (L >= NPM * NPN) return false;
        constexpr int WGM = 8, nig = WGM * NPN;
        const int gid = L / nig, fm = gid * WGM, gsz = (NPM - fm) < WGM ? (NPM - fm) : WGM;
        const int pm = fm + (L % nig) % gsz, pn = (L % nig) / gsz;
        u.A = (unsigned)(pm * GBM * D * 2); u.B = (unsigned)(pn * GBM * D * 2); u.ao[0] = u.ao[1] = u.ao[2] = u.ao[3] = 0u;
        u.i0 = pm; u.i1 = pn; u.i2 = 0; u.i3 = 0; return true;
    }
};
struct InprojEpi {
    bf16_t* P; float* LOGF; unsigned* kmaxw; const f32x2* rot; const float* bfg;
    __device__ __forceinline__ void operator()(f32x4 (&acc)[2][2][4][2], const GUnit& u, int wr, int wc, int fr, int fq) const {
        const int gc0 = u.i1 * GBM + wc * 64;
        if (gc0 >= IN_W) return;
        const int row0 = u.i0 * GBM + wr * 64 + fr;
        if (gc0 >= OFL) {
#pragma unroll
            for (int ai = 0; ai < 2; ++ai)
#pragma unroll
                for (int m = 0; m < 4; ++m)
#pragma unroll
                    for (int j = 0; j < 4; ++j) { const int h = 4 * fq + j; if (h < NFOX) LOGF[(size_t)(row0 + ai * 128 + m * 16) * 8 + h] = log_sigmoid(acc[ai][0][m][0][j] + bfg[h]); }
            return;
        }
        const bool rotary = gc0 < OVR, is_gate = (gc0 >= OGR && gc0 < OQS), is_kf = (gc0 >= OKF && gc0 < OVF);
        const float scale = (gc0 < OKR || (gc0 >= OQS && gc0 < OKS) || (gc0 >= OQF && gc0 < OKF)) ? 0.125f : 1.0f;
        float kmx = 0.f;
        if (rotary) {
#pragma unroll
            for (int am = 0; am < 4; ++am) {
                const int ai = am >> 1, m0 = (am & 1) * 2;
                f32x4 c01[2][2], c23[2][2];
#pragma unroll
                for (int mm = 0; mm < 2; ++mm)
#pragma unroll
                    for (int n = 0; n < 2; ++n) { const f32x2* rp = rot + (size_t)(row0 + ai * 128 + (m0 + mm) * 16) * 32 + n * 16 + 4 * fq; c01[mm][n] = *(const f32x4*)rp; c23[mm][n] = *(const f32x4*)(rp + 2); }
#pragma unroll
                for (int mm = 0; mm < 2; ++mm)
#pragma unroll
                    for (int n = 0; n < 2; ++n) {
                        const int m = m0 + mm;
                        const float cs[4] = {c01[mm][n][0], c01[mm][n][2], c23[mm][n][0], c23[mm][n][2]}, sn[4] = {c01[mm][n][1], c01[mm][n][3], c23[mm][n][1], c23[mm][n][3]};
#pragma unroll
                        for (int j = 0; j < 4; ++j) { const float x1 = acc[ai][0][m][n][j], x2 = acc[ai][1][m][n][j]; acc[ai][0][m][n][j] = x1 * cs[j] - x2 * sn[j]; acc[ai][1][m][n][j] = x1 * sn[j] + x2 * cs[j]; }
                    }
                sched_fence();
            }
        }
#pragma unroll
        for (int ai = 0; ai < 2; ++ai)
#pragma unroll
            for (int m = 0; m < 4; ++m) {
                const int row = row0 + ai * 128 + m * 16;
                float ss = 0.f;
#pragma unroll
                for (int bj = 0; bj < 2; ++bj)
#pragma unroll
                    for (int n = 0; n < 2; ++n) {
                        f32x4 v = acc[ai][bj][m][n] * scale;
                        if (is_gate) {
#pragma unroll
                            for (int j = 0; j < 4; ++j) v[j] = silu(v[j]);
                        }
                        u32x2 o; o[0] = pk2(v[0], v[1]); o[1] = pk2(v[2], v[3]);
                        if (is_kf) {
#pragma unroll
                            for (int j = 0; j < 4; ++j) { const float r = bf2f(f2bf(v[j])); ss += r * r; }
                        }
                        *(u32x2*)(P + (size_t)row * PW + gc0 + 32 * bj + 16 * n + 4 * fq) = o;
                    }
                if (is_kf) { ss += __shfl_xor(ss, 16); ss += __shfl_xor(ss, 32); kmx = fmaxf(kmx, ss); }
            }
        if (is_kf) { kmx = wave_max(kmx); if (lane_id() == 0) atomicMax(kmaxw + (gc0 - OKF) / HD, f2u(kmx)); }
    }
};
__device__ __forceinline__ void phase_inproj(const Params& p, int l, float* ldsf) {
    InprojSched S; S.wid = p.wid; plain_ao(S.ao, D, TIDX(p)); S.vcu = vcu_id(); S.G = gridDim.x;
    InprojEpi E; E.P = (bf16_t*)(p.ws + WS_PROJ); E.LOGF = (float*)(p.ws + WS_LOGF); E.kmaxw = (unsigned*)(p.ws + WS_CTL) + CTL_KMAX + l * 8; E.rot = (const f32x2*)(p.ws + WS_ROT); E.bfg = p.b_forget + l * NFOX;
    gemm_stream((lds_u8*)ldsf, (const char*)(p.ws + WS_H), (const char*)(p.ws + WS_WIN) + (size_t)l * PW * D * 2, D, S, E);
}

__device__ __forceinline__ float ret_log_gamma(int h) { return logf(1.0f - exp2f(-5.0f - (float)h)); }
__device__ __forceinline__ void ret_prep_item(const Params& p, int h, int n, lds_u8* wl) {
    const bf16_t* P = (const bf16_t*)(p.ws + WS_PROJ);
    float* UT = (float*)(p.ws + WS_U);
    const int lane = lane_id(), r32 = lane & 31, hi = lane >> 5;
    const float lg = ret_log_gamma(h);
    wave_barrier();
#pragma unroll
    for (int i = 0; i < 8; ++i) {
        const int c = lane + 64 * i, row = c >> 3, ch = c & 7;
        const bf16_t* src = P + (size_t)(n * CH + row) * PW + h * HD + 8 * ch;
        const u32x4 kv = *(const u32x4*)(src + OKR), vv = *(const u32x4*)(src + OVR);
        const float dk = fast_exp(lg * (float)(CH - 1 - row));
        u32x4 ko;
#pragma unroll
        for (int w = 0; w < 4; ++w) ko[w] = pk2(u2f(kv[w] << 16) * dk, u2f(kv[w] & 0xffff0000u) * dk);
        *(LAS u32x4*)(wl + row * VROWB + ch * 16) = ko;
        *(LAS u32x4*)(wl + IMG64 + row * VROWB + ch * 16) = vv;
    }
    wave_barrier();
    const lds_u8* tb = wl + (8 * hi + ((lane & 15) >> 2)) * VROWB + (16 * ((lane >> 4) & 1) + 4 * (lane & 3)) * 2;
    f32x16 acc[2][2];
#pragma unroll
    for (int a = 0; a < 2; ++a)
#pragma unroll
        for (int b = 0; b < 2; ++b)
#pragma unroll
            for (int r = 0; r < 16; ++r) acc[a][b][r] = 0.f;
#pragma unroll
    for (int s = 0; s < 4; ++s) {
        bf16x8 vf[2], kf[2];
#pragma unroll
        for (int x = 0; x < 2; ++x) { kf[x] = tr_frag(tb, 16 * s, 16 * s + 4, x * 64); vf[x] = tr_frag(tb + IMG64, 16 * s, 16 * s + 4, x * 64); }
#pragma unroll
        for (int eb = 0; eb < 2; ++eb)
#pragma unroll
            for (int db = 0; db < 2; ++db) acc[eb][db] = mfma32(vf[eb], kf[db], acc[eb][db]);
    }
    float* dst = UT + (size_t)(h * NCHUNK + n) * 4096;
#pragma unroll
    for (int eb = 0; eb < 2; ++eb)
#pragma unroll
        for (int db = 0; db < 2; ++db)
#pragma unroll
            for (int r = 0; r < 16; ++r) dst[(32 * eb + crow(r, hi)) * 64 + 32 * db + r32] = acc[eb][db][r];
}
__device__ __forceinline__ void phase_prep(const Params& p, int l, float* ldsf) {
    const int wave = p.wid;
    lds_u8* wl = (lds_u8*)ldsf + wave * RET_WAVE_LDS;
    for (int it = blockIdx.x * NW + wave; it < NRET * NCHUNK; it += gridDim.x * NW) ret_prep_item(p, it / NCHUNK, it % NCHUNK, wl);
}

constexpr int NQ32 = S / 32;
constexpr int MIX_WAVE_LDS = 32 * VROWB + 256;
__device__ __forceinline__ void ret_scan_wave(const Params& p, int item) {
    const float* U = (const float*)(p.ws + WS_U);
    bf16_t* SP = (bf16_t*)(p.ws + WS_SP);
    const int e = item * 64 + lane_id();
    const int h = e >> 12, de = e & 4095;
    const float c = expf(ret_log_gamma(h) * (float)CH);
    float st = 0.f;
    const size_t base = (size_t)h * NCHUNK * 4096 + de;
#pragma unroll 1
    for (int n0 = 0; n0 < NCHUNK; n0 += 32) {
        float u[32];
#pragma unroll
        for (int i = 0; i < 32; ++i) u[i] = (n0 + i < NCHUNK) ? U[base + (size_t)(n0 + i) * 4096] : 0.f;
#pragma unroll
        for (int i = 0; i < 32; ++i) if (n0 + i < NCHUNK) { SP[base + (size_t)(n0 + i) * 4096] = f2bf(st); st = st * c + u[i]; }
    }
}
template <bool FOX>
__device__ __forceinline__ void attn_item(const Params& p, int l, int h, int qb, lds_u8* wl) {
    const bf16_t* P = (const bf16_t*)(p.ws + WS_PROJ);
    const float* LOGF = (const float*)(p.ws + WS_LOGF);
    bf16_t* MG = (bf16_t*)(p.ws + WS_MERGED);
    const int lane = lane_id(), r32 = lane & 31, hi = lane >> 5;
    const int q0 = qb * 32, t = q0 + r32;
    constexpr int oq = FOX ? OQF : OQS, ok = FOX ? OKF : OKS, ov = FOX ? OVF : OVS;
    bf16x8 qf[4];
    { const bf16_t* qp = P + (size_t)t * PW + oq + h * HD + 8 * hi;
#pragma unroll
      for (int ks = 0; ks < 4; ++ks) qf[ks] = *(const bf16x8*)(qp + 16 * ks); }
    float Bt = 0.f;
    if (FOX) {
        float qq = 0.f;
#pragma unroll
        for (int ks = 0; ks < 4; ++ks)
#pragma unroll
            for (int j = 0; j < 8; ++j) { const float v = bf2f((bf16_t)qf[ks][j]); qq += v * v; }
        qq += __shfl_xor(qq, 32);
        const float kmax = sqrtf(u2f(((const unsigned*)(p.ws + WS_CTL))[CTL_KMAX + l * 8 + h]));
        Bt = sqrtf(qq) * kmax * 1.0001f + 1e-6f;
    }
    float fq = 0.f, m = -1e30f, lsum = 0.f, carry = 0.f, Fc = 0.f;
    f32x16 o0, o1;
#pragma unroll
    for (int r = 0; r < 16; ++r) { o0[r] = 0.f; o1[r] = 0.f; }
    LAS float* frl = (LAS float*)(wl + 32 * VROWB);
    const lds_u8* vb = wl + (4 * hi + ((lane & 15) >> 2)) * VROWB + (16 * ((lane >> 4) & 1) + 4 * (lane & 3)) * 2;
    bf16x8 kf1[4], kf2[4]; u32x4 vr1[4], vr2[4]; float lf1 = 0.f, lf2 = 0.f;
#define ATTN_LOAD(KF, VR, LF, kt_) do { const int k0_ = (kt_) * 32; const bf16_t* kp_ = P + (size_t)(k0_ + r32) * PW + ok + h * HD + 8 * hi; \
        _Pragma("unroll") for (int ks = 0; ks < 4; ++ks) KF[ks] = *(const bf16x8*)(kp_ + 16 * ks); \
        _Pragma("unroll") for (int i = 0; i < 4; ++i) { const int c = lane + 64 * i; VR[i] = *(const u32x4*)(P + (size_t)(k0_ + (c >> 3)) * PW + ov + h * HD + 8 * (c & 7)); } \
        if (FOX) LF = -LOGF[(size_t)(k0_ + r32) * 8 + h]; } while (0)
    ATTN_LOAD(kf1, vr1, lf1, qb);
    ATTN_LOAD(kf2, vr2, lf2, qb > 0 ? qb - 1 : 0);
    for (int kt = qb; kt >= 0; --kt) {
        const int key0 = kt * 32;
        const bool diag = (kt == qb);
        bf16x8 kf[4]; u32x4 vr[4];
#pragma unroll
        for (int ks = 0; ks < 4; ++ks) { kf[ks] = kf1[ks]; kf1[ks] = kf2[ks]; }
#pragma unroll
        for (int i = 0; i < 4; ++i) { vr[i] = vr1[i]; vr1[i] = vr2[i]; }
        const float lf = lf1; lf1 = lf2;
        ATTN_LOAD(kf2, vr2, lf2, kt > 1 ? kt - 2 : 0);
        f32x16 st;
#pragma unroll
        for (int r = 0; r < 16; ++r) st[r] = 0.f;
#pragma unroll
        for (int ks = 0; ks < 4; ++ks) st = mfma32(kf[ks], qf[ks], st);
        wave_barrier();
#pragma unroll
        for (int i = 0; i < 4; ++i) { const int c = lane + 64 * i; *(LAS u32x4*)(wl + (c >> 3) * VROWB + (c & 7) * 16) = vr[i]; }
        if (FOX) {
            float inc = row_shl_add<1>(lf); inc = row_shl_add<2>(inc); inc = row_shl_add<4>(inc); inc = row_shl_add<8>(inc);
            { const float up0 = read_lane(inc, 16), up1 = read_lane(inc, 48); if ((lane & 16) == 0) inc += (hi ? up1 : up0); }
            const float exc = Fc + inc - lf;
            const float tot = read_lane(inc, 0);
            if (diag) fq = exc;
            if (lane < 32) frl[lane] = exc;
            wave_barrier();
            float tmax = -1e30f;
#pragma unroll
            for (int g4 = 0; g4 < 4; ++g4) {
                const f32x4 fr4 = *(const LAS f32x4*)(frl + 8 * g4 + 4 * hi);
#pragma unroll
                for (int i = 0; i < 4; ++i) { const int r = 4 * g4 + i; st[r] = st[r] + fq - fr4[i]; }
            }
            if (diag) {
#pragma unroll
                for (int r = 0; r < 16; ++r) if (crow(r, hi) > r32) st[r] = -1e30f;
            }
#pragma unroll
            for (int r = 0; r < 16; ++r) tmax = fmaxf(tmax, st[r]);
            Fc += tot;
            tmax = fmaxf(tmax, partner32(tmax, hi));
            const float mn = fmaxf(m, tmax), f = fast_exp(m - mn);
            m = mn; lsum *= f;
#pragma unroll
            for (int r = 0; r < 16; ++r) { o0[r] *= f; o1[r] *= f; }
            float ps = 0.f;
#pragma unroll
            for (int r = 0; r < 16; ++r) { const float pr = fast_exp(st[r] - mn); st[r] = pr; ps += pr; }
            lsum += ps;
        } else {
            float l1m[16];
#pragma unroll
            for (int r = 0; r < 16; ++r) {
                const float z = st[r], sp = fast_log(1.0f + fast_exp(-fabsf(z)));
                const float lb = fminf(z, 0.f) - sp;
                l1m[r] = lb - z;
                st[r] = lb;
            }
            if (diag) {
#pragma unroll
                for (int r = 0; r < 16; ++r) if (crow(r, hi) >= r32) { l1m[r] = 0.f; st[r] = -1e30f; }
            }
            float gs[4], pg[4], T[4];
#pragma unroll
            for (int k = 0; k < 4; ++k) { gs[k] = (l1m[4 * k] + l1m[4 * k + 1]) + (l1m[4 * k + 2] + l1m[4 * k + 3]); pg[k] = partner32(gs[k], hi); }
            float run = 0.f;
#pragma unroll
            for (int k = 3; k >= 0; --k) { T[k] = run + (hi == 0 ? pg[k] : 0.f); run += gs[k] + pg[k]; }
#pragma unroll
            for (int k = 0; k < 4; ++k) {
                float w = T[k] + carry;
#pragma unroll
                for (int i = 3; i >= 0; --i) { const int r = 4 * k + i; st[r] = fast_exp(st[r] + w); w += l1m[r]; }
            }
            carry += run;
        }
        u32x4 pw0, pw1;
#pragma unroll
        for (int j = 0; j < 4; ++j) { pw0[j] = pk2(st[2 * j], st[2 * j + 1]); pw1[j] = pk2(st[8 + 2 * j], st[9 + 2 * j]); }
        const bf16x8 pf0 = __builtin_bit_cast(bf16x8, pw0), pf1 = __builtin_bit_cast(bf16x8, pw1);
        wave_barrier();
#pragma unroll
        for (int s = 0; s < 2; ++s) {
#pragma unroll
            for (int db = 0; db < 2; ++db) {
                const s16x4 lo = tr16(vb + (16 * s) * VROWB + db * 64), hi4 = tr16(vb + (16 * s + 8) * VROWB + db * 64);
                bf16x8 vf; vf[0] = lo[0]; vf[1] = lo[1]; vf[2] = lo[2]; vf[3] = lo[3]; vf[4] = hi4[0]; vf[5] = hi4[1]; vf[6] = hi4[2]; vf[7] = hi4[3];
                if (db == 0) o0 = mfma32(vf, s == 0 ? pf0 : pf1, o0); else o1 = mfma32(vf, s == 0 ? pf0 : pf1, o1);
            }
        }
        const bool done = FOX ? (Bt + fq - Fc - m + logf((float)(key0 + 1)) < -EXIT_T) : (carry < -EXIT_T);
        if (ballot64(done) == ~0ull) break;
    }
#undef ATTN_LOAD
    if (FOX) { lsum += __shfl_xor(lsum, 32); const float il = 1.0f / lsum;
#pragma unroll
        for (int r = 0; r < 16; ++r) { o0[r] *= il; o1[r] *= il; } }
    float ss = 0.f;
#pragma unroll
    for (int r = 0; r < 16; ++r) ss += o0[r] * o0[r] + o1[r] * o1[r];
    ss += __shfl_xor(ss, 32);
    const float ri = 1.0f / sqrtf(ss * (1.0f / HD) + EPS);
    const float* g = (FOX ? p.g_fox + l * WFOX : p.g_sb + l * WSB) + h * HD;
    bf16_t* dst = MG + (size_t)t * MIXW + (FOX ? WRET + WSB : WRET) + h * HD;
#pragma unroll
    for (int db = 0; db < 2; ++db)
#pragma unroll
        for (int g4 = 0; g4 < 4; ++g4) {
            const int d0 = db * 32 + 8 * g4 + 4 * hi;
            const f32x4 gg = *(const f32x4*)(g + d0);
            float v[4];
#pragma unroll
            for (int i = 0; i < 4; ++i) v[i] = (db == 0 ? o0[4 * g4 + i] : o1[4 * g4 + i]) * ri * gg[i];
            u32x2 o; o[0] = pk2(v[0], v[1]); o[1] = pk2(v[2], v[3]);
            *(u32x2*)(dst + d0) = o;
        }
}
constexpr int WCH = 2, NWCH = (NE * WI_EXPERT + WCH - 1) / WCH;
__device__ __forceinline__ bool mix_weight_step(const Params& p, int l, lds_u8* wl, int shard0, int& wsk) {
    unsigned* wbase = (unsigned*)(p.ws + WS_CTL) + CTL_WQ + 64 * (l * 8);
    const int lane = lane_id();
#pragma unroll 1
    while (wsk < 8) {
        const int shard = (shard0 + wsk) & 7;
        unsigned* head = wbase + 64 * shard;
        unsigned c = 0x0fffffffu;
        if (lane == 0) { if (!(wsk > 0 && (int)ld_relaxed(head) * 8 + shard >= NWCH)) c = atomicAdd(head, 1u); }
        const int chunk = uni((int)__shfl(c, 0)) * 8 + shard;
        if (chunk >= NWCH) { ++wsk; continue; }
#pragma unroll 1
        for (int k = 0; k < WCH; ++k) { const int it = chunk * WCH + k; if (it < NE * WI_EXPERT) weight_item(p, l, WI_DENSE + it, wl, lane); }
        return true;
    }
    return false;
}
__device__ __forceinline__ void phase_mix(const Params& p, int l, float* ldsf) {
    constexpr int NSCANW = NRET * 4096 / 64, NFXI = NFOX * NQ32, NSBI = NSB * NQ32;
    const int wave = p.wid;
    lds_u8* wl = (lds_u8*)ldsf + wave * RET_WAVE_LDS;
    static_assert(MIX_WAVE_LDS <= RET_WAVE_LDS, "per-wave LDS region");
    const int shard0 = xcc_shard();
    int wsk = 0;
    unsigned* qbase = (unsigned*)(p.ws + WS_CTL) + CTL_MQ + 64 * (l * 8);
    const float* bfg = p.b_forget + l * NFOX;
    constexpr int NMIX = NSCANW + NFXI + NSBI;
#pragma unroll 1
    for (int sk = 0; sk < 8; ++sk) {
      const int shard = (shard0 + sk) & 7;
      unsigned* qhead = qbase + 64 * shard;
#pragma unroll 1
      for (;;) {
        unsigned itu = 0;
        if (lane_id() == 0) { if (sk > 0 && (int)ld_relaxed(qhead) * 8 + shard >= NMIX) itu = 0x0fffffffu; else itu = atomicAdd(qhead, 1u); }
        const int it = uni((int)__shfl(itu, 0)) * 8 + shard;
        if (it >= NMIX) break;
        if (it < NSCANW) ret_scan_wave(p, it);
        else if (it < NSCANW + NFXI) {
            const int j = it - NSCANW, rank = j / NQ32;
            int h = 0;
#pragma unroll
            for (int c = 0; c < NFOX; ++c) { int rk = 0;
#pragma unroll
                for (int o = 0; o < NFOX; ++o) rk += (bfg[o] > bfg[c] || (bfg[o] == bfg[c] && o < c)) ? 1 : 0;
                if (rk == rank) h = c; }
            attn_item<true>(p, l, h, NQ32 - 1 - j % NQ32, wl);
        }
        else { const int j = it - NSCANW - NFXI; attn_item<false>(p, l, j % NSB, NQ32 - 1 - j / NSB, wl); }
        (void)mix_weight_step(p, l, wl, shard0, wsk);
      }
    }
    while (mix_weight_step(p, l, wl, shard0, wsk)) {}
}

__device__ __forceinline__ void ret_out_item(const Params& p, int l, int h, int n, int cb, lds_u8* wl) {
    const bf16_t* P = (const bf16_t*)(p.ws + WS_PROJ);
    const bf16_t* SPT = (const bf16_t*)(p.ws + WS_SP) + (size_t)(h * NCHUNK + n) * 4096;
    bf16_t* MG = (bf16_t*)(p.ws + WS_MERGED);
    const int lane = lane_id(), r32 = lane & 31, hi = lane >> 5;
    const float lg = ret_log_gamma(h);
    const size_t rowb = (size_t)(n * CH) * PW + h * HD;
    const int c = 32 * cb + r32;
    wave_barrier();
    {
        u32x4 vv[8];
#pragma unroll
        for (int i = 0; i < 8; ++i) { const int q = lane + 64 * i; vv[i] = *(const u32x4*)(P + rowb + (size_t)(q >> 3) * PW + OVR + 8 * (q & 7)); }
#pragma unroll
        for (int i = 0; i < 8; ++i) { const int q = lane + 64 * i; *(LAS u32x4*)(wl + (q >> 3) * VROWB + (q & 7) * 16) = vv[i]; }
    }
    sched_fence();
    bf16x8 qf[4];
#pragma unroll
    for (int ks = 0; ks < 4; ++ks) qf[ks] = *(const bf16x8*)(P + rowb + (size_t)c * PW + OQR + 16 * ks + 8 * hi);
    f32x16 o[2];
#pragma unroll
    for (int a = 0; a < 2; ++a)
#pragma unroll
        for (int r = 0; r < 16; ++r) o[a][r] = 0.f;
#pragma unroll
    for (int ks = 0; ks < 4; ++ks)
#pragma unroll
        for (int eb = 0; eb < 2; ++eb) { const bf16x8 sf = *(const bf16x8*)(SPT + (32 * eb + r32) * 64 + 16 * ks + 8 * hi); o[eb] = mfma32(sf, qf[ks], o[eb]); }
    { const float qd = fast_exp(lg * (float)(c + 1));
#pragma unroll
      for (int eb = 0; eb < 2; ++eb)
#pragma unroll
          for (int r = 0; r < 16; ++r) o[eb][r] *= qd; }
    wave_barrier();
    const lds_u8* vb = wl + (4 * hi + ((lane & 15) >> 2)) * VROWB + (16 * ((lane >> 4) & 1) + 4 * (lane & 3)) * 2;
#pragma unroll
    for (int kb = 0; kb < 2; ++kb) {
        f32x16 st;
#pragma unroll
        for (int r = 0; r < 16; ++r) st[r] = 0.f;
#pragma unroll
        for (int ks = 0; ks < 4; ++ks) { const bf16x8 kf = *(const bf16x8*)(P + rowb + (size_t)(32 * kb + r32) * PW + OKR + 16 * ks + 8 * hi); st = mfma32(kf, qf[ks], st); }
        bf16x8 pf[2];
#pragma unroll
        for (int r = 0; r < 16; ++r) { const int dist = c - (32 * kb + crow(r, hi)); st[r] *= fast_exp(lg * fabsf((float)dist)); }
        { u32x4 w0, w1;
#pragma unroll
          for (int j = 0; j < 4; ++j) { w0[j] = pk2(st[2 * j], st[2 * j + 1]); w1[j] = pk2(st[8 + 2 * j], st[9 + 2 * j]); }
          pf[0] = __builtin_bit_cast(bf16x8, w0); pf[1] = __builtin_bit_cast(bf16x8, w1); }
#pragma unroll
        for (int s = 0; s < 2; ++s)
#pragma unroll
            for (int eb = 0; eb < 2; ++eb) o[eb] = mfma32(tr_frag(vb, 32 * kb + 16 * s, 32 * kb + 16 * s + 8, eb * 64), pf[s], o[eb]);
    }
    float sm = 0.f;
#pragma unroll
    for (int eb = 0; eb < 2; ++eb)
#pragma unroll
        for (int r = 0; r < 16; ++r) sm += o[eb][r];
    sm += __shfl_xor(sm, 32);
    const float mu = sm * (1.0f / HD);
    float vs = 0.f;
#pragma unroll
    for (int eb = 0; eb < 2; ++eb)
#pragma unroll
        for (int r = 0; r < 16; ++r) { const float dlt = o[eb][r] - mu; o[eb][r] = dlt; vs += dlt * dlt; }
    vs += __shfl_xor(vs, 32);
    const float ri = 1.0f / sqrtf(vs * (1.0f / HD) + EPS);
    const int row = n * CH + c;
#pragma unroll
    for (int eb = 0; eb < 2; ++eb)
#pragma unroll
        for (int g4 = 0; g4 < 4; ++g4) {
            const int e0 = 32 * eb + 8 * g4 + 4 * hi;
            const f32x4 gg = *(const f32x4*)(p.g_ret + l * WRET + h * HD + e0);
            const u32x2 gt = *(const u32x2*)(P + (size_t)row * PW + OGR + h * HD + e0);
            const float ga[4] = {u2f(gt[0] << 16), u2f(gt[0] & 0xffff0000u), u2f(gt[1] << 16), u2f(gt[1] & 0xffff0000u)};
            float v[4];
#pragma unroll
            for (int i = 0; i < 4; ++i) v[i] = o[eb][4 * g4 + i] * ri * gg[i] * ga[i];
            u32x2 ov; ov[0] = pk2(v[0], v[1]); ov[1] = pk2(v[2], v[3]);
            *(u32x2*)(MG + (size_t)row * MIXW + h * HD + e0) = ov;
        }
}
__device__ __forceinline__ void phase_retout(const Params& p, int l, float* ldsf) {
    const int wave = p.wid;
    lds_u8* wl = (lds_u8*)ldsf + wave * RET_WAVE_LDS;
    for (int it = blockIdx.x * NW + wave; it < NRET * NCHUNK * 2; it += gridDim.x * NW) ret_out_item(p, l, (it >> 1) / NCHUNK, (it >> 1) % NCHUNK, it & 1, wl);
}

struct OutprojSched {
    static constexpr bool GATHER = false;
    int wid;
    unsigned ao[4]; int vcu, G;
    static constexpr int NPM = S / GBM, NPN = D / GBM;
    __device__ __forceinline__ bool next(int i, GUnit& u) const {
        const int L = uni(i * G + vcu); if (L >= NPM * NPN) return false;
        const int pm = L / NPN, pn = L % NPN;
        u.A = (unsigned)(pm * GBM * MIXW * 2); u.B = (unsigned)(pn * GBM * MIXW * 2); u.ao[0] = u.ao[1] = u.ao[2] = u.ao[3] = 0u;
        u.i0 = pm; u.i1 = pn; u.i2 = 0; u.i3 = 0; return true;
    }
};
struct OutprojEpi {
    const float* xin; float* X;
    __device__ __forceinline__ void operator()(f32x4 (&acc)[2][2][4][2], const GUnit& u, int wr, int wc, int fr, int fq) const {
        const size_t o0 = (size_t)(u.i0 * GBM + wr * 64 + fr) * D + u.i1 * GBM + wc * 32 + 4 * fq;
#pragma unroll
        for (int ai = 0; ai < 2; ++ai)
#pragma unroll
            for (int mh = 0; mh < 2; ++mh) {
                f32x4 r[2][2][2];
#pragma unroll
                for (int mm = 0; mm < 2; ++mm)
#pragma unroll
                    for (int bj = 0; bj < 2; ++bj)
#pragma unroll
                        for (int n = 0; n < 2; ++n) r[mm][bj][n] = *(const f32x4*)(xin + o0 + (size_t)(ai * 128 + (2 * mh + mm) * 16) * D + bj * 128 + n * 16);
#pragma unroll
                for (int mm = 0; mm < 2; ++mm)
#pragma unroll
                    for (int bj = 0; bj < 2; ++bj)
#pragma unroll
                        for (int n = 0; n < 2; ++n) *(f32x4*)(X + o0 + (size_t)(ai * 128 + (2 * mh + mm) * 16) * D + bj * 128 + n * 16) = r[mm][bj][n] + acc[ai][bj][2 * mh + mm][n];
                sched_fence();
            }
    }
};
__device__ __forceinline__ void phase_outproj(const Params& p, int l, float* ldsf) {
    OutprojSched S; S.wid = p.wid; plain_ao(S.ao, MIXW, TIDX(p)); S.vcu = vcu_id(); S.G = gridDim.x;
    OutprojEpi E; E.X = (float*)(p.ws + WS_X); E.xin = l == 0 ? p.x : E.X;
    gemm_stream((lds_u8*)ldsf, (const char*)(p.ws + WS_MERGED), (const char*)(p.ws + WS_WOUT) + (size_t)l * D * MIXW * 2, MIXW, S, E);
}

constexpr int RW = D + 4;
constexpr int ROUTE_LDS = NROUTE * RW * 4 + 2 * NE * 4 + 2 * 256 * 4;
template <bool DRY = false>
__device__ __forceinline__ void phase_route(const Params& p, int l, float* lds) {
    const float* X = (const float*)(p.ws + WS_X);
    bf16_t* H = (bf16_t*)(p.ws + WS_H);
    unsigned* ctl = (unsigned*)(p.ws + WS_CTL);
    int* LIST = (int*)(p.ws + WS_LIST);
    float* GATE = (float*)(p.ws + WS_GATE);
    const float* gn = p.norm_ffn + l * D;
    const float* wg = p.w_group + (size_t)l * D * NG; const float* wr = p.w_router + (size_t)l * D * NE;
    const float* bg = p.b_group + l * NG; const float* br = p.b_router + l * NE;
    const int lane = lane_id(), wave = p.wid;
    const int tidx = TIDX(p);
    unsigned* lcnt = (unsigned*)(lds + NROUTE * RW); unsigned* lbase = lcnt + NE; unsigned* lrec = lbase + NE;
    __syncthreads();
    if (tidx < NE) lcnt[tidx] = 0u;
    {
        constexpr int NV4 = D * NE / 4 / NT;
        f32x4 t[NV4];
#pragma unroll
        for (int k = 0; k < NV4; ++k) t[k] = *(const f32x4*)(wr + (size_t)(tidx + k * NT) * 4);
        for (int i = tidx; i < D * NG; i += NT) lds[(i % NG) * RW + i / NG] = wg[i];
#pragma unroll
        for (int k = 0; k < NV4; ++k) { const int i = (tidx + k * NT) * 4, c = i / NE, e = i % NE;
#pragma unroll
            for (int j = 0; j < 4; ++j) lds[(NG + e + j) * RW + c] = t[k][j]; }
    }
    __syncthreads();
    f32x4 vn[RJ]; { const int r0 = blockIdx.x * NW + wave; if (r0 < S) row_load(X + (size_t)r0 * D, vn, lane); }
    for (int r = blockIdx.x * NW + wave; r < S; r += gridDim.x * NW) {
        f32x4 v[RJ];
#pragma unroll
        for (int j = 0; j < RJ; ++j) v[j] = vn[j];
        { const int rn = r + gridDim.x * NW; if (rn < S) row_load(X + (size_t)rn * D, vn, lane); }
        const float ri = row_rinv(v);
#pragma unroll
        for (int j = 0; j < RJ; ++j) {
            const f32x4 g = *(const f32x4*)(gn + 256 * j + lane * 4);
            v[j] = v[j] * ri * g;
            u32x2 o; o[0] = pk2(v[j][0], v[j][1]); o[1] = pk2(v[j][2], v[j][3]);
            *(u32x2*)(H + (size_t)r * D + 256 * j + lane * 4) = o;
        }
        float gl[NG];
#pragma unroll
        for (int g = 0; g < NG; ++g) { float s = 0.f;
#pragma unroll
            for (int j = 0; j < RJ; ++j) { const f32x4 w = *(const f32x4*)(lds + g * RW + 256 * j + lane * 4); s += (v[j][0] * w[0] + v[j][1] * w[1]) + (v[j][2] * w[2] + v[j][3] * w[3]); }
            gl[g] = s; }
#pragma unroll
        for (int g = 0; g < NG; ++g) gl[g] = wave_sum(gl[g]) + bg[g];
        int grp = 0; float gm = gl[0];
#pragma unroll
        for (int g = 1; g < NG; ++g) if (gl[g] > gm) { gm = gl[g]; grp = g; }
        float den = 0.f;
#pragma unroll
        for (int g = 0; g < NG; ++g) den += expf(gl[g] - gm);
        const float pg = 1.0f / den;
        float el[EPG];
        const float* wl = lds + (NG + grp * EPG) * RW + lane * 4;
#pragma unroll
        for (int e = 0; e < EPG; ++e) { float s = 0.f;
#pragma unroll
            for (int j = 0; j < RJ; ++j) { const f32x4 w = *(const f32x4*)(wl + e * RW + 256 * j); s += (v[j][0] * w[0] + v[j][1] * w[1]) + (v[j][2] * w[2] + v[j][3] * w[3]); }
            el[e] = s; }
#pragma unroll
        for (int e = 0; e < EPG; ++e) el[e] = wave_sum(el[e]) + br[grp * EPG + e];
        if (lane == 0 && !(DRY && el[0] != 12345.f)) {
            int i1 = 0; float v1 = -INFINITY; int i2 = 0; float v2 = -INFINITY;
#pragma unroll
            for (int e = 0; e < EPG; ++e) { const float x = el[e];
                if (x > v1) { v2 = v1; i2 = i1; v1 = x; i1 = e; } else if (x > v2) { v2 = x; i2 = e; } }
            const float e2 = expf(v2 - v1), g1 = pg / (1.f + e2), g2 = pg * e2 / (1.f + e2);
            const int ea = grp * EPG + i1, eb = grp * EPG + i2;
            GATE[(size_t)r * 2] = g1; GATE[(size_t)r * 2 + 1] = g2;
            const int li = (r - blockIdx.x * NW) / (gridDim.x * NW) * NW + wave;
            const unsigned ra = atomicAdd(lcnt + ea, 1u), rb = atomicAdd(lcnt + eb, 1u);
            lrec[2 * li] = (unsigned)ea | (ra << 8); lrec[2 * li + 1] = (unsigned)eb | (rb << 8);
        }
    }
    if (!DRY) {
        __syncthreads();
        if (tidx < NE) lbase[tidx] = atomicAdd(ctl + CTL_CNT + l * NE + tidx, lcnt[tidx]);
        __syncthreads();
        const int nrows = (S - blockIdx.x * NW + gridDim.x * NW - 1) / (gridDim.x * NW) * NW;
        for (int i = tidx; i < 2 * nrows; i += NT) {
            const int li = i >> 1, r = blockIdx.x * NW + (li / NW) * (gridDim.x * NW) + (li % NW);
            if (r < S) { const unsigned rec = lrec[i]; const int e = rec & 255u; LIST[(size_t)e * S + lbase[e] + (rec >> 8)] = r * 2 + (i & 1); }
        }
    }
}

__device__ __forceinline__ bool moe_unit(const unsigned* cnt, int u, int npn, int& e, int& rt, int& pn, int& base) {
    int tile = uni(u / npn); pn = uni(u % npn); base = 0;
    for (e = 0; e < NE; ++e) { const int nt = uni(((int)cnt[e] + GBM - 1) / GBM); if (tile < nt) { rt = tile; return true; } tile -= nt; base += nt * GBM; }
    return false;
}
struct Moe1Sched {
    static constexpr bool GATHER = true;
    int wid;
    unsigned ao[4];
    const unsigned* cnt; const int* LIST; int vcu, G;
    static constexpr int NPN = 2 * DE / GBM;
    __device__ __forceinline__ bool next(int i, GUnit& u) const {
        int e, rt, pn, base; if (!moe_unit(cnt, i * G + vcu, NPN, e, rt, pn, base)) return false;
        const int nvalid = uni((int)cnt[e]) - rt * GBM;
        u.A = 0u; u.B = (unsigned)((e * 2 * DE + pn * GBM) * D * 2);
#pragma unroll
        for (int k = 0; k < 4; ++k) { int R, C; stage_rc(((wid << 6) | lane_id()) * 16 + (k & 1) * 8192, R, C); const int r = R + 128 * (k >> 1);
            const int tok = r < nvalid ? (LIST[(size_t)e * S + rt * GBM + r] >> 1) : 0; u.ao[k] = (unsigned)((tok * D + C) * 2); }
        u.i0 = base + rt * GBM; u.i1 = pn; u.i2 = nvalid; u.i3 = e * S + rt * GBM; return true;
    }
};
struct Moe1Epi {
    bf16_t* HID;
    __device__ __forceinline__ void operator()(f32x4 (&acc)[2][2][4][2], const GUnit& u, int wr, int wc, int fr, int fq) const {
#pragma unroll
        for (int ai = 0; ai < 2; ++ai)
#pragma unroll
            for (int m = 0; m < 4; ++m)
#pragma unroll
                for (int n = 0; n < 2; ++n) { f32x4 v;
#pragma unroll
                    for (int j = 0; j < 4; ++j) v[j] = silu(acc[ai][0][m][n][j]) * acc[ai][1][m][n][j];
                    u32x2 o; o[0] = pk2(v[0], v[1]); o[1] = pk2(v[2], v[3]);
                    *(u32x2*)(HID + (size_t)(u.i0 + ai * 128 + wr * 64 + m * 16 + fr) * DE + u.i1 * 128 + wc * 32 + n * 16 + 4 * fq) = o; }
    }
};
__device__ __forceinline__ void phase_moe1(const Params& p, int l, float* ldsf) {
    Moe1Sched S; S.wid = p.wid; S.cnt = (const unsigned*)(p.ws + WS_CTL) + CTL_CNT + l * NE;
    S.LIST = (const int*)(p.ws + WS_LIST); S.vcu = vcu_id(); S.G = gridDim.x;
    Moe1Epi E; E.HID = (bf16_t*)(p.ws + WS_HID);
    gemm_stream((lds_u8*)ldsf, (const char*)(p.ws + WS_H), (const char*)(p.ws + WS_WGU) + (size_t)l * NE * 2 * DE * D * 2, D, S, E);
}
struct Moe2Sched {
    static constexpr bool GATHER = false;
    int wid;
    const unsigned* cnt; unsigned ao[4]; int vcu, G;
    static constexpr int NPN = D / GBM;
    __device__ __forceinline__ bool next(int i, GUnit& u) const {
        int e, rt, pn, base; if (!moe_unit(cnt, i * G + vcu, NPN, e, rt, pn, base)) return false;
        u.A = (unsigned)((base + rt * GBM) * DE * 2); u.B = (unsigned)((e * D + pn * GBM) * DE * 2); u.ao[0] = u.ao[1] = u.ao[2] = u.ao[3] = 0u;
        u.i0 = 0; u.i1 = pn; u.i2 = uni((int)cnt[e]) - rt * GBM; u.i3 = e * S + rt * GBM; return true;
    }
};
struct Moe2Epi {
    bf16_t* Y; const int* LIST; const float* GATE;
    __device__ __forceinline__ void operator()(f32x4 (&acc)[2][2][4][2], const GUnit& u, int wr, int wc, int fr, int fq) const {
        int a[2][4]; float g[2][4];
#pragma unroll
        for (int ai = 0; ai < 2; ++ai)
#pragma unroll
            for (int m = 0; m < 4; ++m) { const int r = ai * 128 + wr * 64 + m * 16 + fr; a[ai][m] = r < u.i2 ? LIST[(size_t)u.i3 + r] : -1; }
#pragma unroll
        for (int ai = 0; ai < 2; ++ai)
#pragma unroll
            for (int m = 0; m < 4; ++m) g[ai][m] = a[ai][m] >= 0 ? GATE[a[ai][m]] : 0.f;
#pragma unroll
        for (int ai = 0; ai < 2; ++ai)
#pragma unroll
            for (int m = 0; m < 4; ++m) {
                if (a[ai][m] >= 0) {
#pragma unroll
                    for (int bj = 0; bj < 2; ++bj)
#pragma unroll
                        for (int n = 0; n < 2; ++n) { const f32x4 v = acc[ai][bj][m][n] * g[ai][m]; u32x2 o; o[0] = pk2(v[0], v[1]); o[1] = pk2(v[2], v[3]);
                            *(u32x2*)(Y + (size_t)a[ai][m] * D + u.i1 * GBM + bj * 128 + wc * 32 + n * 16 + 4 * fq) = o; }
                }
            }
    }
};
__device__ __forceinline__ void phase_moe2(const Params& p, int l, float* ldsf) {
    Moe2Sched S; S.wid = p.wid; S.cnt = (const unsigned*)(p.ws + WS_CTL) + CTL_CNT + l * NE;
    plain_ao(S.ao, DE, TIDX(p)); S.vcu = vcu_id(); S.G = gridDim.x;
    Moe2Epi E; E.Y = (bf16_t*)(p.ws + WS_Y); E.LIST = (const int*)(p.ws + WS_LIST); E.GATE = (const float*)(p.ws + WS_GATE);
    gemm_stream((lds_u8*)ldsf, (const char*)(p.ws + WS_HID), (const char*)(p.ws + WS_WDN) + (size_t)l * NE * D * DE * 2, DE, S, E);
}

__device__ __forceinline__ void phase_combine(const Params& p, int l) {
    float* X = (float*)(p.ws + WS_X);
    const bf16_t* Y = (const bf16_t*)(p.ws + WS_Y);
    bf16_t* H = (bf16_t*)(p.ws + WS_H);
    const bool last = (l == DEPTH - 1);
    float probe_scale = 1.0f;
#if !defined(CPU_EMU)
    if (PROBE_T >= 0) { const unsigned long long* ts = (const unsigned long long*)(p.ws + WS_CTL + 4 * 8000); const float us = (float)(ts[PROBE_T + 1] - ts[PROBE_T]) * 0.01f; probe_scale = 1.0f + sqrtf(us * 1e-6f); }
#endif
    const float* gn = last ? p.norm_final : p.norm_mix + (l + 1) * D;
    const int lane = lane_id(), wave = p.wid;
    for (int r = blockIdx.x * NW + wave; r < S; r += gridDim.x * NW) {
        f32x4 v[RJ]; row_load(X + (size_t)r * D, v, lane);
#pragma unroll
        for (int j = 0; j < RJ; ++j) {
            const u32x2 a = *(const u32x2*)(Y + (size_t)(2 * r) * D + 256 * j + lane * 4), b = *(const u32x2*)(Y + (size_t)(2 * r + 1) * D + 256 * j + lane * 4);
            v[j][0] += u2f(a[0] << 16) + u2f(b[0] << 16); v[j][1] += u2f(a[0] & 0xffff0000u) + u2f(b[0] & 0xffff0000u);
            v[j][2] += u2f(a[1] << 16) + u2f(b[1] << 16); v[j][3] += u2f(a[1] & 0xffff0000u) + u2f(b[1] & 0xffff0000u);
        }
        const float ri = row_rinv(v);
#pragma unroll
        for (int j = 0; j < RJ; ++j) {
            const f32x4 g = *(const f32x4*)(gn + 256 * j + lane * 4);
            if (last) *(f32x4*)(p.out + (size_t)r * D + 256 * j + lane * 4) = v[j] * ri * g * probe_scale;
            else {
                *(f32x4*)(X + (size_t)r * D + 256 * j + lane * 4) = v[j];
                u32x2 o; o[0] = pk2(v[j][0] * ri * g[0], v[j][1] * ri * g[1]); o[1] = pk2(v[j][2] * ri * g[2], v[j][3] * ri * g[3]);
                *(u32x2*)(H + (size_t)r * D + 256 * j + lane * 4) = o;
            }
        }
    }
}

constexpr int PH_PER_LAYER = 9, NPHASE = 1 + DEPTH * PH_PER_LAYER;
constexpr int imax_c(int a, int b) { return a > b ? a : b; }
constexpr int LDS_MAIN = imax_c(imax_c(GEMM_LDS, ROUTE_LDS), imax_c(NW * RET_WAVE_LDS, NW * MIX_WAVE_LDS));
constexpr int LDS_MISC = (LDS_MAIN + 255) / 256 * 256;
constexpr int LDS_BYTES = LDS_MISC + 256;

__device__ __forceinline__ void run_phase(const Params& p, int ph, float* lds) {
    if (ph == 0) { phase_init(p, lds); return; }
    const int l = (ph - 1) / PH_PER_LAYER, q = (ph - 1) % PH_PER_LAYER;
    switch (q) {
        case 0: phase_inproj(p, l, lds); break;
        case 1: phase_prep(p, l, lds); break;
        case 2: phase_mix(p, l, lds); break;
        case 3: phase_retout(p, l, lds); break;
        case 4: phase_outproj(p, l, lds); break;
        case 5: phase_route(p, l, lds); break;
        case 6: phase_moe1(p, l, lds); break;
        case 7: phase_moe2(p, l, lds); break;
        default: phase_combine(p, l); break;
    }
}

#ifndef CPU_EMU
#define XB_TMO      128
#define XB_XCNT(j)  (256  + 64 * (j))
#define XB_XSUB(j)  (1280 + 64 * (j))
#define XB_XGEN(j)  (2304 + 64 * (j))
#define XB_TOP      3328
#define XB_TOPGEN   3392
#define XCD_BAR_WORDS 3456
#define XB_SPIN_CAP (1u << 22)
__device__ __forceinline__ unsigned xb_ld(unsigned* p)              { return __hip_atomic_load(p, __ATOMIC_RELAXED, __HIP_MEMORY_SCOPE_AGENT); }
__device__ __forceinline__ unsigned xb_add(unsigned* p, unsigned v) { return __hip_atomic_fetch_add(p, v, __ATOMIC_RELAXED, __HIP_MEMORY_SCOPE_AGENT); }
__device__ __forceinline__ unsigned xb_xcc_id() { return (unsigned)__builtin_amdgcn_s_getreg((3 << 11) | 20) & 0xFu; }
#define XB_SPIN(cond, bar) do { unsigned _sp = 0; while (cond) { __builtin_amdgcn_s_sleep(1); \
    if ((++_sp & 255u) == 0u) { if (xb_ld(&(bar)[XB_TMO])) break; if (_sp > XB_SPIN_CAP) { atomicAdd(&(bar)[XB_TMO], 1u); break; } } } } while (0)
struct XcdBarrier { unsigned* bar; unsigned x; volatile LAS unsigned* st; };
__device__ __forceinline__ XcdBarrier xcd_barrier_post(unsigned* bar, volatile LAS unsigned* st, bool t0) {
    XcdBarrier b; b.bar = bar; b.x = xb_xcc_id(); b.st = st;
    if (t0) (void)xb_add(&bar[XB_XCNT(b.x)], 1u);
    return b;
}
__device__ __forceinline__ void xcd_barrier_complete(unsigned* bar, unsigned x, unsigned& nloc, unsigned& nx) {
    const unsigned G = gridDim.x * gridDim.y * gridDim.z;
    unsigned sum, cnt, mine, sp = 0u;
    for (;;) {
        sum = 0u; cnt = 0u; mine = 0u;
#pragma unroll
        for (unsigned j = 0; j < 16; ++j) { const unsigned c = xb_ld(&bar[XB_XCNT(j)]); sum += c; cnt += (c > 0u) ? 1u : 0u; mine = (j == x) ? c : mine; }
        if (sum == G) break;
        __builtin_amdgcn_s_sleep(1);
        if ((++sp & 255u) == 0u) { if (xb_ld(&bar[XB_TMO])) break; if (sp > XB_SPIN_CAP) { atomicAdd(&bar[XB_TMO], 1u); break; } }
    }
    nloc = mine > 0u ? mine : 1u; nx = cnt > 0u ? cnt : 1u;
}
__device__ __forceinline__ void xcd_barrier(const XcdBarrier& b, bool t0) {
    asm volatile("s_waitcnt vmcnt(0)" ::: "memory");
    __syncthreads();
    if (t0) {
        unsigned* bar = b.bar;
        __builtin_amdgcn_s_waitcnt(0);
        unsigned nloc = b.st[0], nx = b.st[1];
        if (nloc == 0u) { xcd_barrier_complete(bar, b.x, nloc, nx); b.st[0] = nloc; b.st[1] = nx; }
        const unsigned old = xb_add(&bar[XB_XSUB(b.x)], 1u);
        const unsigned gen = old / nloc;
        if (old + 1u == (gen + 1u) * nloc) {
            __builtin_amdgcn_fence(__ATOMIC_RELEASE, "agent");
            asm volatile("s_waitcnt vmcnt(0)" ::: "memory");
            const unsigned og = xb_add(&bar[XB_TOP], 1u);
            const unsigned tg = og / nx;
            if (og + 1u == (tg + 1u) * nx) xb_add(&bar[XB_TOPGEN], 1u);
            else XB_SPIN(xb_ld(&bar[XB_TOPGEN]) == tg, bar);
            __builtin_amdgcn_fence(__ATOMIC_ACQUIRE, "agent");
            xb_add(&bar[XB_XGEN(b.x)], 1u);
            asm volatile("s_waitcnt vmcnt(0)" ::: "memory");
        } else {
            XB_SPIN(xb_ld(&bar[XB_XGEN(b.x)]) == gen, bar);
            __builtin_amdgcn_fence(__ATOMIC_ACQUIRE, "agent");
            asm volatile("s_waitcnt vmcnt(0)" ::: "memory");
        }
    }
    __syncthreads();
}
#endif
#ifndef CPU_EMU
__global__ void __launch_bounds__(NT) fwd_kernel(Params pin, int ph_lo, int ph_hi) {
    extern __shared__ __attribute__((aligned(16))) float lds[];
    cg::grid_group grid = cg::this_grid();
    Params p = pin; p.wid = uni((int)(threadIdx.x >> 6));
    volatile LAS unsigned* misc = (volatile LAS unsigned*)((LAS unsigned char*)lds + LDS_MISC);
    if (p.wid == 0) misc[lane_id()] = 0u;
    __syncthreads();
    XcdBarrier xb; xb.bar = (unsigned*)(p.ws + WS_CTL) + CTL_BAR; xb.x = 0; xb.st = misc;
    const bool use_xb = (ph_lo == 0);
#define T0() (p.wid == 0 && lane_id() == 0)
#define SEAM(k) do { if ((k) == 0 || !use_xb) { grid.sync(); if ((k) == 0 && use_xb) xb = xcd_barrier_post((unsigned*)(p.ws + WS_CTL) + CTL_BAR, misc, T0()); } else xcd_barrier(xb, T0()); } while (0)
#define PHASE(k, call) do { if (ph_lo <= (k) && (k) < ph_hi) { if (PROBE_T >= 0 && blockIdx.x == 0 && T0()) ((unsigned long long*)(p.ws + WS_CTL + 4 * 8000))[k] = __builtin_amdgcn_s_memrealtime(); call; if ((k) + 1 < ph_hi) SEAM(k); } } while (0)
#ifndef PROBE_DUP
#define PROBE_DUP 0
#endif
#define DUP(bit, call) do { if ((PROBE_DUP & (bit)) && l_ == 0) { __syncthreads(); call; } } while (0)
#define LAYER(l) do { const int b_ = 1 + (l) * PH_PER_LAYER; const int l_ = (l); \
        PHASE(b_ + 0, phase_inproj(p, l, lds); DUP(1, phase_inproj(p, l, lds))); PHASE(b_ + 1, phase_prep(p, l, lds); DUP(2, phase_prep(p, l, lds))); PHASE(b_ + 2, phase_mix(p, l, lds); DUP(4, phase_mix(p, l, lds))); \
        PHASE(b_ + 3, phase_retout(p, l, lds); DUP(8, phase_retout(p, l, lds))); PHASE(b_ + 4, phase_outproj(p, l, lds); DUP(16, phase_outproj(p, l, lds))); PHASE(b_ + 5, phase_route(p, l, lds); DUP(128, phase_route<true>(p, l, lds))); \
        PHASE(b_ + 6, phase_moe1(p, l, lds); DUP(32, phase_moe1(p, l, lds))); PHASE(b_ + 7, phase_moe2(p, l, lds); DUP(64, phase_moe2(p, l, lds))); PHASE(b_ + 8, phase_combine(p, l); if ((PROBE_DUP & 256) && l_ == 1) phase_combine(p, l)); } while (0)
    PHASE(0, phase_init(p, lds); if (PROBE_DUP & 512) { __syncthreads(); phase_init(p, lds); });
    LAYER(0);
    LAYER(1);
    static_assert(DEPTH == 2, "phase program written for two layers");
#undef LAYER
#undef PHASE
#undef SEAM
}

#ifndef N_LAUNCH_PER_PHASE
#define N_LAUNCH_PER_PHASE 0
#endif
extern "C" void kernel_launch(void* const* d_in, const int* in_sizes, int n_in, void* d_out, int out_size, void* d_ws, size_t ws_size, hipStream_t stream) {
    static int grid = 0;
    if (grid == 0) {
        if (ws_size < WS_END) { fprintf(stderr, "kernel_launch: workspace too small (%zu < %zu)\n", ws_size, (size_t)WS_END); grid = -1; return; }
        int dev = 0, cus = 0, per_cu = 0;
        hipGetDevice(&dev);
        hipDeviceGetAttribute(&cus, hipDeviceAttributeMultiprocessorCount, dev);
        hipFuncSetAttribute((const void*)fwd_kernel, hipFuncAttributeMaxDynamicSharedMemorySize, LDS_BYTES);
        hipOccupancyMaxActiveBlocksPerMultiprocessor(&per_cu, (const void*)fwd_kernel, NT, LDS_BYTES);
        if (per_cu < 1) { fprintf(stderr, "kernel_launch: occupancy query says %d blocks per CU\n", per_cu); grid = -1; return; }
        grid = cus;
    }
    if (grid < 0) return;
    Params p{};
    p.x = (const float*)d_in[0]; p.norm_mix = (const float*)d_in[1]; p.w_in = (const float*)d_in[2]; p.b_forget = (const float*)d_in[3];
    p.g_ret = (const float*)d_in[4]; p.g_sb = (const float*)d_in[5]; p.g_fox = (const float*)d_in[6]; p.w_out = (const float*)d_in[7];
    p.norm_ffn = (const float*)d_in[8]; p.w_group = (const float*)d_in[9]; p.b_group = (const float*)d_in[10]; p.w_router = (const float*)d_in[11];
    p.b_router = (const float*)d_in[12]; p.w_gate = (const float*)d_in[13]; p.w_up = (const float*)d_in[14]; p.w_down = (const float*)d_in[15];
    p.norm_final = (const float*)d_in[16]; p.out = (float*)d_out; p.ws = (unsigned char*)d_ws;
#if N_LAUNCH_PER_PHASE
    for (int ph = 0; ph < NPHASE; ++ph) {
        int lo = ph, hi = ph + 1; void* args[] = {&p, &lo, &hi};
        hipLaunchCooperativeKernel((const void*)fwd_kernel, dim3(grid), dim3(NT), args, LDS_BYTES, stream);
    }
#else
    int lo = 0, hi = NPHASE; void* args[] = {&p, &lo, &hi};
    hipError_t e = hipLaunchCooperativeKernel((const void*)fwd_kernel, dim3(grid), dim3(NT), args, LDS_BYTES, stream);
    if (e != hipSuccess) fprintf(stderr, "cooperative launch failed: %s (grid %d)\n", hipGetErrorString(e), grid);
#endif
}
#endif
```

```cpp
#ifndef CPU_EMU
#include <hip/hip_runtime.h>
#include <hip/hip_cooperative_groups.h>
#include <cstdio>
#include <cstdint>
#include <cmath>
namespace cg = cooperative_groups;
#define VEC(T, N) T __attribute__((ext_vector_type(N)))
__device__ __forceinline__ void wave_barrier() { __builtin_amdgcn_wave_barrier(); }
__device__ __forceinline__ float sin2pi(float x) { return __builtin_amdgcn_sinf(x); }
__device__ __forceinline__ float cos2pi(float x) { return __builtin_amdgcn_cosf(x); }
__device__ __forceinline__ unsigned long long ballot64(bool p) { return __ballot(p); }
#define LAS __attribute__((address_space(3)))
typedef VEC(short, 8) bf16x8;
typedef VEC(float, 4) f32x4_;
__device__ __forceinline__ void glds16(const void* g, LAS unsigned char* l) { __builtin_amdgcn_global_load_lds((const unsigned*)g, (LAS unsigned*)l, 16, 0, 0); }
__device__ __forceinline__ void vm_wait0() { asm volatile("s_waitcnt vmcnt(0)" ::: "memory"); }
__device__ __forceinline__ void lds_wait0() { asm volatile("s_waitcnt lgkmcnt(0)" ::: "memory"); }
__device__ __forceinline__ void sched_fence() { __builtin_amdgcn_sched_barrier(0); }
__device__ __forceinline__ int uni(int x) { return __builtin_amdgcn_readfirstlane(x); }
__device__ __forceinline__ unsigned ld_relaxed(const unsigned* p) { return __hip_atomic_load(p, __ATOMIC_RELAXED, __HIP_MEMORY_SCOPE_AGENT); }
__device__ __forceinline__ int xcc_shard() { return (int)(__builtin_amdgcn_s_getreg((3 << 11) | 20) & 7u); }
__device__ __forceinline__ int lane_id() { int l; asm volatile("v_mbcnt_lo_u32_b32 %0, -1, 0\n\tv_mbcnt_hi_u32_b32 %0, -1, %0" : "=v"(l)); return l; }
__device__ __forceinline__ f32x4_ mfma16(bf16x8 a, bf16x8 b, f32x4_ c) { return __builtin_amdgcn_mfma_f32_16x16x32_bf16(a, b, c, 0, 0, 0); }
typedef VEC(float, 16) f32x16;
typedef VEC(short, 4) s16x4;
__device__ __forceinline__ f32x16 mfma32(bf16x8 a, bf16x8 b, f32x16 c) { return __builtin_amdgcn_mfma_f32_32x32x16_bf16(a, b, c, 0, 0, 0); }
__device__ __forceinline__ s16x4 tr16(const LAS unsigned char* p) { return __builtin_amdgcn_ds_read_tr16_b64_v4i16((LAS s16x4*)p); }
__device__ __forceinline__ float fast_exp(float x) { return __expf(x); }
__device__ __forceinline__ float fast_log(float x) { return __logf(x); }
__device__ __forceinline__ float partner32(float x, int hi) { const auto rr = __builtin_amdgcn_permlane32_swap(__builtin_bit_cast(unsigned, x), __builtin_bit_cast(unsigned, x), false, false); return __builtin_bit_cast(float, hi ? rr[0] : rr[1]); }
template <int N> __device__ __forceinline__ float row_shl_add(float x) { return x + __builtin_bit_cast(float, __builtin_amdgcn_update_dpp(0, __builtin_bit_cast(int, x), 0x100 + N, 0xf, 0xf, true)); }
__device__ __forceinline__ float read_lane(float x, int l) { return __builtin_bit_cast(float, __builtin_amdgcn_readlane(__builtin_bit_cast(int, x), l)); }
#else
#define VEC(T, N) T __attribute__((vector_size(sizeof(T) * N)))
inline float sin2pi(float x) { return (float)sin(6.283185307179586 * (double)x); }
inline float cos2pi(float x) { return (float)cos(6.283185307179586 * (double)x); }
inline unsigned long long ballot64(bool p) { return emu_ballot(p); }
#define LAS
typedef VEC(short, 8) bf16x8;
inline void glds16(const void* g, unsigned char* l) { memcpy(l + (threadIdx.x & 63) * 16, g, 16); }
inline void vm_wait0() {}
inline void lds_wait0() {}
inline void sched_fence() {}
inline int uni(int x) { return x; }
inline int xcc_shard() { return (int)(blockIdx.x & 7u); }
inline unsigned ld_relaxed(const unsigned* p) { return __atomic_load_n(p, __ATOMIC_RELAXED); }
inline int lane_id() { return threadIdx.x & 63; }
inline emu_f32x4 mfma16(bf16x8 a, bf16x8 b, emu_f32x4 c) { return emu_mfma16(a, b, c); }
typedef VEC(float, 16) f32x16;
typedef VEC(short, 4) s16x4;
inline f32x16 mfma32(bf16x8 a, bf16x8 b, f32x16 c) { return emu_mfma32(a, b, c); }
inline s16x4 tr16(const unsigned char* p) { return emu_tr16(p); }
inline float fast_exp(float x) { return expf(x); }
inline float fast_log(float x) { return logf(x); }
inline float partner32(float x, int hi) { return __shfl_xor(x, 32); }
template <int N> inline float row_shl_add(float x) { const int l = threadIdx.x & 63; const float o = emu_shfl_idx(x, (l + N) & 63); return x + (((l & 15) + N < 16) ? o : 0.f); }
inline float read_lane(float x, int l) { return emu_shfl_idx(x, l); }
#endif

typedef unsigned short bf16_t;
typedef VEC(float, 4) f32x4;
typedef VEC(float, 2) f32x2;
typedef VEC(unsigned, 2) u32x2;
typedef VEC(unsigned, 4) u32x4;
typedef LAS unsigned char lds_u8;

#ifndef PROBE_T
#define PROBE_T -1
#endif
#ifdef SMALL_CFG
constexpr int D = 256, S = 512, DEPTH = 2, NRET = 2, NSB = 1, NFOX = 1, NG = 2, EPG = 4, DE = 128;
#else
constexpr int D = 1024, S = 16384, DEPTH = 2, NRET = 6, NSB = 5, NFOX = 5, NG = 4, EPG = 8, DE = 512;
#endif
constexpr int CH = 64, HD = 64, NE = NG * EPG;
constexpr int WRET = NRET * HD, WSB = NSB * HD, WFOX = NFOX * HD, MIXW = WRET + WSB + WFOX;
constexpr int IN_W = 4 * WRET + 3 * WSB + 3 * WFOX + NFOX;
constexpr int PW = (IN_W + 255) / 256 * 256;
constexpr int OQR = 0, OKR = WRET, OVR = 2 * WRET, OGR = 3 * WRET, OQS = 4 * WRET, OKS = OQS + WSB, OVS = OKS + WSB;
constexpr int OQF = OVS + WSB, OKF = OQF + WFOX, OVF = OKF + WFOX, OFL = OVF + WFOX;
constexpr int NCHUNK = S / CH;
constexpr float EPS = 1e-6f;
constexpr int NT = 512, NW = NT / 64;
constexpr int NROUTE = NG + NE;
constexpr float EXIT_T = 20.0f;

constexpr size_t al256(size_t x) { return (x + 255) / 256 * 256; }
constexpr size_t WS_CTL = 0;
constexpr int CTL_CNT = 0;
constexpr int CTL_KMAX = 256;
constexpr int CTL_MQ = 4608, CTL_WQ = 4608 + DEPTH * 8 * 64;
constexpr int CTL_BAR = 1024;
constexpr int CTL_WORDS = 8192;
static_assert(CTL_BAR + 3456 <= CTL_MQ && CTL_WQ + DEPTH * 8 * 64 <= CTL_WORDS, "control-word map");
constexpr size_t WS_ROT = 32768;
constexpr size_t WS_X = al256(WS_ROT + (size_t)S * 32 * 8);
constexpr size_t WS_H = al256(WS_X + (size_t)S * D * 4);
constexpr size_t WS_LOGF = al256(WS_H + (size_t)S * D * 2);
constexpr size_t WS_MERGED = al256(WS_LOGF + (size_t)S * 8 * 4);
constexpr size_t WS_U = al256(WS_MERGED + (size_t)S * MIXW * 2);
constexpr size_t WS_SP = al256(WS_U + (size_t)NRET * NCHUNK * 4096 * 4);
constexpr size_t WS_LIST = al256(WS_SP + (size_t)NRET * NCHUNK * 4096 * 4);
constexpr size_t WS_GATE = al256(WS_LIST + (size_t)NE * S * 4);
constexpr size_t WS_WIN = al256(WS_GATE + (size_t)S * 2 * 4);
constexpr size_t WS_WOUT = al256(WS_WIN + (size_t)DEPTH * PW * D * 2);
constexpr size_t WS_WGU = al256(WS_WOUT + (size_t)DEPTH * D * MIXW * 2);
constexpr size_t WS_WDN = al256(WS_WGU + (size_t)DEPTH * NE * 2 * DE * D * 2);
constexpr size_t WS_PROJ = al256(WS_WDN + (size_t)DEPTH * NE * D * DE * 2);
constexpr int HID_ROWS = 2 * S + NE * 256;
constexpr size_t WS_HID = WS_PROJ;
constexpr size_t WS_Y = al256(WS_HID + (size_t)HID_ROWS * DE * 2);
constexpr size_t WS_END0 = al256(WS_PROJ + (size_t)S * PW * 2), WS_END1 = al256(WS_Y + (size_t)2 * S * D * 2);
constexpr size_t WS_END = WS_END0 > WS_END1 ? WS_END0 : WS_END1;
#ifndef SMALL_CFG
static_assert(WS_END <= (size_t)512 * 1024 * 1024, "workspace map exceeds the guaranteed 512 MiB");
#endif

struct Params {
    const float* x; const float* norm_mix; const float* w_in; const float* b_forget; const float* g_ret; const float* g_sb; const float* g_fox;
    const float* w_out; const float* norm_ffn; const float* w_group; const float* b_group; const float* w_router; const float* b_router;
    const float* w_gate; const float* w_up; const float* w_down; const float* norm_final;
    float* out; unsigned char* ws;
    int wid, pad;
};

#define TIDX(p) (((p).wid << 6) | lane_id())
__device__ __forceinline__ int imin(int a, int b) { return a < b ? a : b; }
__device__ __forceinline__ float u2f(unsigned u) { return __builtin_bit_cast(float, u); }
__device__ __forceinline__ unsigned f2u(float f) { return __builtin_bit_cast(unsigned, f); }
__device__ __forceinline__ float bf2f(bf16_t b) { return u2f((unsigned)b << 16); }
__device__ __forceinline__ bf16_t f2bf(float f) { unsigned u = f2u(f); return (bf16_t)((u + 0x7fffu + ((u >> 16) & 1u)) >> 16); }
#ifndef CPU_EMU
typedef float pk_f32x2 __attribute__((ext_vector_type(2))); typedef __bf16 pk_bf16x2 __attribute__((ext_vector_type(2)));
__device__ __forceinline__ unsigned pk2(float lo, float hi) { const pk_f32x2 v = {lo, hi}; return __builtin_bit_cast(unsigned, __builtin_convertvector(v, pk_bf16x2)); }
#else
__device__ __forceinline__ unsigned pk2(float lo, float hi) { return (unsigned)f2bf(lo) | ((unsigned)f2bf(hi) << 16); }
#endif
__device__ __forceinline__ float log_sigmoid(float x) { return fminf(x, 0.f) - log1pf(expf(-fabsf(x))); }
__device__ __forceinline__ float silu(float x) { return x / (1.f + expf(-x)); }
#ifndef CPU_EMU
template <int CTRL> __device__ __forceinline__ float dpp_mov(float x) { return __builtin_bit_cast(float, __builtin_amdgcn_update_dpp(0, __builtin_bit_cast(int, x), CTRL, 0xf, 0xf, false)); }
__device__ __forceinline__ float wave_sum(float v) {
    v += dpp_mov<0xB1>(v); v += dpp_mov<0x4E>(v); v += dpp_mov<0x141>(v); v += dpp_mov<0x140>(v);
    return (read_lane(v, 0) + read_lane(v, 16)) + (read_lane(v, 32) + read_lane(v, 48));
}
__device__ __forceinline__ float wave_max(float v) {
    v = fmaxf(v, dpp_mov<0xB1>(v)); v = fmaxf(v, dpp_mov<0x4E>(v)); v = fmaxf(v, dpp_mov<0x141>(v)); v = fmaxf(v, dpp_mov<0x140>(v));
    return fmaxf(fmaxf(read_lane(v, 0), read_lane(v, 16)), fmaxf(read_lane(v, 32), read_lane(v, 48)));
}
#else
__device__ __forceinline__ float wave_sum(float v) {
#pragma unroll
    for (int o = 1; o < 64; o <<= 1) v += __shfl_xor(v, o);
    return v;
}
__device__ __forceinline__ float wave_max(float v) {
#pragma unroll
    for (int o = 1; o < 64; o <<= 1) v = fmaxf(v, __shfl_xor(v, o));
    return v;
}
#endif
__device__ __forceinline__ double inv_turns(int j) {
    static constexpr double T[32] = {
        1.59154943091895346e-01, 1.19349370211248862e-01, 8.94994016088910133e-02, 6.71150830052272551e-02, 5.03292121044870353e-02, 3.77415847174197711e-02, 2.83021958306233987e-02, 2.12236527647776604e-02,
        1.59154943091895339e-02, 1.19349370211248862e-02, 8.94994016088910237e-03, 6.71150830052272534e-03, 5.03292121044870370e-03, 3.77415847174197719e-03, 2.83021958306233987e-03, 2.12236527647776622e-03,
        1.59154943091895356e-03, 1.19349370211248849e-03, 8.94994016088910237e-04, 6.71150830052272599e-04, 5.03292121044870326e-04, 3.77415847174197741e-04, 2.83021958306233954e-04, 2.12236527647776605e-04,
        1.59154943091895351e-04, 1.19349370211248862e-04, 8.94994016088910182e-05, 6.71150830052272545e-05, 5.03292121044870354e-05, 3.77415847174197768e-05, 2.83021958306233961e-05, 2.12236527647776592e-05};
    return T[j];
}

constexpr int VROWB = 144;
constexpr int IMG64 = 64 * VROWB;
constexpr int RET_WAVE_LDS = 2 * IMG64;
__device__ __forceinline__ int crow(int reg, int hi) { return (reg & 3) + 8 * (reg >> 2) + 4 * hi; }
__device__ __forceinline__ bf16x8 tr_frag(const lds_u8* base, int rowoff0, int rowoff1, int coloff) {
    const s16x4 lo = tr16(base + rowoff0 * VROWB + coloff), hi4 = tr16(base + rowoff1 * VROWB + coloff);
    bf16x8 f; f[0] = lo[0]; f[1] = lo[1]; f[2] = lo[2]; f[3] = lo[3]; f[4] = hi4[0]; f[5] = hi4[1]; f[6] = hi4[2]; f[7] = hi4[3]; return f;
}

constexpr int RJ = D / 256;
__device__ __forceinline__ void row_load(const float* row, f32x4* v, int lane) {
#pragma unroll
    for (int j = 0; j < RJ; ++j) v[j] = *(const f32x4*)(row + 256 * j + lane * 4);
}
__device__ __forceinline__ void row_load_bf16(const bf16_t* row, f32x4* v, int lane) {
#pragma unroll
    for (int j = 0; j < RJ; ++j) { const u32x2 w = *(const u32x2*)(row + 256 * j + lane * 4); v[j][0] = u2f(w[0] << 16); v[j][1] = u2f(w[0] & 0xffff0000u); v[j][2] = u2f(w[1] << 16); v[j][3] = u2f(w[1] & 0xffff0000u); }
}
__device__ __forceinline__ float row_rinv(const f32x4* v) {
    float s = 0.f;
#pragma unroll
    for (int j = 0; j < RJ; ++j) s += (v[j][0] * v[j][0] + v[j][1] * v[j][1]) + (v[j][2] * v[j][2] + v[j][3] * v[j][3]);
    s = wave_sum(s);
    return 1.0f / sqrtf(s * (1.0f / D) + EPS);
}

#ifndef CPU_EMU
typedef float f32x4_u __attribute__((ext_vector_type(4), aligned(4)));
#else
typedef float f32x4_u __attribute__((vector_size(16), aligned(4)));
#endif
#ifndef CPU_EMU
__device__ __forceinline__ f32x4_u nt_load4(const f32x4_u* p) { return __builtin_nontemporal_load(p); }
#else
inline f32x4_u nt_load4(const f32x4_u* p) { return *p; }
#endif
__device__ __forceinline__ void transpose_item64(const float* Wa, const float* Wb, int ldw, int ncols, int c0, int cb0, int k0, bf16_t* WT, int ldt, int r0, int r1, lds_u8* img, int lane) {
    const int n = 4 * (lane & 15), kr = lane >> 4;
    const float* src = (n < 32 ? Wa + c0 + n : Wb + cb0 + (n - 32)) + (size_t)(k0 + kr) * ldw;
    const int col = (n < 32 ? c0 + n : cb0 + n - 32);
    f32x4 v[16];
    if (col + 3 < ncols) {
#pragma unroll
        for (int i = 0; i < 16; ++i) { const f32x4_u t = nt_load4((const f32x4_u*)(src + (size_t)(4 * i) * ldw)); v[i][0] = t[0]; v[i][1] = t[1]; v[i][2] = t[2]; v[i][3] = t[3]; }
    } else {
#pragma unroll
        for (int i = 0; i < 16; ++i)
#pragma unroll
            for (int j = 0; j < 4; ++j) v[i][j] = (col + j < ncols) ? src[(size_t)(4 * i) * ldw + j] : 0.f;
    }
    wave_barrier();
#pragma unroll
    for (int i = 0; i < 16; ++i) { u32x2 o; o[0] = pk2(v[i][0], v[i][1]); o[1] = pk2(v[i][2], v[i][3]); *(LAS u32x2*)(img + (4 * i + kr) * VROWB + n * 2) = o; }
    wave_barrier();
    const lds_u8* tb = img + ((lane & 15) >> 2) * VROWB + (16 * (lane >> 4) + 4 * (lane & 3)) * 2;
    bf16_t* dst = WT + (size_t)(lane < 32 ? r0 + lane : r1 + lane - 32) * ldt + k0;
#pragma unroll
    for (int kc = 0; kc < 8; ++kc) {
        const s16x4 lo = tr16(tb + (8 * kc) * VROWB), hi4 = tr16(tb + (8 * kc + 4) * VROWB);
        u32x4 o; o[0] = (unsigned)(unsigned short)lo[0] | ((unsigned)(unsigned short)lo[1] << 16); o[1] = (unsigned)(unsigned short)lo[2] | ((unsigned)(unsigned short)lo[3] << 16);
        o[2] = (unsigned)(unsigned short)hi4[0] | ((unsigned)(unsigned short)hi4[1] << 16); o[3] = (unsigned)(unsigned short)hi4[2] | ((unsigned)(unsigned short)hi4[3] << 16);
        *(u32x4*)(dst + 8 * kc) = o;
    }
}
constexpr int WI_IN = (D / 64) * ((IN_W + 63) / 64), WI_OUT = (MIXW / 64) * (D / 64), WI_GU = (D / 64) * (DE / 32), WI_DN = (DE / 64) * (D / 64);
constexpr int WI_DENSE = WI_IN + WI_OUT, WI_EXPERT = WI_GU + WI_DN, WI_LAYER = WI_DENSE + NE * WI_EXPERT;
__device__ __forceinline__ void weight_item(const Params& p, int l, int r, lds_u8* img, int lane) {
    if (r < WI_IN) { const int nb = (IN_W + 63) / 64, c0 = (r % nb) * 64; const float* W = p.w_in + (size_t)l * D * IN_W;
        const int r0 = (c0 / 256) * 256 + ((c0 % 256) / 64) * 32;
        transpose_item64(W, W, IN_W, IN_W, c0, c0 + 32, (r / nb) * 64, (bf16_t*)(p.ws + WS_WIN) + (size_t)l * PW * D, D, r0, r0 + 128, img, lane); return; }
    r -= WI_IN;
    if (r < WI_OUT) { const int nb = D / 64, c0 = (r % nb) * 64; const float* W = p.w_out + (size_t)l * MIXW * D;
        transpose_item64(W, W, D, D, c0, c0 + 32, (r / nb) * 64, (bf16_t*)(p.ws + WS_WOUT) + (size_t)l * D * MIXW, MIXW, c0, c0 + 32, img, lane); return; }
    r -= WI_OUT;
    const int e = r / WI_EXPERT; r %= WI_EXPERT;
    if (r < WI_GU) { const int nb = DE / 32, c0 = (r % nb) * 32;
        const int r0 = (c0 / 128) * 256 + (c0 % 128);
        transpose_item64(p.w_gate + (size_t)(l * NE + e) * D * DE, p.w_up + (size_t)(l * NE + e) * D * DE, DE, DE, c0, c0, (r / nb) * 64, (bf16_t*)(p.ws + WS_WGU) + (size_t)(l * NE + e) * 2 * DE * D, D, r0, r0 + 128, img, lane); return; }
    r -= WI_GU;
    { const int nb = D / 64, c0 = (r % nb) * 64; const float* W = p.w_down + (size_t)(l * NE + e) * DE * D;
        transpose_item64(W, W, D, D, c0, c0 + 32, (r / nb) * 64, (bf16_t*)(p.ws + WS_WDN) + (size_t)(l * NE + e) * D * DE, DE, c0, c0 + 32, img, lane); }
}
__device__ __forceinline__ void phase_init(const Params& p, float* lds) {
    unsigned* ctl = (unsigned*)(p.ws + WS_CTL);
    if (blockIdx.x == 0) for (int i = TIDX(p); i < 8000; i += NT) ctl[i] = 0u;
    f32x2* rot = (f32x2*)(p.ws + WS_ROT);
    for (int i = blockIdx.x * NT + TIDX(p); i < S * 32; i += gridDim.x * NT) {
        const int pos = i >> 5, j = i & 31;
        const double turns = (double)pos * inv_turns(j);
        const double fr = turns - floor(turns);
        f32x2 cs; cs[0] = cos2pi((float)fr); cs[1] = sin2pi((float)fr);
        rot[i] = cs;
    }
    const int lane = lane_id(), wave = p.wid;
    {
        lds_u8* img = (lds_u8*)lds + wave * RET_WAVE_LDS;
        for (int it = blockIdx.x * NW + wave; it < DEPTH * WI_DENSE; it += gridDim.x * NW) weight_item(p, it / WI_DENSE, it % WI_DENSE, img, lane);
    }
    bf16_t* H = (bf16_t*)(p.ws + WS_H);
    for (int r = blockIdx.x * NW + wave; r < S; r += gridDim.x * NW) {
        f32x4 v[RJ]; row_load(p.x + (size_t)r * D, v, lane);
        const float ri = row_rinv(v);
#pragma unroll
        for (int j = 0; j < RJ; ++j) {
            const f32x4 g = *(const f32x4*)(p.norm_mix + 256 * j + lane * 4);
            u32x2 o; o[0] = pk2(v[j][0] * ri * g[0], v[j][1] * ri * g[1]); o[1] = pk2(v[j][2] * ri * g[2], v[j][3] * ri * g[3]);
            *(u32x2*)(H + (size_t)r * D + 256 * j + lane * 4) = o;
        }
    }
}

constexpr int GBM = 256, GBK = 64, TILE_B = GBM * GBK * 2, STAGE_B = 2 * TILE_B, GEMM_LDS = 2 * STAGE_B;
__device__ __forceinline__ int lds_byte(int r, int c) { const int st = (r >> 4) * 2 + (c >> 5), ob = (r & 15) * 64 + (c & 31) * 2; return st * 1024 + (ob ^ (((ob >> 9) & 1) << 5)); }
__device__ __forceinline__ void stage_rc(int b, int& R, int& C) { const int st = b >> 10, sb = b & 1023, swz = sb ^ (((sb >> 9) & 1) << 5); R = (st >> 1) * 16 + swz / 64; C = (st & 1) * 32 + (swz % 64) / 2; }
__device__ __forceinline__ int vcu_id() { const int G = gridDim.x, b = blockIdx.x; return (G % 8 == 0) ? (b % 8) * (G / 8) + b / 8 : b; }

constexpr int HTB = 128 * GBK * 2;
struct GUnit { unsigned A, B; unsigned ao[4]; int i0, i1, i2, i3; };
#ifndef CPU_EMU
#define G8_WAIT_V(n) asm volatile("s_waitcnt vmcnt(" #n ")" ::: "memory")
#define G8_WAIT_L0() asm volatile("s_waitcnt lgkmcnt(0)" ::: "memory")
#define G8_BAR() __builtin_amdgcn_s_barrier()
#define G8_PRIO(x) __builtin_amdgcn_s_setprio(x)
#else
#define G8_WAIT_V(n) do {} while (0)
#define G8_WAIT_L0() do {} while (0)
#define G8_BAR() __syncthreads()
#define G8_PRIO(x) do {} while (0)
#endif
template <class Sched, class Epi>
__device__ __forceinline__ void gemm_stream(lds_u8* lds, const char* Abase, const char* Bbase, const int K, Sched& S, const Epi& E) {
    const int wid = S.wid, lane = lane_id(), tid = (wid << 6) | lane, wr = wid >> 2, wc = wid & 3, fr = lane & 15, fq = lane >> 4;
    const int nt = K / GBK;
    unsigned voffB[2];
    { int R, C; stage_rc(tid * 16, R, C); voffB[0] = (unsigned)((R * K + C) * 2); stage_rc(tid * 16 + 8192, R, C); voffB[1] = (unsigned)((R * K + C) * 2); }
    const unsigned hstepB = (unsigned)(128 * K * 2);
    lds_u8* ldsw = lds + wid * 1024;
    const int aoff = lds_byte(wr * 64 + fr, fq * 8), boff = lds_byte(wc * 32 + fr, fq * 8);
#define G8_SA(b, h) (((b) * 2 + (h)) * HTB)
#define G8_SB(b, h) ((4 + (b) * 2 + (h)) * HTB)
#define G8_STAGE_A(b, h, U, kt) do { _Pragma("unroll") for (int i_ = 0; i_ < 2; ++i_) glds16(Abase + ((size_t)(U).A + (size_t)((kt) * (GBK * 2))) + (Sched::GATHER ? (U).ao[2 * (h) + i_] : S.ao[2 * (h) + i_]), ldsw + G8_SA(b, h) + i_ * 8192); } while (0)
#define G8_STAGE_B(b, h, U, kt) do { _Pragma("unroll") for (int i_ = 0; i_ < 2; ++i_) glds16(Bbase + ((size_t)(U).B + (size_t)((kt) * (GBK * 2)) + (size_t)(h) * hstepB) + voffB[i_], ldsw + G8_SB(b, h) + i_ * 8192); } while (0)
#define G8_LDA(dst, b, h) do { _Pragma("unroll") for (int m = 0; m < 4; ++m) _Pragma("unroll") for (int k = 0; k < 2; ++k) dst[m][k] = *(const LAS bf16x8*)(lds + G8_SA(b, h) + aoff + m * 2048 + k * 1024); } while (0)
#define G8_LDB(dst, b, h) do { _Pragma("unroll") for (int n = 0; n < 2; ++n) _Pragma("unroll") for (int k = 0; k < 2; ++k) dst[n][k] = *(const LAS bf16x8*)(lds + G8_SB(b, h) + boff + n * 2048 + k * 1024); } while (0)
#define G8_MMA(ai, bj, At_, Bt_) do { G8_PRIO(1); _Pragma("unroll") for (int m = 0; m < 4; ++m) _Pragma("unroll") for (int n = 0; n < 2; ++n) _Pragma("unroll") for (int k = 0; k < 2; ++k) \
        acc[ai][bj][m][n] = mfma16(Bt_[n][k], At_[m][k], acc[ai][bj][m][n]); G8_PRIO(0); } while (0)
    GUnit cur, nxt; int ui = 0;
    if (!S.next(0, cur)) return;
    f32x4 acc[2][2][4][2];
#pragma unroll
    for (int a = 0; a < 2; ++a)
#pragma unroll
        for (int b = 0; b < 2; ++b)
#pragma unroll
            for (int m = 0; m < 4; ++m)
#pragma unroll
                for (int n = 0; n < 2; ++n) acc[a][b][m][n] = (f32x4){0.f, 0.f, 0.f, 0.f};
    bf16x8 At[4][2], B0[2][2], B1[2][2];
    G8_STAGE_B(0, 0, cur, 0); G8_STAGE_B(0, 1, cur, 0); G8_STAGE_A(0, 0, cur, 0); G8_STAGE_A(0, 1, cur, 0);
    if (wr == 1) G8_BAR();
    G8_WAIT_V(2); G8_BAR();
    G8_STAGE_B(1, 0, cur, 1); G8_STAGE_A(1, 0, cur, 1); G8_STAGE_B(1, 1, cur, 1);
    G8_WAIT_V(6); G8_BAR();
    for (;;) {
        const bool has_next = S.next(ui + 1, nxt);
        if (!has_next) nxt = cur;
        for (int t = 0; t < nt; t += 2) {
            const bool last = (t == nt - 2);
            const GUnit& U2 = last ? nxt : cur;
            const int k2 = last ? 0 : t + 2, k3 = k2 + 1;
            G8_LDB(B0, 0, 0); G8_LDB(B1, 0, 1); sched_fence(); G8_LDA(At, 0, 0); G8_STAGE_A(1, 1, cur, t + 1);
            G8_WAIT_V(8); G8_WAIT_L0(); G8_BAR(); G8_MMA(0, 0, At, B0); G8_MMA(0, 1, At, B1); G8_BAR(); sched_fence();
            G8_LDA(At, 0, 1); G8_STAGE_B(0, 0, U2, k2); G8_STAGE_B(0, 1, U2, k2); G8_STAGE_A(0, 0, U2, k2);
            G8_WAIT_V(8); G8_WAIT_L0(); G8_BAR(); G8_MMA(1, 0, At, B0); G8_MMA(1, 1, At, B1); G8_BAR(); sched_fence();
            G8_LDB(B0, 1, 0); G8_LDB(B1, 1, 1); sched_fence(); G8_LDA(At, 1, 0); G8_STAGE_A(0, 1, U2, k2);
            G8_WAIT_V(8); G8_WAIT_L0(); G8_BAR(); G8_MMA(0, 0, At, B0); G8_MMA(0, 1, At, B1); G8_BAR(); sched_fence();
            G8_LDA(At, 1, 1); G8_STAGE_B(1, 0, U2, k3); G8_STAGE_B(1, 1, U2, k3); G8_STAGE_A(1, 0, U2, k3);
            G8_WAIT_V(8); G8_WAIT_L0(); G8_BAR(); G8_MMA(1, 0, At, B0); G8_MMA(1, 1, At, B1); G8_BAR(); sched_fence();
        }
        if (wr == 0) G8_BAR();
        E(acc, cur, wr, wc, fr, fq);
        if (!has_next) break;
#pragma unroll
        for (int a = 0; a < 2; ++a)
#pragma unroll
            for (int b = 0; b < 2; ++b)
#pragma unroll
                for (int m = 0; m < 4; ++m)
#pragma unroll
                    for (int n = 0; n < 2; ++n) acc[a][b][m][n] = (f32x4){0.f, 0.f, 0.f, 0.f};
        cur = nxt; ++ui;
        if (wr == 1) G8_BAR();
    }
    G8_WAIT_V(0);
    G8_BAR();
#undef G8_SA
#undef G8_SB
#undef G8_STAGE_A
#undef G8_STAGE_B
#undef G8_LDA
#undef G8_LDB
#undef G8_MMA
}
__device__ __forceinline__ void plain_ao(unsigned (&ao)[4], int K, int tid) {
    int R, C; stage_rc(tid * 16, R, C); ao[0] = (unsigned)((R * K + C) * 2); ao[2] = ao[0] + (unsigned)(128 * K * 2);
    stage_rc(tid * 16 + 8192, R, C); ao[1] = (unsigned)((R * K + C) * 2); ao[3] = ao[1] + (unsigned)(128 * K * 2);
}

struct InprojSched {
    static constexpr bool GATHER = false;
    int wid;
    unsigned ao[4]; int vcu, G;
    static constexpr int NPM = S / GBM, NPN = PW / GBM;
    __device__ __forceinline__ bool next(int i, GUnit& u) const {
        const int L = uni(i * G + vcu); if (L >= NPM * NPN) return false;
        constexpr int WGM = 8, nig = WGM * NPN;
        const int gid = L / nig, fm = gid * WGM, gsz = (NPM - fm) < WGM ? (NPM - fm) : WGM;
        const int pm = fm + (L % nig) % gsz, pn = (L % nig) / gsz;
        u.A = (unsigned)(pm * GBM * D * 2); u.B = (unsigned)(pn * GBM * D * 2); u.ao[0] = u.ao[1] = u.ao[2] = u.ao[3] = 0u;
        u.i0 = pm; u.i1 = pn; u.i2 = 0; u.i3 = 0; return true;
    }
};
struct InprojEpi {
    bf16_t* P; float* LOGF; unsigned* kmaxw; const f32x2* rot; const float* bfg;
    __device__ __forceinline__ void operator()(f32x4 (&acc)[2][2][4][2], const GUnit& u, int wr, int wc, int fr, int fq) const {
        const int gc0 = u.i1 * GBM + wc * 64;
        if (gc0 >= IN_W) return;
        const int row0 = u.i0 * GBM + wr * 64 + fr;
        if (gc0 >= OFL) {
#pragma unroll
            for (int ai = 0; ai < 2; ++ai)
#pragma unroll
                for (int m = 0; m < 4; ++m)
#pragma unroll
                    for (int j = 0; j < 4; ++j) { const int h = 4 * fq + j; if (h < NFOX) LOGF[(size_t)(row0 + ai * 128 + m * 16) * 8 + h] = log_sigmoid(acc[ai][0][m][0][j] + bfg[h]); }
            return;
        }
        const bool rotary = gc0 < OVR, is_gate = (gc0 >= OGR && gc0 < OQS), is_kf = (gc0 >= OKF && gc0 < OVF);
        const float scale = (gc0 < OKR || (gc0 >= OQS && gc0 < OKS) || (gc0 >= OQF && gc0 < OKF)) ? 0.125f : 1.0f;
        float kmx = 0.f;
        if (rotary) {
#pragma unroll
            for (int am = 0; am < 4; ++am) {
                const int ai = am >> 1, m0 = (am & 1) * 2;
                f32x4 c01[2][2], c23[2][2];
#pragma unroll
                for (int mm = 0; mm < 2; ++mm)
#pragma unroll
                    for (int n = 0; n < 2; ++n) { const f32x2* rp = rot + (size_t)(row0 + ai * 128 + (m0 + mm) * 16) * 32 + n * 16 + 4 * fq; c01[mm][n] = *(const f32x4*)rp; c23[mm][n] = *(const f32x4*)(rp + 2); }
#pragma unroll
                for (int mm = 0; mm < 2; ++mm)
#pragma unroll
                    for (int n = 0; n < 2; ++n) {
                        const int m = m0 + mm;
                        const float cs[4] = {c01[mm][n][0], c01[mm][n][2], c23[mm][n][0], c23[mm][n][2]}, sn[4] = {c01[mm][n][1], c01[mm][n][3], c23[mm][n][1], c23[mm][n][3]};
#pragma unroll
                        for (int j = 0; j < 4; ++j) { const float x1 = acc[ai][0][m][n][j], x2 = acc[ai][1][m][n][j]; acc[ai][0][m][n][j] = x1 * cs[j] - x2 * sn[j]; acc[ai][1][m][n][j] = x1 * sn[j] + x2 * cs[j]; }
                    }
                sched_fence();
            }
        }
#pragma unroll
        for (int ai = 0; ai < 2; ++ai)
#pragma unroll
            for (int m = 0; m < 4; ++m) {
                const int row = row0 + ai * 128 + m * 16;
                float ss = 0.f;
#pragma unroll
                for (int bj = 0; bj < 2; ++bj)
#pragma unroll
                    for (int n = 0; n < 2; ++n) {
                        f32x4 v = acc[ai][bj][m][n] * scale;
                        if (is_gate) {
#pragma unroll
                            for (int j = 0; j < 4; ++j) v[j] = silu(v[j]);
                        }
                        u32x2 o; o[0] = pk2(v[0], v[1]); o[1] = pk2(v[2], v[3]);
                        if (is_kf) {
#pragma unroll
                            for (int j = 0; j < 4; ++j) { const float r = bf2f(f2bf(v[j])); ss += r * r; }
                        }
                        *(u32x2*)(P + (size_t)row * PW + gc0 + 32 * bj + 16 * n + 4 * fq) = o;
                    }
                if (is_kf) { ss += __shfl_xor(ss, 16); ss += __shfl_xor(ss, 32); kmx = fmaxf(kmx, ss); }
            }
        if (is_kf) { kmx = wave_max(kmx); if (lane_id() == 0) atomicMax(kmaxw + (gc0 - OKF) / HD, f2u(kmx)); }
    }
};
__device__ __forceinline__ void phase_inproj(const Params& p, int l, float* ldsf) {
    InprojSched S; S.wid = p.wid; plain_ao(S.ao, D, TIDX(p)); S.vcu = vcu_id(); S.G = gridDim.x;
    InprojEpi E; E.P = (bf16_t*)(p.ws + WS_PROJ); E.LOGF = (float*)(p.ws + WS_LOGF); E.kmaxw = (unsigned*)(p.ws + WS_CTL) + CTL_KMAX + l * 8; E.rot = (const f32x2*)(p.ws + WS_ROT); E.bfg = p.b_forget + l * NFOX;
    gemm_stream((lds_u8*)ldsf, (const char*)(p.ws + WS_H), (const char*)(p.ws + WS_WIN) + (size_t)l * PW * D * 2, D, S, E);
}

__device__ __forceinline__ float ret_log_gamma(int h) { return logf(1.0f - exp2f(-5.0f - (float)h)); }
__device__ __forceinline__ void ret_prep_item(const Params& p, int h, int n, lds_u8* wl) {
    const bf16_t* P = (const bf16_t*)(p.ws + WS_PROJ);
    float* UT = (float*)(p.ws + WS_U);
    const int lane = lane_id(), r32 = lane & 31, hi = lane >> 5;
    const float lg = ret_log_gamma(h);
    wave_barrier();
#pragma unroll
    for (int i = 0; i < 8; ++i) {
        const int c = lane + 64 * i, row = c >> 3, ch = c & 7;
        const bf16_t* src = P + (size_t)(n * CH + row) * PW + h * HD + 8 * ch;
        const u32x4 kv = *(const u32x4*)(src + OKR), vv = *(const u32x4*)(src + OVR);
        const float dk = fast_exp(lg * (float)(CH - 1 - row));
        u32x4 ko;
#pragma unroll
        for (int w = 0; w < 4; ++w) ko[w] = pk2(u2f(kv[w] << 16) * dk, u2f(kv[w] & 0xffff0000u) * dk);
        *(LAS u32x4*)(wl + row * VROWB + ch * 16) = ko;
        *(LAS u32x4*)(wl + IMG64 + row * VROWB + ch * 16) = vv;
    }
    wave_barrier();
    const lds_u8* tb = wl + (8 * hi + ((lane & 15) >> 2)) * VROWB + (16 * ((lane >> 4) & 1) + 4 * (lane & 3)) * 2;
    f32x16 acc[2][2];
#pragma unroll
    for (int a = 0; a < 2; ++a)
#pragma unroll
        for (int b = 0; b < 2; ++b)
#pragma unroll
            for (int r = 0; r < 16; ++r) acc[a][b][r] = 0.f;
#pragma unroll
    for (int s = 0; s < 4; ++s) {
        bf16x8 vf[2], kf[2];
#pragma unroll
        for (int x = 0; x < 2; ++x) { kf[x] = tr_frag(tb, 16 * s, 16 * s + 4, x * 64); vf[x] = tr_frag(tb + IMG64, 16 * s, 16 * s + 4, x * 64); }
#pragma unroll
        for (int eb = 0; eb < 2; ++eb)
#pragma unroll
            for (int db = 0; db < 2; ++db) acc[eb][db] = mfma32(vf[eb], kf[db], acc[eb][db]);
    }
    float* dst = UT + (size_t)(h * NCHUNK + n) * 4096;
#pragma unroll
    for (int eb = 0; eb < 2; ++eb)
#pragma unroll
        for (int db = 0; db < 2; ++db)
#pragma unroll
            for (int r = 0; r < 16; ++r) dst[(32 * eb + crow(r, hi)) * 64 + 32 * db + r32] = acc[eb][db][r];
}
__device__ __forceinline__ void phase_prep(const Params& p, int l, float* ldsf) {
    const int wave = p.wid;
    lds_u8* wl = (lds_u8*)ldsf + wave * RET_WAVE_LDS;
    for (int it = blockIdx.x * NW + wave; it < NRET * NCHUNK; it += gridDim.x * NW) ret_prep_item(p, it / NCHUNK, it % NCHUNK, wl);
}

constexpr int NQ32 = S / 32;
constexpr int MIX_WAVE_LDS = 32 * VROWB + 256;
__device__ __forceinline__ void ret_scan_wave(const Params& p, int item) {
    const float* U = (const float*)(p.ws + WS_U);
    bf16_t* SP = (bf16_t*)(p.ws + WS_SP);
    const int e = item * 64 + lane_id();
    const int h = e >> 12, de = e & 4095;
    const float c = expf(ret_log_gamma(h) * (float)CH);
    float st = 0.f;
    const size_t base = (size_t)h * NCHUNK * 4096 + de;
#pragma unroll 1
    for (int n0 = 0; n0 < NCHUNK; n0 += 32) {
        float u[32];
#pragma unroll
        for (int i = 0; i < 32; ++i) u[i] = (n0 + i < NCHUNK) ? U[base + (size_t)(n0 + i) * 4096] : 0.f;
#pragma unroll
        for (int i = 0; i < 32; ++i) if (n0 + i < NCHUNK) { SP[base + (size_t)(n0 + i) * 4096] = f2bf(st); st = st * c + u[i]; }
    }
}
template <bool FOX>
__device__ __forceinline__ void attn_item(const Params& p, int l, int h, int qb, lds_u8* wl) {
    const bf16_t* P = (const bf16_t*)(p.ws + WS_PROJ);
    const float* LOGF = (const float*)(p.ws + WS_LOGF);
    bf16_t* MG = (bf16_t*)(p.ws + WS_MERGED);
    const int lane = lane_id(), r32 = lane & 31, hi = lane >> 5;
    const int q0 = qb * 32, t = q0 + r32;
    constexpr int oq = FOX ? OQF : OQS, ok = FOX ? OKF : OKS, ov = FOX ? OVF : OVS;
    bf16x8 qf[4];
    { const bf16_t* qp = P + (size_t)t * PW + oq + h * HD + 8 * hi;
#pragma unroll
      for (int ks = 0; ks < 4; ++ks) qf[ks] = *(const bf16x8*)(qp + 16 * ks); }
    float Bt = 0.f;
    if (FOX) {
        float qq = 0.f;
#pragma unroll
        for (int ks = 0; ks < 4; ++ks)
#pragma unroll
            for (int j = 0; j < 8; ++j) { const float v = bf2f((bf16_t)qf[ks][j]); qq += v * v; }
        qq += __shfl_xor(qq, 32);
        const float kmax = sqrtf(u2f(((const unsigned*)(p.ws + WS_CTL))[CTL_KMAX + l * 8 + h]));
        Bt = sqrtf(qq) * kmax * 1.0001f + 1e-6f;
    }
    float fq = 0.f, m = -1e30f, lsum = 0.f, carry = 0.f, Fc = 0.f;
    f32x16 o0, o1;
#pragma unroll
    for (int r = 0; r < 16; ++r) { o0[r] = 0.f; o1[r] = 0.f; }
    LAS float* frl = (LAS float*)(wl + 32 * VROWB);
    const lds_u8* vb = wl + (4 * hi + ((lane & 15) >> 2)) * VROWB + (16 * ((lane >> 4) & 1) + 4 * (lane & 3)) * 2;
    bf16x8 kf1[4], kf2[4]; u32x4 vr1[4], vr2[4]; float lf1 = 0.f, lf2 = 0.f;
#define ATTN_LOAD(KF, VR, LF, kt_) do { const int k0_ = (kt_) * 32; const bf16_t* kp_ = P + (size_t)(k0_ + r32) * PW + ok + h * HD + 8 * hi; \
        _Pragma("unroll") for (int ks = 0; ks < 4; ++ks) KF[ks] = *(const bf16x8*)(kp_ + 16 * ks); \
        _Pragma("unroll") for (int i = 0; i < 4; ++i) { const int c = lane + 64 * i; VR[i] = *(const u32x4*)(P + (size_t)(k0_ + (c >> 3)) * PW + ov + h * HD + 8 * (c & 7)); } \
        if (FOX) LF = -LOGF[(size_t)(k0_ + r32) * 8 + h]; } while (0)
    ATTN_LOAD(kf1, vr1, lf1, qb);
    ATTN_LOAD(kf2, vr2, lf2, qb > 0 ? qb - 1 : 0);
    for (int kt = qb; kt >= 0; --kt) {
        const int key0 = kt * 32;
        const bool diag = (kt == qb);
        bf16x8 kf[4]; u32x4 vr[4];
#pragma unroll
        for (int ks = 0; ks < 4; ++ks) { kf[ks] = kf1[ks]; kf1[ks] = kf2[ks]; }
#pragma unroll
        for (int i = 0; i < 4; ++i) { vr[i] = vr1[i]; vr1[i] = vr2[i]; }
        const float lf = lf1; lf1 = lf2;
        ATTN_LOAD(kf2, vr2, lf2, kt > 1 ? kt - 2 : 0);
        f32x16 st;
#pragma unroll
        for (int r = 0; r < 16; ++r) st[r] = 0.f;
#pragma unroll
        for (int ks = 0; ks < 4; ++ks) st = mfma32(kf[ks], qf[ks], st);
        wave_barrier();
#pragma unroll
        for (int i = 0; i < 4; ++i) { const int c = lane + 64 * i; *(LAS u32x4*)(wl + (c >> 3) * VROWB + (c & 7) * 16) = vr[i]; }
        if (FOX) {
            float inc = row_shl_add<1>(lf); inc = row_shl_add<2>(inc); inc = row_shl_add<4>(inc); inc = row_shl_add<8>(inc);
            { const float up0 = read_lane(inc, 16), up1 = read_lane(inc, 48); if ((lane & 16) == 0) inc += (hi ? up1 : up0); }
            const float exc = Fc + inc - lf;
            const float tot = read_lane(inc, 0);
            if (diag) fq = exc;
            if (lane < 32) frl[lane] = exc;
            wave_barrier();
            float tmax = -1e30f;
#pragma unroll
            for (int g4 = 0; g4 < 4; ++g4) {
                const f32x4 fr4 = *(const LAS f32x4*)(frl + 8 * g4 + 4 * hi);
#pragma unroll
                for (int i = 0; i < 4; ++i) { const int r = 4 * g4 + i; st[r] = st[r] + fq - fr4[i]; }
            }
            if (diag) {
#pragma unroll
                for (int r = 0; r < 16; ++r) if (crow(r, hi) > r32) st[r] = -1e30f;
            }
#pragma unroll
            for (int r = 0; r < 16; ++r) tmax = fmaxf(tmax, st[r]);
            Fc += tot;
            tmax = fmaxf(tmax, partner32(tmax, hi));
            const float mn = fmaxf(m, tmax), f = fast_exp(m - mn);
            m = mn; lsum *= f;
#pragma unroll
            for (int r = 0; r < 16; ++r) { o0[r] *= f; o1[r] *= f; }
            float ps = 0.f;
#pragma unroll
            for (int r = 0; r < 16; ++r) { const float pr = fast_exp(st[r] - mn); st[r] = pr; ps += pr; }
            lsum += ps;
        } else {
            float l1m[16];
#pragma unroll
            for (int r = 0; r < 16; ++r) {
                const float z = st[r], sp = fast_log(1.0f + fast_exp(-fabsf(z)));
                const float lb = fminf(z, 0.f) - sp;
                l1m[r] = lb - z;
                st[r] = lb;
            }
            if (diag) {
#pragma unroll
                for (int r = 0; r < 16; ++r) if (crow(r, hi) >= r32) { l1m[r] = 0.f; st[r] = -1e30f; }
            }
            float gs[4], pg[4], T[4];
#pragma unroll
            for (int k = 0; k < 4; ++k) { gs[k] = (l1m[4 * k] + l1m[4 * k + 1]) + (l1m[4 * k + 2] + l1m[4 * k + 3]); pg[k] = partner32(gs[k], hi); }
            float run = 0.f;
#pragma unroll
            for (int k = 3; k >= 0; --k) { T[k] = run + (hi == 0 ? pg[k] : 0.f); run += gs[k] + pg[k]; }
#pragma unroll
            for (int k = 0; k < 4; ++k) {
                float w = T[k] + carry;
#pragma unroll
                for (int i = 3; i >= 0; --i) { const int r = 4 * k + i; st[r] = fast_exp(st[r] + w); w += l1m[r]; }
            }
            carry += run;
        }
        u32x4 pw0, pw1;
#pragma unroll
        for (int j = 0; j < 4; ++j) { pw0[j] = pk2(st[2 * j], st[2 * j + 1]); pw1[j] = pk2(st[8 + 2 * j], st[9 + 2 * j]); }
        const bf16x8 pf0 = __builtin_bit_cast(bf16x8, pw0), pf1 = __builtin_bit_cast(bf16x8, pw1);
        wave_barrier();
#pragma unroll
        for (int s = 0; s < 2; ++s) {
#pragma unroll
            for (int db = 0; db < 2; ++db) {
                const s16x4 lo = tr16(vb + (16 * s) * VROWB + db * 64), hi4 = tr16(vb + (16 * s + 8) * VROWB + db * 64);
                bf16x8 vf; vf[0] = lo[0]; vf[1] = lo[1]; vf[2] = lo[2]; vf[3] = lo[3]; vf[4] = hi4[0]; vf[5] = hi4[1]; vf[6] = hi4[2]; vf[7] = hi4[3];
                if (db == 0) o0 = mfma32(vf, s == 0 ? pf0 : pf1, o0); else o1 = mfma32(vf, s == 0 ? pf0 : pf1, o1);
            }
        }
        const bool done = FOX ? (Bt + fq - Fc - m + logf((float)(key0 + 1)) < -EXIT_T) : (carry < -EXIT_T);
        if (ballot64(done) == ~0ull) break;
    }
#undef ATTN_LOAD
    if (FOX) { lsum += __shfl_xor(lsum, 32); const float il = 1.0f / lsum;
#pragma unroll
        for (int r = 0; r < 16; ++r) { o0[r] *= il; o1[r] *= il; } }
    float ss = 0.f;
#pragma unroll
    for (int r = 0; r < 16; ++r) ss += o0[r] * o0[r] + o1[r] * o1[r];
    ss += __shfl_xor(ss, 32);
    const float ri = 1.0f / sqrtf(ss * (1.0f / HD) + EPS);
    const float* g = (FOX ? p.g_fox + l * WFOX : p.g_sb + l * WSB) + h * HD;
    bf16_t* dst = MG + (size_t)t * MIXW + (FOX ? WRET + WSB : WRET) + h * HD;
#pragma unroll
    for (int db = 0; db < 2; ++db)
#pragma unroll
        for (int g4 = 0; g4 < 4; ++g4) {
            const int d0 = db * 32 + 8 * g4 + 4 * hi;
            const f32x4 gg = *(const f32x4*)(g + d0);
            float v[4];
#pragma unroll
            for (int i = 0; i < 4; ++i) v[i] = (db == 0 ? o0[4 * g4 + i] : o1[4 * g4 + i]) * ri * gg[i];
            u32x2 o; o[0] = pk2(v[0], v[1]); o[1] = pk2(v[2], v[3]);
            *(u32x2*)(dst + d0) = o;
        }
}
constexpr int WCH = 2, NWCH = (NE * WI_EXPERT + WCH - 1) / WCH;
__device__ __forceinline__ bool mix_weight_step(const Params& p, int l, lds_u8* wl, int shard0, int& wsk) {
    unsigned* wbase = (unsigned*)(p.ws + WS_CTL) + CTL_WQ + 64 * (l * 8);
    const int lane = lane_id();
#pragma unroll 1
    while (wsk < 8) {
        const int shard = (shard0 + wsk) & 7;
        unsigned* head = wbase + 64 * shard;
        unsigned c = 0x0fffffffu;
        if (lane == 0) { if (!(wsk > 0 && (int)ld_relaxed(head) * 8 + shard >= NWCH)) c = atomicAdd(head, 1u); }
        const int chunk = uni((int)__shfl(c, 0)) * 8 + shard;
        if (chunk >= NWCH) { ++wsk; continue; }
#pragma unroll 1
        for (int k = 0; k < WCH; ++k) { const int it = chunk * WCH + k; if (it < NE * WI_EXPERT) weight_item(p, l, WI_DENSE + it, wl, lane); }
        return true;
    }
    return false;
}
__device__ __forceinline__ void phase_mix(const Params& p, int l, float* ldsf) {
    constexpr int NSCANW = NRET * 4096 / 64, NFXI = NFOX * NQ32, NSBI = NSB * NQ32;
    const int wave = p.wid;
    lds_u8* wl = (lds_u8*)ldsf + wave * RET_WAVE_LDS;
    static_assert(MIX_WAVE_LDS <= RET_WAVE_LDS, "per-wave LDS region");
    const int shard0 = xcc_shard();
    int wsk = 0;
    unsigned* qbase = (unsigned*)(p.ws + WS_CTL) + CTL_MQ + 64 * (l * 8);
    const float* bfg = p.b_forget + l * NFOX;
    constexpr int NMIX = NSCANW + NFXI + NSBI;
#pragma unroll 1
    for (int sk = 0; sk < 8; ++sk) {
      const int shard = (shard0 + sk) & 7;
      unsigned* qhead = qbase + 64 * shard;
#pragma unroll 1
      for (;;) {
        unsigned itu = 0;
        if (lane_id() == 0) { if (sk > 0 && (int)ld_relaxed(qhead) * 8 + shard >= NMIX) itu = 0x0fffffffu; else itu = atomicAdd(qhead, 1u); }
        const int it = uni((int)__shfl(itu, 0)) * 8 + shard;
        if (it >= NMIX) break;
        if (it < NSCANW) ret_scan_wave(p, it);
        else if (it < NSCANW + NFXI) {
            const int j = it - NSCANW, rank = j / NQ32;
            int h = 0;
#pragma unroll
            for (int c = 0; c < NFOX; ++c) { int rk = 0;
#pragma unroll
                for (int o = 0; o < NFOX; ++o) rk += (bfg[o] > bfg[c] || (bfg[o] == bfg[c] && o < c)) ? 1 : 0;
                if (rk == rank) h = c; }
            attn_item<true>(p, l, h, NQ32 - 1 - j % NQ32, wl);
        }
        else { const int j = it - NSCANW - NFXI; attn_item<false>(p, l, j % NSB, NQ32 - 1 - j / NSB, wl); }
        (void)mix_weight_step(p, l, wl, shard0, wsk);
      }
    }
    while (mix_weight_step(p, l, wl, shard0, wsk)) {}
}

__device__ __forceinline__ void ret_out_item(const Params& p, int l, int h, int n, int cb, lds_u8* wl) {
    const bf16_t* P = (const bf16_t*)(p.ws + WS_PROJ);
    const bf16_t* SPT = (const bf16_t*)(p.ws + WS_SP) + (size_t)(h * NCHUNK + n) * 4096;
    bf16_t* MG = (bf16_t*)(p.ws + WS_MERGED);
    const int lane = lane_id(), r32 = lane & 31, hi = lane >> 5;
    const float lg = ret_log_gamma(h);
    const size_t rowb = (size_t)(n * CH) * PW + h * HD;
    const int c = 32 * cb + r32;
    wave_barrier();
    {
        u32x4 vv[8];
#pragma unroll
        for (int i = 0; i < 8; ++i) { const int q = lane + 64 * i; vv[i] = *(const u32x4*)(P + rowb + (size_t)(q >> 3) * PW + OVR + 8 * (q & 7)); }
#pragma unroll
        for (int i = 0; i < 8; ++i) { const int q = lane + 64 * i; *(LAS u32x4*)(wl + (q >> 3) * VROWB + (q & 7) * 16) = vv[i]; }
    }
    sched_fence();
    bf16x8 qf[4];
#pragma unroll
    for (int ks = 0; ks < 4; ++ks) qf[ks] = *(const bf16x8*)(P + rowb + (size_t)c * PW + OQR + 16 * ks + 8 * hi);
    f32x16 o[2];
#pragma unroll
    for (int a = 0; a < 2; ++a)
#pragma unroll
        for (int r = 0; r < 16; ++r) o[a][r] = 0.f;
#pragma unroll
    for (int ks = 0; ks < 4; ++ks)
#pragma unroll
        for (int eb = 0; eb < 2; ++eb) { const bf16x8 sf = *(const bf16x8*)(SPT + (32 * eb + r32) * 64 + 16 * ks + 8 * hi); o[eb] = mfma32(sf, qf[ks], o[eb]); }
    { const float qd = fast_exp(lg * (float)(c + 1));
#pragma unroll
      for (int eb = 0; eb < 2; ++eb)
#pragma unroll
          for (int r = 0; r < 16; ++r) o[eb][r] *= qd; }
    wave_barrier();
    const lds_u8* vb = wl + (4 * hi + ((lane & 15) >> 2)) * VROWB + (16 * ((lane >> 4) & 1) + 4 * (lane & 3)) * 2;
#pragma unroll
    for (int kb = 0; kb < 2; ++kb) {
        f32x16 st;
#pragma unroll
        for (int r = 0; r < 16; ++r) st[r] = 0.f;
#pragma unroll
        for (int ks = 0; ks < 4; ++ks) { const bf16x8 kf = *(const bf16x8*)(P + rowb + (size_t)(32 * kb + r32) * PW + OKR + 16 * ks + 8 * hi); st = mfma32(kf, qf[ks], st); }
        bf16x8 pf[2];
#pragma unroll
        for (int r = 0; r < 16; ++r) { const int dist = c - (32 * kb + crow(r, hi)); st[r] *= fast_exp(lg * fabsf((float)dist)); }
        { u32x4 w0, w1;
#pragma unroll
          for (int j = 0; j < 4; ++j) { w0[j] = pk2(st[2 * j], st[2 * j + 1]); w1[j] = pk2(st[8 + 2 * j], st[9 + 2 * j]); }
          pf[0] = __builtin_bit_cast(bf16x8, w0); pf[1] = __builtin_bit_cast(bf16x8, w1); }
#pragma unroll
        for (int s = 0; s < 2; ++s)
#pragma unroll
            for (int eb = 0; eb < 2; ++eb) o[eb] = mfma32(tr_frag(vb, 32 * kb + 16 * s, 32 * kb + 16 * s + 8, eb * 64), pf[s], o[eb]);
    }
    float sm = 0.f;
#pragma unroll
    for (int eb = 0; eb < 2; ++eb)
#pragma unroll
        for (int r = 0; r < 16; ++r) sm += o[eb][r];
    sm += __shfl_xor(sm, 32);
    const float mu = sm * (1.0f / HD);
    float vs = 0.f;
#pragma unroll
    for (int eb = 0; eb < 2; ++eb)
#pragma unroll
        for (int r = 0; r < 16; ++r) { const float dlt = o[eb][r] - mu; o[eb][r] = dlt; vs += dlt * dlt; }
    vs += __shfl_xor(vs, 32);
    const float ri = 1.0f / sqrtf(vs * (1.0f / HD) + EPS);
    const int row = n * CH + c;
#pragma unroll
    for (int eb = 0; eb < 2; ++eb)
#pragma unroll
        for (int g4 = 0; g4 < 4; ++g4) {
            const int e0 = 32 * eb + 8 * g4 + 4 * hi;
            const f32x4 gg = *(const f32x4*)(p.g_ret + l * WRET + h * HD + e0);
            const u32x2 gt = *(const u32x2*)(P + (size_t)row * PW + OGR + h * HD + e0);
            const float ga[4] = {u2f(gt[0] << 16), u2f(gt[0] & 0xffff0000u), u2f(gt[1] << 16), u2f(gt[1] & 0xffff0000u)};
            float v[4];
#pragma unroll
            for (int i = 0; i < 4; ++i) v[i] = o[eb][4 * g4 + i] * ri * gg[i] * ga[i];
            u32x2 ov; ov[0] = pk2(v[0], v[1]); ov[1] = pk2(v[2], v[3]);
            *(u32x2*)(MG + (size_t)row * MIXW + h * HD + e0) = ov;
        }
}
__device__ __forceinline__ void phase_retout(const Params& p, int l, float* ldsf) {
    const int wave = p.wid;
    lds_u8* wl = (lds_u8*)ldsf + wave * RET_WAVE_LDS;
    for (int it = blockIdx.x * NW + wave; it < NRET * NCHUNK * 2; it += gridDim.x * NW) ret_out_item(p, l, (it >> 1) / NCHUNK, (it >> 1) % NCHUNK, it & 1, wl);
}

struct OutprojSched {
    static constexpr bool GATHER = false;
    int wid;
    unsigned ao[4]; int vcu, G;
    static constexpr int NPM = S / GBM, NPN = D / GBM;
    __device__ __forceinline__ bool next(int i, GUnit& u) const {
        const int L = uni(i * G + vcu); if (L >= NPM * NPN) return false;
        const int pm = L / NPN, pn = L % NPN;
        u.A = (unsigned)(pm * GBM * MIXW * 2); u.B = (unsigned)(pn * GBM * MIXW * 2); u.ao[0] = u.ao[1] = u.ao[2] = u.ao[3] = 0u;
        u.i0 = pm; u.i1 = pn; u.i2 = 0; u.i3 = 0; return true;
    }
};
struct OutprojEpi {
    const float* xin32; const bf16_t* xin16; bf16_t* X;
    __device__ __forceinline__ void operator()(f32x4 (&acc)[2][2][4][2], const GUnit& u, int wr, int wc, int fr, int fq) const {
        const size_t o0 = (size_t)(u.i0 * GBM + wr * 64 + fr) * D + u.i1 * GBM + wc * 32 + 4 * fq;
#pragma unroll
        for (int ai = 0; ai < 2; ++ai)
#pragma unroll
            for (int mh = 0; mh < 2; ++mh) {
                f32x4 r[2][2][2];
#pragma unroll
                for (int mm = 0; mm < 2; ++mm)
#pragma unroll
                    for (int bj = 0; bj < 2; ++bj)
#pragma unroll
                        for (int n = 0; n < 2; ++n) { const size_t o = o0 + (size_t)(ai * 128 + (2 * mh + mm) * 16) * D + bj * 128 + n * 16;
                            if (xin32) r[mm][bj][n] = *(const f32x4*)(xin32 + o);
                            else { const u32x2 w = *(const u32x2*)(xin16 + o); r[mm][bj][n] = (f32x4){u2f(w[0] << 16), u2f(w[0] & 0xffff0000u), u2f(w[1] << 16), u2f(w[1] & 0xffff0000u)}; } }
#pragma unroll
                for (int mm = 0; mm < 2; ++mm)
#pragma unroll
                    for (int bj = 0; bj < 2; ++bj)
#pragma unroll
                        for (int n = 0; n < 2; ++n) { const f32x4 v = r[mm][bj][n] + acc[ai][bj][2 * mh + mm][n]; u32x2 ov; ov[0] = pk2(v[0], v[1]); ov[1] = pk2(v[2], v[3]);
                            *(u32x2*)(X + o0 + (size_t)(ai * 128 + (2 * mh + mm) * 16) * D + bj * 128 + n * 16) = ov; }
                sched_fence();
            }
    }
};
__device__ __forceinline__ void phase_outproj(const Params& p, int l, float* ldsf) {
    OutprojSched S; S.wid = p.wid; plain_ao(S.ao, MIXW, TIDX(p)); S.vcu = vcu_id(); S.G = gridDim.x;
    OutprojEpi E; E.X = (bf16_t*)(p.ws + WS_X); E.xin32 = l == 0 ? p.x : nullptr; E.xin16 = E.X;
    gemm_stream((lds_u8*)ldsf, (const char*)(p.ws + WS_MERGED), (const char*)(p.ws + WS_WOUT) + (size_t)l * D * MIXW * 2, MIXW, S, E);
}

constexpr int RW = D + 4;
constexpr int ROUTE_LDS = NROUTE * RW * 4 + 2 * NE * 4 + 2 * 256 * 4;
template <bool DRY = false>
__device__ __forceinline__ void phase_route(const Params& p, int l, float* lds) {
    const bf16_t* X = (const bf16_t*)(p.ws + WS_X);
    bf16_t* H = (bf16_t*)(p.ws + WS_H);
    unsigned* ctl = (unsigned*)(p.ws + WS_CTL);
    int* LIST = (int*)(p.ws + WS_LIST);
    float* GATE = (float*)(p.ws + WS_GATE);
    const float* gn = p.norm_ffn + l * D;
    const float* wg = p.w_group + (size_t)l * D * NG; const float* wr = p.w_router + (size_t)l * D * NE;
    const float* bg = p.b_group + l * NG; const float* br = p.b_router + l * NE;
    const int lane = lane_id(), wave = p.wid;
    const int tidx = TIDX(p);
    unsigned* lcnt = (unsigned*)(lds + NROUTE * RW); unsigned* lbase = lcnt + NE; unsigned* lrec = lbase + NE;
    __syncthreads();
    if (tidx < NE) lcnt[tidx] = 0u;
    {
        constexpr int NV4 = D * NE / 4 / NT;
        f32x4 t[NV4];
#pragma unroll
        for (int k = 0; k < NV4; ++k) t[k] = *(const f32x4*)(wr + (size_t)(tidx + k * NT) * 4);
        for (int i = tidx; i < D * NG; i += NT) lds[(i % NG) * RW + i / NG] = wg[i];
#pragma unroll
        for (int k = 0; k < NV4; ++k) { const int i = (tidx + k * NT) * 4, c = i / NE, e = i % NE;
#pragma unroll
            for (int j = 0; j < 4; ++j) lds[(NG + e + j) * RW + c] = t[k][j]; }
    }
    __syncthreads();
    f32x4 vn[RJ]; { const int r0 = blockIdx.x * NW + wave; if (r0 < S) row_load_bf16(X + (size_t)r0 * D, vn, lane); }
    for (int r = blockIdx.x * NW + wave; r < S; r += gridDim.x * NW) {
        f32x4 v[RJ];
#pragma unroll
        for (int j = 0; j < RJ; ++j) v[j] = vn[j];
        { const int rn = r + gridDim.x * NW; if (rn < S) row_load_bf16(X + (size_t)rn * D, vn, lane); }
        const float ri = row_rinv(v);
#pragma unroll
        for (int j = 0; j < RJ; ++j) {
            const f32x4 g = *(const f32x4*)(gn + 256 * j + lane * 4);
            v[j] = v[j] * ri * g;
            u32x2 o; o[0] = pk2(v[j][0], v[j][1]); o[1] = pk2(v[j][2], v[j][3]);
            *(u32x2*)(H + (size_t)r * D + 256 * j + lane * 4) = o;
        }
        float gl[NG];
#pragma unroll
        for (int g = 0; g < NG; ++g) { float s = 0.f;
#pragma unroll
            for (int j = 0; j < RJ; ++j) { const f32x4 w = *(const f32x4*)(lds + g * RW + 256 * j + lane * 4); s += (v[j][0] * w[0] + v[j][1] * w[1]) + (v[j][2] * w[2] + v[j][3] * w[3]); }
            gl[g] = s; }
#pragma unroll
        for (int g = 0; g < NG; ++g) gl[g] = wave_sum(gl[g]) + bg[g];
        int grp = 0; float gm = gl[0];
#pragma unroll
        for (int g = 1; g < NG; ++g) if (gl[g] > gm) { gm = gl[g]; grp = g; }
        float den = 0.f;
#pragma unroll
        for (int g = 0; g < NG; ++g) den += expf(gl[g] - gm);
        const float pg = 1.0f / den;
        float el[EPG];
        const float* wl = lds + (NG + grp * EPG) * RW + lane * 4;
#pragma unroll
        for (int e = 0; e < EPG; ++e) { float s = 0.f;
#pragma unroll
            for (int j = 0; j < RJ; ++j) { const f32x4 w = *(const f32x4*)(wl + e * RW + 256 * j); s += (v[j][0] * w[0] + v[j][1] * w[1]) + (v[j][2] * w[2] + v[j][3] * w[3]); }
            el[e] = s; }
#pragma unroll
        for (int e = 0; e < EPG; ++e) el[e] = wave_sum(el[e]) + br[grp * EPG + e];
        if (lane == 0 && !(DRY && el[0] != 12345.f)) {
            int i1 = 0; float v1 = -INFINITY; int i2 = 0; float v2 = -INFINITY;
#pragma unroll
            for (int e = 0; e < EPG; ++e) { const float x = el[e];
                if (x > v1) { v2 = v1; i2 = i1; v1 = x; i1 = e; } else if (x > v2) { v2 = x; i2 = e; } }
            const float e2 = expf(v2 - v1), g1 = pg / (1.f + e2), g2 = pg * e2 / (1.f + e2);
            const int ea = grp * EPG + i1, eb = grp * EPG + i2;
            GATE[(size_t)r * 2] = g1; GATE[(size_t)r * 2 + 1] = g2;
            const int li = (r - blockIdx.x * NW) / (gridDim.x * NW) * NW + wave;
            const unsigned ra = atomicAdd(lcnt + ea, 1u), rb = atomicAdd(lcnt + eb, 1u);
            lrec[2 * li] = (unsigned)ea | (ra << 8); lrec[2 * li + 1] = (unsigned)eb | (rb << 8);
        }
    }
    if (!DRY) {
        __syncthreads();
        if (tidx < NE) lbase[tidx] = atomicAdd(ctl + CTL_CNT + l * NE + tidx, lcnt[tidx]);
        __syncthreads();
        const int nrows = (S - blockIdx.x * NW + gridDim.x * NW - 1) / (gridDim.x * NW) * NW;
        for (int i = tidx; i < 2 * nrows; i += NT) {
            const int li = i >> 1, r = blockIdx.x * NW + (li / NW) * (gridDim.x * NW) + (li % NW);
            if (r < S) { const unsigned rec = lrec[i]; const int e = rec & 255u; LIST[(size_t)e * S + lbase[e] + (rec >> 8)] = r * 2 + (i & 1); }
        }
    }
}

__device__ __forceinline__ void moe_table(const unsigned* cnt, volatile LAS unsigned* tab, int tid) {
    __syncthreads();
    if (tid < 64) {
        const unsigned c = tid < NE ? cnt[tid] : 0u;
        unsigned nt = (c + GBM - 1) / GBM, inc = nt;
#pragma unroll
        for (int d = 1; d < 64; d <<= 1) { const unsigned o = (unsigned)__shfl_up((int)inc, d); if ((tid & 63) >= d) inc += o; }
        if (tid < NE) { tab[tid + 1] = inc; tab[64 + tid] = c; }
        if (tid == 0) tab[0] = 0u;
    }
    __syncthreads();
}
__device__ __forceinline__ bool moe_unit(volatile LAS unsigned* tab, int u, int npn, int& e, int& rt, int& pn, int& base, int& count) {
    const int tile = uni(u / npn); pn = uni(u % npn);
    if (tile >= (int)tab[NE]) return false;
    int lo = 0;
#pragma unroll
    for (int s = NE / 2; s >= 1; s >>= 1) if ((int)tab[lo + s] <= tile) lo += s;
    e = uni(lo); rt = tile - (int)tab[e]; base = (int)tab[e] * GBM; count = (int)tab[64 + e];
    rt = uni(rt); base = uni(base); count = uni(count);
    return true;
}
struct Moe1Sched {
    static constexpr bool GATHER = true;
    int wid;
    unsigned ao[4];
    volatile LAS unsigned* tab; const int* LIST; int vcu, G;
    static constexpr int NPN = 2 * DE / GBM;
    __device__ __forceinline__ bool next(int i, GUnit& u) const {
        int e, rt, pn, base, count; if (!moe_unit(tab, i * G + vcu, NPN, e, rt, pn, base, count)) return false;
        const int nvalid = count - rt * GBM;
        u.A = 0u; u.B = (unsigned)((e * 2 * DE + pn * GBM) * D * 2);
#pragma unroll
        for (int k = 0; k < 4; ++k) { int R, C; stage_rc(((wid << 6) | lane_id()) * 16 + (k & 1) * 8192, R, C); const int r = R + 128 * (k >> 1);
            const int tok = r < nvalid ? (LIST[(size_t)e * S + rt * GBM + r] >> 1) : 0; u.ao[k] = (unsigned)((tok * D + C) * 2); }
        u.i0 = base + rt * GBM; u.i1 = pn; u.i2 = nvalid; u.i3 = e * S + rt * GBM; return true;
    }
};
struct Moe1Epi {
    bf16_t* HID;
    __device__ __forceinline__ void operator()(f32x4 (&acc)[2][2][4][2], const GUnit& u, int wr, int wc, int fr, int fq) const {
#pragma unroll
        for (int ai = 0; ai < 2; ++ai)
#pragma unroll
            for (int m = 0; m < 4; ++m)
#pragma unroll
                for (int n = 0; n < 2; ++n) { f32x4 v;
#pragma unroll
                    for (int j = 0; j < 4; ++j) v[j] = silu(acc[ai][0][m][n][j]) * acc[ai][1][m][n][j];
                    u32x2 o; o[0] = pk2(v[0], v[1]); o[1] = pk2(v[2], v[3]);
                    *(u32x2*)(HID + (size_t)(u.i0 + ai * 128 + wr * 64 + m * 16 + fr) * DE + u.i1 * 128 + wc * 32 + n * 16 + 4 * fq) = o; }
    }
};
__device__ __forceinline__ void phase_moe1(const Params& p, int l, float* ldsf) {
    Moe1Sched S; S.wid = p.wid; S.tab = (volatile LAS unsigned*)((LAS unsigned char*)ldsf + GEMM_LDS);
    moe_table((const unsigned*)(p.ws + WS_CTL) + CTL_CNT + l * NE, S.tab, TIDX(p));
    S.LIST = (const int*)(p.ws + WS_LIST); S.vcu = vcu_id(); S.G = gridDim.x;
    Moe1Epi E; E.HID = (bf16_t*)(p.ws + WS_HID);
    gemm_stream((lds_u8*)ldsf, (const char*)(p.ws + WS_H), (const char*)(p.ws + WS_WGU) + (size_t)l * NE * 2 * DE * D * 2, D, S, E);
}
struct Moe2Sched {
    static constexpr bool GATHER = false;
    int wid;
    volatile LAS unsigned* tab; unsigned ao[4]; int vcu, G;
    static constexpr int NPN = D / GBM;
    __device__ __forceinline__ bool next(int i, GUnit& u) const {
        int e, rt, pn, base, count; if (!moe_unit(tab, i * G + vcu, NPN, e, rt, pn, base, count)) return false;
        u.A = (unsigned)((base + rt * GBM) * DE * 2); u.B = (unsigned)((e * D + pn * GBM) * DE * 2); u.ao[0] = u.ao[1] = u.ao[2] = u.ao[3] = 0u;
        u.i0 = 0; u.i1 = pn; u.i2 = count - rt * GBM; u.i3 = e * S + rt * GBM; return true;
    }
};
struct Moe2Epi {
    bf16_t* Y; const int* LIST; const float* GATE;
    __device__ __forceinline__ void operator()(f32x4 (&acc)[2][2][4][2], const GUnit& u, int wr, int wc, int fr, int fq) const {
        int a[2][4]; float g[2][4];
#pragma unroll
        for (int ai = 0; ai < 2; ++ai)
#pragma unroll
            for (int m = 0; m < 4; ++m) { const int r = ai * 128 + wr * 64 + m * 16 + fr; a[ai][m] = r < u.i2 ? LIST[(size_t)u.i3 + r] : -1; }
#pragma unroll
        for (int ai = 0; ai < 2; ++ai)
#pragma unroll
            for (int m = 0; m < 4; ++m) g[ai][m] = a[ai][m] >= 0 ? GATE[a[ai][m]] : 0.f;
#pragma unroll
        for (int ai = 0; ai < 2; ++ai)
#pragma unroll
            for (int m = 0; m < 4; ++m) {
                if (a[ai][m] >= 0) {
#pragma unroll
                    for (int bj = 0; bj < 2; ++bj)
#pragma unroll
                        for (int n = 0; n < 2; ++n) { const f32x4 v = acc[ai][bj][m][n] * g[ai][m]; u32x2 o; o[0] = pk2(v[0], v[1]); o[1] = pk2(v[2], v[3]);
                            *(u32x2*)(Y + (size_t)a[ai][m] * D + u.i1 * GBM + bj * 128 + wc * 32 + n * 16 + 4 * fq) = o; }
                }
            }
    }
};
__device__ __forceinline__ void phase_moe2(const Params& p, int l, float* ldsf) {
    Moe2Sched S; S.wid = p.wid; S.tab = (volatile LAS unsigned*)((LAS unsigned char*)ldsf + GEMM_LDS);
    moe_table((const unsigned*)(p.ws + WS_CTL) + CTL_CNT + l * NE, S.tab, TIDX(p));
    plain_ao(S.ao, DE, TIDX(p)); S.vcu = vcu_id(); S.G = gridDim.x;
    Moe2Epi E; E.Y = (bf16_t*)(p.ws + WS_Y); E.LIST = (const int*)(p.ws + WS_LIST); E.GATE = (const float*)(p.ws + WS_GATE);
    gemm_stream((lds_u8*)ldsf, (const char*)(p.ws + WS_HID), (const char*)(p.ws + WS_WDN) + (size_t)l * NE * D * DE * 2, DE, S, E);
}

__device__ __forceinline__ void phase_combine(const Params& p, int l) {
    bf16_t* X = (bf16_t*)(p.ws + WS_X);
    const bf16_t* Y = (const bf16_t*)(p.ws + WS_Y);
    bf16_t* H = (bf16_t*)(p.ws + WS_H);
    const bool last = (l == DEPTH - 1);
    float probe_scale = 1.0f;
#if !defined(CPU_EMU)
    if (PROBE_T >= 0) { const unsigned long long* ts = (const unsigned long long*)(p.ws + WS_CTL + 4 * 8000); const float us = (float)(ts[PROBE_T + 1] - ts[PROBE_T]) * 0.01f; probe_scale = 1.0f + sqrtf(us * 1e-6f); }
#endif
    const float* gn = last ? p.norm_final : p.norm_mix + (l + 1) * D;
    const int lane = lane_id(), wave = p.wid;
    for (int r = blockIdx.x * NW + wave; r < S; r += gridDim.x * NW) {
        f32x4 v[RJ]; row_load_bf16(X + (size_t)r * D, v, lane);
#pragma unroll
        for (int j = 0; j < RJ; ++j) {
            const u32x2 a = *(const u32x2*)(Y + (size_t)(2 * r) * D + 256 * j + lane * 4), b = *(const u32x2*)(Y + (size_t)(2 * r + 1) * D + 256 * j + lane * 4);
            v[j][0] += u2f(a[0] << 16) + u2f(b[0] << 16); v[j][1] += u2f(a[0] & 0xffff0000u) + u2f(b[0] & 0xffff0000u);
            v[j][2] += u2f(a[1] << 16) + u2f(b[1] << 16); v[j][3] += u2f(a[1] & 0xffff0000u) + u2f(b[1] & 0xffff0000u);
        }
        const float ri = row_rinv(v);
#pragma unroll
        for (int j = 0; j < RJ; ++j) {
            const f32x4 g = *(const f32x4*)(gn + 256 * j + lane * 4);
            if (last) *(f32x4*)(p.out + (size_t)r * D + 256 * j + lane * 4) = v[j] * ri * g * probe_scale;
            else {
                { u32x2 xo; xo[0] = pk2(v[j][0], v[j][1]); xo[1] = pk2(v[j][2], v[j][3]); *(u32x2*)(X + (size_t)r * D + 256 * j + lane * 4) = xo; }
                u32x2 o; o[0] = pk2(v[j][0] * ri * g[0], v[j][1] * ri * g[1]); o[1] = pk2(v[j][2] * ri * g[2], v[j][3] * ri * g[3]);
                *(u32x2*)(H + (size_t)r * D + 256 * j + lane * 4) = o;
            }
        }
    }
}

constexpr int PH_PER_LAYER = 9, NPHASE = 1 + DEPTH * PH_PER_LAYER;
constexpr int imax_c(int a, int b) { return a > b ? a : b; }
constexpr int LDS_MAIN = imax_c(imax_c(GEMM_LDS + 1024, ROUTE_LDS), imax_c(NW * RET_WAVE_LDS, NW * MIX_WAVE_LDS));
constexpr int LDS_MISC = (LDS_MAIN + 255) / 256 * 256;
constexpr int LDS_BYTES = LDS_MISC + 256;

__device__ __forceinline__ void run_phase(const Params& p, int ph, float* lds) {
    if (ph == 0) { phase_init(p, lds); return; }
    const int l = (ph - 1) / PH_PER_LAYER, q = (ph - 1) % PH_PER_LAYER;
    switch (q) {
        case 0: phase_inproj(p, l, lds); break;
        case 1: phase_prep(p, l, lds); break;
        case 2: phase_mix(p, l, lds); break;
        case 3: phase_retout(p, l, lds); break;
        case 4: phase_outproj(p, l, lds); break;
        case 5: phase_route(p, l, lds); break;
        case 6: phase_moe1(p, l, lds); break;
        case 7: phase_moe2(p, l, lds); break;
        default: phase_combine(p, l); break;
    }
}

#ifndef CPU_EMU
#define XB_TMO      128
#define XB_XCNT(j)  (256  + 64 * (j))
#define XB_XSUB(j)  (1280 + 64 * (j))
#define XB_XGEN(j)  (2304 + 64 * (j))
#define XB_TOP      3328
#define XB_TOPGEN   3392
#define XCD_BAR_WORDS 3456
#define XB_SPIN_CAP (1u << 22)
__device__ __forceinline__ unsigned xb_ld(unsigned* p)              { return __hip_atomic_load(p, __ATOMIC_RELAXED, __HIP_MEMORY_SCOPE_AGENT); }
__device__ __forceinline__ unsigned xb_add(unsigned* p, unsigned v) { return __hip_atomic_fetch_add(p, v, __ATOMIC_RELAXED, __HIP_MEMORY_SCOPE_AGENT); }
__device__ __forceinline__ unsigned xb_xcc_id() { return (unsigned)__builtin_amdgcn_s_getreg((3 << 11) | 20) & 0xFu; }
#define XB_SPIN(cond, bar) do { unsigned _sp = 0; while (cond) { __builtin_amdgcn_s_sleep(1); \
    if ((++_sp & 255u) == 0u) { if (xb_ld(&(bar)[XB_TMO])) break; if (_sp > XB_SPIN_CAP) { atomicAdd(&(bar)[XB_TMO], 1u); break; } } } } while (0)
struct XcdBarrier { unsigned* bar; unsigned x; volatile LAS unsigned* st; };
__device__ __forceinline__ XcdBarrier xcd_barrier_post(unsigned* bar, volatile LAS unsigned* st, bool t0) {
    XcdBarrier b; b.bar = bar; b.x = xb_xcc_id(); b.st = st;
    if (t0) (void)xb_add(&bar[XB_XCNT(b.x)], 1u);
    return b;
}
__device__ __forceinline__ void xcd_barrier_complete(unsigned* bar, unsigned x, unsigned& nloc, unsigned& nx) {
    const unsigned G = gridDim.x * gridDim.y * gridDim.z;
    unsigned sum, cnt, mine, sp = 0u;
    for (;;) {
        sum = 0u; cnt = 0u; mine = 0u;
#pragma unroll
        for (unsigned j = 0; j < 16; ++j) { const unsigned c = xb_ld(&bar[XB_XCNT(j)]); sum += c; cnt += (c > 0u) ? 1u : 0u; mine = (j == x) ? c : mine; }
        if (sum == G) break;
        __builtin_amdgcn_s_sleep(1);
        if ((++sp & 255u) == 0u) { if (xb_ld(&bar[XB_TMO])) break; if (sp > XB_SPIN_CAP) { atomicAdd(&bar[XB_TMO], 1u); break; } }
    }
    nloc = mine > 0u ? mine : 1u; nx = cnt > 0u ? cnt : 1u;
}
__device__ __forceinline__ void xcd_barrier(const XcdBarrier& b, bool t0) {
    asm volatile("s_waitcnt vmcnt(0)" ::: "memory");
    __syncthreads();
    if (t0) {
        unsigned* bar = b.bar;
        __builtin_amdgcn_s_waitcnt(0);
        unsigned nloc = b.st[0], nx = b.st[1];
        if (nloc == 0u) { xcd_barrier_complete(bar, b.x, nloc, nx); b.st[0] = nloc; b.st[1] = nx; }
        const unsigned old = xb_add(&bar[XB_XSUB(b.x)], 1u);
        const unsigned gen = old / nloc;
        if (old + 1u == (gen + 1u) * nloc) {
            __builtin_amdgcn_fence(__ATOMIC_RELEASE, "agent");
            asm volatile("s_waitcnt vmcnt(0)" ::: "memory");
            const unsigned og = xb_add(&bar[XB_TOP], 1u);
            const unsigned tg = og / nx;
            if (og + 1u == (tg + 1u) * nx) xb_add(&bar[XB_TOPGEN], 1u);
            else XB_SPIN(xb_ld(&bar[XB_TOPGEN]) == tg, bar);
            __builtin_amdgcn_fence(__ATOMIC_ACQUIRE, "agent");
            xb_add(&bar[XB_XGEN(b.x)], 1u);
            asm volatile("s_waitcnt vmcnt(0)" ::: "memory");
        } else {
            XB_SPIN(xb_ld(&bar[XB_XGEN(b.x)]) == gen, bar);
            __builtin_amdgcn_fence(__ATOMIC_ACQUIRE, "agent");
            asm volatile("s_waitcnt vmcnt(0)" ::: "memory");
        }
    }
    __syncthreads();
}
#endif
#ifndef CPU_EMU
__global__ void __launch_bounds__(NT) fwd_kernel(Params pin, int ph_lo, int ph_hi) {
    extern __shared__ __attribute__((aligned(16))) float lds[];
    cg::grid_group grid = cg::this_grid();
    Params p = pin; p.wid = uni((int)(threadIdx.x >> 6));
    volatile LAS unsigned* misc = (volatile LAS unsigned*)((LAS unsigned char*)lds + LDS_MISC);
    if (p.wid == 0) misc[lane_id()] = 0u;
    __syncthreads();
    XcdBarrier xb; xb.bar = (unsigned*)(p.ws + WS_CTL) + CTL_BAR; xb.x = 0; xb.st = misc;
    const bool use_xb = (ph_lo == 0);
#define T0() (p.wid == 0 && lane_id() == 0)
#define SEAM(k) do { if ((k) == 0 || !use_xb) { grid.sync(); if ((k) == 0 && use_xb) xb = xcd_barrier_post((unsigned*)(p.ws + WS_CTL) + CTL_BAR, misc, T0()); } else xcd_barrier(xb, T0()); } while (0)
#define PHASE(k, call) do { if (ph_lo <= (k) && (k) < ph_hi) { if (PROBE_T >= 0 && blockIdx.x == 0 && T0()) ((unsigned long long*)(p.ws + WS_CTL + 4 * 8000))[k] = __builtin_amdgcn_s_memrealtime(); call; if ((k) + 1 < ph_hi) SEAM(k); } } while (0)
#ifndef PROBE_DUP
#define PROBE_DUP 0
#endif
#define DUP(bit, call) do { if ((PROBE_DUP & (bit)) && l_ == 0) { __syncthreads(); call; } } while (0)
#define LAYER(l) do { const int b_ = 1 + (l) * PH_PER_LAYER; const int l_ = (l); \
        PHASE(b_ + 0, phase_inproj(p, l, lds); DUP(1, phase_inproj(p, l, lds))); PHASE(b_ + 1, phase_prep(p, l, lds); DUP(2, phase_prep(p, l, lds))); PHASE(b_ + 2, phase_mix(p, l, lds); DUP(4, phase_mix(p, l, lds))); \
        PHASE(b_ + 3, phase_retout(p, l, lds); DUP(8, phase_retout(p, l, lds))); PHASE(b_ + 4, phase_outproj(p, l, lds); DUP(16, phase_outproj(p, l, lds))); PHASE(b_ + 5, phase_route(p, l, lds); DUP(128, phase_route<true>(p, l, lds))); \
        PHASE(b_ + 6, phase_moe1(p, l, lds); DUP(32, phase_moe1(p, l, lds))); PHASE(b_ + 7, phase_moe2(p, l, lds); DUP(64, phase_moe2(p, l, lds))); PHASE(b_ + 8, phase_combine(p, l); if ((PROBE_DUP & 256) && l_ == 1) phase_combine(p, l)); } while (0)
    PHASE(0, phase_init(p, lds); if (PROBE_DUP & 512) { __syncthreads(); phase_init(p, lds); });
    LAYER(0);
    LAYER(1);
    static_assert(DEPTH == 2, "phase program written for two layers");
#undef LAYER
#undef PHASE
#undef SEAM
}

#ifndef N_LAUNCH_PER_PHASE
#define N_LAUNCH_PER_PHASE 0
#endif
extern "C" void kernel_launch(void* const* d_in, const int* in_sizes, int n_in, void* d_out, int out_size, void* d_ws, size_t ws_size, hipStream_t stream) {
    static int grid = 0;
    if (grid == 0) {
        if (ws_size < WS_END) { fprintf(stderr, "kernel_launch: workspace too small (%zu < %zu)\n", ws_size, (size_t)WS_END); grid = -1; return; }
        int dev = 0, cus = 0, per_cu = 0;
        hipGetDevice(&dev);
        hipDeviceGetAttribute(&cus, hipDeviceAttributeMultiprocessorCount, dev);
        hipFuncSetAttribute((const void*)fwd_kernel, hipFuncAttributeMaxDynamicSharedMemorySize, LDS_BYTES);
        hipOccupancyMaxActiveBlocksPerMultiprocessor(&per_cu, (const void*)fwd_kernel, NT, LDS_BYTES);
        if (per_cu < 1) { fprintf(stderr, "kernel_launch: occupancy query says %d blocks per CU\n", per_cu); grid = -1; return; }
        grid = cus;
    }
    if (grid < 0) return;
    Params p{};
    p.x = (const float*)d_in[0]; p.norm_mix = (const float*)d_in[1]; p.w_in = (const float*)d_in[2]; p.b_forget = (const float*)d_in[3];
    p.g_ret = (const float*)d_in[4]; p.g_sb = (const float*)d_in[5]; p.g_fox = (const float*)d_in[6]; p.w_out = (const float*)d_in[7];
    p.norm_ffn = (const float*)d_in[8]; p.w_group = (const float*)d_in[9]; p.b_group = (const float*)d_in[10]; p.w_router = (const float*)d_in[11];
    p.b_router = (const float*)d_in[12]; p.w_gate = (const float*)d_in[13]; p.w_up = (const float*)d_in[14]; p.w_down = (const float*)d_in[15];
    p.norm_final = (const float*)d_in[16]; p.out = (float*)d_out; p.ws = (unsigned char*)d_ws;
#if N_LAUNCH_PER_PHASE
    for (int ph = 0; ph < NPHASE; ++ph) {
        int lo = ph, hi = ph + 1; void* args[] = {&p, &lo, &hi};
        hipLaunchCooperativeKernel((const void*)fwd_kernel, dim3(grid), dim3(NT), args, LDS_BYTES, stream);
    }
#else
    int lo = 0, hi = NPHASE; void* args[] = {&p, &lo, &hi};
    hipError_t e = hipLaunchCooperativeKernel((const void*)fwd_kernel, dim3(grid), dim3(NT), args, LDS_BYTES, stream);
    if (e != hipSuccess) fprintf(stderr, "cooperative launch failed: %s (grid %d)\n", hipGetErrorString(e), grid);
#endif
}
#endif
```

```cpp
#ifndef CPU_EMU
#include <hip/hip_runtime.h>
#include <hip/hip_cooperative_groups.h>
#include <cstdio>
#include <cstdint>
#include <cmath>
namespace cg = cooperative_groups;
#define VEC(T, N) T __attribute__((ext_vector_type(N)))
__device__ __forceinline__ void wave_barrier() { __builtin_amdgcn_wave_barrier(); }
__device__ __forceinline__ float sin2pi(float x) { return __builtin_amdgcn_sinf(x); }
__device__ __forceinline__ float cos2pi(float x) { return __builtin_amdgcn_cosf(x); }
__device__ __forceinline__ unsigned long long ballot64(bool p) { return __ballot(p); }
#define LAS __attribute__((address_space(3)))
typedef VEC(short, 8) bf16x8;
typedef VEC(float, 4) f32x4_;
__device__ __forceinline__ void glds16(const void* g, LAS unsigned char* l) { __builtin_amdgcn_global_load_lds((const unsigned*)g, (LAS unsigned*)l, 16, 0, 0); }
__device__ __forceinline__ void vm_wait0() { asm volatile("s_waitcnt vmcnt(0)" ::: "memory"); }
__device__ __forceinline__ void lds_wait0() { asm volatile("s_waitcnt lgkmcnt(0)" ::: "memory"); }
__device__ __forceinline__ void sched_fence() { __builtin_amdgcn_sched_barrier(0); }
__device__ __forceinline__ int uni(int x) { return __builtin_amdgcn_readfirstlane(x); }
__device__ __forceinline__ unsigned ld_relaxed(const unsigned* p) { return __hip_atomic_load(p, __ATOMIC_RELAXED, __HIP_MEMORY_SCOPE_AGENT); }
__device__ __forceinline__ int xcc_shard() { return (int)(__builtin_amdgcn_s_getreg((3 << 11) | 20) & 7u); }
__device__ __forceinline__ int lane_id() { int l; asm volatile("v_mbcnt_lo_u32_b32 %0, -1, 0\n\tv_mbcnt_hi_u32_b32 %0, -1, %0" : "=v"(l)); return l; }
__device__ __forceinline__ f32x4_ mfma16(bf16x8 a, bf16x8 b, f32x4_ c) { return __builtin_amdgcn_mfma_f32_16x16x32_bf16(a, b, c, 0, 0, 0); }
typedef VEC(float, 16) f32x16;
typedef VEC(short, 4) s16x4;
__device__ __forceinline__ f32x16 mfma32(bf16x8 a, bf16x8 b, f32x16 c) { return __builtin_amdgcn_mfma_f32_32x32x16_bf16(a, b, c, 0, 0, 0); }
__device__ __forceinline__ s16x4 tr16(const LAS unsigned char* p) { return __builtin_amdgcn_ds_read_tr16_b64_v4i16((LAS s16x4*)p); }
__device__ __forceinline__ float fast_exp(float x) { return __expf(x); }
__device__ __forceinline__ float fast_log(float x) { return __logf(x); }
__device__ __forceinline__ float partner32(float x, int hi) { const auto rr = __builtin_amdgcn_permlane32_swap(__builtin_bit_cast(unsigned, x), __builtin_bit_cast(unsigned, x), false, false); return __builtin_bit_cast(float, hi ? rr[0] : rr[1]); }
template <int N> __device__ __forceinline__ float row_shl_add(float x) { return x + __builtin_bit_cast(float, __builtin_amdgcn_update_dpp(0, __builtin_bit_cast(int, x), 0x100 + N, 0xf, 0xf, true)); }
__device__ __forceinline__ float read_lane(float x, int l) { return __builtin_bit_cast(float, __builtin_amdgcn_readlane(__builtin_bit_cast(int, x), l)); }
#else
#define VEC(T, N) T __attribute__((vector_size(sizeof(T) * N)))
inline float sin2pi(float x) { return (float)sin(6.283185307179586 * (double)x); }
inline float cos2pi(float x) { return (float)cos(6.283185307179586 * (double)x); }
inline unsigned long long ballot64(bool p) { return emu_ballot(p); }
#define LAS
typedef VEC(short, 8) bf16x8;
inline void glds16(const void* g, unsigned char* l) { memcpy(l + (threadIdx.x & 63) * 16, g, 16); }
inline void vm_wait0() {}
inline void lds_wait0() {}
inline void sched_fence() {}
inline int uni(int x) { return x; }
inline int xcc_shard() { return (int)(blockIdx.x & 7u); }
inline unsigned ld_relaxed(const unsigned* p) { return __atomic_load_n(p, __ATOMIC_RELAXED); }
inline int lane_id() { return threadIdx.x & 63; }
inline emu_f32x4 mfma16(bf16x8 a, bf16x8 b, emu_f32x4 c) { return emu_mfma16(a, b, c); }
typedef VEC(float, 16) f32x16;
typedef VEC(short, 4) s16x4;
inline f32x16 mfma32(bf16x8 a, bf16x8 b, f32x16 c) { return emu_mfma32(a, b, c); }
inline s16x4 tr16(const unsigned char* p) { return emu_tr16(p); }
inline float fast_exp(float x) { return expf(x); }
inline float fast_log(float x) { return logf(x); }
inline float partner32(float x, int hi) { return __shfl_xor(x, 32); }
template <int N> inline float row_shl_add(float x) { const int l = threadIdx.x & 63; const float o = emu_shfl_idx(x, (l + N) & 63); return x + (((l & 15) + N < 16) ? o : 0.f); }
inline float read_lane(float x, int l) { return emu_shfl_idx(x, l); }
#endif

typedef unsigned short bf16_t;
typedef VEC(float, 4) f32x4;
typedef VEC(float, 2) f32x2;
typedef VEC(unsigned, 2) u32x2;
typedef VEC(unsigned, 4) u32x4;
typedef LAS unsigned char lds_u8;

#ifndef PROBE_T
#define PROBE_T -1
#endif
#ifdef SMALL_CFG
constexpr int D = 256, S = 512, DEPTH = 2, NRET = 2, NSB = 1, NFOX = 1, NG = 2, EPG = 4, DE = 128;
#else
constexpr int D = 1024, S = 16384, DEPTH = 2, NRET = 6, NSB = 5, NFOX = 5, NG = 4, EPG = 8, DE = 512;
#endif
constexpr int CH = 64, HD = 64, NE = NG * EPG;
constexpr int WRET = NRET * HD, WSB = NSB * HD, WFOX = NFOX * HD, MIXW = WRET + WSB + WFOX;
constexpr int IN_W = 4 * WRET + 3 * WSB + 3 * WFOX + NFOX;
constexpr int PW = (IN_W + 255) / 256 * 256;
constexpr int OQR = 0, OKR = WRET, OVR = 2 * WRET, OGR = 3 * WRET, OQS = 4 * WRET, OKS = OQS + WSB, OVS = OKS + WSB;
constexpr int OQF = OVS + WSB, OKF = OQF + WFOX, OVF = OKF + WFOX, OFL = OVF + WFOX;
constexpr int NCHUNK = S / CH;
constexpr float EPS = 1e-6f;
constexpr int NT = 512, NW = NT / 64;
constexpr int NROUTE = NG + NE;
constexpr float EXIT_T = 18.0f;

constexpr size_t al256(size_t x) { return (x + 255) / 256 * 256; }
constexpr size_t WS_CTL = 0;
constexpr int CTL_CNT = 0;
constexpr int CTL_KMAX = 256;
constexpr int CTL_MQ = 4608, CTL_WQ = 4608 + DEPTH * 8 * 64;
constexpr int CTL_BAR = 1024;
constexpr int CTL_WORDS = 8192;
static_assert(CTL_BAR + 3456 <= CTL_MQ && CTL_WQ + DEPTH * 8 * 64 <= CTL_WORDS, "control-word map");
constexpr size_t WS_ROT = 32768;
constexpr size_t WS_X = al256(WS_ROT + (size_t)S * 32 * 8);
constexpr size_t WS_H = al256(WS_X + (size_t)S * D * 4);
constexpr size_t WS_LOGF = al256(WS_H + (size_t)S * D * 2);
constexpr size_t WS_FCUM = al256(WS_LOGF + (size_t)S * 8 * 4);
constexpr size_t WS_MERGED = al256(WS_FCUM + (size_t)S * 8 * 4);
constexpr size_t WS_U = al256(WS_MERGED + (size_t)S * MIXW * 2);
constexpr size_t WS_SP = al256(WS_U + (size_t)NRET * NCHUNK * 4096 * 4);
constexpr size_t WS_LIST = al256(WS_SP + (size_t)NRET * NCHUNK * 4096 * 4);
constexpr size_t WS_GATE = al256(WS_LIST + (size_t)NE * S * 4);
constexpr size_t WS_WIN = al256(WS_GATE + (size_t)S * 2 * 4);
constexpr size_t WS_WOUT = al256(WS_WIN + (size_t)DEPTH * PW * D * 2);
constexpr size_t WS_WGU = al256(WS_WOUT + (size_t)DEPTH * D * MIXW * 2);
constexpr size_t WS_WDN = al256(WS_WGU + (size_t)DEPTH * NE * 2 * DE * D * 2);
constexpr size_t WS_PROJ = al256(WS_WDN + (size_t)DEPTH * NE * D * DE * 2);
constexpr int HID_ROWS = 2 * S + NE * 256;
constexpr size_t WS_HID = WS_PROJ;
constexpr size_t WS_Y = al256(WS_HID + (size_t)HID_ROWS * DE * 2);
constexpr size_t WS_END0 = al256(WS_PROJ + (size_t)S * PW * 2), WS_END1 = al256(WS_Y + (size_t)2 * S * D * 2);
constexpr size_t WS_END = WS_END0 > WS_END1 ? WS_END0 : WS_END1;
#ifndef SMALL_CFG
static_assert(WS_END <= (size_t)512 * 1024 * 1024, "workspace map exceeds the guaranteed 512 MiB");
#endif

struct Params {
    const float* x; const float* norm_mix; const float* w_in; const float* b_forget; const float* g_ret; const float* g_sb; const float* g_fox;
    const float* w_out; const float* norm_ffn; const float* w_group; const float* b_group; const float* w_router; const float* b_router;
    const float* w_gate; const float* w_up; const float* w_down; const float* norm_final;
    float* out; unsigned char* ws;
    int wid, pad;
};

#define TIDX(p) (((p).wid << 6) | lane_id())
__device__ __forceinline__ int imin(int a, int b) { return a < b ? a : b; }
__device__ __forceinline__ float u2f(unsigned u) { return __builtin_bit_cast(float, u); }
__device__ __forceinline__ unsigned f2u(float f) { return __builtin_bit_cast(unsigned, f); }
__device__ __forceinline__ float bf2f(bf16_t b) { return u2f((unsigned)b << 16); }
__device__ __forceinline__ bf16_t f2bf(float f) { unsigned u = f2u(f); return (bf16_t)((u + 0x7fffu + ((u >> 16) & 1u)) >> 16); }
#ifndef CPU_EMU
typedef float pk_f32x2 __attribute__((ext_vector_type(2))); typedef __bf16 pk_bf16x2 __attribute__((ext_vector_type(2)));
__device__ __forceinline__ unsigned pk2(float lo, float hi) { const pk_f32x2 v = {lo, hi}; return __builtin_bit_cast(unsigned, __builtin_convertvector(v, pk_bf16x2)); }
#else
__device__ __forceinline__ unsigned pk2(float lo, float hi) { return (unsigned)f2bf(lo) | ((unsigned)f2bf(hi) << 16); }
#endif
__device__ __forceinline__ float log_sigmoid(float x) { return fminf(x, 0.f) - log1pf(expf(-fabsf(x))); }
__device__ __forceinline__ float silu(float x) { return x / (1.f + expf(-x)); }
#ifndef CPU_EMU
template <int CTRL> __device__ __forceinline__ float dpp_mov(float x) { return __builtin_bit_cast(float, __builtin_amdgcn_update_dpp(0, __builtin_bit_cast(int, x), CTRL, 0xf, 0xf, false)); }
__device__ __forceinline__ float wave_sum(float v) {
    v += dpp_mov<0xB1>(v); v += dpp_mov<0x4E>(v); v += dpp_mov<0x141>(v); v += dpp_mov<0x140>(v);
    return (read_lane(v, 0) + read_lane(v, 16)) + (read_lane(v, 32) + read_lane(v, 48));
}
__device__ __forceinline__ float wave_max(float v) {
    v = fmaxf(v, dpp_mov<0xB1>(v)); v = fmaxf(v, dpp_mov<0x4E>(v)); v = fmaxf(v, dpp_mov<0x141>(v)); v = fmaxf(v, dpp_mov<0x140>(v));
    return fmaxf(fmaxf(read_lane(v, 0), read_lane(v, 16)), fmaxf(read_lane(v, 32), read_lane(v, 48)));
}
#else
__device__ __forceinline__ float wave_sum(float v) {
#pragma unroll
    for (int o = 1; o < 64; o <<= 1) v += __shfl_xor(v, o);
    return v;
}
__device__ __forceinline__ float wave_max(float v) {
#pragma unroll
    for (int o = 1; o < 64; o <<= 1) v = fmaxf(v, __shfl_xor(v, o));
    return v;
}
#endif
__device__ __forceinline__ double inv_turns(int j) {
    static constexpr double T[32] = {
        1.59154943091895346e-01, 1.19349370211248862e-01, 8.94994016088910133e-02, 6.71150830052272551e-02, 5.03292121044870353e-02, 3.77415847174197711e-02, 2.83021958306233987e-02, 2.12236527647776604e-02,
        1.59154943091895339e-02, 1.19349370211248862e-02, 8.94994016088910237e-03, 6.71150830052272534e-03, 5.03292121044870370e-03, 3.77415847174197719e-03, 2.83021958306233987e-03, 2.12236527647776622e-03,
        1.59154943091895356e-03, 1.19349370211248849e-03, 8.94994016088910237e-04, 6.71150830052272599e-04, 5.03292121044870326e-04, 3.77415847174197741e-04, 2.83021958306233954e-04, 2.12236527647776605e-04,
        1.59154943091895351e-04, 1.19349370211248862e-04, 8.94994016088910182e-05, 6.71150830052272545e-05, 5.03292121044870354e-05, 3.77415847174197768e-05, 2.83021958306233961e-05, 2.12236527647776592e-05};
    return T[j];
}

constexpr int VROWB = 144;
constexpr int IMG64 = 64 * VROWB;
constexpr int RET_WAVE_LDS = 2 * IMG64;
__device__ __forceinline__ int crow(int reg, int hi) { return (reg & 3) + 8 * (reg >> 2) + 4 * hi; }
__device__ __forceinline__ bf16x8 tr_frag(const lds_u8* base, int rowoff0, int rowoff1, int coloff) {
    const s16x4 lo = tr16(base + rowoff0 * VROWB + coloff), hi4 = tr16(base + rowoff1 * VROWB + coloff);
    bf16x8 f; f[0] = lo[0]; f[1] = lo[1]; f[2] = lo[2]; f[3] = lo[3]; f[4] = hi4[0]; f[5] = hi4[1]; f[6] = hi4[2]; f[7] = hi4[3]; return f;
}

constexpr int RJ = D / 256;
__device__ __forceinline__ void row_load(const float* row, f32x4* v, int lane) {
#pragma unroll
    for (int j = 0; j < RJ; ++j) v[j] = *(const f32x4*)(row + 256 * j + lane * 4);
}
__device__ __forceinline__ void row_load_bf16(const bf16_t* row, f32x4* v, int lane) {
#pragma unroll
    for (int j = 0; j < RJ; ++j) { const u32x2 w = *(const u32x2*)(row + 256 * j + lane * 4); v[j][0] = u2f(w[0] << 16); v[j][1] = u2f(w[0] & 0xffff0000u); v[j][2] = u2f(w[1] << 16); v[j][3] = u2f(w[1] & 0xffff0000u); }
}
__device__ __forceinline__ float row_rinv(const f32x4* v) {
    float s = 0.f;
#pragma unroll
    for (int j = 0; j < RJ; ++j) s += (v[j][0] * v[j][0] + v[j][1] * v[j][1]) + (v[j][2] * v[j][2] + v[j][3] * v[j][3]);
    s = wave_sum(s);
    return 1.0f / sqrtf(s * (1.0f / D) + EPS);
}

#ifndef CPU_EMU
typedef float f32x4_u __attribute__((ext_vector_type(4), aligned(4)));
#else
typedef float f32x4_u __attribute__((vector_size(16), aligned(4)));
#endif
#ifndef CPU_EMU
__device__ __forceinline__ f32x4_u nt_load4(const f32x4_u* p) { return __builtin_nontemporal_load(p); }
#else
inline f32x4_u nt_load4(const f32x4_u* p) { return *p; }
#endif
struct TrDesc { const float* Wa; const float* Wb; int ldw, ncols, c0, cb0, k0; bf16_t* WT; int ldt, r0, r1; };
__device__ __forceinline__ void tr_load(const TrDesc& d, f32x4 (&v)[16], int lane) {
    const int n = 4 * (lane & 15), kr = lane >> 4;
    const float* src = (n < 32 ? d.Wa + d.c0 + n : d.Wb + d.cb0 + (n - 32)) + (size_t)(d.k0 + kr) * d.ldw;
    const int col = (n < 32 ? d.c0 + n : d.cb0 + n - 32);
    if (col + 3 < d.ncols) {
#pragma unroll
        for (int i = 0; i < 16; ++i) { const f32x4_u t = nt_load4((const f32x4_u*)(src + (size_t)(4 * i) * d.ldw)); v[i][0] = t[0]; v[i][1] = t[1]; v[i][2] = t[2]; v[i][3] = t[3]; }
    } else {
#pragma unroll
        for (int i = 0; i < 16; ++i)
#pragma unroll
            for (int j = 0; j < 4; ++j) v[i][j] = (col + j < d.ncols) ? src[(size_t)(4 * i) * d.ldw + j] : 0.f;
    }
}
__device__ __forceinline__ void tr_store(const TrDesc& d, const f32x4 (&v)[16], lds_u8* img, int lane) {
    const int n = 4 * (lane & 15), kr = lane >> 4;
    wave_barrier();
#pragma unroll
    for (int i = 0; i < 16; ++i) { u32x2 o; o[0] = pk2(v[i][0], v[i][1]); o[1] = pk2(v[i][2], v[i][3]); *(LAS u32x2*)(img + (4 * i + kr) * VROWB + n * 2) = o; }
    wave_barrier();
    const lds_u8* tb = img + ((lane & 15) >> 2) * VROWB + (16 * (lane >> 4) + 4 * (lane & 3)) * 2;
    bf16_t* dst = d.WT + (size_t)(lane < 32 ? d.r0 + lane : d.r1 + lane - 32) * d.ldt + d.k0;
#pragma unroll
    for (int kc = 0; kc < 8; ++kc) {
        const s16x4 lo = tr16(tb + (8 * kc) * VROWB), hi4 = tr16(tb + (8 * kc + 4) * VROWB);
        u32x4 o; o[0] = (unsigned)(unsigned short)lo[0] | ((unsigned)(unsigned short)lo[1] << 16); o[1] = (unsigned)(unsigned short)lo[2] | ((unsigned)(unsigned short)lo[3] << 16);
        o[2] = (unsigned)(unsigned short)hi4[0] | ((unsigned)(unsigned short)hi4[1] << 16); o[3] = (unsigned)(unsigned short)hi4[2] | ((unsigned)(unsigned short)hi4[3] << 16);
        *(u32x4*)(dst + 8 * kc) = o;
    }
}
constexpr int WI_IN = (D / 64) * ((IN_W + 63) / 64), WI_OUT = (MIXW / 64) * (D / 64), WI_GU = (D / 64) * (DE / 32), WI_DN = (DE / 64) * (D / 64);
constexpr int WI_DENSE = WI_IN + WI_OUT, WI_EXPERT = WI_GU + WI_DN, WI_LAYER = WI_DENSE + NE * WI_EXPERT;
__device__ __forceinline__ TrDesc weight_desc(const Params& p, int l, int r) {
    if (r < WI_IN) { const int nb = (IN_W + 63) / 64, c0 = (r % nb) * 64; const float* W = p.w_in + (size_t)l * D * IN_W;
        const int r0 = (c0 / 256) * 256 + ((c0 % 256) / 64) * 32;
        return TrDesc{W, W, IN_W, IN_W, c0, c0 + 32, (r / nb) * 64, (bf16_t*)(p.ws + WS_WIN) + (size_t)l * PW * D, D, r0, r0 + 128}; }
    r -= WI_IN;
    if (r < WI_OUT) { const int nb = D / 64, c0 = (r % nb) * 64; const float* W = p.w_out + (size_t)l * MIXW * D;
        return TrDesc{W, W, D, D, c0, c0 + 32, (r / nb) * 64, (bf16_t*)(p.ws + WS_WOUT) + (size_t)l * D * MIXW, MIXW, c0, c0 + 32}; }
    r -= WI_OUT;
    const int e = r / WI_EXPERT; r %= WI_EXPERT;
    if (r < WI_GU) { const int nb = DE / 32, c0 = (r % nb) * 32;
        const int r0 = (c0 / 128) * 256 + (c0 % 128);
        return TrDesc{p.w_gate + (size_t)(l * NE + e) * D * DE, p.w_up + (size_t)(l * NE + e) * D * DE, DE, DE, c0, c0, (r / nb) * 64, (bf16_t*)(p.ws + WS_WGU) + (size_t)(l * NE + e) * 2 * DE * D, D, r0, r0 + 128}; }
    r -= WI_GU;
    { const int nb = D / 64, c0 = (r % nb) * 64; const float* W = p.w_down + (size_t)(l * NE + e) * DE * D;
        return TrDesc{W, W, D, D, c0, c0 + 32, (r / nb) * 64, (bf16_t*)(p.ws + WS_WDN) + (size_t)(l * NE + e) * D * DE, DE, c0, c0 + 32}; }
}
__device__ __forceinline__ void weight_item(const Params& p, int l, int r, lds_u8* img, int lane) { const TrDesc d = weight_desc(p, l, r); f32x4 v[16]; tr_load(d, v, lane); tr_store(d, v, img, lane); }
__device__ __forceinline__ void weight_item2(const Params& p, int l, int ra, int rb, lds_u8* img, int lane) {
    const TrDesc da = weight_desc(p, l, ra), db = weight_desc(p, l, rb); f32x4 va[16], vb[16];
    tr_load(da, va, lane); tr_load(db, vb, lane); tr_store(da, va, img, lane); tr_store(db, vb, img + IMG64, lane);
}
__device__ __forceinline__ void phase_init(const Params& p, float* lds) {
    unsigned* ctl = (unsigned*)(p.ws + WS_CTL);
    if (blockIdx.x == 0) for (int i = TIDX(p); i < 8000; i += NT) if (i < CTL_BAR || i >= CTL_BAR + 3456) ctl[i] = 0u;
    f32x2* rot = (f32x2*)(p.ws + WS_ROT);
    for (int i = blockIdx.x * NT + TIDX(p); i < S * 32; i += gridDim.x * NT) {
        const int pos = i >> 5, j = i & 31;
        const double turns = (double)pos * inv_turns(j);
        const double fr = turns - floor(turns);
        f32x2 cs; cs[0] = cos2pi((float)fr); cs[1] = sin2pi((float)fr);
        rot[i] = cs;
    }
    const int lane = lane_id(), wave = p.wid;
    {
        lds_u8* img = (lds_u8*)lds + wave * RET_WAVE_LDS;
        for (int it = blockIdx.x * NW + wave; it < DEPTH * WI_DENSE; it += gridDim.x * NW) weight_item(p, it / WI_DENSE, it % WI_DENSE, img, lane);
    }
    bf16_t* H = (bf16_t*)(p.ws + WS_H);
    for (int r = blockIdx.x * NW + wave; r < S; r += gridDim.x * NW) {
        f32x4 v[RJ]; row_load(p.x + (size_t)r * D, v, lane);
        const float ri = row_rinv(v);
#pragma unroll
        for (int j = 0; j < RJ; ++j) {
            const f32x4 g = *(const f32x4*)(p.norm_mix + 256 * j + lane * 4);
            u32x2 o; o[0] = pk2(v[j][0] * ri * g[0], v[j][1] * ri * g[1]); o[1] = pk2(v[j][2] * ri * g[2], v[j][3] * ri * g[3]);
            *(u32x2*)(H + (size_t)r * D + 256 * j + lane * 4) = o;
        }
    }
}

constexpr int GBM = 256, GBK = 64, TILE_B = GBM * GBK * 2, STAGE_B = 2 * TILE_B, GEMM_LDS = 2 * STAGE_B;
__device__ __forceinline__ int lds_byte(int r, int c) { const int st = (r >> 4) * 2 + (c >> 5), ob = (r & 15) * 64 + (c & 31) * 2; return st * 1024 + (ob ^ (((ob >> 9) & 1) << 5)); }
__device__ __forceinline__ void stage_rc(int b, int& R, int& C) { const int st = b >> 10, sb = b & 1023, swz = sb ^ (((sb >> 9) & 1) << 5); R = (st >> 1) * 16 + swz / 64; C = (st & 1) * 32 + (swz % 64) / 2; }
__device__ __forceinline__ int vcu_id() { const int G = gridDim.x, b = blockIdx.x; return (G % 8 == 0) ? (b % 8) * (G / 8) + b / 8 : b; }

constexpr int HTB = 128 * GBK * 2;
struct GUnit { unsigned A, B; unsigned ao[4]; int i0, i1, i2, i3; };
#ifndef CPU_EMU
#define G8_WAIT_V(n) asm volatile("s_waitcnt vmcnt(" #n ")" ::: "memory")
#define G8_WAIT_L0() asm volatile("s_waitcnt lgkmcnt(0)" ::: "memory")
#define G8_BAR() __builtin_amdgcn_s_barrier()
#define G8_PRIO(x) __builtin_amdgcn_s_setprio(x)
#else
#define G8_WAIT_V(n) do {} while (0)
#define G8_WAIT_L0() do {} while (0)
#define G8_BAR() __syncthreads()
#define G8_PRIO(x) do {} while (0)
#endif
template <class Sched, class Epi>
__device__ __forceinline__ void gemm_stream(lds_u8* lds, const char* Abase, const char* Bbase, const int K, Sched& S, const Epi& E) {
    const int wid = S.wid, lane = lane_id(), tid = (wid << 6) | lane, wr = wid >> 2, wc = wid & 3, fr = lane & 15, fq = lane >> 4;
    const int nt = K / GBK;
    unsigned voffB[2];
    { int R, C; stage_rc(tid * 16, R, C); voffB[0] = (unsigned)((R * K + C) * 2); stage_rc(tid * 16 + 8192, R, C); voffB[1] = (unsigned)((R * K + C) * 2); }
    const unsigned hstepB = (unsigned)(128 * K * 2);
    lds_u8* ldsw = lds + wid * 1024;
    const int aoff = lds_byte(wr * 64 + fr, fq * 8), boff = lds_byte(wc * 32 + fr, fq * 8);
#define G8_SA(b, h) (((b) * 2 + (h)) * HTB)
#define G8_SB(b, h) ((4 + (b) * 2 + (h)) * HTB)
#define G8_STAGE_A(b, h, U, kt) do { _Pragma("unroll") for (int i_ = 0; i_ < 2; ++i_) glds16(Abase + ((size_t)(U).A + (size_t)((kt) * (GBK * 2))) + (Sched::GATHER ? (U).ao[2 * (h) + i_] : S.ao[2 * (h) + i_]), ldsw + G8_SA(b, h) + i_ * 8192); } while (0)
#define G8_STAGE_B(b, h, U, kt) do { _Pragma("unroll") for (int i_ = 0; i_ < 2; ++i_) glds16(Bbase + ((size_t)(U).B + (size_t)((kt) * (GBK * 2)) + (size_t)(h) * hstepB) + voffB[i_], ldsw + G8_SB(b, h) + i_ * 8192); } while (0)
#define G8_LDA(dst, b, h) do { _Pragma("unroll") for (int m = 0; m < 4; ++m) _Pragma("unroll") for (int k = 0; k < 2; ++k) dst[m][k] = *(const LAS bf16x8*)(lds + G8_SA(b, h) + aoff + m * 2048 + k * 1024); } while (0)
#define G8_LDB(dst, b, h) do { _Pragma("unroll") for (int n = 0; n < 2; ++n) _Pragma("unroll") for (int k = 0; k < 2; ++k) dst[n][k] = *(const LAS bf16x8*)(lds + G8_SB(b, h) + boff + n * 2048 + k * 1024); } while (0)
#define G8_MMA(ai, bj, At_, Bt_) do { G8_PRIO(1); _Pragma("unroll") for (int m = 0; m < 4; ++m) _Pragma("unroll") for (int n = 0; n < 2; ++n) _Pragma("unroll") for (int k = 0; k < 2; ++k) \
        acc[ai][bj][m][n] = mfma16(Bt_[n][k], At_[m][k], acc[ai][bj][m][n]); G8_PRIO(0); } while (0)
    GUnit cur, nxt; int ui = 0;
    if (!S.next(0, cur)) return;
    f32x4 acc[2][2][4][2];
#pragma unroll
    for (int a = 0; a < 2; ++a)
#pragma unroll
        for (int b = 0; b < 2; ++b)
#pragma unroll
            for (int m = 0; m < 4; ++m)
#pragma unroll
                for (int n = 0; n < 2; ++n) acc[a][b][m][n] = (f32x4){0.f, 0.f, 0.f, 0.f};
    bf16x8 At[4][2], B0[2][2], B1[2][2];
    G8_STAGE_B(0, 0, cur, 0); G8_STAGE_B(0, 1, cur, 0); G8_STAGE_A(0, 0, cur, 0); G8_STAGE_A(0, 1, cur, 0);
    if (wr == 1) G8_BAR();
    G8_WAIT_V(2); G8_BAR();
    G8_STAGE_B(1, 0, cur, 1); G8_STAGE_A(1, 0, cur, 1); G8_STAGE_B(1, 1, cur, 1);
    G8_WAIT_V(6); G8_BAR();
    for (;;) {
        const bool has_next = S.next(ui + 1, nxt);
        if (!has_next) nxt = cur;
        for (int t = 0; t < nt; t += 2) {
            const bool last = (t == nt - 2);
            const GUnit& U2 = last ? nxt : cur;
            const int k2 = last ? 0 : t + 2, k3 = k2 + 1;
            G8_LDB(B0, 0, 0); G8_LDB(B1, 0, 1); sched_fence(); G8_LDA(At, 0, 0); G8_STAGE_A(1, 1, cur, t + 1);
            G8_WAIT_V(8); G8_WAIT_L0(); G8_BAR(); G8_MMA(0, 0, At, B0); G8_MMA(0, 1, At, B1); G8_BAR(); sched_fence();
            G8_LDA(At, 0, 1); G8_STAGE_B(0, 0, U2, k2); G8_STAGE_B(0, 1, U2, k2); G8_STAGE_A(0, 0, U2, k2);
            G8_WAIT_V(8); G8_WAIT_L0(); G8_BAR(); G8_MMA(1, 0, At, B0); G8_MMA(1, 1, At, B1); G8_BAR(); sched_fence();
            G8_LDB(B0, 1, 0); G8_LDB(B1, 1, 1); sched_fence(); G8_LDA(At, 1, 0); G8_STAGE_A(0, 1, U2, k2);
            G8_WAIT_V(8); G8_WAIT_L0(); G8_BAR(); G8_MMA(0, 0, At, B0); G8_MMA(0, 1, At, B1); G8_BAR(); sched_fence();
            G8_LDA(At, 1, 1); G8_STAGE_B(1, 0, U2, k3); G8_STAGE_B(1, 1, U2, k3); G8_STAGE_A(1, 0, U2, k3);
            G8_WAIT_V(8); G8_WAIT_L0(); G8_BAR(); G8_MMA(1, 0, At, B0); G8_MMA(1, 1, At, B1); G8_BAR(); sched_fence();
        }
        if (wr == 0) G8_BAR();
        E(acc, cur, wr, wc, fr, fq);
        if (!has_next) break;
#pragma unroll
        for (int a = 0; a < 2; ++a)
#pragma unroll
            for (int b = 0; b < 2; ++b)
#pragma unroll
                for (int m = 0; m < 4; ++m)
#pragma unroll
                    for (int n = 0; n < 2; ++n) acc[a][b][m][n] = (f32x4){0.f, 0.f, 0.f, 0.f};
        cur = nxt; ++ui;
        if (wr == 1) G8_BAR();
    }
    G8_WAIT_V(0);
    G8_BAR();
#undef G8_SA
#undef G8_SB
#undef G8_STAGE_A
#undef G8_STAGE_B
#undef G8_LDA
#undef G8_LDB
#undef G8_MMA
}
__device__ __forceinline__ void plain_ao(unsigned (&ao)[4], int K, int tid) {
    int R, C; stage_rc(tid * 16, R, C); ao[0] = (unsigned)((R * K + C) * 2); ao[2] = ao[0] + (unsigned)(128 * K * 2);
    stage_rc(tid * 16 + 8192, R, C); ao[1] = (unsigned)((R * K + C) * 2); ao[3] = ao[1] + (unsigned)(128 * K * 2);
}

struct InprojSched {
    static constexpr bool GATHER = false;
    int wid;
    unsigned ao[4]; int vcu, G;
    static constexpr int NPM = S / GBM, NPN = PW / GBM;
    __device__ __forceinline__ bool next(int i, GUnit& u) const {
        const int L = uni(i * G + vcu); if (L >= NPM * NPN) return false;
        constexpr int WGM = 8, nig = WGM * NPN;
        const int gid = L / nig, fm = gid * WGM, gsz = (NPM - fm) < WGM ? (NPM - fm) : WGM;
        const int pm = fm + (L % nig) % gsz, pn = (L % nig) / gsz;
        u.A = (unsigned)(pm * GBM * D * 2); u.B = (unsigned)(pn * GBM * D * 2); u.ao[0] = u.ao[1] = u.ao[2] = u.ao[3] = 0u;
        u.i0 = pm; u.i1 = pn; u.i2 = 0; u.i3 = 0; return true;
    }
};
struct InprojEpi {
    bf16_t* P; float* LOGF; unsigned* kmaxw; const f32x2* rot; const float* bfg;
    __device__ __forceinline__ void operator()(f32x4 (&acc)[2][2][4][2], const GUnit& u, int wr, int wc, int fr, int fq) const {
        const int gc0 = u.i1 * GBM + wc * 64;
        if (gc0 >= IN_W) return;
        const int row0 = u.i0 * GBM + wr * 64 + fr;
        if (gc0 >= OFL) {
#pragma unroll
            for (int ai = 0; ai < 2; ++ai)
#pragma unroll
                for (int m = 0; m < 4; ++m)
#pragma unroll
                    for (int j = 0; j < 4; ++j) { const int h = 4 * fq + j; if (h < NFOX) LOGF[(size_t)h * S + row0 + ai * 128 + m * 16] = log_sigmoid(acc[ai][0][m][0][j] + bfg[h]); }
            return;
        }
        const bool rotary = gc0 < OVR, is_gate = (gc0 >= OGR && gc0 < OQS), is_kf = (gc0 >= OKF && gc0 < OVF);
        const float scale = (gc0 < OKR || (gc0 >= OQS && gc0 < OKS) || (gc0 >= OQF && gc0 < OKF)) ? 0.125f : 1.0f;
        float kmx = 0.f;
        if (rotary) {
#pragma unroll
            for (int am = 0; am < 4; ++am) {
                const int ai = am >> 1, m0 = (am & 1) * 2;
                f32x4 c01[2][2], c23[2][2];
#pragma unroll
                for (int mm = 0; mm < 2; ++mm)
#pragma unroll
                    for (int n = 0; n < 2; ++n) { const f32x2* rp = rot + (size_t)(row0 + ai * 128 + (m0 + mm) * 16) * 32 + n * 16 + 4 * fq; c01[mm][n] = *(const f32x4*)rp; c23[mm][n] = *(const f32x4*)(rp + 2); }
#pragma unroll
                for (int mm = 0; mm < 2; ++mm)
#pragma unroll
                    for (int n = 0; n < 2; ++n) {
                        const int m = m0 + mm;
                        const float cs[4] = {c01[mm][n][0], c01[mm][n][2], c23[mm][n][0], c23[mm][n][2]}, sn[4] = {c01[mm][n][1], c01[mm][n][3], c23[mm][n][1], c23[mm][n][3]};
#pragma unroll
                        for (int j = 0; j < 4; ++j) { const float x1 = acc[ai][0][m][n][j], x2 = acc[ai][1][m][n][j]; acc[ai][0][m][n][j] = x1 * cs[j] - x2 * sn[j]; acc[ai][1][m][n][j] = x1 * sn[j] + x2 * cs[j]; }
                    }
                sched_fence();
            }
        }
#pragma unroll
        for (int ai = 0; ai < 2; ++ai)
#pragma unroll
            for (int m = 0; m < 4; ++m) {
                const int row = row0 + ai * 128 + m * 16;
                float ss = 0.f;
#pragma unroll
                for (int bj = 0; bj < 2; ++bj)
#pragma unroll
                    for (int n = 0; n < 2; ++n) {
                        f32x4 v = acc[ai][bj][m][n] * scale;
                        if (is_gate) {
#pragma unroll
                            for (int j = 0; j < 4; ++j) v[j] = silu(v[j]);
                        }
                        u32x2 o; o[0] = pk2(v[0], v[1]); o[1] = pk2(v[2], v[3]);
                        if (is_kf) {
#pragma unroll
                            for (int j = 0; j < 4; ++j) { const float r = bf2f(f2bf(v[j])); ss += r * r; }
                        }
                        *(u32x2*)(P + (size_t)row * PW + gc0 + 32 * bj + 16 * n + 4 * fq) = o;
                    }
                if (is_kf) { ss += __shfl_xor(ss, 16); ss += __shfl_xor(ss, 32); kmx = fmaxf(kmx, ss); }
            }
        if (is_kf) { kmx = wave_max(kmx); if (lane_id() == 0) atomicMax(kmaxw + (gc0 - OKF) / HD, f2u(kmx)); }
    }
};
__device__ __forceinline__ void phase_inproj(const Params& p, int l, float* ldsf) {
    InprojSched S; S.wid = p.wid; plain_ao(S.ao, D, TIDX(p)); S.vcu = vcu_id(); S.G = gridDim.x;
    InprojEpi E; E.P = (bf16_t*)(p.ws + WS_PROJ); E.LOGF = (float*)(p.ws + WS_LOGF); E.kmaxw = (unsigned*)(p.ws + WS_CTL) + CTL_KMAX + l * 8; E.rot = (const f32x2*)(p.ws + WS_ROT); E.bfg = p.b_forget + l * NFOX;
    gemm_stream((lds_u8*)ldsf, (const char*)(p.ws + WS_H), (const char*)(p.ws + WS_WIN) + (size_t)l * PW * D * 2, D, S, E);
}

__device__ __forceinline__ float ret_log_gamma(int h) { return logf(1.0f - exp2f(-5.0f - (float)h)); }
__device__ __forceinline__ void ret_prep_item(const Params& p, int h, int n, lds_u8* wl) {
    const bf16_t* P = (const bf16_t*)(p.ws + WS_PROJ);
    float* UT = (float*)(p.ws + WS_U);
    const int lane = lane_id(), r32 = lane & 31, hi = lane >> 5;
    const float lg = ret_log_gamma(h);
    wave_barrier();
#pragma unroll
    for (int i = 0; i < 8; ++i) {
        const int c = lane + 64 * i, row = c >> 3, ch = c & 7;
        const bf16_t* src = P + (size_t)(n * CH + row) * PW + h * HD + 8 * ch;
        const u32x4 kv = *(const u32x4*)(src + OKR), vv = *(const u32x4*)(src + OVR);
        const float dk = fast_exp(lg * (float)(CH - 1 - row));
        u32x4 ko;
#pragma unroll
        for (int w = 0; w < 4; ++w) ko[w] = pk2(u2f(kv[w] << 16) * dk, u2f(kv[w] & 0xffff0000u) * dk);
        *(LAS u32x4*)(wl + row * VROWB + ch * 16) = ko;
        *(LAS u32x4*)(wl + IMG64 + row * VROWB + ch * 16) = vv;
    }
    wave_barrier();
    const lds_u8* tb = wl + (8 * hi + ((lane & 15) >> 2)) * VROWB + (16 * ((lane >> 4) & 1) + 4 * (lane & 3)) * 2;
    f32x16 acc[2][2];
#pragma unroll
    for (int a = 0; a < 2; ++a)
#pragma unroll
        for (int b = 0; b < 2; ++b)
#pragma unroll
            for (int r = 0; r < 16; ++r) acc[a][b][r] = 0.f;
#pragma unroll
    for (int s = 0; s < 4; ++s) {
        bf16x8 vf[2], kf[2];
#pragma unroll
        for (int x = 0; x < 2; ++x) { kf[x] = tr_frag(tb, 16 * s, 16 * s + 4, x * 64); vf[x] = tr_frag(tb + IMG64, 16 * s, 16 * s + 4, x * 64); }
#pragma unroll
        for (int eb = 0; eb < 2; ++eb)
#pragma unroll
            for (int db = 0; db < 2; ++db) acc[eb][db] = mfma32(vf[eb], kf[db], acc[eb][db]);
    }
    float* dst = UT + (size_t)(h * NCHUNK + n) * 4096;
#pragma unroll
    for (int eb = 0; eb < 2; ++eb)
#pragma unroll
        for (int db = 0; db < 2; ++db)
#pragma unroll
            for (int r = 0; r < 16; ++r) dst[(32 * eb + crow(r, hi)) * 64 + 32 * db + r32] = acc[eb][db][r];
}
__device__ __forceinline__ void fcum_block(const Params& p, int h, float* ldsf) {
    const float* LF = (const float*)(p.ws + WS_LOGF) + (size_t)h * S;
    float* F = (float*)(p.ws + WS_FCUM) + (size_t)h * S;
    constexpr int KPT = S / NT;
    const int tid = TIDX(p), lane = lane_id(), w = p.wid;
    float v[KPT];
#pragma unroll
    for (int i = 0; i < KPT; ++i) v[i] = LF[tid * KPT + i];
#pragma unroll
    for (int i = 1; i < KPT; ++i) v[i] += v[i - 1];
    float inc = v[KPT - 1];
#pragma unroll
    for (int d = 1; d < 64; d <<= 1) { const float o = __shfl_up(inc, d); if (lane >= d) inc += o; }
    __syncthreads();
    if (lane == 63) ldsf[w] = inc;
    __syncthreads();
    float off = inc - v[KPT - 1];
    for (int ww = 0; ww < w; ++ww) off += ldsf[ww];
#pragma unroll
    for (int i = 0; i < KPT; ++i) F[tid * KPT + i] = v[i] + off;
    __syncthreads();
}
__device__ __forceinline__ void phase_prep(const Params& p, int l, float* ldsf) {
    if ((int)blockIdx.x < NFOX) fcum_block(p, (int)blockIdx.x, ldsf);
    const int wave = p.wid;
    lds_u8* wl = (lds_u8*)ldsf + wave * RET_WAVE_LDS;
    for (int it = blockIdx.x * NW + wave; it < NRET * NCHUNK; it += gridDim.x * NW) ret_prep_item(p, it / NCHUNK, it % NCHUNK, wl);
}

constexpr int NQ32 = S / 32;
constexpr int MIX_WAVE_LDS = 32 * VROWB;
__device__ __forceinline__ void ret_scan_wave(const Params& p, int item) {
    const float* U = (const float*)(p.ws + WS_U);
    bf16_t* SP = (bf16_t*)(p.ws + WS_SP);
    const int e = item * 64 + lane_id();
    const int h = e >> 12, de = e & 4095;
    const float c = expf(ret_log_gamma(h) * (float)CH);
    float st = 0.f;
    const size_t base = (size_t)h * NCHUNK * 4096 + de;
#pragma unroll 1
    for (int n0 = 0; n0 < NCHUNK; n0 += 32) {
        float u[32];
#pragma unroll
        for (int i = 0; i < 32; ++i) u[i] = (n0 + i < NCHUNK) ? U[base + (size_t)(n0 + i) * 4096] : 0.f;
#pragma unroll
        for (int i = 0; i < 32; ++i) if (n0 + i < NCHUNK) { SP[base + (size_t)(n0 + i) * 4096] = f2bf(st); st = st * c + u[i]; }
    }
}
template <bool FOX>
__device__ __forceinline__ void attn_item(const Params& p, int l, int h, int qb, lds_u8* wl) {
    const bf16_t* P = (const bf16_t*)(p.ws + WS_PROJ);
    const float* Fh = (const float*)(p.ws + WS_FCUM) + (size_t)h * S;
    bf16_t* MG = (bf16_t*)(p.ws + WS_MERGED);
    const int lane = lane_id(), r32 = lane & 31, hi = lane >> 5;
    const int q0 = qb * 32, t = q0 + r32;
    constexpr int oq = FOX ? OQF : OQS, ok = FOX ? OKF : OKS, ov = FOX ? OVF : OVS;
    bf16x8 qf[4];
    { const bf16_t* qp = P + (size_t)t * PW + oq + h * HD + 8 * hi;
#pragma unroll
      for (int ks = 0; ks < 4; ++ks) qf[ks] = *(const bf16x8*)(qp + 16 * ks); }
    float Bt = 0.f;
    if (FOX) {
        float qq = 0.f;
#pragma unroll
        for (int ks = 0; ks < 4; ++ks)
#pragma unroll
            for (int j = 0; j < 8; ++j) { const float v = bf2f((bf16_t)qf[ks][j]); qq += v * v; }
        qq += __shfl_xor(qq, 32);
        const float kmax = sqrtf(u2f(((const unsigned*)(p.ws + WS_CTL))[CTL_KMAX + l * 8 + h]));
        Bt = sqrtf(qq) * kmax * 1.0001f + 1e-6f;
    }
    const float fq = FOX ? Fh[t] : 0.f;
    float m = -1e30f, lsum = 0.f, carry = 0.f;
    f32x16 o0, o1;
#pragma unroll
    for (int r = 0; r < 16; ++r) { o0[r] = 0.f; o1[r] = 0.f; }
    const lds_u8* vb = wl + (4 * hi + ((lane & 15) >> 2)) * VROWB + (16 * ((lane >> 4) & 1) + 4 * (lane & 3)) * 2;
    bf16x8 kf1[4], kf2[4]; u32x4 vr1[4], vr2[4];
#define ATTN_LOAD(KF, VR, kt_) do { const int k0_ = (kt_) * 32; const bf16_t* kp_ = P + (size_t)(k0_ + r32) * PW + ok + h * HD + 8 * hi; \
        _Pragma("unroll") for (int ks = 0; ks < 4; ++ks) KF[ks] = *(const bf16x8*)(kp_ + 16 * ks); \
        _Pragma("unroll") for (int i = 0; i < 4; ++i) { const int c = lane + 64 * i; VR[i] = *(const u32x4*)(P + (size_t)(k0_ + (c >> 3)) * PW + ov + h * HD + 8 * (c & 7)); } \
        } while (0)
    ATTN_LOAD(kf1, vr1, qb);
    ATTN_LOAD(kf2, vr2, qb > 0 ? qb - 1 : 0);
    for (int kt = qb; kt >= 0; --kt) {
        const int key0 = kt * 32;
        const bool diag = (kt == qb);
        bf16x8 kf[4]; u32x4 vr[4];
#pragma unroll
        for (int ks = 0; ks < 4; ++ks) { kf[ks] = kf1[ks]; kf1[ks] = kf2[ks]; }
#pragma unroll
        for (int i = 0; i < 4; ++i) { vr[i] = vr1[i]; vr1[i] = vr2[i]; }
        ATTN_LOAD(kf2, vr2, kt > 1 ? kt - 2 : 0);
        f32x4 fk[4]; float fkm1 = 0.f;
        if (FOX) {
#pragma unroll
            for (int g4 = 0; g4 < 4; ++g4) fk[g4] = *(const f32x4*)(Fh + key0 + 8 * g4 + 4 * hi);
            fkm1 = Fh[key0 > 0 ? key0 - 1 : 0];
        }
        f32x16 st;
#pragma unroll
        for (int r = 0; r < 16; ++r) st[r] = 0.f;
#pragma unroll
        for (int ks = 0; ks < 4; ++ks) st = mfma32(kf[ks], qf[ks], st);
        wave_barrier();
#pragma unroll
        for (int i = 0; i < 4; ++i) { const int c = lane + 64 * i; *(LAS u32x4*)(wl + (c >> 3) * VROWB + (c & 7) * 16) = vr[i]; }
        if (FOX) {
            float tmax = -1e30f;
#pragma unroll
            for (int g4 = 0; g4 < 4; ++g4)
#pragma unroll
                for (int i = 0; i < 4; ++i) { const int r = 4 * g4 + i; st[r] = st[r] + (fq - fk[g4][i]); }
            if (diag) {
#pragma unroll
                for (int r = 0; r < 16; ++r) if (crow(r, hi) > r32) st[r] = -1e30f;
            }
#pragma unroll
            for (int r = 0; r < 16; ++r) tmax = fmaxf(tmax, st[r]);
            tmax = fmaxf(tmax, partner32(tmax, hi));
            const float mn = fmaxf(m, tmax), f = fast_exp(m - mn);
            m = mn; lsum *= f;
#pragma unroll
            for (int r = 0; r < 16; ++r) { o0[r] *= f; o1[r] *= f; }
            float ps = 0.f;
#pragma unroll
            for (int r = 0; r < 16; ++r) { const float pr = fast_exp(st[r] - mn); st[r] = pr; ps += pr; }
            lsum += ps;
        } else {
            float l1m[16];
#pragma unroll
            for (int r = 0; r < 16; ++r) {
                const float z = st[r], sp = fast_log(1.0f + fast_exp(-fabsf(z)));
                const float lb = fminf(z, 0.f) - sp;
                l1m[r] = lb - z;
                st[r] = lb;
            }
            if (diag) {
#pragma unroll
                for (int r = 0; r < 16; ++r) if (crow(r, hi) >= r32) { l1m[r] = 0.f; st[r] = -1e30f; }
            }
            float gs[4], pg[4], T[4];
#pragma unroll
            for (int k = 0; k < 4; ++k) { gs[k] = (l1m[4 * k] + l1m[4 * k + 1]) + (l1m[4 * k + 2] + l1m[4 * k + 3]); pg[k] = partner32(gs[k], hi); }
            float run = 0.f;
#pragma unroll
            for (int k = 3; k >= 0; --k) { T[k] = run + (hi == 0 ? pg[k] : 0.f); run += gs[k] + pg[k]; }
#pragma unroll
            for (int k = 0; k < 4; ++k) {
                float w = T[k] + carry;
#pragma unroll
                for (int i = 3; i >= 0; --i) { const int r = 4 * k + i; st[r] = fast_exp(st[r] + w); w += l1m[r]; }
            }
            carry += run;
        }
        u32x4 pw0, pw1;
#pragma unroll
        for (int j = 0; j < 4; ++j) { pw0[j] = pk2(st[2 * j], st[2 * j + 1]); pw1[j] = pk2(st[8 + 2 * j], st[9 + 2 * j]); }
        const bf16x8 pf0 = __builtin_bit_cast(bf16x8, pw0), pf1 = __builtin_bit_cast(bf16x8, pw1);
        wave_barrier();
#pragma unroll
        for (int s = 0; s < 2; ++s) {
#pragma unroll
            for (int db = 0; db < 2; ++db) {
                const s16x4 lo = tr16(vb + (16 * s) * VROWB + db * 64), hi4 = tr16(vb + (16 * s + 8) * VROWB + db * 64);
                bf16x8 vf; vf[0] = lo[0]; vf[1] = lo[1]; vf[2] = lo[2]; vf[3] = lo[3]; vf[4] = hi4[0]; vf[5] = hi4[1]; vf[6] = hi4[2]; vf[7] = hi4[3];
                if (db == 0) o0 = mfma32(vf, s == 0 ? pf0 : pf1, o0); else o1 = mfma32(vf, s == 0 ? pf0 : pf1, o1);
            }
        }
        const bool done = FOX ? (Bt + (fq - fkm1) - m + logf((float)(key0 + 1)) < -EXIT_T) : (carry < -EXIT_T);
        if (ballot64(done) == ~0ull) break;
    }
#undef ATTN_LOAD
    if (FOX) { lsum += __shfl_xor(lsum, 32); const float il = 1.0f / lsum;
#pragma unroll
        for (int r = 0; r < 16; ++r) { o0[r] *= il; o1[r] *= il; } }
    float ss = 0.f;
#pragma unroll
    for (int r = 0; r < 16; ++r) ss += o0[r] * o0[r] + o1[r] * o1[r];
    ss += __shfl_xor(ss, 32);
    const float ri = 1.0f / sqrtf(ss * (1.0f / HD) + EPS);
    const float* g = (FOX ? p.g_fox + l * WFOX : p.g_sb + l * WSB) + h * HD;
    bf16_t* dst = MG + (size_t)t * MIXW + (FOX ? WRET + WSB : WRET) + h * HD;
#pragma unroll
    for (int db = 0; db < 2; ++db)
#pragma unroll
        for (int g4 = 0; g4 < 4; ++g4) {
            const int d0 = db * 32 + 8 * g4 + 4 * hi;
            const f32x4 gg = *(const f32x4*)(g + d0);
            float v[4];
#pragma unroll
            for (int i = 0; i < 4; ++i) v[i] = (db == 0 ? o0[4 * g4 + i] : o1[4 * g4 + i]) * ri * gg[i];
            u32x2 o; o[0] = pk2(v[0], v[1]); o[1] = pk2(v[2], v[3]);
            *(u32x2*)(dst + d0) = o;
        }
}
constexpr int WCH = 2, NWCH = (NE * WI_EXPERT + WCH - 1) / WCH;
__device__ __forceinline__ bool mix_weight_step(const Params& p, int l, lds_u8* wl, int shard0, int& wsk) {
    unsigned* wbase = (unsigned*)(p.ws + WS_CTL) + CTL_WQ + 64 * (l * 8);
    const int lane = lane_id();
#pragma unroll 1
    while (wsk < 8) {
        const int shard = (shard0 + wsk) & 7;
        unsigned* head = wbase + 64 * shard;
        unsigned c = 0x0fffffffu;
        if (lane == 0) { if (!(wsk > 0 && (int)ld_relaxed(head) * 8 + shard >= NWCH)) c = atomicAdd(head, 1u); }
        const int chunk = uni((int)__shfl(c, 0)) * 8 + shard;
        if (chunk >= NWCH) { ++wsk; continue; }
        static_assert(WCH == 2 && (NE * WI_EXPERT) % 2 == 0, "two tiles per dequeue");
        weight_item2(p, l, WI_DENSE + chunk * 2, WI_DENSE + chunk * 2 + 1, wl, lane);
        return true;
    }
    return false;
}
__device__ __forceinline__ void phase_mix(const Params& p, int l, float* ldsf) {
    constexpr int NSCANW = NRET * 4096 / 64, NFXI = NFOX * NQ32, NSBI = NSB * NQ32;
    const int wave = p.wid;
    lds_u8* wl = (lds_u8*)ldsf + wave * RET_WAVE_LDS;
    static_assert(MIX_WAVE_LDS <= RET_WAVE_LDS, "per-wave LDS region");
    const int shard0 = xcc_shard();
    int wsk = 0;
    unsigned* qbase = (unsigned*)(p.ws + WS_CTL) + CTL_MQ + 64 * (l * 8);
    const float* bfg = p.b_forget + l * NFOX;
    constexpr int NMIX = NSCANW + NFXI + NSBI;
#pragma unroll 1
    for (int sk = 0; sk < 8; ++sk) {
      const int shard = (shard0 + sk) & 7;
      unsigned* qhead = qbase + 64 * shard;
#pragma unroll 1
      for (;;) {
        unsigned itu = 0;
        if (lane_id() == 0) { if (sk > 0 && (int)ld_relaxed(qhead) * 8 + shard >= NMIX) itu = 0x0fffffffu; else itu = atomicAdd(qhead, 1u); }
        const int it = uni((int)__shfl(itu, 0)) * 8 + shard;
        if (it >= NMIX) break;
        if (it < NSCANW) ret_scan_wave(p, it);
        else if (it < NSCANW + NFXI) {
            const int j = it - NSCANW, rank = j / NQ32;
            int h = 0;
#pragma unroll
            for (int c = 0; c < NFOX; ++c) { int rk = 0;
#pragma unroll
                for (int o = 0; o < NFOX; ++o) rk += (bfg[o] > bfg[c] || (bfg[o] == bfg[c] && o < c)) ? 1 : 0;
                if (rk == rank) h = c; }
            attn_item<true>(p, l, h, NQ32 - 1 - j % NQ32, wl);
        }
        else { const int j = it - NSCANW - NFXI; attn_item<false>(p, l, j % NSB, NQ32 - 1 - j / NSB, wl); }
        (void)mix_weight_step(p, l, wl, shard0, wsk);
      }
    }
    while (mix_weight_step(p, l, wl, shard0, wsk)) {}
}

__device__ __forceinline__ void ret_out_item(const Params& p, int l, int h, int n, int cb, lds_u8* wl) {
    const bf16_t* P = (const bf16_t*)(p.ws + WS_PROJ);
    const bf16_t* SPT = (const bf16_t*)(p.ws + WS_SP) + (size_t)(h * NCHUNK + n) * 4096;
    bf16_t* MG = (bf16_t*)(p.ws + WS_MERGED);
    const int lane = lane_id(), r32 = lane & 31, hi = lane >> 5;
    const float lg = ret_log_gamma(h);
    const size_t rowb = (size_t)(n * CH) * PW + h * HD;
    const int c = 32 * cb + r32;
    wave_barrier();
    {
        u32x4 vv[8];
#pragma unroll
        for (int i = 0; i < 8; ++i) { const int q = lane + 64 * i; vv[i] = *(const u32x4*)(P + rowb + (size_t)(q >> 3) * PW + OVR + 8 * (q & 7)); }
#pragma unroll
        for (int i = 0; i < 8; ++i) { const int q = lane + 64 * i; *(LAS u32x4*)(wl + (q >> 3) * VROWB + (q & 7) * 16) = vv[i]; }
    }
    sched_fence();
    bf16x8 qf[4];
#pragma unroll
    for (int ks = 0; ks < 4; ++ks) qf[ks] = *(const bf16x8*)(P + rowb + (size_t)c * PW + OQR + 16 * ks + 8 * hi);
    f32x16 o[2];
#pragma unroll
    for (int a = 0; a < 2; ++a)
#pragma unroll
        for (int r = 0; r < 16; ++r) o[a][r] = 0.f;
#pragma unroll
    for (int ks = 0; ks < 4; ++ks)
#pragma unroll
        for (int eb = 0; eb < 2; ++eb) { const bf16x8 sf = *(const bf16x8*)(SPT + (32 * eb + r32) * 64 + 16 * ks + 8 * hi); o[eb] = mfma32(sf, qf[ks], o[eb]); }
    { const float qd = fast_exp(lg * (float)(c + 1));
#pragma unroll
      for (int eb = 0; eb < 2; ++eb)
#pragma unroll
          for (int r = 0; r < 16; ++r) o[eb][r] *= qd; }
    wave_barrier();
    const lds_u8* vb = wl + (4 * hi + ((lane & 15) >> 2)) * VROWB + (16 * ((lane >> 4) & 1) + 4 * (lane & 3)) * 2;
#pragma unroll
    for (int kb = 0; kb < 2; ++kb) {
        f32x16 st;
#pragma unroll
        for (int r = 0; r < 16; ++r) st[r] = 0.f;
#pragma unroll
        for (int ks = 0; ks < 4; ++ks) { const bf16x8 kf = *(const bf16x8*)(P + rowb + (size_t)(32 * kb + r32) * PW + OKR + 16 * ks + 8 * hi); st = mfma32(kf, qf[ks], st); }
        bf16x8 pf[2];
#pragma unroll
        for (int r = 0; r < 16; ++r) { const int dist = c - (32 * kb + crow(r, hi)); st[r] *= fast_exp(lg * fabsf((float)dist)); }
        { u32x4 w0, w1;
#pragma unroll
          for (int j = 0; j < 4; ++j) { w0[j] = pk2(st[2 * j], st[2 * j + 1]); w1[j] = pk2(st[8 + 2 * j], st[9 + 2 * j]); }
          pf[0] = __builtin_bit_cast(bf16x8, w0); pf[1] = __builtin_bit_cast(bf16x8, w1); }
#pragma unroll
        for (int s = 0; s < 2; ++s)
#pragma unroll
            for (int eb = 0; eb < 2; ++eb) o[eb] = mfma32(tr_frag(vb, 32 * kb + 16 * s, 32 * kb + 16 * s + 8, eb * 64), pf[s], o[eb]);
    }
    float sm = 0.f;
#pragma unroll
    for (int eb = 0; eb < 2; ++eb)
#pragma unroll
        for (int r = 0; r < 16; ++r) sm += o[eb][r];
    sm += __shfl_xor(sm, 32);
    const float mu = sm * (1.0f / HD);
    float vs = 0.f;
#pragma unroll
    for (int eb = 0; eb < 2; ++eb)
#pragma unroll
        for (int r = 0; r < 16; ++r) { const float dlt = o[eb][r] - mu; o[eb][r] = dlt; vs += dlt * dlt; }
    vs += __shfl_xor(vs, 32);
    const float ri = 1.0f / sqrtf(vs * (1.0f / HD) + EPS);
    const int row = n * CH + c;
#pragma unroll
    for (int eb = 0; eb < 2; ++eb)
#pragma unroll
        for (int g4 = 0; g4 < 4; ++g4) {
            const int e0 = 32 * eb + 8 * g4 + 4 * hi;
            const f32x4 gg = *(const f32x4*)(p.g_ret + l * WRET + h * HD + e0);
            const u32x2 gt = *(const u32x2*)(P + (size_t)row * PW + OGR + h * HD + e0);
            const float ga[4] = {u2f(gt[0] << 16), u2f(gt[0] & 0xffff0000u), u2f(gt[1] << 16), u2f(gt[1] & 0xffff0000u)};
            float v[4];
#pragma unroll
            for (int i = 0; i < 4; ++i) v[i] = o[eb][4 * g4 + i] * ri * gg[i] * ga[i];
            u32x2 ov; ov[0] = pk2(v[0], v[1]); ov[1] = pk2(v[2], v[3]);
            *(u32x2*)(MG + (size_t)row * MIXW + h * HD + e0) = ov;
        }
}
__device__ __forceinline__ void phase_retout(const Params& p, int l, float* ldsf) {
    const int wave = p.wid;
    lds_u8* wl = (lds_u8*)ldsf + wave * RET_WAVE_LDS;
    for (int it = blockIdx.x * NW + wave; it < NRET * NCHUNK * 2; it += gridDim.x * NW) ret_out_item(p, l, (it >> 1) / NCHUNK, (it >> 1) % NCHUNK, it & 1, wl);
}

struct OutprojSched {
    static constexpr bool GATHER = false;
    int wid;
    unsigned ao[4]; int vcu, G;
    static constexpr int NPM = S / GBM, NPN = D / GBM;
    __device__ __forceinline__ bool next(int i, GUnit& u) const {
        const int L = uni(i * G + vcu); if (L >= NPM * NPN) return false;
        const int pm = L / NPN, pn = L % NPN;
        u.A = (unsigned)(pm * GBM * MIXW * 2); u.B = (unsigned)(pn * GBM * MIXW * 2); u.ao[0] = u.ao[1] = u.ao[2] = u.ao[3] = 0u;
        u.i0 = pm; u.i1 = pn; u.i2 = 0; u.i3 = 0; return true;
    }
};
struct OutprojEpi {
    const float* xin32; const bf16_t* xin16; bf16_t* X;
    __device__ __forceinline__ void operator()(f32x4 (&acc)[2][2][4][2], const GUnit& u, int wr, int wc, int fr, int fq) const {
        const size_t o0 = (size_t)(u.i0 * GBM + wr * 64 + fr) * D + u.i1 * GBM + wc * 32 + 4 * fq;
#pragma unroll
        for (int ai = 0; ai < 2; ++ai)
#pragma unroll
            for (int mh = 0; mh < 2; ++mh) {
                f32x4 r[2][2][2];
#pragma unroll
                for (int mm = 0; mm < 2; ++mm)
#pragma unroll
                    for (int bj = 0; bj < 2; ++bj)
#pragma unroll
                        for (int n = 0; n < 2; ++n) { const size_t o = o0 + (size_t)(ai * 128 + (2 * mh + mm) * 16) * D + bj * 128 + n * 16;
                            if (xin32) r[mm][bj][n] = *(const f32x4*)(xin32 + o);
                            else { const u32x2 w = *(const u32x2*)(xin16 + o); r[mm][bj][n] = (f32x4){u2f(w[0] << 16), u2f(w[0] & 0xffff0000u), u2f(w[1] << 16), u2f(w[1] & 0xffff0000u)}; } }
#pragma unroll
                for (int mm = 0; mm < 2; ++mm)
#pragma unroll
                    for (int bj = 0; bj < 2; ++bj)
#pragma unroll
                        for (int n = 0; n < 2; ++n) { const f32x4 v = r[mm][bj][n] + acc[ai][bj][2 * mh + mm][n]; u32x2 ov; ov[0] = pk2(v[0], v[1]); ov[1] = pk2(v[2], v[3]);
                            *(u32x2*)(X + o0 + (size_t)(ai * 128 + (2 * mh + mm) * 16) * D + bj * 128 + n * 16) = ov; }
                sched_fence();
            }
    }
};
__device__ __forceinline__ void phase_outproj(const Params& p, int l, float* ldsf) {
    OutprojSched S; S.wid = p.wid; plain_ao(S.ao, MIXW, TIDX(p)); S.vcu = vcu_id(); S.G = gridDim.x;
    OutprojEpi E; E.X = (bf16_t*)(p.ws + WS_X); E.xin32 = l == 0 ? p.x : nullptr; E.xin16 = E.X;
    gemm_stream((lds_u8*)ldsf, (const char*)(p.ws + WS_MERGED), (const char*)(p.ws + WS_WOUT) + (size_t)l * D * MIXW * 2, MIXW, S, E);
}

constexpr int RW = D + 4;
constexpr int ROUTE_LDS = NROUTE * RW * 4 + 2 * NE * 4 + 2 * 256 * 4;
template <bool DRY = false>
__device__ __forceinline__ void phase_route(const Params& p, int l, float* lds) {
    const bf16_t* X = (const bf16_t*)(p.ws + WS_X);
    bf16_t* H = (bf16_t*)(p.ws + WS_H);
    unsigned* ctl = (unsigned*)(p.ws + WS_CTL);
    int* LIST = (int*)(p.ws + WS_LIST);
    float* GATE = (float*)(p.ws + WS_GATE);
    const float* gn = p.norm_ffn + l * D;
    const float* wg = p.w_group + (size_t)l * D * NG; const float* wr = p.w_router + (size_t)l * D * NE;
    const float* bg = p.b_group + l * NG; const float* br = p.b_router + l * NE;
    const int lane = lane_id(), wave = p.wid;
    const int tidx = TIDX(p);
    unsigned* lcnt = (unsigned*)(lds + NROUTE * RW); unsigned* lbase = lcnt + NE; unsigned* lrec = lbase + NE;
    __syncthreads();
    if (tidx < NE) lcnt[tidx] = 0u;
    {
        constexpr int NV4 = D * NE / 4 / NT;
        f32x4 t[NV4];
#pragma unroll
        for (int k = 0; k < NV4; ++k) t[k] = *(const f32x4*)(wr + (size_t)(tidx + k * NT) * 4);
        for (int i = tidx; i < D * NG; i += NT) lds[(i % NG) * RW + i / NG] = wg[i];
#pragma unroll
        for (int k = 0; k < NV4; ++k) { const int i = (tidx + k * NT) * 4, c = i / NE, e = i % NE;
#pragma unroll
            for (int j = 0; j < 4; ++j) lds[(NG + e + j) * RW + c] = t[k][j]; }
    }
    __syncthreads();
    f32x4 vn[RJ]; { const int r0 = blockIdx.x * NW + wave; if (r0 < S) row_load_bf16(X + (size_t)r0 * D, vn, lane); }
    for (int r = blockIdx.x * NW + wave; r < S; r += gridDim.x * NW) {
        f32x4 v[RJ];
#pragma unroll
        for (int j = 0; j < RJ; ++j) v[j] = vn[j];
        { const int rn = r + gridDim.x * NW; if (rn < S) row_load_bf16(X + (size_t)rn * D, vn, lane); }
        const float ri = row_rinv(v);
#pragma unroll
        for (int j = 0; j < RJ; ++j) {
            const f32x4 g = *(const f32x4*)(gn + 256 * j + lane * 4);
            v[j] = v[j] * ri * g;
            u32x2 o; o[0] = pk2(v[j][0], v[j][1]); o[1] = pk2(v[j][2], v[j][3]);
            *(u32x2*)(H + (size_t)r * D + 256 * j + lane * 4) = o;
        }
        float gl[NG];
#pragma unroll
        for (int g = 0; g < NG; ++g) { float s = 0.f;
#pragma unroll
            for (int j = 0; j < RJ; ++j) { const f32x4 w = *(const f32x4*)(lds + g * RW + 256 * j + lane * 4); s += (v[j][0] * w[0] + v[j][1] * w[1]) + (v[j][2] * w[2] + v[j][3] * w[3]); }
            gl[g] = s; }
#pragma unroll
        for (int g = 0; g < NG; ++g) gl[g] = wave_sum(gl[g]) + bg[g];
        int grp = 0; float gm = gl[0];
#pragma unroll
        for (int g = 1; g < NG; ++g) if (gl[g] > gm) { gm = gl[g]; grp = g; }
        float den = 0.f;
#pragma unroll
        for (int g = 0; g < NG; ++g) den += expf(gl[g] - gm);
        const float pg = 1.0f / den;
        float el[EPG];
        const float* wl = lds + (NG + grp * EPG) * RW + lane * 4;
#pragma unroll
        for (int e = 0; e < EPG; ++e) { float s = 0.f;
#pragma unroll
            for (int j = 0; j < RJ; ++j) { const f32x4 w = *(const f32x4*)(wl + e * RW + 256 * j); s += (v[j][0] * w[0] + v[j][1] * w[1]) + (v[j][2] * w[2] + v[j][3] * w[3]); }
            el[e] = s; }
#pragma unroll
        for (int e = 0; e < EPG; ++e) el[e] = wave_sum(el[e]) + br[grp * EPG + e];
        if (lane == 0 && !(DRY && el[0] != 12345.f)) {
            int i1 = 0; float v1 = -INFINITY; int i2 = 0; float v2 = -INFINITY;
#pragma unroll
            for (int e = 0; e < EPG; ++e) { const float x = el[e];
                if (x > v1) { v2 = v1; i2 = i1; v1 = x; i1 = e; } else if (x > v2) { v2 = x; i2 = e; } }
            const float e2 = expf(v2 - v1), g1 = pg / (1.f + e2), g2 = pg * e2 / (1.f + e2);
            const int ea = grp * EPG + i1, eb = grp * EPG + i2;
            GATE[(size_t)r * 2] = g1; GATE[(size_t)r * 2 + 1] = g2;
            const int li = (r - blockIdx.x * NW) / (gridDim.x * NW) * NW + wave;
            const unsigned ra = atomicAdd(lcnt + ea, 1u), rb = atomicAdd(lcnt + eb, 1u);
            lrec[2 * li] = (unsigned)ea | (ra << 8); lrec[2 * li + 1] = (unsigned)eb | (rb << 8);
        }
    }
    if (!DRY) {
        __syncthreads();
        if (tidx < NE) lbase[tidx] = atomicAdd(ctl + CTL_CNT + l * NE + tidx, lcnt[tidx]);
        __syncthreads();
        const int nrows = (S - blockIdx.x * NW + gridDim.x * NW - 1) / (gridDim.x * NW) * NW;
        for (int i = tidx; i < 2 * nrows; i += NT) {
            const int li = i >> 1, r = blockIdx.x * NW + (li / NW) * (gridDim.x * NW) + (li % NW);
            if (r < S) { const unsigned rec = lrec[i]; const int e = rec & 255u; LIST[(size_t)e * S + lbase[e] + (rec >> 8)] = r * 2 + (i & 1); }
        }
    }
}

__device__ __forceinline__ void moe_table(const unsigned* cnt, volatile LAS unsigned* tab, int tid) {
    __syncthreads();
    if (tid < 64) {
        const unsigned c = tid < NE ? cnt[tid] : 0u;
        unsigned nt = (c + GBM - 1) / GBM, inc = nt;
#pragma unroll
        for (int d = 1; d < 64; d <<= 1) { const unsigned o = (unsigned)__shfl_up((int)inc, d); if ((tid & 63) >= d) inc += o; }
        if (tid < NE) { tab[tid + 1] = inc; tab[64 + tid] = c; }
        if (tid == 0) tab[0] = 0u;
    }
    __syncthreads();
}
__device__ __forceinline__ bool moe_unit(volatile LAS unsigned* tab, int u, int npn, int& e, int& rt, int& pn, int& base, int& count) {
    const int tile = uni(u / npn); pn = uni(u % npn);
    if (tile >= (int)tab[NE]) return false;
    int lo = 0;
#pragma unroll
    for (int s = NE / 2; s >= 1; s >>= 1) if ((int)tab[lo + s] <= tile) lo += s;
    e = uni(lo); rt = tile - (int)tab[e]; base = (int)tab[e] * GBM; count = (int)tab[64 + e];
    rt = uni(rt); base = uni(base); count = uni(count);
    return true;
}
struct Moe1Sched {
    static constexpr bool GATHER = true;
    int wid;
    unsigned ao[4];
    volatile LAS unsigned* tab; const int* LIST; int vcu, G;
    static constexpr int NPN = 2 * DE / GBM;
    __device__ __forceinline__ bool next(int i, GUnit& u) const {
        int e, rt, pn, base, count; if (!moe_unit(tab, i * G + vcu, NPN, e, rt, pn, base, count)) return false;
        const int nvalid = count - rt * GBM;
        u.A = 0u; u.B = (unsigned)((e * 2 * DE + pn * GBM) * D * 2);
#pragma unroll
        for (int k = 0; k < 4; ++k) { int R, C; stage_rc(((wid << 6) | lane_id()) * 16 + (k & 1) * 8192, R, C); const int r = R + 128 * (k >> 1);
            const int tok = r < nvalid ? (LIST[(size_t)e * S + rt * GBM + r] >> 1) : 0; u.ao[k] = (unsigned)((tok * D + C) * 2); }
        u.i0 = base + rt * GBM; u.i1 = pn; u.i2 = nvalid; u.i3 = e * S + rt * GBM; return true;
    }
};
struct Moe1Epi {
    bf16_t* HID;
    __device__ __forceinline__ void operator()(f32x4 (&acc)[2][2][4][2], const GUnit& u, int wr, int wc, int fr, int fq) const {
#pragma unroll
        for (int ai = 0; ai < 2; ++ai)
#pragma unroll
            for (int m = 0; m < 4; ++m)
#pragma unroll
                for (int n = 0; n < 2; ++n) { f32x4 v;
#pragma unroll
                    for (int j = 0; j < 4; ++j) v[j] = silu(acc[ai][0][m][n][j]) * acc[ai][1][m][n][j];
                    u32x2 o; o[0] = pk2(v[0], v[1]); o[1] = pk2(v[2], v[3]);
                    *(u32x2*)(HID + (size_t)(u.i0 + ai * 128 + wr * 64 + m * 16 + fr) * DE + u.i1 * 128 + wc * 32 + n * 16 + 4 * fq) = o; }
    }
};
__device__ __forceinline__ void phase_moe1(const Params& p, int l, float* ldsf) {
    Moe1Sched S; S.wid = p.wid; S.tab = (volatile LAS unsigned*)((LAS unsigned char*)ldsf + GEMM_LDS);
    moe_table((const unsigned*)(p.ws + WS_CTL) + CTL_CNT + l * NE, S.tab, TIDX(p));
    S.LIST = (const int*)(p.ws + WS_LIST); S.vcu = vcu_id(); S.G = gridDim.x;
    Moe1Epi E; E.HID = (bf16_t*)(p.ws + WS_HID);
    gemm_stream((lds_u8*)ldsf, (const char*)(p.ws + WS_H), (const char*)(p.ws + WS_WGU) + (size_t)l * NE * 2 * DE * D * 2, D, S, E);
}
struct Moe2Sched {
    static constexpr bool GATHER = false;
    int wid;
    volatile LAS unsigned* tab; unsigned ao[4]; int vcu, G;
    static constexpr int NPN = D / GBM;
    __device__ __forceinline__ bool next(int i, GUnit& u) const {
        int e, rt, pn, base, count; if (!moe_unit(tab, i * G + vcu, NPN, e, rt, pn, base, count)) return false;
        u.A = (unsigned)((base + rt * GBM) * DE * 2); u.B = (unsigned)((e * D + pn * GBM) * DE * 2); u.ao[0] = u.ao[1] = u.ao[2] = u.ao[3] = 0u;
        u.i0 = 0; u.i1 = pn; u.i2 = count - rt * GBM; u.i3 = e * S + rt * GBM; return true;
    }
};
struct Moe2Epi {
    bf16_t* Y; const int* LIST; const float* GATE;
    __device__ __forceinline__ void operator()(f32x4 (&acc)[2][2][4][2], const GUnit& u, int wr, int wc, int fr, int fq) const {
        int a[2][4]; float g[2][4];
#pragma unroll
        for (int ai = 0; ai < 2; ++ai)
#pragma unroll
            for (int m = 0; m < 4; ++m) { const int r = ai * 128 + wr * 64 + m * 16 + fr; a[ai][m] = r < u.i2 ? LIST[(size_t)u.i3 + r] : -1; }
#pragma unroll
        for (int ai = 0; ai < 2; ++ai)
#pragma unroll
            for (int m = 0; m < 4; ++m) g[ai][m] = a[ai][m] >= 0 ? GATE[a[ai][m]] : 0.f;
#pragma unroll
        for (int ai = 0; ai < 2; ++ai)
#pragma unroll
            for (int m = 0; m < 4; ++m) {
                if (a[ai][m] >= 0) {
#pragma unroll
                    for (int bj = 0; bj < 2; ++bj)
#pragma unroll
                        for (int n = 0; n < 2; ++n) { const f32x4 v = acc[ai][bj][m][n] * g[ai][m]; u32x2 o; o[0] = pk2(v[0], v[1]); o[1] = pk2(v[2], v[3]);
                            *(u32x2*)(Y + (size_t)a[ai][m] * D + u.i1 * GBM + bj * 128 + wc * 32 + n * 16 + 4 * fq) = o; }
                }
            }
    }
};
__device__ __forceinline__ void phase_moe2(const Params& p, int l, float* ldsf) {
    Moe2Sched S; S.wid = p.wid; S.tab = (volatile LAS unsigned*)((LAS unsigned char*)ldsf + GEMM_LDS);
    moe_table((const unsigned*)(p.ws + WS_CTL) + CTL_CNT + l * NE, S.tab, TIDX(p));
    plain_ao(S.ao, DE, TIDX(p)); S.vcu = vcu_id(); S.G = gridDim.x;
    Moe2Epi E; E.Y = (bf16_t*)(p.ws + WS_Y); E.LIST = (const int*)(p.ws + WS_LIST); E.GATE = (const float*)(p.ws + WS_GATE);
    gemm_stream((lds_u8*)ldsf, (const char*)(p.ws + WS_HID), (const char*)(p.ws + WS_WDN) + (size_t)l * NE * D * DE * 2, DE, S, E);
}

__device__ __forceinline__ void phase_combine(const Params& p, int l) {
    bf16_t* X = (bf16_t*)(p.ws + WS_X);
    const bf16_t* Y = (const bf16_t*)(p.ws + WS_Y);
    bf16_t* H = (bf16_t*)(p.ws + WS_H);
    const bool last = (l == DEPTH - 1);
    float probe_scale = 1.0f;
#if !defined(CPU_EMU)
    if (PROBE_T >= 0) { const unsigned long long* ts = (const unsigned long long*)(p.ws + WS_CTL + 4 * 8000); const float us = (float)(ts[PROBE_T + 1] - ts[PROBE_T]) * 0.01f; probe_scale = 1.0f + sqrtf(us * 1e-6f); }
#endif
    const float* gn = last ? p.norm_final : p.norm_mix + (l + 1) * D;
    const int lane = lane_id(), wave = p.wid;
    for (int r = blockIdx.x * NW + wave; r < S; r += gridDim.x * NW) {
        f32x4 v[RJ]; row_load_bf16(X + (size_t)r * D, v, lane);
#pragma unroll
        for (int j = 0; j < RJ; ++j) {
            const u32x2 a = *(const u32x2*)(Y + (size_t)(2 * r) * D + 256 * j + lane * 4), b = *(const u32x2*)(Y + (size_t)(2 * r + 1) * D + 256 * j + lane * 4);
            v[j][0] += u2f(a[0] << 16) + u2f(b[0] << 16); v[j][1] += u2f(a[0] & 0xffff0000u) + u2f(b[0] & 0xffff0000u);
            v[j][2] += u2f(a[1] << 16) + u2f(b[1] << 16); v[j][3] += u2f(a[1] & 0xffff0000u) + u2f(b[1] & 0xffff0000u);
        }
        const float ri = row_rinv(v);
#pragma unroll
        for (int j = 0; j < RJ; ++j) {
            const f32x4 g = *(const f32x4*)(gn + 256 * j + lane * 4);
            if (last) *(f32x4*)(p.out + (size_t)r * D + 256 * j + lane * 4) = v[j] * ri * g * probe_scale;
            else {
                { u32x2 xo; xo[0] = pk2(v[j][0], v[j][1]); xo[1] = pk2(v[j][2], v[j][3]); *(u32x2*)(X + (size_t)r * D + 256 * j + lane * 4) = xo; }
                u32x2 o; o[0] = pk2(v[j][0] * ri * g[0], v[j][1] * ri * g[1]); o[1] = pk2(v[j][2] * ri * g[2], v[j][3] * ri * g[3]);
                *(u32x2*)(H + (size_t)r * D + 256 * j + lane * 4) = o;
            }
        }
    }
}

constexpr int PH_PER_LAYER = 9, NPHASE = 1 + DEPTH * PH_PER_LAYER;
constexpr int imax_c(int a, int b) { return a > b ? a : b; }
constexpr int LDS_MAIN = imax_c(imax_c(GEMM_LDS + 1024, ROUTE_LDS), imax_c(NW * RET_WAVE_LDS, NW * MIX_WAVE_LDS));
constexpr int LDS_MISC = (LDS_MAIN + 255) / 256 * 256;
constexpr int LDS_BYTES = LDS_MISC + 256;

__device__ __forceinline__ void run_phase(const Params& p, int ph, float* lds) {
    if (ph == 0) { phase_init(p, lds); return; }
    const int l = (ph - 1) / PH_PER_LAYER, q = (ph - 1) % PH_PER_LAYER;
    switch (q) {
        case 0: phase_inproj(p, l, lds); break;
        case 1: phase_prep(p, l, lds); break;
        case 2: phase_mix(p, l, lds); break;
        case 3: phase_retout(p, l, lds); break;
        case 4: phase_outproj(p, l, lds); break;
        case 5: phase_route(p, l, lds); break;
        case 6: phase_moe1(p, l, lds); break;
        case 7: phase_moe2(p, l, lds); break;
        default: phase_combine(p, l); break;
    }
}

#ifndef CPU_EMU
#define XB_TMO      128
#define XB_XCNT(j)  (256  + 64 * (j))
#define XB_XSUB(j)  (1280 + 64 * (j))
#define XB_XGEN(j)  (2304 + 64 * (j))
#define XB_TOP      3328
#define XB_TOPGEN   3392
#define XCD_BAR_WORDS 3456
#define XB_SPIN_CAP (1u << 22)
__device__ __forceinline__ unsigned xb_ld(unsigned* p)              { return __hip_atomic_load(p, __ATOMIC_RELAXED, __HIP_MEMORY_SCOPE_AGENT); }
__device__ __forceinline__ unsigned xb_add(unsigned* p, unsigned v) { return __hip_atomic_fetch_add(p, v, __ATOMIC_RELAXED, __HIP_MEMORY_SCOPE_AGENT); }
__device__ __forceinline__ unsigned xb_xcc_id() { return (unsigned)__builtin_amdgcn_s_getreg((3 << 11) | 20) & 0xFu; }
#define XB_SPIN(cond, bar) do { unsigned _sp = 0; while (cond) { __builtin_amdgcn_s_sleep(1); \
    if ((++_sp & 255u) == 0u) { if (xb_ld(&(bar)[XB_TMO])) break; if (_sp > XB_SPIN_CAP) { atomicAdd(&(bar)[XB_TMO], 1u); break; } } } } while (0)
struct XcdBarrier { unsigned* bar; unsigned x; volatile LAS unsigned* st; };
__device__ __forceinline__ XcdBarrier xcd_barrier_post(unsigned* bar, volatile LAS unsigned* st, bool t0) {
    XcdBarrier b; b.bar = bar; b.x = xb_xcc_id(); b.st = st;
    if (t0) (void)xb_add(&bar[XB_XCNT(b.x)], 1u);
    return b;
}
__device__ __forceinline__ void xcd_barrier_complete(unsigned* bar, unsigned x, unsigned& nloc, unsigned& nx) {
    const unsigned G = gridDim.x * gridDim.y * gridDim.z;
    unsigned sum, cnt, mine, sp = 0u;
    for (;;) {
        sum = 0u; cnt = 0u; mine = 0u;
#pragma unroll
        for (unsigned j = 0; j < 16; ++j) { const unsigned c = xb_ld(&bar[XB_XCNT(j)]); sum += c; cnt += (c > 0u) ? 1u : 0u; mine = (j == x) ? c : mine; }
        if (sum == G) break;
        __builtin_amdgcn_s_sleep(1);
        if ((++sp & 255u) == 0u) { if (xb_ld(&bar[XB_TMO])) break; if (sp > XB_SPIN_CAP) { atomicAdd(&bar[XB_TMO], 1u); break; } }
    }
    nloc = mine > 0u ? mine : 1u; nx = cnt > 0u ? cnt : 1u;
}
__device__ __forceinline__ void xcd_barrier(const XcdBarrier& b, bool t0) {
    asm volatile("s_waitcnt vmcnt(0)" ::: "memory");
    __syncthreads();
    if (t0) {
        unsigned* bar = b.bar;
        __builtin_amdgcn_s_waitcnt(0);
        unsigned nloc = b.st[0], nx = b.st[1];
        if (nloc == 0u) { xcd_barrier_complete(bar, b.x, nloc, nx); b.st[0] = nloc; b.st[1] = nx; }
        const unsigned old = xb_add(&bar[XB_XSUB(b.x)], 1u);
        const unsigned gen = old / nloc;
        if (old + 1u == (gen + 1u) * nloc) {
            __builtin_amdgcn_fence(__ATOMIC_RELEASE, "agent");
            asm volatile("s_waitcnt vmcnt(0)" ::: "memory");
            const unsigned og = xb_add(&bar[XB_TOP], 1u);
            const unsigned tg = og / nx;
            if (og + 1u == (tg + 1u) * nx) xb_add(&bar[XB_TOPGEN], 1u);
            else XB_SPIN(xb_ld(&bar[XB_TOPGEN]) == tg, bar);
            __builtin_amdgcn_fence(__ATOMIC_ACQUIRE, "agent");
            xb_add(&bar[XB_XGEN(b.x)], 1u);
            asm volatile("s_waitcnt vmcnt(0)" ::: "memory");
        } else {
            XB_SPIN(xb_ld(&bar[XB_XGEN(b.x)]) == gen, bar);
            __builtin_amdgcn_fence(__ATOMIC_ACQUIRE, "agent");
            asm volatile("s_waitcnt vmcnt(0)" ::: "memory");
        }
    }
    __syncthreads();
}
#endif
#ifndef CPU_EMU
__global__ void __launch_bounds__(NT) fwd_kernel(Params pin, int ph_lo, int ph_hi) {
    extern __shared__ __attribute__((aligned(16))) float lds[];
    cg::grid_group grid = cg::this_grid();
    Params p = pin; p.wid = uni((int)(threadIdx.x >> 6));
    volatile LAS unsigned* misc = (volatile LAS unsigned*)((LAS unsigned char*)lds + LDS_MISC);
    if (p.wid == 0) misc[lane_id()] = 0u;
    __syncthreads();
    XcdBarrier xb; xb.bar = (unsigned*)(p.ws + WS_CTL) + CTL_BAR; xb.x = 0; xb.st = misc;
    const bool use_xb = (ph_lo == 0);
#define T0() (p.wid == 0 && lane_id() == 0)
    if (use_xb) xb = xcd_barrier_post((unsigned*)(p.ws + WS_CTL) + CTL_BAR, misc, T0());
#define SEAM(k) do { if (!use_xb) grid.sync(); else xcd_barrier(xb, T0()); } while (0)
#define PHASE(k, call) do { if (ph_lo <= (k) && (k) < ph_hi) { if (PROBE_T >= 0 && blockIdx.x == 0 && T0()) ((unsigned long long*)(p.ws + WS_CTL + 4 * 8000))[k] = __builtin_amdgcn_s_memrealtime(); call; if ((k) + 1 < ph_hi) SEAM(k); } } while (0)
#ifndef PROBE_DUP
#define PROBE_DUP 0
#endif
#define DUP(bit, call) do { if ((PROBE_DUP & (bit)) && l_ == 0) { __syncthreads(); call; } } while (0)
#define LAYER(l) do { const int b_ = 1 + (l) * PH_PER_LAYER; const int l_ = (l); \
        PHASE(b_ + 0, phase_inproj(p, l, lds); DUP(1, phase_inproj(p, l, lds))); PHASE(b_ + 1, phase_prep(p, l, lds); DUP(2, phase_prep(p, l, lds))); PHASE(b_ + 2, phase_mix(p, l, lds); DUP(4, phase_mix(p, l, lds))); \
        PHASE(b_ + 3, phase_retout(p, l, lds); DUP(8, phase_retout(p, l, lds))); PHASE(b_ + 4, phase_outproj(p, l, lds); DUP(16, phase_outproj(p, l, lds))); PHASE(b_ + 5, phase_route(p, l, lds); DUP(128, phase_route<true>(p, l, lds))); \
        PHASE(b_ + 6, phase_moe1(p, l, lds); DUP(32, phase_moe1(p, l, lds))); PHASE(b_ + 7, phase_moe2(p, l, lds); DUP(64, phase_moe2(p, l, lds))); PHASE(b_ + 8, phase_combine(p, l); if ((PROBE_DUP & 256) && l_ == 1) phase_combine(p, l)); } while (0)
    PHASE(0, phase_init(p, lds); if (PROBE_DUP & 512) { __syncthreads(); phase_init(p, lds); });
    LAYER(0);
    LAYER(1);
    static_assert(DEPTH == 2, "phase program written for two layers");
#undef LAYER
#undef PHASE
#undef SEAM
}

#ifndef N_LAUNCH_PER_PHASE
#define N_LAUNCH_PER_PHASE 0
#endif
extern "C" void kernel_launch(void* const* d_in, const int* in_sizes, int n_in, void* d_out, int out_size, void* d_ws, size_t ws_size, hipStream_t stream) {
    static int grid = 0;
    if (grid == 0) {
        if (ws_size < WS_END) { fprintf(stderr, "kernel_launch: workspace too small (%zu < %zu)\n", ws_size, (size_t)WS_END); grid = -1; return; }
        int dev = 0, cus = 0, per_cu = 0;
        hipGetDevice(&dev);
        hipDeviceGetAttribute(&cus, hipDeviceAttributeMultiprocessorCount, dev);
        hipFuncSetAttribute((const void*)fwd_kernel, hipFuncAttributeMaxDynamicSharedMemorySize, LDS_BYTES);
        hipOccupancyMaxActiveBlocksPerMultiprocessor(&per_cu, (const void*)fwd_kernel, NT, LDS_BYTES);
        if (per_cu < 1) { fprintf(stderr, "kernel_launch: occupancy query says %d blocks per CU\n", per_cu); grid = -1; return; }
        grid = cus;
    }
    if (grid < 0) return;
    Params p{};
    p.x = (const float*)d_in[0]; p.norm_mix = (const float*)d_in[1]; p.w_in = (const float*)d_in[2]; p.b_forget = (const float*)d_in[3];
    p.g_ret = (const float*)d_in[4]; p.g_sb = (const float*)d_in[5]; p.g_fox = (const float*)d_in[6]; p.w_out = (const float*)d_in[7];
    p.norm_ffn = (const float*)d_in[8]; p.w_group = (const float*)d_in[9]; p.b_group = (const float*)d_in[10]; p.w_router = (const float*)d_in[11];
    p.b_router = (const float*)d_in[12]; p.w_gate = (const float*)d_in[13]; p.w_up = (const float*)d_in[14]; p.w_down = (const float*)d_in[15];
    p.norm_final = (const float*)d_in[16]; p.out = (float*)d_out; p.ws = (unsigned char*)d_ws;
#if N_LAUNCH_PER_PHASE
    for (int ph = 0; ph < NPHASE; ++ph) {
        int lo = ph, hi = ph + 1; void* args[] = {&p, &lo, &hi};
        hipLaunchCooperativeKernel((const void*)fwd_kernel, dim3(grid), dim3(NT), args, LDS_BYTES, stream);
    }
#else
    (void)hipMemsetAsync((char*)d_ws + WS_CTL + (size_t)CTL_BAR * 4, 0, 3456 * 4, stream);
    int lo = 0, hi = NPHASE; void* args[] = {&p, &lo, &hi};
    hipError_t e = hipLaunchCooperativeKernel((const void*)fwd_kernel, dim3(grid), dim3(NT), args, LDS_BYTES, stream);
    if (e != hipSuccess) fprintf(stderr, "cooperative launch failed: %s (grid %d)\n", hipGetErrorString(e), grid);
#endif
}
#endif
```

```cpp
#ifndef CPU_EMU
#include <hip/hip_runtime.h>
#include <hip/hip_cooperative_groups.h>
#include <cstdio>
#include <cstdint>
#include <cmath>
namespace cg = cooperative_groups;
#define VEC(T, N) T __attribute__((ext_vector_type(N)))
__device__ __forceinline__ void wave_barrier() { __builtin_amdgcn_wave_barrier(); }
__device__ __forceinline__ float sin2pi(float x) { return __builtin_amdgcn_sinf(x); }
__device__ __forceinline__ float cos2pi(float x) { return __builtin_amdgcn_cosf(x); }
__device__ __forceinline__ unsigned long long ballot64(bool p) { return __ballot(p); }
#define LAS __attribute__((address_space(3)))
typedef VEC(short, 8) bf16x8;
typedef VEC(float, 4) f32x4_;
__device__ __forceinline__ void glds16(const void* g, LAS unsigned char* l) { __builtin_amdgcn_global_load_lds((const unsigned*)g, (LAS unsigned*)l, 16, 0, 0); }
__device__ __forceinline__ void vm_wait0() { asm volatile("s_waitcnt vmcnt(0)" ::: "memory"); }
__device__ __forceinline__ void lds_wait0() { asm volatile("s_waitcnt lgkmcnt(0)" ::: "memory"); }
__device__ __forceinline__ void sched_fence() { __builtin_amdgcn_sched_barrier(0); }
__device__ __forceinline__ int uni(int x) { return __builtin_amdgcn_readfirstlane(x); }
__device__ __forceinline__ unsigned ld_relaxed(const unsigned* p) { return __hip_atomic_load(p, __ATOMIC_RELAXED, __HIP_MEMORY_SCOPE_AGENT); }
__device__ __forceinline__ int xcc_shard() { return (int)(__builtin_amdgcn_s_getreg((3 << 11) | 20) & 7u); }
__device__ __forceinline__ int lane_id() { int l; asm volatile("v_mbcnt_lo_u32_b32 %0, -1, 0\n\tv_mbcnt_hi_u32_b32 %0, -1, %0" : "=v"(l)); return l; }
__device__ __forceinline__ f32x4_ mfma16(bf16x8 a, bf16x8 b, f32x4_ c) { return __builtin_amdgcn_mfma_f32_16x16x32_bf16(a, b, c, 0, 0, 0); }
typedef VEC(float, 16) f32x16;
typedef VEC(short, 4) s16x4;
__device__ __forceinline__ f32x16 mfma32(bf16x8 a, bf16x8 b, f32x16 c) { return __builtin_amdgcn_mfma_f32_32x32x16_bf16(a, b, c, 0, 0, 0); }
__device__ __forceinline__ s16x4 tr16(const LAS unsigned char* p) { return __builtin_amdgcn_ds_read_tr16_b64_v4i16((LAS s16x4*)p); }
__device__ __forceinline__ float fast_exp(float x) { return __expf(x); }
__device__ __forceinline__ float fast_log(float x) { return __logf(x); }
__device__ __forceinline__ float partner32(float x, int hi) { const auto rr = __builtin_amdgcn_permlane32_swap(__builtin_bit_cast(unsigned, x), __builtin_bit_cast(unsigned, x), false, false); return __builtin_bit_cast(float, hi ? rr[0] : rr[1]); }
template <int N> __device__ __forceinline__ float row_shl_add(float x) { return x + __builtin_bit_cast(float, __builtin_amdgcn_update_dpp(0, __builtin_bit_cast(int, x), 0x100 + N, 0xf, 0xf, true)); }
__device__ __forceinline__ float read_lane(float x, int l) { return __builtin_bit_cast(float, __builtin_amdgcn_readlane(__builtin_bit_cast(int, x), l)); }
#else
#define VEC(T, N) T __attribute__((vector_size(sizeof(T) * N)))
inline float sin2pi(float x) { return (float)sin(6.283185307179586 * (double)x); }
inline float cos2pi(float x) { return (float)cos(6.283185307179586 * (double)x); }
inline unsigned long long ballot64(bool p) { return emu_ballot(p); }
#define LAS
typedef VEC(short, 8) bf16x8;
inline void glds16(const void* g, unsigned char* l) { memcpy(l + (threadIdx.x & 63) * 16, g, 16); }
inline void vm_wait0() {}
inline void lds_wait0() {}
inline void sched_fence() {}
inline int uni(int x) { return x; }
inline int xcc_shard() { return (int)(blockIdx.x & 7u); }
inline unsigned ld_relaxed(const unsigned* p) { return __atomic_load_n(p, __ATOMIC_RELAXED); }
inline int lane_id() { return threadIdx.x & 63; }
inline emu_f32x4 mfma16(bf16x8 a, bf16x8 b, emu_f32x4 c) { return emu_mfma16(a, b, c); }
typedef VEC(float, 16) f32x16;
typedef VEC(short, 4) s16x4;
inline f32x16 mfma32(bf16x8 a, bf16x8 b, f32x16 c) { return emu_mfma32(a, b, c); }
inline s16x4 tr16(const unsigned char* p) { return emu_tr16(p); }
inline float fast_exp(float x) { return expf(x); }
inline float fast_log(float x) { return logf(x); }
inline float partner32(float x, int hi) { return __shfl_xor(x, 32); }
template <int N> inline float row_shl_add(float x) { const int l = threadIdx.x & 63; const float o = emu_shfl_idx(x, (l + N) & 63); return x + (((l & 15) + N < 16) ? o : 0.f); }
inline float read_lane(float x, int l) { return emu_shfl_idx(x, l); }
#endif

typedef unsigned short bf16_t;
typedef VEC(float, 4) f32x4;
typedef VEC(float, 2) f32x2;
typedef VEC(unsigned, 2) u32x2;
typedef VEC(unsigned, 4) u32x4;
typedef LAS unsigned char lds_u8;

#ifndef PROBE_T
#define PROBE_T -1
#endif
#ifdef SMALL_CFG
constexpr int D = 256, S = 512, DEPTH = 2, NRET = 2, NSB = 1, NFOX = 1, NG = 2, EPG = 4, DE = 128;
#else
constexpr int D = 1024, S = 16384, DEPTH = 2, NRET = 6, NSB = 5, NFOX = 5, NG = 4, EPG = 8, DE = 512;
#endif
constexpr int CH = 64, HD = 64, NE = NG * EPG;
constexpr int WRET = NRET * HD, WSB = NSB * HD, WFOX = NFOX * HD, MIXW = WRET + WSB + WFOX;
constexpr int IN_W = 4 * WRET + 3 * WSB + 3 * WFOX + NFOX;
constexpr int PW = (IN_W + 255) / 256 * 256;
constexpr int OQR = 0, OKR = WRET, OVR = 2 * WRET, OGR = 3 * WRET, OQS = 4 * WRET, OKS = OQS + WSB, OVS = OKS + WSB;
constexpr int OQF = OVS + WSB, OKF = OQF + WFOX, OVF = OKF + WFOX, OFL = OVF + WFOX;
constexpr int NCHUNK = S / CH;
constexpr float EPS = 1e-6f;
constexpr int NT = 512, NW = NT / 64;
constexpr int NROUTE = NG + NE;
constexpr float EXIT_T = 18.0f;

constexpr size_t al256(size_t x) { return (x + 255) / 256 * 256; }
constexpr size_t WS_CTL = 0;
constexpr int CTL_CNT = 0;
constexpr int CTL_KMAX = 256;
constexpr int CTL_MQ = 4608, CTL_WQ = 4608 + DEPTH * 8 * 64;
constexpr int CTL_BAR = 1024;
constexpr int CTL_WORDS = 8192;
static_assert(CTL_BAR + 3456 <= CTL_MQ && CTL_WQ + DEPTH * 8 * 64 <= CTL_WORDS, "control-word map");
constexpr size_t WS_ROT = 32768;
constexpr size_t WS_X = al256(WS_ROT + (size_t)S * 32 * 8);
constexpr size_t WS_H = al256(WS_X + (size_t)S * D * 4);
constexpr size_t WS_LOGF = al256(WS_H + (size_t)S * D * 2);
constexpr size_t WS_FCUM = al256(WS_LOGF + (size_t)S * 8 * 4);
constexpr size_t WS_MERGED = al256(WS_FCUM + (size_t)S * 8 * 4);
constexpr size_t WS_U = al256(WS_MERGED + (size_t)S * MIXW * 2);
constexpr size_t WS_SP = al256(WS_U + (size_t)NRET * NCHUNK * 4096 * 4);
constexpr size_t WS_LIST = al256(WS_SP + (size_t)NRET * NCHUNK * 4096 * 4);
constexpr size_t WS_GATE = al256(WS_LIST + (size_t)NE * S * 4);
constexpr size_t WS_WIN = al256(WS_GATE + (size_t)S * 2 * 4);
constexpr size_t WS_WOUT = al256(WS_WIN + (size_t)DEPTH * PW * D * 2);
constexpr size_t WS_WGU = al256(WS_WOUT + (size_t)DEPTH * D * MIXW * 2);
constexpr size_t WS_WDN = al256(WS_WGU + (size_t)DEPTH * NE * 2 * DE * D * 2);
constexpr size_t WS_PROJ = al256(WS_WDN + (size_t)DEPTH * NE * D * DE * 2);
constexpr int HID_ROWS = 2 * S + NE * 256;
constexpr size_t WS_HID = WS_PROJ;
constexpr size_t WS_Y = al256(WS_HID + (size_t)HID_ROWS * DE * 2);
constexpr size_t WS_END0 = al256(WS_PROJ + (size_t)S * PW * 2), WS_END1 = al256(WS_Y + (size_t)2 * S * D * 2);
constexpr size_t WS_END = WS_END0 > WS_END1 ? WS_END0 : WS_END1;
#ifndef SMALL_CFG
static_assert(WS_END <= (size_t)512 * 1024 * 1024, "workspace map exceeds the guaranteed 512 MiB");
#endif

struct Params {
    const float* x; const float* norm_mix; const float* w_in; const float* b_forget; const float* g_ret; const float* g_sb; const float* g_fox;
    const float* w_out; const float* norm_ffn; const float* w_group; const float* b_group; const float* w_router; const float* b_router;
    const float* w_gate; const float* w_up; const float* w_down; const float* norm_final;
    float* out; unsigned char* ws;
    int wid, pad;
};

#define TIDX(p) (((p).wid << 6) | lane_id())
__device__ __forceinline__ int imin(int a, int b) { return a < b ? a : b; }
__device__ __forceinline__ float u2f(unsigned u) { return __builtin_bit_cast(float, u); }
__device__ __forceinline__ unsigned f2u(float f) { return __builtin_bit_cast(unsigned, f); }
__device__ __forceinline__ float bf2f(bf16_t b) { return u2f((unsigned)b << 16); }
__device__ __forceinline__ bf16_t f2bf(float f) { unsigned u = f2u(f); return (bf16_t)((u + 0x7fffu + ((u >> 16) & 1u)) >> 16); }
#ifndef CPU_EMU
typedef float pk_f32x2 __attribute__((ext_vector_type(2))); typedef __bf16 pk_bf16x2 __attribute__((ext_vector_type(2)));
__device__ __forceinline__ unsigned pk2(float lo, float hi) { const pk_f32x2 v = {lo, hi}; return __builtin_bit_cast(unsigned, __builtin_convertvector(v, pk_bf16x2)); }
#else
__device__ __forceinline__ unsigned pk2(float lo, float hi) { return (unsigned)f2bf(lo) | ((unsigned)f2bf(hi) << 16); }
#endif
__device__ __forceinline__ float log_sigmoid(float x) { return fminf(x, 0.f) - log1pf(expf(-fabsf(x))); }
__device__ __forceinline__ float silu(float x) { return x / (1.f + expf(-x)); }
#ifndef CPU_EMU
template <int CTRL> __device__ __forceinline__ float dpp_mov(float x) { return __builtin_bit_cast(float, __builtin_amdgcn_update_dpp(0, __builtin_bit_cast(int, x), CTRL, 0xf, 0xf, false)); }
__device__ __forceinline__ float wave_sum(float v) {
    v += dpp_mov<0xB1>(v); v += dpp_mov<0x4E>(v); v += dpp_mov<0x141>(v); v += dpp_mov<0x140>(v);
    return (read_lane(v, 0) + read_lane(v, 16)) + (read_lane(v, 32) + read_lane(v, 48));
}
__device__ __forceinline__ float wave_max(float v) {
    v = fmaxf(v, dpp_mov<0xB1>(v)); v = fmaxf(v, dpp_mov<0x4E>(v)); v = fmaxf(v, dpp_mov<0x141>(v)); v = fmaxf(v, dpp_mov<0x140>(v));
    return fmaxf(fmaxf(read_lane(v, 0), read_lane(v, 16)), fmaxf(read_lane(v, 32), read_lane(v, 48)));
}
#else
__device__ __forceinline__ float wave_sum(float v) {
#pragma unroll
    for (int o = 1; o < 64; o <<= 1) v += __shfl_xor(v, o);
    return v;
}
__device__ __forceinline__ float wave_max(float v) {
#pragma unroll
    for (int o = 1; o < 64; o <<= 1) v = fmaxf(v, __shfl_xor(v, o));
    return v;
}
#endif
__device__ __forceinline__ double inv_turns(int j) {
    static constexpr double T[32] = {
        1.59154943091895346e-01, 1.19349370211248862e-01, 8.94994016088910133e-02, 6.71150830052272551e-02, 5.03292121044870353e-02, 3.77415847174197711e-02, 2.83021958306233987e-02, 2.12236527647776604e-02,
        1.59154943091895339e-02, 1.19349370211248862e-02, 8.94994016088910237e-03, 6.71150830052272534e-03, 5.03292121044870370e-03, 3.77415847174197719e-03, 2.83021958306233987e-03, 2.12236527647776622e-03,
        1.59154943091895356e-03, 1.19349370211248849e-03, 8.94994016088910237e-04, 6.71150830052272599e-04, 5.03292121044870326e-04, 3.77415847174197741e-04, 2.83021958306233954e-04, 2.12236527647776605e-04,
        1.59154943091895351e-04, 1.19349370211248862e-04, 8.94994016088910182e-05, 6.71150830052272545e-05, 5.03292121044870354e-05, 3.77415847174197768e-05, 2.83021958306233961e-05, 2.12236527647776592e-05};
    return T[j];
}

constexpr int VROWB = 144;
constexpr int IMG64 = 64 * VROWB;
constexpr int RET_WAVE_LDS = 2 * IMG64;
__device__ __forceinline__ int crow(int reg, int hi) { return (reg & 3) + 8 * (reg >> 2) + 4 * hi; }
__device__ __forceinline__ bf16x8 tr_frag(const lds_u8* base, int rowoff0, int rowoff1, int coloff) {
    const s16x4 lo = tr16(base + rowoff0 * VROWB + coloff), hi4 = tr16(base + rowoff1 * VROWB + coloff);
    bf16x8 f; f[0] = lo[0]; f[1] = lo[1]; f[2] = lo[2]; f[3] = lo[3]; f[4] = hi4[0]; f[5] = hi4[1]; f[6] = hi4[2]; f[7] = hi4[3]; return f;
}

constexpr int RJ = D / 256;
__device__ __forceinline__ void row_load(const float* row, f32x4* v, int lane) {
#pragma unroll
    for (int j = 0; j < RJ; ++j) v[j] = *(const f32x4*)(row + 256 * j + lane * 4);
}
__device__ __forceinline__ void row_load_bf16(const bf16_t* row, f32x4* v, int lane) {
#pragma unroll
    for (int j = 0; j < RJ; ++j) { const u32x2 w = *(const u32x2*)(row + 256 * j + lane * 4); v[j][0] = u2f(w[0] << 16); v[j][1] = u2f(w[0] & 0xffff0000u); v[j][2] = u2f(w[1] << 16); v[j][3] = u2f(w[1] & 0xffff0000u); }
}
__device__ __forceinline__ float row_rinv(const f32x4* v) {
    float s = 0.f;
#pragma unroll
    for (int j = 0; j < RJ; ++j) s += (v[j][0] * v[j][0] + v[j][1] * v[j][1]) + (v[j][2] * v[j][2] + v[j][3] * v[j][3]);
    s = wave_sum(s);
    return 1.0f / sqrtf(s * (1.0f / D) + EPS);
}

#ifndef CPU_EMU
typedef float f32x4_u __attribute__((ext_vector_type(4), aligned(4)));
#else
typedef float f32x4_u __attribute__((vector_size(16), aligned(4)));
#endif
#ifndef CPU_EMU
__device__ __forceinline__ f32x4_u nt_load4(const f32x4_u* p) { return __builtin_nontemporal_load(p); }
#else
inline f32x4_u nt_load4(const f32x4_u* p) { return *p; }
#endif
struct TrDesc { const float* Wa; const float* Wb; int ldw, ncols, c0, cb0, k0; bf16_t* WT; int ldt, r0, r1; };
__device__ __forceinline__ void tr_load(const TrDesc& d, f32x4 (&v)[16], int lane) {
    const int n = 4 * (lane & 15), kr = lane >> 4;
    const float* src = (n < 32 ? d.Wa + d.c0 + n : d.Wb + d.cb0 + (n - 32)) + (size_t)(d.k0 + kr) * d.ldw;
    const int col = (n < 32 ? d.c0 + n : d.cb0 + n - 32);
    if (col + 3 < d.ncols) {
#pragma unroll
        for (int i = 0; i < 16; ++i) { const f32x4_u t = nt_load4((const f32x4_u*)(src + (size_t)(4 * i) * d.ldw)); v[i][0] = t[0]; v[i][1] = t[1]; v[i][2] = t[2]; v[i][3] = t[3]; }
    } else {
#pragma unroll
        for (int i = 0; i < 16; ++i)
#pragma unroll
            for (int j = 0; j < 4; ++j) v[i][j] = (col + j < d.ncols) ? src[(size_t)(4 * i) * d.ldw + j] : 0.f;
    }
}
__device__ __forceinline__ void tr_store(const TrDesc& d, const f32x4 (&v)[16], lds_u8* img, int lane) {
    const int n = 4 * (lane & 15), kr = lane >> 4;
    wave_barrier();
#pragma unroll
    for (int i = 0; i < 16; ++i) { u32x2 o; o[0] = pk2(v[i][0], v[i][1]); o[1] = pk2(v[i][2], v[i][3]); *(LAS u32x2*)(img + (4 * i + kr) * VROWB + n * 2) = o; }
    wave_barrier();
    const lds_u8* tb = img + ((lane & 15) >> 2) * VROWB + (16 * (lane >> 4) + 4 * (lane & 3)) * 2;
    const int x32 = lane & 31, pos32 = 16 * ((x32 >> 2) & 1) + 4 * (x32 >> 3) + (x32 & 3);
    bf16_t* dst = d.WT + (size_t)((lane < 32 ? d.r0 : d.r1) + pos32) * d.ldt + d.k0;
#pragma unroll
    for (int kc = 0; kc < 8; ++kc) {
        const s16x4 lo = tr16(tb + (8 * kc) * VROWB), hi4 = tr16(tb + (8 * kc + 4) * VROWB);
        u32x4 o; o[0] = (unsigned)(unsigned short)lo[0] | ((unsigned)(unsigned short)lo[1] << 16); o[1] = (unsigned)(unsigned short)lo[2] | ((unsigned)(unsigned short)lo[3] << 16);
        o[2] = (unsigned)(unsigned short)hi4[0] | ((unsigned)(unsigned short)hi4[1] << 16); o[3] = (unsigned)(unsigned short)hi4[2] | ((unsigned)(unsigned short)hi4[3] << 16);
        *(u32x4*)(dst + 8 * kc) = o;
    }
}
constexpr int WI_IN = (D / 64) * ((IN_W + 63) / 64), WI_OUT = (MIXW / 64) * (D / 64), WI_GU = (D / 64) * (DE / 32), WI_DN = (DE / 64) * (D / 64);
constexpr int WI_DENSE = WI_IN + WI_OUT, WI_EXPERT = WI_GU + WI_DN, WI_LAYER = WI_DENSE + NE * WI_EXPERT;
__device__ __forceinline__ TrDesc weight_desc(const Params& p, int l, int r) {
    if (r < WI_IN) { const int nb = (IN_W + 63) / 64, c0 = (r % nb) * 64; const float* W = p.w_in + (size_t)l * D * IN_W;
        const int r0 = (c0 / 256) * 256 + ((c0 % 256) / 64) * 32;
        return TrDesc{W, W, IN_W, IN_W, c0, c0 + 32, (r / nb) * 64, (bf16_t*)(p.ws + WS_WIN) + (size_t)l * PW * D, D, r0, r0 + 128}; }
    r -= WI_IN;
    if (r < WI_OUT) { const int nb = D / 64, c0 = (r % nb) * 64; const float* W = p.w_out + (size_t)l * MIXW * D;
        return TrDesc{W, W, D, D, c0, c0 + 32, (r / nb) * 64, (bf16_t*)(p.ws + WS_WOUT) + (size_t)l * D * MIXW, MIXW, c0, c0 + 32}; }
    r -= WI_OUT;
    const int e = r / WI_EXPERT; r %= WI_EXPERT;
    if (r < WI_GU) { const int nb = DE / 32, c0 = (r % nb) * 32;
        const int r0 = (c0 / 128) * 256 + (c0 % 128);
        return TrDesc{p.w_gate + (size_t)(l * NE + e) * D * DE, p.w_up + (size_t)(l * NE + e) * D * DE, DE, DE, c0, c0, (r / nb) * 64, (bf16_t*)(p.ws + WS_WGU) + (size_t)(l * NE + e) * 2 * DE * D, D, r0, r0 + 128}; }
    r -= WI_GU;
    { const int nb = D / 64, c0 = (r % nb) * 64; const float* W = p.w_down + (size_t)(l * NE + e) * DE * D;
        return TrDesc{W, W, D, D, c0, c0 + 32, (r / nb) * 64, (bf16_t*)(p.ws + WS_WDN) + (size_t)(l * NE + e) * D * DE, DE, c0, c0 + 32}; }
}
__device__ __forceinline__ void weight_item(const Params& p, int l, int r, lds_u8* img, int lane) { const TrDesc d = weight_desc(p, l, r); f32x4 v[16]; tr_load(d, v, lane); tr_store(d, v, img, lane); }
__device__ __forceinline__ void weight_item2(const Params& p, int l, int ra, int rb, lds_u8* img, int lane) {
    const TrDesc da = weight_desc(p, l, ra), db = weight_desc(p, l, rb); f32x4 va[16], vb[16];
    tr_load(da, va, lane); tr_load(db, vb, lane); tr_store(da, va, img, lane); tr_store(db, vb, img + IMG64, lane);
}
__device__ __forceinline__ void phase_init(const Params& p, float* lds) {
    unsigned* ctl = (unsigned*)(p.ws + WS_CTL);
    if (blockIdx.x == 0) for (int i = TIDX(p); i < 8000; i += NT) if (i < CTL_BAR || i >= CTL_BAR + 3456) ctl[i] = 0u;
    f32x2* rot = (f32x2*)(p.ws + WS_ROT);
    for (int i = blockIdx.x * NT + TIDX(p); i < S * 32; i += gridDim.x * NT) {
        const int pos = i >> 5, j = i & 31;
        const double turns = (double)pos * inv_turns(j);
        const double fr = turns - floor(turns);
        f32x2 cs; cs[0] = cos2pi((float)fr); cs[1] = sin2pi((float)fr);
        rot[i] = cs;
    }
    const int lane = lane_id(), wave = p.wid;
    {
        lds_u8* img = (lds_u8*)lds + wave * RET_WAVE_LDS;
        for (int it = blockIdx.x * NW + wave; it < DEPTH * WI_DENSE; it += gridDim.x * NW) weight_item(p, it / WI_DENSE, it % WI_DENSE, img, lane);
    }
    bf16_t* H = (bf16_t*)(p.ws + WS_H);
    for (int r = blockIdx.x * NW + wave; r < S; r += gridDim.x * NW) {
        f32x4 v[RJ]; row_load(p.x + (size_t)r * D, v, lane);
        const float ri = row_rinv(v);
#pragma unroll
        for (int j = 0; j < RJ; ++j) {
            const f32x4 g = *(const f32x4*)(p.norm_mix + 256 * j + lane * 4);
            u32x2 o; o[0] = pk2(v[j][0] * ri * g[0], v[j][1] * ri * g[1]); o[1] = pk2(v[j][2] * ri * g[2], v[j][3] * ri * g[3]);
            *(u32x2*)(H + (size_t)r * D + 256 * j + lane * 4) = o;
        }
    }
}

constexpr int GBM = 256, GBK = 64, TILE_B = GBM * GBK * 2, STAGE_B = 2 * TILE_B, GEMM_LDS = 2 * STAGE_B;
__device__ __forceinline__ int lds_byte(int r, int c) { const int st = (r >> 4) * 2 + (c >> 5), ob = (r & 15) * 64 + (c & 31) * 2; return st * 1024 + (ob ^ (((ob >> 9) & 1) << 5)); }
__device__ __forceinline__ void stage_rc(int b, int& R, int& C) { const int st = b >> 10, sb = b & 1023, swz = sb ^ (((sb >> 9) & 1) << 5); R = (st >> 1) * 16 + swz / 64; C = (st & 1) * 32 + (swz % 64) / 2; }
__device__ __forceinline__ int vcu_id() { const int G = gridDim.x, b = blockIdx.x; return (G % 8 == 0) ? (b % 8) * (G / 8) + b / 8 : b; }

constexpr int HTB = 128 * GBK * 2;
struct GUnit { unsigned A, B; unsigned ao[4]; int i0, i1, i2, i3; };
#ifndef CPU_EMU
#define G8_WAIT_V(n) asm volatile("s_waitcnt vmcnt(" #n ")" ::: "memory")
#define G8_WAIT_L0() asm volatile("s_waitcnt lgkmcnt(0)" ::: "memory")
#define G8_BAR() __builtin_amdgcn_s_barrier()
#define G8_PRIO(x) __builtin_amdgcn_s_setprio(x)
#else
#define G8_WAIT_V(n) do {} while (0)
#define G8_WAIT_L0() do {} while (0)
#define G8_BAR() __syncthreads()
#define G8_PRIO(x) do {} while (0)
#endif
template <class Sched, class Epi>
__device__ __forceinline__ void gemm_stream(lds_u8* lds, const char* Abase, const char* Bbase, const int K, Sched& S, const Epi& E) {
    const int wid = S.wid, lane = lane_id(), tid = (wid << 6) | lane, wr = wid >> 2, wc = wid & 3, fr = lane & 15, fq = lane >> 4;
    const int nt = K / GBK;
    unsigned voffB[2];
    { int R, C; stage_rc(tid * 16, R, C); voffB[0] = (unsigned)((R * K + C) * 2); stage_rc(tid * 16 + 8192, R, C); voffB[1] = (unsigned)((R * K + C) * 2); }
    const unsigned hstepB = (unsigned)(128 * K * 2);
    lds_u8* ldsw = lds + wid * 1024;
    const int aoff = lds_byte(wr * 64 + fr, fq * 8), boff = lds_byte(wc * 32 + fr, fq * 8);
#define G8_SA(b, h) (((b) * 2 + (h)) * HTB)
#define G8_SB(b, h) ((4 + (b) * 2 + (h)) * HTB)
#define G8_STAGE_A(b, h, U, kt) do { _Pragma("unroll") for (int i_ = 0; i_ < 2; ++i_) glds16(Abase + ((size_t)(U).A + (size_t)((kt) * (GBK * 2))) + (Sched::GATHER ? (U).ao[2 * (h) + i_] : S.ao[2 * (h) + i_]), ldsw + G8_SA(b, h) + i_ * 8192); } while (0)
#define G8_STAGE_B(b, h, U, kt) do { _Pragma("unroll") for (int i_ = 0; i_ < 2; ++i_) glds16(Bbase + ((size_t)(U).B + (size_t)((kt) * (GBK * 2)) + (size_t)(h) * hstepB) + voffB[i_], ldsw + G8_SB(b, h) + i_ * 8192); } while (0)
#define G8_LDA(dst, b, h) do { _Pragma("unroll") for (int m = 0; m < 4; ++m) _Pragma("unroll") for (int k = 0; k < 2; ++k) dst[m][k] = *(const LAS bf16x8*)(lds + G8_SA(b, h) + aoff + m * 2048 + k * 1024); } while (0)
#define G8_LDB(dst, b, h) do { _Pragma("unroll") for (int n = 0; n < 2; ++n) _Pragma("unroll") for (int k = 0; k < 2; ++k) dst[n][k] = *(const LAS bf16x8*)(lds + G8_SB(b, h) + boff + n * 2048 + k * 1024); } while (0)
#define G8_MMA(ai, bj, At_, Bt_) do { G8_PRIO(1); _Pragma("unroll") for (int m = 0; m < 4; ++m) _Pragma("unroll") for (int n = 0; n < 2; ++n) _Pragma("unroll") for (int k = 0; k < 2; ++k) \
        acc[ai][bj][m][n] = mfma16(Bt_[n][k], At_[m][k], acc[ai][bj][m][n]); G8_PRIO(0); } while (0)
    GUnit cur, nxt; int ui = 0;
    if (!S.next(0, cur)) return;
    f32x4 acc[2][2][4][2];
#pragma unroll
    for (int a = 0; a < 2; ++a)
#pragma unroll
        for (int b = 0; b < 2; ++b)
#pragma unroll
            for (int m = 0; m < 4; ++m)
#pragma unroll
                for (int n = 0; n < 2; ++n) acc[a][b][m][n] = (f32x4){0.f, 0.f, 0.f, 0.f};
    bf16x8 At[4][2], B0[2][2], B1[2][2];
    G8_STAGE_B(0, 0, cur, 0); G8_STAGE_B(0, 1, cur, 0); G8_STAGE_A(0, 0, cur, 0); G8_STAGE_A(0, 1, cur, 0);
    if (wr == 1) G8_BAR();
    G8_WAIT_V(2); G8_BAR();
    G8_STAGE_B(1, 0, cur, 1); G8_STAGE_A(1, 0, cur, 1); G8_STAGE_B(1, 1, cur, 1);
    G8_WAIT_V(6); G8_BAR();
    for (;;) {
        const bool has_next = S.next(ui + 1, nxt);
        if (!has_next) nxt = cur;
        for (int t = 0; t < nt; t += 2) {
            const bool last = (t == nt - 2);
            const GUnit& U2 = last ? nxt : cur;
            const int k2 = last ? 0 : t + 2, k3 = k2 + 1;
            G8_LDB(B0, 0, 0); G8_LDB(B1, 0, 1); sched_fence(); G8_LDA(At, 0, 0); G8_STAGE_A(1, 1, cur, t + 1);
            G8_WAIT_V(8); G8_WAIT_L0(); G8_BAR(); G8_MMA(0, 0, At, B0); G8_MMA(0, 1, At, B1); G8_BAR(); sched_fence();
            G8_LDA(At, 0, 1); G8_STAGE_B(0, 0, U2, k2); G8_STAGE_B(0, 1, U2, k2); G8_STAGE_A(0, 0, U2, k2);
            G8_WAIT_V(8); G8_WAIT_L0(); G8_BAR(); G8_MMA(1, 0, At, B0); G8_MMA(1, 1, At, B1); G8_BAR(); sched_fence();
            G8_LDB(B0, 1, 0); G8_LDB(B1, 1, 1); sched_fence(); G8_LDA(At, 1, 0); G8_STAGE_A(0, 1, U2, k2);
            G8_WAIT_V(8); G8_WAIT_L0(); G8_BAR(); G8_MMA(0, 0, At, B0); G8_MMA(0, 1, At, B1); G8_BAR(); sched_fence();
            G8_LDA(At, 1, 1); G8_STAGE_B(1, 0, U2, k3); G8_STAGE_B(1, 1, U2, k3); G8_STAGE_A(1, 0, U2, k3);
            G8_WAIT_V(8); G8_WAIT_L0(); G8_BAR(); G8_MMA(1, 0, At, B0); G8_MMA(1, 1, At, B1); G8_BAR(); sched_fence();
        }
        if (wr == 0) G8_BAR();
        E(acc, cur, wr, wc, fr, fq);
        if (!has_next) break;
#pragma unroll
        for (int a = 0; a < 2; ++a)
#pragma unroll
            for (int b = 0; b < 2; ++b)
#pragma unroll
                for (int m = 0; m < 4; ++m)
#pragma unroll
                    for (int n = 0; n < 2; ++n) acc[a][b][m][n] = (f32x4){0.f, 0.f, 0.f, 0.f};
        cur = nxt; ++ui;
        if (wr == 1) G8_BAR();
    }
    G8_WAIT_V(0);
    G8_BAR();
#undef G8_SA
#undef G8_SB
#undef G8_STAGE_A
#undef G8_STAGE_B
#undef G8_LDA
#undef G8_LDB
#undef G8_MMA
}
__device__ __forceinline__ void plain_ao(unsigned (&ao)[4], int K, int tid) {
    int R, C; stage_rc(tid * 16, R, C); ao[0] = (unsigned)((R * K + C) * 2); ao[2] = ao[0] + (unsigned)(128 * K * 2);
    stage_rc(tid * 16 + 8192, R, C); ao[1] = (unsigned)((R * K + C) * 2); ao[3] = ao[1] + (unsigned)(128 * K * 2);
}

struct InprojSched {
    static constexpr bool GATHER = false;
    int wid;
    unsigned ao[4]; int vcu, G;
    static constexpr int NPM = S / GBM, NPN = PW / GBM;
    __device__ __forceinline__ bool next(int i, GUnit& u) const {
        const int L = uni(i * G + vcu); if (L >= NPM * NPN) return false;
        constexpr int WGM = 8, nig = WGM * NPN;
        const int gid = L / nig, fm = gid * WGM, gsz = (NPM - fm) < WGM ? (NPM - fm) : WGM;
        const int pm = fm + (L % nig) % gsz, pn = (L % nig) / gsz;
        u.A = (unsigned)(pm * GBM * D * 2); u.B = (unsigned)(pn * GBM * D * 2); u.ao[0] = u.ao[1] = u.ao[2] = u.ao[3] = 0u;
        u.i0 = pm; u.i1 = pn; u.i2 = 0; u.i3 = 0; return true;
    }
};
struct InprojEpi {
    bf16_t* P; float* LOGF; unsigned* kmaxw; const f32x2* rot; const float* bfg;
    __device__ __forceinline__ void operator()(f32x4 (&acc)[2][2][4][2], const GUnit& u, int wr, int wc, int fr, int fq) const {
        const int gc0 = u.i1 * GBM + wc * 64;
        if (gc0 >= IN_W) return;
        const int row0 = u.i0 * GBM + wr * 64 + fr;
        if (gc0 >= OFL) {
#pragma unroll
            for (int ai = 0; ai < 2; ++ai)
#pragma unroll
                for (int m = 0; m < 4; ++m)
#pragma unroll
                    for (int n = 0; n < 2; ++n)
#pragma unroll
                        for (int j = 0; j < 4; ++j) { const int h = 4 * n + j; if (fq == 0 && h < NFOX) LOGF[(size_t)h * S + row0 + ai * 128 + m * 16] = log_sigmoid(acc[ai][0][m][n][j] + bfg[h]); }
            return;
        }
        const bool rotary = gc0 < OVR, is_gate = (gc0 >= OGR && gc0 < OQS), is_kf = (gc0 >= OKF && gc0 < OVF);
        const float scale = (gc0 < OKR || (gc0 >= OQS && gc0 < OKS) || (gc0 >= OQF && gc0 < OKF)) ? 0.125f : 1.0f;
        float kmx = 0.f;
        if (rotary) {
#pragma unroll
            for (int am = 0; am < 4; ++am) {
                const int ai = am >> 1, m0 = (am & 1) * 2;
                f32x4 c01[2][2], c23[2][2];
#pragma unroll
                for (int mm = 0; mm < 2; ++mm)
#pragma unroll
                    for (int n = 0; n < 2; ++n) { const f32x2* rp = rot + (size_t)(row0 + ai * 128 + (m0 + mm) * 16) * 32 + 8 * fq + 4 * n; c01[mm][n] = *(const f32x4*)rp; c23[mm][n] = *(const f32x4*)(rp + 2); }
#pragma unroll
                for (int mm = 0; mm < 2; ++mm)
#pragma unroll
                    for (int n = 0; n < 2; ++n) {
                        const int m = m0 + mm;
                        const float cs[4] = {c01[mm][n][0], c01[mm][n][2], c23[mm][n][0], c23[mm][n][2]}, sn[4] = {c01[mm][n][1], c01[mm][n][3], c23[mm][n][1], c23[mm][n][3]};
#pragma unroll
                        for (int j = 0; j < 4; ++j) { const float x1 = acc[ai][0][m][n][j], x2 = acc[ai][1][m][n][j]; acc[ai][0][m][n][j] = x1 * cs[j] - x2 * sn[j]; acc[ai][1][m][n][j] = x1 * sn[j] + x2 * cs[j]; }
                    }
                sched_fence();
            }
        }
#pragma unroll
        for (int ai = 0; ai < 2; ++ai)
#pragma unroll
            for (int m = 0; m < 4; ++m) {
                const int row = row0 + ai * 128 + m * 16;
                float ss = 0.f;
#pragma unroll
                for (int bj = 0; bj < 2; ++bj) {
                    u32x4 o;
#pragma unroll
                    for (int n = 0; n < 2; ++n) {
                        f32x4 v = acc[ai][bj][m][n] * scale;
                        if (is_gate) {
#pragma unroll
                            for (int j = 0; j < 4; ++j) v[j] = silu(v[j]);
                        }
                        o[2 * n] = pk2(v[0], v[1]); o[2 * n + 1] = pk2(v[2], v[3]);
                        if (is_kf) {
#pragma unroll
                            for (int j = 0; j < 4; ++j) { const float r = bf2f(f2bf(v[j])); ss += r * r; }
                        }
                    }
                    *(u32x4*)(P + (size_t)row * PW + gc0 + 32 * bj + 8 * fq) = o;
                }
                if (is_kf) { ss += __shfl_xor(ss, 16); ss += __shfl_xor(ss, 32); kmx = fmaxf(kmx, ss); }
            }
        if (is_kf) { kmx = wave_max(kmx); if (lane_id() == 0) atomicMax(kmaxw + (gc0 - OKF) / HD, f2u(kmx)); }
    }
};
__device__ __forceinline__ void phase_inproj(const Params& p, int l, float* ldsf) {
    InprojSched S; S.wid = p.wid; plain_ao(S.ao, D, TIDX(p)); S.vcu = vcu_id(); S.G = gridDim.x;
    InprojEpi E; E.P = (bf16_t*)(p.ws + WS_PROJ); E.LOGF = (float*)(p.ws + WS_LOGF); E.kmaxw = (unsigned*)(p.ws + WS_CTL) + CTL_KMAX + l * 8; E.rot = (const f32x2*)(p.ws + WS_ROT); E.bfg = p.b_forget + l * NFOX;
    gemm_stream((lds_u8*)ldsf, (const char*)(p.ws + WS_H), (const char*)(p.ws + WS_WIN) + (size_t)l * PW * D * 2, D, S, E);
}

__device__ __forceinline__ float ret_log_gamma(int h) { return logf(1.0f - exp2f(-5.0f - (float)h)); }
__device__ __forceinline__ void ret_prep_item(const Params& p, int h, int n, lds_u8* wl) {
    const bf16_t* P = (const bf16_t*)(p.ws + WS_PROJ);
    float* UT = (float*)(p.ws + WS_U);
    const int lane = lane_id(), r32 = lane & 31, hi = lane >> 5;
    const float lg = ret_log_gamma(h);
    wave_barrier();
#pragma unroll
    for (int i = 0; i < 8; ++i) {
        const int c = lane + 64 * i, row = c >> 3, ch = c & 7;
        const bf16_t* src = P + (size_t)(n * CH + row) * PW + h * HD + 8 * ch;
        const u32x4 kv = *(const u32x4*)(src + OKR), vv = *(const u32x4*)(src + OVR);
        const float dk = fast_exp(lg * (float)(CH - 1 - row));
        u32x4 ko;
#pragma unroll
        for (int w = 0; w < 4; ++w) ko[w] = pk2(u2f(kv[w] << 16) * dk, u2f(kv[w] & 0xffff0000u) * dk);
        *(LAS u32x4*)(wl + row * VROWB + ch * 16) = ko;
        *(LAS u32x4*)(wl + IMG64 + row * VROWB + ch * 16) = vv;
    }
    wave_barrier();
    const lds_u8* tb = wl + (8 * hi + ((lane & 15) >> 2)) * VROWB + (16 * ((lane >> 4) & 1) + 4 * (lane & 3)) * 2;
    f32x16 acc[2][2];
#pragma unroll
    for (int a = 0; a < 2; ++a)
#pragma unroll
        for (int b = 0; b < 2; ++b)
#pragma unroll
            for (int r = 0; r < 16; ++r) acc[a][b][r] = 0.f;
#pragma unroll
    for (int s = 0; s < 4; ++s) {
        bf16x8 vf[2], kf[2];
#pragma unroll
        for (int x = 0; x < 2; ++x) { kf[x] = tr_frag(tb, 16 * s, 16 * s + 4, x * 64); vf[x] = tr_frag(tb + IMG64, 16 * s, 16 * s + 4, x * 64); }
#pragma unroll
        for (int eb = 0; eb < 2; ++eb)
#pragma unroll
            for (int db = 0; db < 2; ++db) acc[eb][db] = mfma32(vf[eb], kf[db], acc[eb][db]);
    }
    float* dst = UT + (size_t)(h * NCHUNK + n) * 4096;
#pragma unroll
    for (int eb = 0; eb < 2; ++eb)
#pragma unroll
        for (int db = 0; db < 2; ++db)
#pragma unroll
            for (int r = 0; r < 16; ++r) dst[(32 * eb + crow(r, hi)) * 64 + 32 * db + r32] = acc[eb][db][r];
}
__device__ __forceinline__ void fcum_block(const Params& p, int h, float* ldsf) {
    const float* LF = (const float*)(p.ws + WS_LOGF) + (size_t)h * S;
    float* F = (float*)(p.ws + WS_FCUM) + (size_t)h * S;
    constexpr int KPT = S / NT;
    const int tid = TIDX(p), lane = lane_id(), w = p.wid;
    float v[KPT];
#pragma unroll
    for (int i = 0; i < KPT; ++i) v[i] = LF[tid * KPT + i];
#pragma unroll
    for (int i = 1; i < KPT; ++i) v[i] += v[i - 1];
    float inc = v[KPT - 1];
#pragma unroll
    for (int d = 1; d < 64; d <<= 1) { const float o = __shfl_up(inc, d); if (lane >= d) inc += o; }
    __syncthreads();
    if (lane == 63) ldsf[w] = inc;
    __syncthreads();
    float off = inc - v[KPT - 1];
    for (int ww = 0; ww < w; ++ww) off += ldsf[ww];
#pragma unroll
    for (int i = 0; i < KPT; ++i) F[tid * KPT + i] = v[i] + off;
    __syncthreads();
}
__device__ __forceinline__ void phase_prep(const Params& p, int l, float* ldsf) {
    if ((int)blockIdx.x < NFOX) fcum_block(p, (int)blockIdx.x, ldsf);
    const int wave = p.wid;
    lds_u8* wl = (lds_u8*)ldsf + wave * RET_WAVE_LDS;
    for (int it = blockIdx.x * NW + wave; it < NRET * NCHUNK; it += gridDim.x * NW) ret_prep_item(p, it / NCHUNK, it % NCHUNK, wl);
}

constexpr int NQ32 = S / 32;
constexpr int MIX_WAVE_LDS = 32 * VROWB;
__device__ __forceinline__ void ret_scan_wave(const Params& p, int item) {
    const float* U = (const float*)(p.ws + WS_U);
    bf16_t* SP = (bf16_t*)(p.ws + WS_SP);
    const int e = item * 64 + lane_id();
    const int h = e >> 12, de = e & 4095;
    const float c = expf(ret_log_gamma(h) * (float)CH);
    float st = 0.f;
    const size_t base = (size_t)h * NCHUNK * 4096 + de;
#pragma unroll 1
    for (int n0 = 0; n0 < NCHUNK; n0 += 32) {
        float u[32];
#pragma unroll
        for (int i = 0; i < 32; ++i) u[i] = (n0 + i < NCHUNK) ? U[base + (size_t)(n0 + i) * 4096] : 0.f;
#pragma unroll
        for (int i = 0; i < 32; ++i) if (n0 + i < NCHUNK) { SP[base + (size_t)(n0 + i) * 4096] = f2bf(st); st = st * c + u[i]; }
    }
}
template <bool FOX>
__device__ __forceinline__ void attn_item(const Params& p, int l, int h, int qb, lds_u8* wl) {
    const bf16_t* P = (const bf16_t*)(p.ws + WS_PROJ);
    const float* Fh = (const float*)(p.ws + WS_FCUM) + (size_t)h * S;
    bf16_t* MG = (bf16_t*)(p.ws + WS_MERGED);
    const int lane = lane_id(), r32 = lane & 31, hi = lane >> 5;
    const int q0 = qb * 32, t = q0 + r32;
    constexpr int oq = FOX ? OQF : OQS, ok = FOX ? OKF : OKS, ov = FOX ? OVF : OVS;
    bf16x8 qf[4];
    { const bf16_t* qp = P + (size_t)t * PW + oq + h * HD + 8 * hi;
#pragma unroll
      for (int ks = 0; ks < 4; ++ks) qf[ks] = *(const bf16x8*)(qp + 16 * ks); }
    float Bt = 0.f;
    if (FOX) {
        float qq = 0.f;
#pragma unroll
        for (int ks = 0; ks < 4; ++ks)
#pragma unroll
            for (int j = 0; j < 8; ++j) { const float v = bf2f((bf16_t)qf[ks][j]); qq += v * v; }
        qq += __shfl_xor(qq, 32);
        const float kmax = sqrtf(u2f(((const unsigned*)(p.ws + WS_CTL))[CTL_KMAX + l * 8 + h]));
        Bt = sqrtf(qq) * kmax * 1.0001f + 1e-6f;
    }
    const float fq = FOX ? Fh[t] : 0.f;
    float m = -1e30f, lsum = 0.f, carry = 0.f;
    f32x16 o0, o1;
#pragma unroll
    for (int r = 0; r < 16; ++r) { o0[r] = 0.f; o1[r] = 0.f; }
    const lds_u8* vb = wl + (4 * hi + ((lane & 15) >> 2)) * VROWB + (16 * ((lane >> 4) & 1) + 4 * (lane & 3)) * 2;
    bf16x8 kf1[4], kf2[4]; u32x4 vr1[4], vr2[4];
#define ATTN_LOAD(KF, VR, kt_) do { const int k0_ = (kt_) * 32; const bf16_t* kp_ = P + (size_t)(k0_ + r32) * PW + ok + h * HD + 8 * hi; \
        _Pragma("unroll") for (int ks = 0; ks < 4; ++ks) KF[ks] = *(const bf16x8*)(kp_ + 16 * ks); \
        _Pragma("unroll") for (int i = 0; i < 4; ++i) { const int c = lane + 64 * i; VR[i] = *(const u32x4*)(P + (size_t)(k0_ + (c >> 3)) * PW + ov + h * HD + 8 * (c & 7)); } \
        } while (0)
    ATTN_LOAD(kf1, vr1, qb);
    ATTN_LOAD(kf2, vr2, qb > 0 ? qb - 1 : 0);
    for (int kt = qb; kt >= 0; --kt) {
        const int key0 = kt * 32;
        const bool diag = (kt == qb);
        bf16x8 kf[4]; u32x4 vr[4];
#pragma unroll
        for (int ks = 0; ks < 4; ++ks) { kf[ks] = kf1[ks]; kf1[ks] = kf2[ks]; }
#pragma unroll
        for (int i = 0; i < 4; ++i) { vr[i] = vr1[i]; vr1[i] = vr2[i]; }
        ATTN_LOAD(kf2, vr2, kt > 1 ? kt - 2 : 0);
        f32x4 fk[4]; float fkm1 = 0.f;
        if (FOX) {
#pragma unroll
            for (int g4 = 0; g4 < 4; ++g4) fk[g4] = *(const f32x4*)(Fh + key0 + 8 * g4 + 4 * hi);
            fkm1 = Fh[key0 > 0 ? key0 - 1 : 0];
        }
        f32x16 st;
#pragma unroll
        for (int r = 0; r < 16; ++r) st[r] = 0.f;
#pragma unroll
        for (int ks = 0; ks < 4; ++ks) st = mfma32(kf[ks], qf[ks], st);
        wave_barrier();
#pragma unroll
        for (int i = 0; i < 4; ++i) { const int c = lane + 64 * i; *(LAS u32x4*)(wl + (c >> 3) * VROWB + (c & 7) * 16) = vr[i]; }
        if (FOX) {
            float tmax = -1e30f;
#pragma unroll
            for (int g4 = 0; g4 < 4; ++g4)
#pragma unroll
                for (int i = 0; i < 4; ++i) { const int r = 4 * g4 + i; st[r] = st[r] + (fq - fk[g4][i]); }
            if (diag) {
#pragma unroll
                for (int r = 0; r < 16; ++r) if (crow(r, hi) > r32) st[r] = -1e30f;
            }
#pragma unroll
            for (int r = 0; r < 16; ++r) tmax = fmaxf(tmax, st[r]);
            tmax = fmaxf(tmax, partner32(tmax, hi));
            const float mn = fmaxf(m, tmax), f = fast_exp(m - mn);
            m = mn; lsum *= f;
#pragma unroll
            for (int r = 0; r < 16; ++r) { o0[r] *= f; o1[r] *= f; }
            float ps = 0.f;
#pragma unroll
            for (int r = 0; r < 16; ++r) { const float pr = fast_exp(st[r] - mn); st[r] = pr; ps += pr; }
            lsum += ps;
        } else {
            float l1m[16];
#pragma unroll
            for (int r = 0; r < 16; ++r) {
                const float z = st[r], sp = fast_log(1.0f + fast_exp(-fabsf(z)));
                const float lb = fminf(z, 0.f) - sp;
                l1m[r] = lb - z;
                st[r] = lb;
            }
            if (diag) {
#pragma unroll
                for (int r = 0; r < 16; ++r) if (crow(r, hi) >= r32) { l1m[r] = 0.f; st[r] = -1e30f; }
            }
            float gs[4], pg[4], T[4];
#pragma unroll
            for (int k = 0; k < 4; ++k) { gs[k] = (l1m[4 * k] + l1m[4 * k + 1]) + (l1m[4 * k + 2] + l1m[4 * k + 3]); pg[k] = partner32(gs[k], hi); }
            float run = 0.f;
#pragma unroll
            for (int k = 3; k >= 0; --k) { T[k] = run + (hi == 0 ? pg[k] : 0.f); run += gs[k] + pg[k]; }
#pragma unroll
            for (int k = 0; k < 4; ++k) {
                float w = T[k] + carry;
#pragma unroll
                for (int i = 3; i >= 0; --i) { const int r = 4 * k + i; st[r] = fast_exp(st[r] + w); w += l1m[r]; }
            }
            carry += run;
        }
        u32x4 pw0, pw1;
#pragma unroll
        for (int j = 0; j < 4; ++j) { pw0[j] = pk2(st[2 * j], st[2 * j + 1]); pw1[j] = pk2(st[8 + 2 * j], st[9 + 2 * j]); }
        const bf16x8 pf0 = __builtin_bit_cast(bf16x8, pw0), pf1 = __builtin_bit_cast(bf16x8, pw1);
        wave_barrier();
#pragma unroll
        for (int s = 0; s < 2; ++s) {
#pragma unroll
            for (int db = 0; db < 2; ++db) {
                const s16x4 lo = tr16(vb + (16 * s) * VROWB + db * 64), hi4 = tr16(vb + (16 * s + 8) * VROWB + db * 64);
                bf16x8 vf; vf[0] = lo[0]; vf[1] = lo[1]; vf[2] = lo[2]; vf[3] = lo[3]; vf[4] = hi4[0]; vf[5] = hi4[1]; vf[6] = hi4[2]; vf[7] = hi4[3];
                if (db == 0) o0 = mfma32(vf, s == 0 ? pf0 : pf1, o0); else o1 = mfma32(vf, s == 0 ? pf0 : pf1, o1);
            }
        }
        const bool done = FOX ? (Bt + (fq - fkm1) - m + logf((float)(key0 + 1)) < -EXIT_T) : (carry < -EXIT_T);
        if (ballot64(done) == ~0ull) break;
    }
#undef ATTN_LOAD
    if (FOX) { lsum += __shfl_xor(lsum, 32); const float il = 1.0f / lsum;
#pragma unroll
        for (int r = 0; r < 16; ++r) { o0[r] *= il; o1[r] *= il; } }
    float ss = 0.f;
#pragma unroll
    for (int r = 0; r < 16; ++r) ss += o0[r] * o0[r] + o1[r] * o1[r];
    ss += __shfl_xor(ss, 32);
    const float ri = 1.0f / sqrtf(ss * (1.0f / HD) + EPS);
    const float* g = (FOX ? p.g_fox + l * WFOX : p.g_sb + l * WSB) + h * HD;
    bf16_t* dst = MG + (size_t)t * MIXW + (FOX ? WRET + WSB : WRET) + h * HD;
#pragma unroll
    for (int db = 0; db < 2; ++db)
#pragma unroll
        for (int g4 = 0; g4 < 4; ++g4) {
            const int d0 = db * 32 + 8 * g4 + 4 * hi;
            const f32x4 gg = *(const f32x4*)(g + d0);
            float v[4];
#pragma unroll
            for (int i = 0; i < 4; ++i) v[i] = (db == 0 ? o0[4 * g4 + i] : o1[4 * g4 + i]) * ri * gg[i];
            u32x2 o; o[0] = pk2(v[0], v[1]); o[1] = pk2(v[2], v[3]);
            *(u32x2*)(dst + d0) = o;
        }
}
constexpr int WCH = 2, NWCH = (NE * WI_EXPERT + WCH - 1) / WCH;
__device__ __forceinline__ bool mix_weight_step(const Params& p, int l, lds_u8* wl, int shard0, int& wsk) {
    unsigned* wbase = (unsigned*)(p.ws + WS_CTL) + CTL_WQ + 64 * (l * 8);
    const int lane = lane_id();
#pragma unroll 1
    while (wsk < 8) {
        const int shard = (shard0 + wsk) & 7;
        unsigned* head = wbase + 64 * shard;
        unsigned c = 0x0fffffffu;
        if (lane == 0) { if (!(wsk > 0 && (int)ld_relaxed(head) * 8 + shard >= NWCH)) c = atomicAdd(head, 1u); }
        const int chunk = uni((int)__shfl(c, 0)) * 8 + shard;
        if (chunk >= NWCH) { ++wsk; continue; }
        static_assert(WCH == 2 && (NE * WI_EXPERT) % 2 == 0, "two tiles per dequeue");
        weight_item2(p, l, WI_DENSE + chunk * 2, WI_DENSE + chunk * 2 + 1, wl, lane);
        return true;
    }
    return false;
}
__device__ __forceinline__ void phase_mix(const Params& p, int l, float* ldsf) {
    constexpr int NSCANW = NRET * 4096 / 64, NFXI = NFOX * NQ32, NSBI = NSB * NQ32;
    const int wave = p.wid;
    lds_u8* wl = (lds_u8*)ldsf + wave * RET_WAVE_LDS;
    static_assert(MIX_WAVE_LDS <= RET_WAVE_LDS, "per-wave LDS region");
    const int shard0 = xcc_shard();
    int wsk = 0;
    unsigned* qbase = (unsigned*)(p.ws + WS_CTL) + CTL_MQ + 64 * (l * 8);
    const float* bfg = p.b_forget + l * NFOX;
    constexpr int NMIX = NSCANW + NFXI + NSBI;
#pragma unroll 1
    for (int sk = 0; sk < 8; ++sk) {
      const int shard = (shard0 + sk) & 7;
      unsigned* qhead = qbase + 64 * shard;
#pragma unroll 1
      for (;;) {
        unsigned itu = 0;
        if (lane_id() == 0) { if (sk > 0 && (int)ld_relaxed(qhead) * 8 + shard >= NMIX) itu = 0x0fffffffu; else itu = atomicAdd(qhead, 1u); }
        const int it = uni((int)__shfl(itu, 0)) * 8 + shard;
        if (it >= NMIX) break;
        if (it < NSCANW) ret_scan_wave(p, it);
        else if (it < NSCANW + NFXI) {
            const int j = it - NSCANW, rank = j / NQ32;
            int h = 0;
#pragma unroll
            for (int c = 0; c < NFOX; ++c) { int rk = 0;
#pragma unroll
                for (int o = 0; o < NFOX; ++o) rk += (bfg[o] > bfg[c] || (bfg[o] == bfg[c] && o < c)) ? 1 : 0;
                if (rk == rank) h = c; }
            attn_item<true>(p, l, h, NQ32 - 1 - j % NQ32, wl);
        }
        else { const int j = it - NSCANW - NFXI; attn_item<false>(p, l, j % NSB, NQ32 - 1 - j / NSB, wl); }
        (void)mix_weight_step(p, l, wl, shard0, wsk);
      }
    }
    while (mix_weight_step(p, l, wl, shard0, wsk)) {}
}

__device__ __forceinline__ void ret_out_item(const Params& p, int l, int h, int n, int cb, lds_u8* wl) {
    const bf16_t* P = (const bf16_t*)(p.ws + WS_PROJ);
    const bf16_t* SPT = (const bf16_t*)(p.ws + WS_SP) + (size_t)(h * NCHUNK + n) * 4096;
    bf16_t* MG = (bf16_t*)(p.ws + WS_MERGED);
    const int lane = lane_id(), r32 = lane & 31, hi = lane >> 5;
    const float lg = ret_log_gamma(h);
    const size_t rowb = (size_t)(n * CH) * PW + h * HD;
    const int c = 32 * cb + r32;
    wave_barrier();
    {
        u32x4 vv[8];
#pragma unroll
        for (int i = 0; i < 8; ++i) { const int q = lane + 64 * i; vv[i] = *(const u32x4*)(P + rowb + (size_t)(q >> 3) * PW + OVR + 8 * (q & 7)); }
#pragma unroll
        for (int i = 0; i < 8; ++i) { const int q = lane + 64 * i; *(LAS u32x4*)(wl + (q >> 3) * VROWB + (q & 7) * 16) = vv[i]; }
    }
    sched_fence();
    bf16x8 qf[4];
#pragma unroll
    for (int ks = 0; ks < 4; ++ks) qf[ks] = *(const bf16x8*)(P + rowb + (size_t)c * PW + OQR + 16 * ks + 8 * hi);
    f32x16 o[2];
#pragma unroll
    for (int a = 0; a < 2; ++a)
#pragma unroll
        for (int r = 0; r < 16; ++r) o[a][r] = 0.f;
#pragma unroll
    for (int ks = 0; ks < 4; ++ks)
#pragma unroll
        for (int eb = 0; eb < 2; ++eb) { const bf16x8 sf = *(const bf16x8*)(SPT + (32 * eb + r32) * 64 + 16 * ks + 8 * hi); o[eb] = mfma32(sf, qf[ks], o[eb]); }
    { const float qd = fast_exp(lg * (float)(c + 1));
#pragma unroll
      for (int eb = 0; eb < 2; ++eb)
#pragma unroll
          for (int r = 0; r < 16; ++r) o[eb][r] *= qd; }
    wave_barrier();
    const lds_u8* vb = wl + (4 * hi + ((lane & 15) >> 2)) * VROWB + (16 * ((lane >> 4) & 1) + 4 * (lane & 3)) * 2;
#pragma unroll
    for (int kb = 0; kb < 2; ++kb) {
        f32x16 st;
#pragma unroll
        for (int r = 0; r < 16; ++r) st[r] = 0.f;
#pragma unroll
        for (int ks = 0; ks < 4; ++ks) { const bf16x8 kf = *(const bf16x8*)(P + rowb + (size_t)(32 * kb + r32) * PW + OKR + 16 * ks + 8 * hi); st = mfma32(kf, qf[ks], st); }
        bf16x8 pf[2];
#pragma unroll
        for (int r = 0; r < 16; ++r) { const int dist = c - (32 * kb + crow(r, hi)); st[r] *= fast_exp(lg * fabsf((float)dist)); }
        { u32x4 w0, w1;
#pragma unroll
          for (int j = 0; j < 4; ++j) { w0[j] = pk2(st[2 * j], st[2 * j + 1]); w1[j] = pk2(st[8 + 2 * j], st[9 + 2 * j]); }
          pf[0] = __builtin_bit_cast(bf16x8, w0); pf[1] = __builtin_bit_cast(bf16x8, w1); }
#pragma unroll
        for (int s = 0; s < 2; ++s)
#pragma unroll
            for (int eb = 0; eb < 2; ++eb) o[eb] = mfma32(tr_frag(vb, 32 * kb + 16 * s, 32 * kb + 16 * s + 8, eb * 64), pf[s], o[eb]);
    }
    float sm = 0.f;
#pragma unroll
    for (int eb = 0; eb < 2; ++eb)
#pragma unroll
        for (int r = 0; r < 16; ++r) sm += o[eb][r];
    sm += __shfl_xor(sm, 32);
    const float mu = sm * (1.0f / HD);
    float vs = 0.f;
#pragma unroll
    for (int eb = 0; eb < 2; ++eb)
#pragma unroll
        for (int r = 0; r < 16; ++r) { const float dlt = o[eb][r] - mu; o[eb][r] = dlt; vs += dlt * dlt; }
    vs += __shfl_xor(vs, 32);
    const float ri = 1.0f / sqrtf(vs * (1.0f / HD) + EPS);
    const int row = n * CH + c;
#pragma unroll
    for (int eb = 0; eb < 2; ++eb)
#pragma unroll
        for (int g4 = 0; g4 < 4; ++g4) {
            const int e0 = 32 * eb + 8 * g4 + 4 * hi;
            const f32x4 gg = *(const f32x4*)(p.g_ret + l * WRET + h * HD + e0);
            const u32x2 gt = *(const u32x2*)(P + (size_t)row * PW + OGR + h * HD + e0);
            const float ga[4] = {u2f(gt[0] << 16), u2f(gt[0] & 0xffff0000u), u2f(gt[1] << 16), u2f(gt[1] & 0xffff0000u)};
            float v[4];
#pragma unroll
            for (int i = 0; i < 4; ++i) v[i] = o[eb][4 * g4 + i] * ri * gg[i] * ga[i];
            u32x2 ov; ov[0] = pk2(v[0], v[1]); ov[1] = pk2(v[2], v[3]);
            *(u32x2*)(MG + (size_t)row * MIXW + h * HD + e0) = ov;
        }
}
__device__ __forceinline__ void phase_retout(const Params& p, int l, float* ldsf) {
    const int wave = p.wid;
    lds_u8* wl = (lds_u8*)ldsf + wave * RET_WAVE_LDS;
    for (int it = blockIdx.x * NW + wave; it < NRET * NCHUNK * 2; it += gridDim.x * NW) ret_out_item(p, l, (it >> 1) / NCHUNK, (it >> 1) % NCHUNK, it & 1, wl);
}

struct OutprojSched {
    static constexpr bool GATHER = false;
    int wid;
    unsigned ao[4]; int vcu, G;
    static constexpr int NPM = S / GBM, NPN = D / GBM;
    __device__ __forceinline__ bool next(int i, GUnit& u) const {
        const int L = uni(i * G + vcu); if (L >= NPM * NPN) return false;
        const int pm = L / NPN, pn = L % NPN;
        u.A = (unsigned)(pm * GBM * MIXW * 2); u.B = (unsigned)(pn * GBM * MIXW * 2); u.ao[0] = u.ao[1] = u.ao[2] = u.ao[3] = 0u;
        u.i0 = pm; u.i1 = pn; u.i2 = 0; u.i3 = 0; return true;
    }
};
struct OutprojEpi {
    const float* xin32; const bf16_t* xin16; bf16_t* X;
    __device__ __forceinline__ void operator()(f32x4 (&acc)[2][2][4][2], const GUnit& u, int wr, int wc, int fr, int fq) const {
        const size_t o0 = (size_t)(u.i0 * GBM + wr * 64 + fr) * D + u.i1 * GBM + wc * 32 + 8 * fq;
#pragma unroll
        for (int ai = 0; ai < 2; ++ai)
#pragma unroll
            for (int mh = 0; mh < 2; ++mh) {
                f32x4 r[2][2][2];
#pragma unroll
                for (int mm = 0; mm < 2; ++mm)
#pragma unroll
                    for (int bj = 0; bj < 2; ++bj) { const size_t o = o0 + (size_t)(ai * 128 + (2 * mh + mm) * 16) * D + bj * 128;
                        if (xin32) { r[mm][bj][0] = *(const f32x4*)(xin32 + o); r[mm][bj][1] = *(const f32x4*)(xin32 + o + 4); }
                        else { const u32x4 w = *(const u32x4*)(xin16 + o);
                            r[mm][bj][0] = (f32x4){u2f(w[0] << 16), u2f(w[0] & 0xffff0000u), u2f(w[1] << 16), u2f(w[1] & 0xffff0000u)};
                            r[mm][bj][1] = (f32x4){u2f(w[2] << 16), u2f(w[2] & 0xffff0000u), u2f(w[3] << 16), u2f(w[3] & 0xffff0000u)}; } }
#pragma unroll
                for (int mm = 0; mm < 2; ++mm)
#pragma unroll
                    for (int bj = 0; bj < 2; ++bj) { u32x4 ov;
#pragma unroll
                        for (int n = 0; n < 2; ++n) { const f32x4 v = r[mm][bj][n] + acc[ai][bj][2 * mh + mm][n]; ov[2 * n] = pk2(v[0], v[1]); ov[2 * n + 1] = pk2(v[2], v[3]); }
                        *(u32x4*)(X + o0 + (size_t)(ai * 128 + (2 * mh + mm) * 16) * D + bj * 128) = ov; }
                sched_fence();
            }
    }
};
__device__ __forceinline__ void phase_outproj(const Params& p, int l, float* ldsf) {
    OutprojSched S; S.wid = p.wid; plain_ao(S.ao, MIXW, TIDX(p)); S.vcu = vcu_id(); S.G = gridDim.x;
    OutprojEpi E; E.X = (bf16_t*)(p.ws + WS_X); E.xin32 = l == 0 ? p.x : nullptr; E.xin16 = E.X;
    gemm_stream((lds_u8*)ldsf, (const char*)(p.ws + WS_MERGED), (const char*)(p.ws + WS_WOUT) + (size_t)l * D * MIXW * 2, MIXW, S, E);
}

constexpr int RW = D + 4;
constexpr int ROUTE_LDS = NROUTE * RW * 4 + 2 * NE * 4 + 2 * 256 * 4;
template <bool DRY = false>
__device__ __forceinline__ void phase_route(const Params& p, int l, float* lds) {
    const bf16_t* X = (const bf16_t*)(p.ws + WS_X);
    bf16_t* H = (bf16_t*)(p.ws + WS_H);
    unsigned* ctl = (unsigned*)(p.ws + WS_CTL);
    int* LIST = (int*)(p.ws + WS_LIST);
    float* GATE = (float*)(p.ws + WS_GATE);
    const float* gn = p.norm_ffn + l * D;
    const float* wg = p.w_group + (size_t)l * D * NG; const float* wr = p.w_router + (size_t)l * D * NE;
    const float* bg = p.b_group + l * NG; const float* br = p.b_router + l * NE;
    const int lane = lane_id(), wave = p.wid;
    const int tidx = TIDX(p);
    unsigned* lcnt = (unsigned*)(lds + NROUTE * RW); unsigned* lbase = lcnt + NE; unsigned* lrec = lbase + NE;
    __syncthreads();
    if (tidx < NE) lcnt[tidx] = 0u;
    {
        constexpr int NV4 = D * NE / 4 / NT;
        f32x4 t[NV4];
#pragma unroll
        for (int k = 0; k < NV4; ++k) t[k] = *(const f32x4*)(wr + (size_t)(tidx + k * NT) * 4);
        for (int i = tidx; i < D * NG; i += NT) lds[(i % NG) * RW + i / NG] = wg[i];
#pragma unroll
        for (int k = 0; k < NV4; ++k) { const int i = (tidx + k * NT) * 4, c = i / NE, e = i % NE;
#pragma unroll
            for (int j = 0; j < 4; ++j) lds[(NG + e + j) * RW + c] = t[k][j]; }
    }
    __syncthreads();
    f32x4 vn[RJ]; { const int r0 = blockIdx.x * NW + wave; if (r0 < S) row_load_bf16(X + (size_t)r0 * D, vn, lane); }
    for (int r = blockIdx.x * NW + wave; r < S; r += gridDim.x * NW) {
        f32x4 v[RJ];
#pragma unroll
        for (int j = 0; j < RJ; ++j) v[j] = vn[j];
        { const int rn = r + gridDim.x * NW; if (rn < S) row_load_bf16(X + (size_t)rn * D, vn, lane); }
        const float ri = row_rinv(v);
#pragma unroll
        for (int j = 0; j < RJ; ++j) {
            const f32x4 g = *(const f32x4*)(gn + 256 * j + lane * 4);
            v[j] = v[j] * ri * g;
            u32x2 o; o[0] = pk2(v[j][0], v[j][1]); o[1] = pk2(v[j][2], v[j][3]);
            *(u32x2*)(H + (size_t)r * D + 256 * j + lane * 4) = o;
        }
        float gl[NG];
#pragma unroll
        for (int g = 0; g < NG; ++g) { float s = 0.f;
#pragma unroll
            for (int j = 0; j < RJ; ++j) { const f32x4 w = *(const f32x4*)(lds + g * RW + 256 * j + lane * 4); s += (v[j][0] * w[0] + v[j][1] * w[1]) + (v[j][2] * w[2] + v[j][3] * w[3]); }
            gl[g] = s; }
#pragma unroll
        for (int g = 0; g < NG; ++g) gl[g] = wave_sum(gl[g]) + bg[g];
        int grp = 0; float gm = gl[0];
#pragma unroll
        for (int g = 1; g < NG; ++g) if (gl[g] > gm) { gm = gl[g]; grp = g; }
        float den = 0.f;
#pragma unroll
        for (int g = 0; g < NG; ++g) den += expf(gl[g] - gm);
        const float pg = 1.0f / den;
        float el[EPG];
        const float* wl = lds + (NG + grp * EPG) * RW + lane * 4;
#pragma unroll
        for (int e = 0; e < EPG; ++e) { float s = 0.f;
#pragma unroll
            for (int j = 0; j < RJ; ++j) { const f32x4 w = *(const f32x4*)(wl + e * RW + 256 * j); s += (v[j][0] * w[0] + v[j][1] * w[1]) + (v[j][2] * w[2] + v[j][3] * w[3]); }
            el[e] = s; }
#pragma unroll
        for (int e = 0; e < EPG; ++e) el[e] = wave_sum(el[e]) + br[grp * EPG + e];
        if (lane == 0 && !(DRY && el[0] != 12345.f)) {
            int i1 = 0; float v1 = -INFINITY; int i2 = 0; float v2 = -INFINITY;
#pragma unroll
            for (int e = 0; e < EPG; ++e) { const float x = el[e];
                if (x > v1) { v2 = v1; i2 = i1; v1 = x; i1 = e; } else if (x > v2) { v2 = x; i2 = e; } }
            const float e2 = expf(v2 - v1), g1 = pg / (1.f + e2), g2 = pg * e2 / (1.f + e2);
            const int ea = grp * EPG + i1, eb = grp * EPG + i2;
            GATE[(size_t)r * 2] = g1; GATE[(size_t)r * 2 + 1] = g2;
            const int li = (r - blockIdx.x * NW) / (gridDim.x * NW) * NW + wave;
            const unsigned ra = atomicAdd(lcnt + ea, 1u), rb = atomicAdd(lcnt + eb, 1u);
            lrec[2 * li] = (unsigned)ea | (ra << 8); lrec[2 * li + 1] = (unsigned)eb | (rb << 8);
        }
    }
    if (!DRY) {
        __syncthreads();
        if (tidx < NE) lbase[tidx] = atomicAdd(ctl + CTL_CNT + l * NE + tidx, lcnt[tidx]);
        __syncthreads();
        const int nrows = (S - blockIdx.x * NW + gridDim.x * NW - 1) / (gridDim.x * NW) * NW;
        for (int i = tidx; i < 2 * nrows; i += NT) {
            const int li = i >> 1, r = blockIdx.x * NW + (li / NW) * (gridDim.x * NW) + (li % NW);
            if (r < S) { const unsigned rec = lrec[i]; const int e = rec & 255u; LIST[(size_t)e * S + lbase[e] + (rec >> 8)] = r * 2 + (i & 1); }
        }
    }
}

__device__ __forceinline__ void moe_table(const unsigned* cnt, volatile LAS unsigned* tab, int tid) {
    __syncthreads();
    if (tid < 64) {
        const unsigned c = tid < NE ? cnt[tid] : 0u;
        unsigned nt = (c + GBM - 1) / GBM, inc = nt;
#pragma unroll
        for (int d = 1; d < 64; d <<= 1) { const unsigned o = (unsigned)__shfl_up((int)inc, d); if ((tid & 63) >= d) inc += o; }
        if (tid < NE) { tab[tid + 1] = inc; tab[64 + tid] = c; }
        if (tid == 0) tab[0] = 0u;
    }
    __syncthreads();
}
__device__ __forceinline__ bool moe_unit(volatile LAS unsigned* tab, int u, int npn, int& e, int& rt, int& pn, int& base, int& count) {
    const int tile = uni(u / npn); pn = uni(u % npn);
    if (tile >= (int)tab[NE]) return false;
    int lo = 0;
#pragma unroll
    for (int s = NE / 2; s >= 1; s >>= 1) if ((int)tab[lo + s] <= tile) lo += s;
    e = uni(lo); rt = tile - (int)tab[e]; base = (int)tab[e] * GBM; count = (int)tab[64 + e];
    rt = uni(rt); base = uni(base); count = uni(count);
    return true;
}
struct Moe1Sched {
    static constexpr bool GATHER = true;
    int wid;
    unsigned ao[4];
    volatile LAS unsigned* tab; const int* LIST; int vcu, G;
    static constexpr int NPN = 2 * DE / GBM;
    __device__ __forceinline__ bool next(int i, GUnit& u) const {
        int e, rt, pn, base, count; if (!moe_unit(tab, i * G + vcu, NPN, e, rt, pn, base, count)) return false;
        const int nvalid = count - rt * GBM;
        u.A = 0u; u.B = (unsigned)((e * 2 * DE + pn * GBM) * D * 2);
#pragma unroll
        for (int k = 0; k < 4; ++k) { int R, C; stage_rc(((wid << 6) | lane_id()) * 16 + (k & 1) * 8192, R, C); const int r = R + 128 * (k >> 1);
            const int tok = r < nvalid ? (LIST[(size_t)e * S + rt * GBM + r] >> 1) : 0; u.ao[k] = (unsigned)((tok * D + C) * 2); }
        u.i0 = base + rt * GBM; u.i1 = pn; u.i2 = nvalid; u.i3 = e * S + rt * GBM; return true;
    }
};
struct Moe1Epi {
    bf16_t* HID;
    __device__ __forceinline__ void operator()(f32x4 (&acc)[2][2][4][2], const GUnit& u, int wr, int wc, int fr, int fq) const {
#pragma unroll
        for (int ai = 0; ai < 2; ++ai)
#pragma unroll
            for (int m = 0; m < 4; ++m)
{ u32x4 o;
#pragma unroll
                for (int n = 0; n < 2; ++n) { f32x4 v;
#pragma unroll
                    for (int j = 0; j < 4; ++j) v[j] = silu(acc[ai][0][m][n][j]) * acc[ai][1][m][n][j];
                    o[2 * n] = pk2(v[0], v[1]); o[2 * n + 1] = pk2(v[2], v[3]); }
                *(u32x4*)(HID + (size_t)(u.i0 + ai * 128 + wr * 64 + m * 16 + fr) * DE + u.i1 * 128 + wc * 32 + 8 * fq) = o; }
    }
};
__device__ __forceinline__ void phase_moe1(const Params& p, int l, float* ldsf) {
    Moe1Sched S; S.wid = p.wid; S.tab = (volatile LAS unsigned*)((LAS unsigned char*)ldsf + GEMM_LDS);
    moe_table((const unsigned*)(p.ws + WS_CTL) + CTL_CNT + l * NE, S.tab, TIDX(p));
    S.LIST = (const int*)(p.ws + WS_LIST); S.vcu = vcu_id(); S.G = gridDim.x;
    Moe1Epi E; E.HID = (bf16_t*)(p.ws + WS_HID);
    gemm_stream((lds_u8*)ldsf, (const char*)(p.ws + WS_H), (const char*)(p.ws + WS_WGU) + (size_t)l * NE * 2 * DE * D * 2, D, S, E);
}
struct Moe2Sched {
    static constexpr bool GATHER = false;
    int wid;
    volatile LAS unsigned* tab; unsigned ao[4]; int vcu, G;
    static constexpr int NPN = D / GBM;
    __device__ __forceinline__ bool next(int i, GUnit& u) const {
        int e, rt, pn, base, count; if (!moe_unit(tab, i * G + vcu, NPN, e, rt, pn, base, count)) return false;
        u.A = (unsigned)((base + rt * GBM) * DE * 2); u.B = (unsigned)((e * D + pn * GBM) * DE * 2); u.ao[0] = u.ao[1] = u.ao[2] = u.ao[3] = 0u;
        u.i0 = 0; u.i1 = pn; u.i2 = count - rt * GBM; u.i3 = e * S + rt * GBM; return true;
    }
};
struct Moe2Epi {
    bf16_t* Y; const int* LIST; const float* GATE;
    __device__ __forceinline__ void operator()(f32x4 (&acc)[2][2][4][2], const GUnit& u, int wr, int wc, int fr, int fq) const {
        int a[2][4]; float g[2][4];
#pragma unroll
        for (int ai = 0; ai < 2; ++ai)
#pragma unroll
            for (int m = 0; m < 4; ++m) { const int r = ai * 128 + wr * 64 + m * 16 + fr; a[ai][m] = r < u.i2 ? LIST[(size_t)u.i3 + r] : -1; }
#pragma unroll
        for (int ai = 0; ai < 2; ++ai)
#pragma unroll
            for (int m = 0; m < 4; ++m) g[ai][m] = a[ai][m] >= 0 ? GATE[a[ai][m]] : 0.f;
#pragma unroll
        for (int ai = 0; ai < 2; ++ai)
#pragma unroll
            for (int m = 0; m < 4; ++m) {
                if (a[ai][m] >= 0) {
#pragma unroll
                    for (int bj = 0; bj < 2; ++bj) { u32x4 o;
#pragma unroll
                        for (int n = 0; n < 2; ++n) { const f32x4 v = acc[ai][bj][m][n] * g[ai][m]; o[2 * n] = pk2(v[0], v[1]); o[2 * n + 1] = pk2(v[2], v[3]); }
                        *(u32x4*)(Y + (size_t)a[ai][m] * D + u.i1 * GBM + bj * 128 + wc * 32 + 8 * fq) = o; }
                }
            }
    }
};
__device__ __forceinline__ void phase_moe2(const Params& p, int l, float* ldsf) {
    Moe2Sched S; S.wid = p.wid; S.tab = (volatile LAS unsigned*)((LAS unsigned char*)ldsf + GEMM_LDS);
    moe_table((const unsigned*)(p.ws + WS_CTL) + CTL_CNT + l * NE, S.tab, TIDX(p));
    plain_ao(S.ao, DE, TIDX(p)); S.vcu = vcu_id(); S.G = gridDim.x;
    Moe2Epi E; E.Y = (bf16_t*)(p.ws + WS_Y); E.LIST = (const int*)(p.ws + WS_LIST); E.GATE = (const float*)(p.ws + WS_GATE);
    gemm_stream((lds_u8*)ldsf, (const char*)(p.ws + WS_HID), (const char*)(p.ws + WS_WDN) + (size_t)l * NE * D * DE * 2, DE, S, E);
}

__device__ __forceinline__ void phase_combine(const Params& p, int l) {
    bf16_t* X = (bf16_t*)(p.ws + WS_X);
    const bf16_t* Y = (const bf16_t*)(p.ws + WS_Y);
    bf16_t* H = (bf16_t*)(p.ws + WS_H);
    const bool last = (l == DEPTH - 1);
    float probe_scale = 1.0f;
#if !defined(CPU_EMU)
    if (PROBE_T >= 0) { const unsigned long long* ts = (const unsigned long long*)(p.ws + WS_CTL + 4 * 8000); const float us = (float)(ts[PROBE_T + 1] - ts[PROBE_T]) * 0.01f; probe_scale = 1.0f + sqrtf(us * 1e-6f); }
#endif
    const float* gn = last ? p.norm_final : p.norm_mix + (l + 1) * D;
    const int lane = lane_id(), wave = p.wid;
    for (int r = blockIdx.x * NW + wave; r < S; r += gridDim.x * NW) {
        f32x4 v[RJ]; row_load_bf16(X + (size_t)r * D, v, lane);
#pragma unroll
        for (int j = 0; j < RJ; ++j) {
            const u32x2 a = *(const u32x2*)(Y + (size_t)(2 * r) * D + 256 * j + lane * 4), b = *(const u32x2*)(Y + (size_t)(2 * r + 1) * D + 256 * j + lane * 4);
            v[j][0] += u2f(a[0] << 16) + u2f(b[0] << 16); v[j][1] += u2f(a[0] & 0xffff0000u) + u2f(b[0] & 0xffff0000u);
            v[j][2] += u2f(a[1] << 16) + u2f(b[1] << 16); v[j][3] += u2f(a[1] & 0xffff0000u) + u2f(b[1] & 0xffff0000u);
        }
        const float ri = row_rinv(v);
#pragma unroll
        for (int j = 0; j < RJ; ++j) {
            const f32x4 g = *(const f32x4*)(gn + 256 * j + lane * 4);
            if (last) *(f32x4*)(p.out + (size_t)r * D + 256 * j + lane * 4) = v[j] * ri * g * probe_scale;
            else {
                { u32x2 xo; xo[0] = pk2(v[j][0], v[j][1]); xo[1] = pk2(v[j][2], v[j][3]); *(u32x2*)(X + (size_t)r * D + 256 * j + lane * 4) = xo; }
                u32x2 o; o[0] = pk2(v[j][0] * ri * g[0], v[j][1] * ri * g[1]); o[1] = pk2(v[j][2] * ri * g[2], v[j][3] * ri * g[3]);
                *(u32x2*)(H + (size_t)r * D + 256 * j + lane * 4) = o;
            }
        }
    }
}

constexpr int PH_PER_LAYER = 9, NPHASE = 1 + DEPTH * PH_PER_LAYER;
constexpr int imax_c(int a, int b) { return a > b ? a : b; }
constexpr int LDS_MAIN = imax_c(imax_c(GEMM_LDS + 1024, ROUTE_LDS), imax_c(NW * RET_WAVE_LDS, NW * MIX_WAVE_LDS));
constexpr int LDS_MISC = (LDS_MAIN + 255) / 256 * 256;
constexpr int LDS_BYTES = LDS_MISC + 256;

__device__ __forceinline__ void run_phase(const Params& p, int ph, float* lds) {
    if (ph == 0) { phase_init(p, lds); return; }
    const int l = (ph - 1) / PH_PER_LAYER, q = (ph - 1) % PH_PER_LAYER;
    switch (q) {
        case 0: phase_inproj(p, l, lds); break;
        case 1: phase_prep(p, l, lds); break;
        case 2: phase_mix(p, l, lds); break;
        case 3: phase_retout(p, l, lds); break;
        case 4: phase_outproj(p, l, lds); break;
        case 5: phase_route(p, l, lds); break;
        case 6: phase_moe1(p, l, lds); break;
        case 7: phase_moe2(p, l, lds); break;
        default: phase_combine(p, l); break;
    }
}

#ifndef CPU_EMU
#define XB_TMO      128
#define XB_XCNT(j)  (256  + 64 * (j))
#define XB_XSUB(j)  (1280 + 64 * (j))
#define XB_XGEN(j)  (2304 + 64 * (j))
#define XB_TOP      3328
#define XB_TOPGEN   3392
#define XCD_BAR_WORDS 3456
#define XB_SPIN_CAP (1u << 22)
__device__ __forceinline__ unsigned xb_ld(unsigned* p)              { return __hip_atomic_load(p, __ATOMIC_RELAXED, __HIP_MEMORY_SCOPE_AGENT); }
__device__ __forceinline__ unsigned xb_add(unsigned* p, unsigned v) { return __hip_atomic_fetch_add(p, v, __ATOMIC_RELAXED, __HIP_MEMORY_SCOPE_AGENT); }
__device__ __forceinline__ unsigned xb_xcc_id() { return (unsigned)__builtin_amdgcn_s_getreg((3 << 11) | 20) & 0xFu; }
#define XB_SPIN(cond, bar) do { unsigned _sp = 0; while (cond) { __builtin_amdgcn_s_sleep(1); \
    if ((++_sp & 255u) == 0u) { if (xb_ld(&(bar)[XB_TMO])) break; if (_sp > XB_SPIN_CAP) { atomicAdd(&(bar)[XB_TMO], 1u); break; } } } } while (0)
struct XcdBarrier { unsigned* bar; unsigned x; volatile LAS unsigned* st; };
__device__ __forceinline__ XcdBarrier xcd_barrier_post(unsigned* bar, volatile LAS unsigned* st, bool t0) {
    XcdBarrier b; b.bar = bar; b.x = xb_xcc_id(); b.st = st;
    if (t0) (void)xb_add(&bar[XB_XCNT(b.x)], 1u);
    return b;
}
__device__ __forceinline__ void xcd_barrier_complete(unsigned* bar, unsigned x, unsigned& nloc, unsigned& nx) {
    const unsigned G = gridDim.x * gridDim.y * gridDim.z;
    unsigned sum, cnt, mine, sp = 0u;
    for (;;) {
        sum = 0u; cnt = 0u; mine = 0u;
#pragma unroll
        for (unsigned j = 0; j < 16; ++j) { const unsigned c = xb_ld(&bar[XB_XCNT(j)]); sum += c; cnt += (c > 0u) ? 1u : 0u; mine = (j == x) ? c : mine; }
        if (sum == G) break;
        __builtin_amdgcn_s_sleep(1);
        if ((++sp & 255u) == 0u) { if (xb_ld(&bar[XB_TMO])) break; if (sp > XB_SPIN_CAP) { atomicAdd(&bar[XB_TMO], 1u); break; } }
    }
    nloc = mine > 0u ? mine : 1u; nx = cnt > 0u ? cnt : 1u;
}
__device__ __forceinline__ void xcd_barrier(const XcdBarrier& b, bool t0) {
    asm volatile("s_waitcnt vmcnt(0)" ::: "memory");
    __syncthreads();
    if (t0) {
        unsigned* bar = b.bar;
        __builtin_amdgcn_s_waitcnt(0);
        unsigned nloc = b.st[0], nx = b.st[1];
        if (nloc == 0u) { xcd_barrier_complete(bar, b.x, nloc, nx); b.st[0] = nloc; b.st[1] = nx; }
        const unsigned old = xb_add(&bar[XB_XSUB(b.x)], 1u);
        const unsigned gen = old / nloc;
        if (old + 1u == (gen + 1u) * nloc) {
            __builtin_amdgcn_fence(__ATOMIC_RELEASE, "agent");
            asm volatile("s_waitcnt vmcnt(0)" ::: "memory");
            const unsigned og = xb_add(&bar[XB_TOP], 1u);
            const unsigned tg = og / nx;
            if (og + 1u == (tg + 1u) * nx) xb_add(&bar[XB_TOPGEN], 1u);
            else XB_SPIN(xb_ld(&bar[XB_TOPGEN]) == tg, bar);
            __builtin_amdgcn_fence(__ATOMIC_ACQUIRE, "agent");
            xb_add(&bar[XB_XGEN(b.x)], 1u);
            asm volatile("s_waitcnt vmcnt(0)" ::: "memory");
        } else {
            XB_SPIN(xb_ld(&bar[XB_XGEN(b.x)]) == gen, bar);
            __builtin_amdgcn_fence(__ATOMIC_ACQUIRE, "agent");
            asm volatile("s_waitcnt vmcnt(0)" ::: "memory");
        }
    }
    __syncthreads();
}
#endif
#ifndef CPU_EMU
__global__ void __launch_bounds__(NT) fwd_kernel(Params pin, int ph_lo, int ph_hi) {
    extern __shared__ __attribute__((aligned(16))) float lds[];
    cg::grid_group grid = cg::this_grid();
    Params p = pin; p.wid = uni((int)(threadIdx.x >> 6));
    volatile LAS unsigned* misc = (volatile LAS unsigned*)((LAS unsigned char*)lds + LDS_MISC);
    if (p.wid == 0) misc[lane_id()] = 0u;
    __syncthreads();
    XcdBarrier xb; xb.bar = (unsigned*)(p.ws + WS_CTL) + CTL_BAR; xb.x = 0; xb.st = misc;
    const bool use_xb = (ph_lo == 0);
#define T0() (p.wid == 0 && lane_id() == 0)
    if (use_xb) xb = xcd_barrier_post((unsigned*)(p.ws + WS_CTL) + CTL_BAR, misc, T0());
#define SEAM(k) do { if (!use_xb) grid.sync(); else xcd_barrier(xb, T0()); } while (0)
#define PHASE(k, call) do { if (ph_lo <= (k) && (k) < ph_hi) { if (PROBE_T >= 0 && blockIdx.x == 0 && T0()) ((unsigned long long*)(p.ws + WS_CTL + 4 * 8000))[k] = __builtin_amdgcn_s_memrealtime(); call; if ((k) + 1 < ph_hi) SEAM(k); } } while (0)
#ifndef PROBE_DUP
#define PROBE_DUP 0
#endif
#define DUP(bit, call) do { if ((PROBE_DUP & (bit)) && l_ == 0) { __syncthreads(); call; } } while (0)
#define LAYER(l) do { const int b_ = 1 + (l) * PH_PER_LAYER; const int l_ = (l); \
        PHASE(b_ + 0, phase_inproj(p, l, lds); DUP(1, phase_inproj(p, l, lds))); PHASE(b_ + 1, phase_prep(p, l, lds); DUP(2, phase_prep(p, l, lds))); PHASE(b_ + 2, phase_mix(p, l, lds); DUP(4, phase_mix(p, l, lds))); \
        PHASE(b_ + 3, phase_retout(p, l, lds); DUP(8, phase_retout(p, l, lds))); PHASE(b_ + 4, phase_outproj(p, l, lds); DUP(16, phase_outproj(p, l, lds))); PHASE(b_ + 5, phase_route(p, l, lds); DUP(128, phase_route<true>(p, l, lds))); \
        PHASE(b_ + 6, phase_moe1(p, l, lds); DUP(32, phase_moe1(p, l, lds))); PHASE(b_ + 7, phase_moe2(p, l, lds); DUP(64, phase_moe2(p, l, lds))); PHASE(b_ + 8, phase_combine(p, l); if ((PROBE_DUP & 256) && l_ == 1) phase_combine(p, l)); } while (0)
    PHASE(0, phase_init(p, lds); if (PROBE_DUP & 512) { __syncthreads(); phase_init(p, lds); });
    LAYER(0);
    LAYER(1);
    static_assert(DEPTH == 2, "phase program written for two layers");
#undef LAYER
#undef PHASE
#undef SEAM
}

#ifndef N_LAUNCH_PER_PHASE
#define N_LAUNCH_PER_PHASE 0
#endif
extern "C" void kernel_launch(void* const* d_in, const int* in_sizes, int n_in, void* d_out, int out_size, void* d_ws, size_t ws_size, hipStream_t stream) {
    static int grid = 0;
    if (grid == 0) {
        if (ws_size < WS_END) { fprintf(stderr, "kernel_launch: workspace too small (%zu < %zu)\n", ws_size, (size_t)WS_END); grid = -1; return; }
        int dev = 0, cus = 0, per_cu = 0;
        hipGetDevice(&dev);
        hipDeviceGetAttribute(&cus, hipDeviceAttributeMultiprocessorCount, dev);
        hipFuncSetAttribute((const void*)fwd_kernel, hipFuncAttributeMaxDynamicSharedMemorySize, LDS_BYTES);
        hipOccupancyMaxActiveBlocksPerMultiprocessor(&per_cu, (const void*)fwd_kernel, NT, LDS_BYTES);
        if (per_cu < 1) { fprintf(stderr, "kernel_launch: occupancy query says %d blocks per CU\n", per_cu); grid = -1; return; }
        grid = cus;
    }
    if (grid < 0) return;
    Params p{};
    p.x = (const float*)d_in[0]; p.norm_mix = (const float*)d_in[1]; p.w_in = (const float*)d_in[2]; p.b_forget = (const float*)d_in[3];
    p.g_ret = (const float*)d_in[4]; p.g_sb = (const float*)d_in[5]; p.g_fox = (const float*)d_in[6]; p.w_out = (const float*)d_in[7];
    p.norm_ffn = (const float*)d_in[8]; p.w_group = (const float*)d_in[9]; p.b_group = (const float*)d_in[10]; p.w_router = (const float*)d_in[11];
    p.b_router = (const float*)d_in[12]; p.w_gate = (const float*)d_in[13]; p.w_up = (const float*)d_in[14]; p.w_down = (const float*)d_in[15];
    p.norm_final = (const float*)d_in[16]; p.out = (float*)d_out; p.ws = (unsigned char*)d_ws;
#if N_LAUNCH_PER_PHASE
    for (int ph = 0; ph < NPHASE; ++ph) {
        int lo = ph, hi = ph + 1; void* args[] = {&p, &lo, &hi};
        hipLaunchCooperativeKernel((const void*)fwd_kernel, dim3(grid), dim3(NT), args, LDS_BYTES, stream);
    }
#else
    (void)hipMemsetAsync((char*)d_ws + WS_CTL + (size_t)CTL_BAR * 4, 0, 3456 * 4, stream);
    int lo = 0, hi = NPHASE; void* args[] = {&p, &lo, &hi};
    hipError_t e = hipLaunchCooperativeKernel((const void*)fwd_kernel, dim3(grid), dim3(NT), args, LDS_BYTES, stream);
    if (e != hipSuccess) fprintf(stderr, "cooperative launch failed: %s (grid %d)\n", hipGetErrorString(e), grid);
#endif
}
#endif
```

```cpp
#ifndef CPU_EMU
#include <hip/hip_runtime.h>
#include <hip/hip_cooperative_groups.h>
#include <cstdio>
#include <cstdint>
#include <cmath>
namespace cg = cooperative_groups;
#define VEC(T, N) T __attribute__((ext_vector_type(N)))
__device__ __forceinline__ void wave_barrier() { __builtin_amdgcn_wave_barrier(); }
__device__ __forceinline__ float sin2pi(float x) { return __builtin_amdgcn_sinf(x); }
__device__ __forceinline__ float cos2pi(float x) { return __builtin_amdgcn_cosf(x); }
__device__ __forceinline__ unsigned long long ballot64(bool p) { return __ballot(p); }
#define LAS __attribute__((address_space(3)))
typedef VEC(short, 8) bf16x8;
typedef VEC(float, 4) f32x4_;
__device__ __forceinline__ void glds16(const void* g, LAS unsigned char* l) { __builtin_amdgcn_global_load_lds((const unsigned*)g, (LAS unsigned*)l, 16, 0, 0); }
__device__ __forceinline__ void vm_wait0() { asm volatile("s_waitcnt vmcnt(0)" ::: "memory"); }
__device__ __forceinline__ void lds_wait0() { asm volatile("s_waitcnt lgkmcnt(0)" ::: "memory"); }
__device__ __forceinline__ void sched_fence() { __builtin_amdgcn_sched_barrier(0); }
__device__ __forceinline__ int uni(int x) { return __builtin_amdgcn_readfirstlane(x); }
__device__ __forceinline__ unsigned ld_relaxed(const unsigned* p) { return __hip_atomic_load(p, __ATOMIC_RELAXED, __HIP_MEMORY_SCOPE_AGENT); }
__device__ __forceinline__ int xcc_shard() { return (int)(__builtin_amdgcn_s_getreg((3 << 11) | 20) & 7u); }
__device__ __forceinline__ int lane_id() { int l; asm volatile("v_mbcnt_lo_u32_b32 %0, -1, 0\n\tv_mbcnt_hi_u32_b32 %0, -1, %0" : "=v"(l)); return l; }
__device__ __forceinline__ f32x4_ mfma16(bf16x8 a, bf16x8 b, f32x4_ c) { return __builtin_amdgcn_mfma_f32_16x16x32_bf16(a, b, c, 0, 0, 0); }
typedef VEC(float, 16) f32x16;
typedef VEC(short, 4) s16x4;
__device__ __forceinline__ f32x16 mfma32(bf16x8 a, bf16x8 b, f32x16 c) { return __builtin_amdgcn_mfma_f32_32x32x16_bf16(a, b, c, 0, 0, 0); }
__device__ __forceinline__ s16x4 tr16(const LAS unsigned char* p) { return __builtin_amdgcn_ds_read_tr16_b64_v4i16((LAS s16x4*)p); }
__device__ __forceinline__ float fast_exp(float x) { return __expf(x); }
__device__ __forceinline__ float fast_log(float x) { return __logf(x); }
__device__ __forceinline__ float partner32(float x, int hi) { const auto rr = __builtin_amdgcn_permlane32_swap(__builtin_bit_cast(unsigned, x), __builtin_bit_cast(unsigned, x), false, false); return __builtin_bit_cast(float, hi ? rr[0] : rr[1]); }
template <int N> __device__ __forceinline__ float row_shl_add(float x) { return x + __builtin_bit_cast(float, __builtin_amdgcn_update_dpp(0, __builtin_bit_cast(int, x), 0x100 + N, 0xf, 0xf, true)); }
__device__ __forceinline__ float read_lane(float x, int l) { return __builtin_bit_cast(float, __builtin_amdgcn_readlane(__builtin_bit_cast(int, x), l)); }
#else
#define VEC(T, N) T __attribute__((vector_size(sizeof(T) * N)))
inline float sin2pi(float x) { return (float)sin(6.283185307179586 * (double)x); }
inline float cos2pi(float x) { return (float)cos(6.283185307179586 * (double)x); }
inline unsigned long long ballot64(bool p) { return emu_ballot(p); }
#define LAS
typedef VEC(short, 8) bf16x8;
inline void glds16(const void* g, unsigned char* l) { memcpy(l + (threadIdx.x & 63) * 16, g, 16); }
inline void vm_wait0() {}
inline void lds_wait0() {}
inline void sched_fence() {}
inline int uni(int x) { return x; }
inline int xcc_shard() { return (int)(blockIdx.x & 7u); }
inline unsigned ld_relaxed(const unsigned* p) { return __atomic_load_n(p, __ATOMIC_RELAXED); }
inline int lane_id() { return threadIdx.x & 63; }
inline emu_f32x4 mfma16(bf16x8 a, bf16x8 b, emu_f32x4 c) { return emu_mfma16(a, b, c); }
typedef VEC(float, 16) f32x16;
typedef VEC(short, 4) s16x4;
inline f32x16 mfma32(bf16x8 a, bf16x8 b, f32x16 c) { return emu_mfma32(a, b, c); }
inline s16x4 tr16(const unsigned char* p) { return emu_tr16(p); }
inline float fast_exp(float x) { return expf(x); }
inline float fast_log(float x) { return logf(x); }
inline float partner32(float x, int hi) { return __shfl_xor(x, 32); }
template <int N> inline float row_shl_add(float x) { const int l = threadIdx.x & 63; const float o = emu_shfl_idx(x, (l + N) & 63); return x + (((l & 15) + N < 16) ? o : 0.f); }
inline float read_lane(float x, int l) { return emu_shfl_idx(x, l); }
#endif

typedef unsigned short bf16_t;
typedef VEC(float, 4) f32x4;
typedef VEC(float, 2) f32x2;
typedef VEC(unsigned, 2) u32x2;
typedef VEC(unsigned, 4) u32x4;
typedef LAS unsigned char lds_u8;

#ifndef PROBE_T
#define PROBE_T -1
#endif
#ifdef SMALL_CFG
constexpr int D = 256, S = 512, DEPTH = 2, NRET = 2, NSB = 1, NFOX = 1, NG = 2, EPG = 4, DE = 128;
#else
constexpr int D = 1024, S = 16384, DEPTH = 2, NRET = 6, NSB = 5, NFOX = 5, NG = 4, EPG = 8, DE = 512;
#endif
constexpr int CH = 64, HD = 64, NE = NG * EPG;
constexpr int WRET = NRET * HD, WSB = NSB * HD, WFOX = NFOX * HD, MIXW = WRET + WSB + WFOX;
constexpr int IN_W = 4 * WRET + 3 * WSB + 3 * WFOX + NFOX;
constexpr int PW = (IN_W + 255) / 256 * 256;
constexpr int OQR = 0, OKR = WRET, OVR = 2 * WRET, OGR = 3 * WRET, OQS = 4 * WRET, OKS = OQS + WSB, OVS = OKS + WSB;
constexpr int OQF = OVS + WSB, OKF = OQF + WFOX, OVF = OKF + WFOX, OFL = OVF + WFOX;
constexpr int NCHUNK = S / CH;
constexpr float EPS = 1e-6f;
constexpr int NT = 512, NW = NT / 64;
constexpr int NROUTE = NG + NE;
constexpr float EXIT_T = 18.0f;

constexpr size_t al256(size_t x) { return (x + 255) / 256 * 256; }
constexpr size_t WS_CTL = 0;
constexpr int CTL_CNT = 0;
constexpr int CTL_KMAX = 256;
constexpr int CTL_MQ = 4608, CTL_WQ = 4608 + DEPTH * 8 * 64;
constexpr int CTL_BAR = 1024;
constexpr int CTL_WORDS = 8192;
static_assert(CTL_BAR + 3456 <= CTL_MQ && CTL_WQ + DEPTH * 8 * 64 <= CTL_WORDS, "control-word map");
constexpr size_t WS_ROT = 32768;
constexpr size_t WS_X = al256(WS_ROT + (size_t)S * 32 * 8);
constexpr size_t WS_H = al256(WS_X + (size_t)S * D * 4);
constexpr size_t WS_LOGF = al256(WS_H + (size_t)S * D * 2);
constexpr size_t WS_FCUM = al256(WS_LOGF + (size_t)S * 8 * 4);
constexpr size_t WS_MERGED = al256(WS_FCUM + (size_t)S * 8 * 4);
constexpr size_t WS_U = al256(WS_MERGED + (size_t)S * MIXW * 2);
constexpr size_t WS_SP = al256(WS_U + (size_t)NRET * NCHUNK * 4096 * 4);
constexpr size_t WS_LIST = al256(WS_SP + (size_t)NRET * NCHUNK * 4096 * 4);
constexpr size_t WS_GATE = al256(WS_LIST + (size_t)NE * S * 4);
constexpr size_t WS_WIN = al256(WS_GATE + (size_t)S * 2 * 4);
constexpr size_t WS_WOUT = al256(WS_WIN + (size_t)DEPTH * PW * D * 2);
constexpr size_t WS_WGU = al256(WS_WOUT + (size_t)DEPTH * D * MIXW * 2);
constexpr size_t WS_WDN = al256(WS_WGU + (size_t)DEPTH * NE * 2 * DE * D * 2);
constexpr size_t WS_PROJ = al256(WS_WDN + (size_t)DEPTH * NE * D * DE * 2);
constexpr int HID_ROWS = 2 * S + NE * 256;
constexpr size_t WS_HID = WS_PROJ;
constexpr size_t WS_Y = al256(WS_HID + (size_t)HID_ROWS * DE * 2);
constexpr size_t WS_END0 = al256(WS_PROJ + (size_t)S * PW * 2), WS_END1 = al256(WS_Y + (size_t)2 * S * D * 2);
constexpr size_t WS_END = WS_END0 > WS_END1 ? WS_END0 : WS_END1;
#ifndef SMALL_CFG
static_assert(WS_END <= (size_t)512 * 1024 * 1024, "workspace map exceeds the guaranteed 512 MiB");
#endif

struct Params {
    const float* x; const float* norm_mix; const float* w_in; const float* b_forget; const float* g_ret; const float* g_sb; const float* g_fox;
    const float* w_out; const float* norm_ffn; const float* w_group; const float* b_group; const float* w_router; const float* b_router;
    const float* w_gate; const float* w_up; const float* w_down; const float* norm_final;
    float* out; unsigned char* ws;
    int wid, pad;
};

#define TIDX(p) (((p).wid << 6) | lane_id())
__device__ __forceinline__ int imin(int a, int b) { return a < b ? a : b; }
__device__ __forceinline__ float u2f(unsigned u) { return __builtin_bit_cast(float, u); }
__device__ __forceinline__ unsigned f2u(float f) { return __builtin_bit_cast(unsigned, f); }
__device__ __forceinline__ float bf2f(bf16_t b) { return u2f((unsigned)b << 16); }
__device__ __forceinline__ bf16_t f2bf(float f) { unsigned u = f2u(f); return (bf16_t)((u + 0x7fffu + ((u >> 16) & 1u)) >> 16); }
#ifndef CPU_EMU
typedef float pk_f32x2 __attribute__((ext_vector_type(2))); typedef __bf16 pk_bf16x2 __attribute__((ext_vector_type(2)));
__device__ __forceinline__ unsigned pk2(float lo, float hi) { const pk_f32x2 v = {lo, hi}; return __builtin_bit_cast(unsigned, __builtin_convertvector(v, pk_bf16x2)); }
#else
__device__ __forceinline__ unsigned pk2(float lo, float hi) { return (unsigned)f2bf(lo) | ((unsigned)f2bf(hi) << 16); }
#endif
__device__ __forceinline__ float log_sigmoid(float x) { return fminf(x, 0.f) - log1pf(expf(-fabsf(x))); }
#ifndef CPU_EMU
__device__ __forceinline__ float silu(float x) { return x * __builtin_amdgcn_rcpf(1.f + __expf(-x)); }
#else
__device__ __forceinline__ float silu(float x) { return x / (1.f + expf(-x)); }
#endif
#ifndef CPU_EMU
template <int CTRL> __device__ __forceinline__ float dpp_mov(float x) { return __builtin_bit_cast(float, __builtin_amdgcn_update_dpp(0, __builtin_bit_cast(int, x), CTRL, 0xf, 0xf, false)); }
__device__ __forceinline__ float wave_sum(float v) {
    v += dpp_mov<0xB1>(v); v += dpp_mov<0x4E>(v); v += dpp_mov<0x141>(v); v += dpp_mov<0x140>(v);
    return (read_lane(v, 0) + read_lane(v, 16)) + (read_lane(v, 32) + read_lane(v, 48));
}
__device__ __forceinline__ float wave_max(float v) {
    v = fmaxf(v, dpp_mov<0xB1>(v)); v = fmaxf(v, dpp_mov<0x4E>(v)); v = fmaxf(v, dpp_mov<0x141>(v)); v = fmaxf(v, dpp_mov<0x140>(v));
    return fmaxf(fmaxf(read_lane(v, 0), read_lane(v, 16)), fmaxf(read_lane(v, 32), read_lane(v, 48)));
}
#else
__device__ __forceinline__ float wave_sum(float v) {
#pragma unroll
    for (int o = 1; o < 64; o <<= 1) v += __shfl_xor(v, o);
    return v;
}
__device__ __forceinline__ float wave_max(float v) {
#pragma unroll
    for (int o = 1; o < 64; o <<= 1) v = fmaxf(v, __shfl_xor(v, o));
    return v;
}
#endif
__device__ __forceinline__ double inv_turns(int j) {
    static constexpr double T[32] = {
        1.59154943091895346e-01, 1.19349370211248862e-01, 8.94994016088910133e-02, 6.71150830052272551e-02, 5.03292121044870353e-02, 3.77415847174197711e-02, 2.83021958306233987e-02, 2.12236527647776604e-02,
        1.59154943091895339e-02, 1.19349370211248862e-02, 8.94994016088910237e-03, 6.71150830052272534e-03, 5.03292121044870370e-03, 3.77415847174197719e-03, 2.83021958306233987e-03, 2.12236527647776622e-03,
        1.59154943091895356e-03, 1.19349370211248849e-03, 8.94994016088910237e-04, 6.71150830052272599e-04, 5.03292121044870326e-04, 3.77415847174197741e-04, 2.83021958306233954e-04, 2.12236527647776605e-04,
        1.59154943091895351e-04, 1.19349370211248862e-04, 8.94994016088910182e-05, 6.71150830052272545e-05, 5.03292121044870354e-05, 3.77415847174197768e-05, 2.83021958306233961e-05, 2.12236527647776592e-05};
    return T[j];
}

constexpr int VROWB = 144;
constexpr int IMG64 = 64 * VROWB;
constexpr int RET_WAVE_LDS = 2 * IMG64;
__device__ __forceinline__ int crow(int reg, int hi) { return (reg & 3) + 8 * (reg >> 2) + 4 * hi; }
__device__ __forceinline__ bf16x8 tr_frag(const lds_u8* base, int rowoff0, int rowoff1, int coloff) {
    const s16x4 lo = tr16(base + rowoff0 * VROWB + coloff), hi4 = tr16(base + rowoff1 * VROWB + coloff);
    bf16x8 f; f[0] = lo[0]; f[1] = lo[1]; f[2] = lo[2]; f[3] = lo[3]; f[4] = hi4[0]; f[5] = hi4[1]; f[6] = hi4[2]; f[7] = hi4[3]; return f;
}

constexpr int RJ = D / 256;
__device__ __forceinline__ void row_load(const float* row, f32x4* v, int lane) {
#pragma unroll
    for (int j = 0; j < RJ; ++j) v[j] = *(const f32x4*)(row + 256 * j + lane * 4);
}
__device__ __forceinline__ void row_load_bf16(const bf16_t* row, f32x4* v, int lane) {
#pragma unroll
    for (int j = 0; j < RJ; ++j) { const u32x2 w = *(const u32x2*)(row + 256 * j + lane * 4); v[j][0] = u2f(w[0] << 16); v[j][1] = u2f(w[0] & 0xffff0000u); v[j][2] = u2f(w[1] << 16); v[j][3] = u2f(w[1] & 0xffff0000u); }
}
__device__ __forceinline__ float row_rinv(const f32x4* v) {
    float s = 0.f;
#pragma unroll
    for (int j = 0; j < RJ; ++j) s += (v[j][0] * v[j][0] + v[j][1] * v[j][1]) + (v[j][2] * v[j][2] + v[j][3] * v[j][3]);
    s = wave_sum(s);
    return 1.0f / sqrtf(s * (1.0f / D) + EPS);
}

#ifndef CPU_EMU
typedef float f32x4_u __attribute__((ext_vector_type(4), aligned(4)));
#else
typedef float f32x4_u __attribute__((vector_size(16), aligned(4)));
#endif
#ifndef CPU_EMU
__device__ __forceinline__ f32x4_u nt_load4(const f32x4_u* p) { return __builtin_nontemporal_load(p); }
#else
inline f32x4_u nt_load4(const f32x4_u* p) { return *p; }
#endif
struct TrDesc { const float* Wa; const float* Wb; int ldw, ncols, c0, cb0, k0; bf16_t* WT; int ldt, r0, r1; };
__device__ __forceinline__ void tr_load(const TrDesc& d, f32x4 (&v)[16], int lane) {
    const int n = 4 * (lane & 15), kr = lane >> 4;
    const float* src = (n < 32 ? d.Wa + d.c0 + n : d.Wb + d.cb0 + (n - 32)) + (size_t)(d.k0 + kr) * d.ldw;
    const int col = (n < 32 ? d.c0 + n : d.cb0 + n - 32);
    if (col + 3 < d.ncols) {
#pragma unroll
        for (int i = 0; i < 16; ++i) { const f32x4_u t = nt_load4((const f32x4_u*)(src + (size_t)(4 * i) * d.ldw)); v[i][0] = t[0]; v[i][1] = t[1]; v[i][2] = t[2]; v[i][3] = t[3]; }
    } else {
#pragma unroll
        for (int i = 0; i < 16; ++i)
#pragma unroll
            for (int j = 0; j < 4; ++j) v[i][j] = (col + j < d.ncols) ? src[(size_t)(4 * i) * d.ldw + j] : 0.f;
    }
}
__device__ __forceinline__ void tr_store(const TrDesc& d, const f32x4 (&v)[16], lds_u8* img, int lane) {
    const int n = 4 * (lane & 15), kr = lane >> 4;
    wave_barrier();
#pragma unroll
    for (int i = 0; i < 16; ++i) { u32x2 o; o[0] = pk2(v[i][0], v[i][1]); o[1] = pk2(v[i][2], v[i][3]); *(LAS u32x2*)(img + (4 * i + kr) * VROWB + n * 2) = o; }
    wave_barrier();
    const lds_u8* tb = img + ((lane & 15) >> 2) * VROWB + (16 * (lane >> 4) + 4 * (lane & 3)) * 2;
    const int x32 = lane & 31, pos32 = 16 * ((x32 >> 2) & 1) + 4 * (x32 >> 3) + (x32 & 3);
    bf16_t* dst = d.WT + (size_t)((lane < 32 ? d.r0 : d.r1) + pos32) * d.ldt + d.k0;
#pragma unroll
    for (int kc = 0; kc < 8; ++kc) {
        const s16x4 lo = tr16(tb + (8 * kc) * VROWB), hi4 = tr16(tb + (8 * kc + 4) * VROWB);
        u32x4 o; o[0] = (unsigned)(unsigned short)lo[0] | ((unsigned)(unsigned short)lo[1] << 16); o[1] = (unsigned)(unsigned short)lo[2] | ((unsigned)(unsigned short)lo[3] << 16);
        o[2] = (unsigned)(unsigned short)hi4[0] | ((unsigned)(unsigned short)hi4[1] << 16); o[3] = (unsigned)(unsigned short)hi4[2] | ((unsigned)(unsigned short)hi4[3] << 16);
        *(u32x4*)(dst + 8 * kc) = o;
    }
}
constexpr int WI_IN = (D / 64) * ((IN_W + 63) / 64), WI_OUT = (MIXW / 64) * (D / 64), WI_GU = (D / 64) * (DE / 32), WI_DN = (DE / 64) * (D / 64);
constexpr int WI_DENSE = WI_IN + WI_OUT, WI_EXPERT = WI_GU + WI_DN, WI_LAYER = WI_DENSE + NE * WI_EXPERT;
__device__ __forceinline__ TrDesc weight_desc(const Params& p, int l, int r) {
    if (r < WI_IN) { const int nb = (IN_W + 63) / 64, c0 = (r % nb) * 64; const float* W = p.w_in + (size_t)l * D * IN_W;
        const int r0 = (c0 / 256) * 256 + ((c0 % 256) / 64) * 32;
        return TrDesc{W, W, IN_W, IN_W, c0, c0 + 32, (r / nb) * 64, (bf16_t*)(p.ws + WS_WIN) + (size_t)l * PW * D, D, r0, r0 + 128}; }
    r -= WI_IN;
    if (r < WI_OUT) { const int nb = D / 64, c0 = (r % nb) * 64; const float* W = p.w_out + (size_t)l * MIXW * D;
        return TrDesc{W, W, D, D, c0, c0 + 32, (r / nb) * 64, (bf16_t*)(p.ws + WS_WOUT) + (size_t)l * D * MIXW, MIXW, c0, c0 + 32}; }
    r -= WI_OUT;
    const int e = r / WI_EXPERT; r %= WI_EXPERT;
    if (r < WI_GU) { const int nb = DE / 32, c0 = (r % nb) * 32;
        const int r0 = (c0 / 128) * 256 + (c0 % 128);
        return TrDesc{p.w_gate + (size_t)(l * NE + e) * D * DE, p.w_up + (size_t)(l * NE + e) * D * DE, DE, DE, c0, c0, (r / nb) * 64, (bf16_t*)(p.ws + WS_WGU) + (size_t)(l * NE + e) * 2 * DE * D, D, r0, r0 + 128}; }
    r -= WI_GU;
    { const int nb = D / 64, c0 = (r % nb) * 64; const float* W = p.w_down + (size_t)(l * NE + e) * DE * D;
        return TrDesc{W, W, D, D, c0, c0 + 32, (r / nb) * 64, (bf16_t*)(p.ws + WS_WDN) + (size_t)(l * NE + e) * D * DE, DE, c0, c0 + 32}; }
}
__device__ __forceinline__ void weight_item(const Params& p, int l, int r, lds_u8* img, int lane) { const TrDesc d = weight_desc(p, l, r); f32x4 v[16]; tr_load(d, v, lane); tr_store(d, v, img, lane); }
__device__ __forceinline__ void weight_item2(const Params& p, int l, int ra, int rb, lds_u8* img, int lane) {
    const TrDesc da = weight_desc(p, l, ra), db = weight_desc(p, l, rb); f32x4 va[16], vb[16];
    tr_load(da, va, lane); tr_load(db, vb, lane); tr_store(da, va, img, lane); tr_store(db, vb, img + IMG64, lane);
}
__device__ __forceinline__ void phase_init(const Params& p, float* lds) {
    unsigned* ctl = (unsigned*)(p.ws + WS_CTL);
    if (blockIdx.x == 0) for (int i = TIDX(p); i < 8000; i += NT) if (i < CTL_BAR || i >= CTL_BAR + 3456) ctl[i] = 0u;
    f32x2* rot = (f32x2*)(p.ws + WS_ROT);
    for (int i = blockIdx.x * NT + TIDX(p); i < S * 32; i += gridDim.x * NT) {
        const int pos = i >> 5, j = i & 31;
        const double turns = (double)pos * inv_turns(j);
        const double fr = turns - floor(turns);
        f32x2 cs; cs[0] = cos2pi((float)fr); cs[1] = sin2pi((float)fr);
        rot[i] = cs;
    }
    const int lane = lane_id(), wave = p.wid;
    {
        lds_u8* img = (lds_u8*)lds + wave * RET_WAVE_LDS;
        for (int it = blockIdx.x * NW + wave; it < DEPTH * WI_DENSE; it += gridDim.x * NW) weight_item(p, it / WI_DENSE, it % WI_DENSE, img, lane);
    }
    bf16_t* H = (bf16_t*)(p.ws + WS_H);
    for (int r = blockIdx.x * NW + wave; r < S; r += gridDim.x * NW) {
        f32x4 v[RJ]; row_load(p.x + (size_t)r * D, v, lane);
        const float ri = row_rinv(v);
#pragma unroll
        for (int j = 0; j < RJ; ++j) {
            const f32x4 g = *(const f32x4*)(p.norm_mix + 256 * j + lane * 4);
            u32x2 o; o[0] = pk2(v[j][0] * ri * g[0], v[j][1] * ri * g[1]); o[1] = pk2(v[j][2] * ri * g[2], v[j][3] * ri * g[3]);
            *(u32x2*)(H + (size_t)r * D + 256 * j + lane * 4) = o;
        }
    }
}

constexpr int GBM = 256, GBK = 64, TILE_B = GBM * GBK * 2, STAGE_B = 2 * TILE_B, GEMM_LDS = 2 * STAGE_B;
__device__ __forceinline__ int lds_byte(int r, int c) { const int st = (r >> 4) * 2 + (c >> 5), ob = (r & 15) * 64 + (c & 31) * 2; return st * 1024 + (ob ^ (((ob >> 9) & 1) << 5)); }
__device__ __forceinline__ void stage_rc(int b, int& R, int& C) { const int st = b >> 10, sb = b & 1023, swz = sb ^ (((sb >> 9) & 1) << 5); R = (st >> 1) * 16 + swz / 64; C = (st & 1) * 32 + (swz % 64) / 2; }
__device__ __forceinline__ int vcu_id() { const int G = gridDim.x, b = blockIdx.x; return (G % 8 == 0) ? (b % 8) * (G / 8) + b / 8 : b; }

constexpr int HTB = 128 * GBK * 2;
struct GUnit { unsigned A, B; unsigned ao[4]; int i0, i1, i2, i3; };
#ifndef CPU_EMU
#define G8_WAIT_V(n) asm volatile("s_waitcnt vmcnt(" #n ")" ::: "memory")
#define G8_WAIT_L0() asm volatile("s_waitcnt lgkmcnt(0)" ::: "memory")
#define G8_BAR() __builtin_amdgcn_s_barrier()
#define G8_PRIO(x) __builtin_amdgcn_s_setprio(x)
#else
#define G8_WAIT_V(n) do {} while (0)
#define G8_WAIT_L0() do {} while (0)
#define G8_BAR() __syncthreads()
#define G8_PRIO(x) do {} while (0)
#endif
template <class Sched, class Epi>
__device__ __forceinline__ void gemm_stream(lds_u8* lds, const char* Abase, const char* Bbase, const int K, Sched& S, const Epi& E) {
    const int wid = S.wid, lane = lane_id(), tid = (wid << 6) | lane, wr = wid >> 2, wc = wid & 3, fr = lane & 15, fq = lane >> 4;
    const int nt = K / GBK;
    unsigned voffB[2];
    { int R, C; stage_rc(tid * 16, R, C); voffB[0] = (unsigned)((R * K + C) * 2); stage_rc(tid * 16 + 8192, R, C); voffB[1] = (unsigned)((R * K + C) * 2); }
    const unsigned hstepB = (unsigned)(128 * K * 2);
    lds_u8* ldsw = lds + wid * 1024;
    const int aoff = lds_byte(wr * 64 + fr, fq * 8), boff = lds_byte(wc * 32 + fr, fq * 8);
#define G8_SA(b, h) (((b) * 2 + (h)) * HTB)
#define G8_SB(b, h) ((4 + (b) * 2 + (h)) * HTB)
#define G8_STAGE_A(b, h, U, kt) do { _Pragma("unroll") for (int i_ = 0; i_ < 2; ++i_) glds16(Abase + ((size_t)(U).A + (size_t)((kt) * (GBK * 2))) + (Sched::GATHER ? (U).ao[2 * (h) + i_] : S.ao[2 * (h) + i_]), ldsw + G8_SA(b, h) + i_ * 8192); } while (0)
#define G8_STAGE_B(b, h, U, kt) do { _Pragma("unroll") for (int i_ = 0; i_ < 2; ++i_) glds16(Bbase + ((size_t)(U).B + (size_t)((kt) * (GBK * 2)) + (size_t)(h) * hstepB) + voffB[i_], ldsw + G8_SB(b, h) + i_ * 8192); } while (0)
#define G8_LDA(dst, b, h) do { _Pragma("unroll") for (int m = 0; m < 4; ++m) _Pragma("unroll") for (int k = 0; k < 2; ++k) dst[m][k] = *(const LAS bf16x8*)(lds + G8_SA(b, h) + aoff + m * 2048 + k * 1024); } while (0)
#define G8_LDB(dst, b, h) do { _Pragma("unroll") for (int n = 0; n < 2; ++n) _Pragma("unroll") for (int k = 0; k < 2; ++k) dst[n][k] = *(const LAS bf16x8*)(lds + G8_SB(b, h) + boff + n * 2048 + k * 1024); } while (0)
#define G8_MMA(ai, bj, At_, Bt_) do { G8_PRIO(1); _Pragma("unroll") for (int m = 0; m < 4; ++m) _Pragma("unroll") for (int n = 0; n < 2; ++n) _Pragma("unroll") for (int k = 0; k < 2; ++k) \
        acc[ai][bj][m][n] = mfma16(Bt_[n][k], At_[m][k], acc[ai][bj][m][n]); G8_PRIO(0); } while (0)
    GUnit cur, nxt; int ui = 0;
    if (!S.next(0, cur)) return;
    f32x4 acc[2][2][4][2];
#pragma unroll
    for (int a = 0; a < 2; ++a)
#pragma unroll
        for (int b = 0; b < 2; ++b)
#pragma unroll
            for (int m = 0; m < 4; ++m)
#pragma unroll
                for (int n = 0; n < 2; ++n) acc[a][b][m][n] = (f32x4){0.f, 0.f, 0.f, 0.f};
    bf16x8 At[4][2], B0[2][2], B1[2][2];
    G8_STAGE_B(0, 0, cur, 0); G8_STAGE_B(0, 1, cur, 0); G8_STAGE_A(0, 0, cur, 0); G8_STAGE_A(0, 1, cur, 0);
    if (wr == 1) G8_BAR();
    G8_WAIT_V(2); G8_BAR();
    G8_STAGE_B(1, 0, cur, 1); G8_STAGE_A(1, 0, cur, 1); G8_STAGE_B(1, 1, cur, 1);
    G8_WAIT_V(6); G8_BAR();
    for (;;) {
        const bool has_next = S.next(ui + 1, nxt);
        if (!has_next) nxt = cur;
        for (int t = 0; t < nt; t += 2) {
            const bool last = (t == nt - 2);
            const GUnit& U2 = last ? nxt : cur;
            const int k2 = last ? 0 : t + 2, k3 = k2 + 1;
            G8_LDB(B0, 0, 0); G8_LDB(B1, 0, 1); sched_fence(); G8_LDA(At, 0, 0); G8_STAGE_A(1, 1, cur, t + 1);
            G8_WAIT_V(8); G8_WAIT_L0(); G8_BAR(); G8_MMA(0, 0, At, B0); G8_MMA(0, 1, At, B1); G8_BAR(); sched_fence();
            G8_LDA(At, 0, 1); G8_STAGE_B(0, 0, U2, k2); G8_STAGE_B(0, 1, U2, k2); G8_STAGE_A(0, 0, U2, k2);
            G8_WAIT_V(8); G8_WAIT_L0(); G8_BAR(); G8_MMA(1, 0, At, B0); G8_MMA(1, 1, At, B1); G8_BAR(); sched_fence();
            G8_LDB(B0, 1, 0); G8_LDB(B1, 1, 1); sched_fence(); G8_LDA(At, 1, 0); G8_STAGE_A(0, 1, U2, k2);
            G8_WAIT_V(8); G8_WAIT_L0(); G8_BAR(); G8_MMA(0, 0, At, B0); G8_MMA(0, 1, At, B1); G8_BAR(); sched_fence();
            G8_LDA(At, 1, 1); G8_STAGE_B(1, 0, U2, k3); G8_STAGE_B(1, 1, U2, k3); G8_STAGE_A(1, 0, U2, k3);
            G8_WAIT_V(8); G8_WAIT_L0(); G8_BAR(); G8_MMA(1, 0, At, B0); G8_MMA(1, 1, At, B1); G8_BAR(); sched_fence();
        }
        if (wr == 0) G8_BAR();
        E(acc, cur, wr, wc, fr, fq);
        if (!has_next) break;
#pragma unroll
        for (int a = 0; a < 2; ++a)
#pragma unroll
            for (int b = 0; b < 2; ++b)
#pragma unroll
                for (int m = 0; m < 4; ++m)
#pragma unroll
                    for (int n = 0; n < 2; ++n) acc[a][b][m][n] = (f32x4){0.f, 0.f, 0.f, 0.f};
        cur = nxt; ++ui;
        if (wr == 1) G8_BAR();
    }
    G8_WAIT_V(0);
    G8_BAR();
#undef G8_SA
#undef G8_SB
#undef G8_STAGE_A
#undef G8_STAGE_B
#undef G8_LDA
#undef G8_LDB
#undef G8_MMA
}
__device__ __forceinline__ void plain_ao(unsigned (&ao)[4], int K, int tid) {
    int R, C; stage_rc(tid * 16, R, C); ao[0] = (unsigned)((R * K + C) * 2); ao[2] = ao[0] + (unsigned)(128 * K * 2);
    stage_rc(tid * 16 + 8192, R, C); ao[1] = (unsigned)((R * K + C) * 2); ao[3] = ao[1] + (unsigned)(128 * K * 2);
}

struct InprojSched {
    static constexpr bool GATHER = false;
    int wid;
    unsigned ao[4]; int vcu, G;
    static constexpr int NPM = S / GBM, NPN = PW / GBM;
    __device__ __forceinline__ bool next(int i, GUnit& u) const {
        const int L = uni(i * G + vcu); if (L >= NPM * NPN) return false;
        constexpr int WGM = 8, nig = WGM * NPN;
        const int gid = L / nig, fm = gid * WGM, gsz = (NPM - fm) < WGM ? (NPM - fm) : WGM;
        const int pm = fm + (L % nig) % gsz, pn = (L % nig) / gsz;
        u.A = (unsigned)(pm * GBM * D * 2); u.B = (unsigned)(pn * GBM * D * 2); u.ao[0] = u.ao[1] = u.ao[2] = u.ao[3] = 0u;
        u.i0 = pm; u.i1 = pn; u.i2 = 0; u.i3 = 0; return true;
    }
};
struct InprojEpi {
    bf16_t* P; float* LOGF; unsigned* kmaxw; const f32x2* rot; const float* bfg;
    __device__ __forceinline__ void operator()(f32x4 (&acc)[2][2][4][2], const GUnit& u, int wr, int wc, int fr, int fq) const {
        const int gc0 = u.i1 * GBM + wc * 64;
        if (gc0 >= IN_W) return;
        const int row0 = u.i0 * GBM + wr * 64 + fr;
        if (gc0 >= OFL) {
#pragma unroll
            for (int ai = 0; ai < 2; ++ai)
#pragma unroll
                for (int m = 0; m < 4; ++m)
#pragma unroll
                    for (int n = 0; n < 2; ++n)
#pragma unroll
                        for (int j = 0; j < 4; ++j) { const int h = 4 * n + j; if (fq == 0 && h < NFOX) LOGF[(size_t)h * S + row0 + ai * 128 + m * 16] = log_sigmoid(acc[ai][0][m][n][j] + bfg[h]); }
            return;
        }
        const bool rotary = gc0 < OVR, is_gate = (gc0 >= OGR && gc0 < OQS), is_kf = (gc0 >= OKF && gc0 < OVF);
        const float scale = (gc0 < OKR || (gc0 >= OQS && gc0 < OKS) || (gc0 >= OQF && gc0 < OKF)) ? 0.125f : 1.0f;
        float kmx = 0.f;
        if (rotary) {
#pragma unroll
            for (int am = 0; am < 4; ++am) {
                const int ai = am >> 1, m0 = (am & 1) * 2;
                f32x4 c01[2][2], c23[2][2];
#pragma unroll
                for (int mm = 0; mm < 2; ++mm)
#pragma unroll
                    for (int n = 0; n < 2; ++n) { const f32x2* rp = rot + (size_t)(row0 + ai * 128 + (m0 + mm) * 16) * 32 + 8 * fq + 4 * n; c01[mm][n] = *(const f32x4*)rp; c23[mm][n] = *(const f32x4*)(rp + 2); }
#pragma unroll
                for (int mm = 0; mm < 2; ++mm)
#pragma unroll
                    for (int n = 0; n < 2; ++n) {
                        const int m = m0 + mm;
                        const float cs[4] = {c01[mm][n][0], c01[mm][n][2], c23[mm][n][0], c23[mm][n][2]}, sn[4] = {c01[mm][n][1], c01[mm][n][3], c23[mm][n][1], c23[mm][n][3]};
#pragma unroll
                        for (int j = 0; j < 4; ++j) { const float x1 = acc[ai][0][m][n][j], x2 = acc[ai][1][m][n][j]; acc[ai][0][m][n][j] = x1 * cs[j] - x2 * sn[j]; acc[ai][1][m][n][j] = x1 * sn[j] + x2 * cs[j]; }
                    }
                sched_fence();
            }
        }
#pragma unroll
        for (int ai = 0; ai < 2; ++ai)
#pragma unroll
            for (int m = 0; m < 4; ++m) {
                const int row = row0 + ai * 128 + m * 16;
                float ss = 0.f;
#pragma unroll
                for (int bj = 0; bj < 2; ++bj) {
                    u32x4 o;
#pragma unroll
                    for (int n = 0; n < 2; ++n) {
                        f32x4 v = acc[ai][bj][m][n] * scale;
                        if (is_gate) {
#pragma unroll
                            for (int j = 0; j < 4; ++j) v[j] = silu(v[j]);
                        }
                        o[2 * n] = pk2(v[0], v[1]); o[2 * n + 1] = pk2(v[2], v[3]);
                        if (is_kf) {
#pragma unroll
                            for (int j = 0; j < 4; ++j) { const float r = bf2f(f2bf(v[j])); ss += r * r; }
                        }
                    }
                    *(u32x4*)(P + (size_t)row * PW + gc0 + 32 * bj + 8 * fq) = o;
                }
                if (is_kf) { ss += __shfl_xor(ss, 16); ss += __shfl_xor(ss, 32); kmx = fmaxf(kmx, ss); }
            }
        if (is_kf) { kmx = wave_max(kmx); if (lane_id() == 0) atomicMax(kmaxw + (gc0 - OKF) / HD, f2u(kmx)); }
    }
};
__device__ __forceinline__ void phase_inproj(const Params& p, int l, float* ldsf) {
    InprojSched S; S.wid = p.wid; plain_ao(S.ao, D, TIDX(p)); S.vcu = vcu_id(); S.G = gridDim.x;
    InprojEpi E; E.P = (bf16_t*)(p.ws + WS_PROJ); E.LOGF = (float*)(p.ws + WS_LOGF); E.kmaxw = (unsigned*)(p.ws + WS_CTL) + CTL_KMAX + l * 8; E.rot = (const f32x2*)(p.ws + WS_ROT); E.bfg = p.b_forget + l * NFOX;
    gemm_stream((lds_u8*)ldsf, (const char*)(p.ws + WS_H), (const char*)(p.ws + WS_WIN) + (size_t)l * PW * D * 2, D, S, E);
}

__device__ __forceinline__ float ret_log_gamma(int h) { return logf(1.0f - exp2f(-5.0f - (float)h)); }
__device__ __forceinline__ void ret_prep_item(const Params& p, int h, int n, lds_u8* wl) {
    const bf16_t* P = (const bf16_t*)(p.ws + WS_PROJ);
    float* UT = (float*)(p.ws + WS_U);
    const int lane = lane_id(), r32 = lane & 31, hi = lane >> 5;
    const float lg = ret_log_gamma(h);
    wave_barrier();
#pragma unroll
    for (int i = 0; i < 8; ++i) {
        const int c = lane + 64 * i, row = c >> 3, ch = c & 7;
        const bf16_t* src = P + (size_t)(n * CH + row) * PW + h * HD + 8 * ch;
        const u32x4 kv = *(const u32x4*)(src + OKR), vv = *(const u32x4*)(src + OVR);
        const float dk = fast_exp(lg * (float)(CH - 1 - row));
        u32x4 ko;
#pragma unroll
        for (int w = 0; w < 4; ++w) ko[w] = pk2(u2f(kv[w] << 16) * dk, u2f(kv[w] & 0xffff0000u) * dk);
        *(LAS u32x4*)(wl + row * VROWB + ch * 16) = ko;
        *(LAS u32x4*)(wl + IMG64 + row * VROWB + ch * 16) = vv;
    }
    wave_barrier();
    const lds_u8* tb = wl + (8 * hi + ((lane & 15) >> 2)) * VROWB + (16 * ((lane >> 4) & 1) + 4 * (lane & 3)) * 2;
    f32x16 acc[2][2];
#pragma unroll
    for (int a = 0; a < 2; ++a)
#pragma unroll
        for (int b = 0; b < 2; ++b)
#pragma unroll
            for (int r = 0; r < 16; ++r) acc[a][b][r] = 0.f;
#pragma unroll
    for (int s = 0; s < 4; ++s) {
        bf16x8 vf[2], kf[2];
#pragma unroll
        for (int x = 0; x < 2; ++x) { kf[x] = tr_frag(tb, 16 * s, 16 * s + 4, x * 64); vf[x] = tr_frag(tb + IMG64, 16 * s, 16 * s + 4, x * 64); }
#pragma unroll
        for (int eb = 0; eb < 2; ++eb)
#pragma unroll
            for (int db = 0; db < 2; ++db) acc[eb][db] = mfma32(vf[eb], kf[db], acc[eb][db]);
    }
    float* dst = UT + (size_t)(h * NCHUNK + n) * 4096;
#pragma unroll
    for (int eb = 0; eb < 2; ++eb)
#pragma unroll
        for (int db = 0; db < 2; ++db)
#pragma unroll
            for (int r = 0; r < 16; ++r) dst[(32 * eb + crow(r, hi)) * 64 + 32 * db + r32] = acc[eb][db][r];
}
__device__ __forceinline__ void fcum_block(const Params& p, int h, float* ldsf) {
    const float* LF = (const float*)(p.ws + WS_LOGF) + (size_t)h * S;
    float* F = (float*)(p.ws + WS_FCUM) + (size_t)h * S;
    constexpr int KPT = S / NT;
    const int tid = TIDX(p), lane = lane_id(), w = p.wid;
    float v[KPT];
#pragma unroll
    for (int i = 0; i < KPT; ++i) v[i] = LF[tid * KPT + i];
#pragma unroll
    for (int i = 1; i < KPT; ++i) v[i] += v[i - 1];
    float inc = v[KPT - 1];
#pragma unroll
    for (int d = 1; d < 64; d <<= 1) { const float o = __shfl_up(inc, d); if (lane >= d) inc += o; }
    __syncthreads();
    if (lane == 63) ldsf[w] = inc;
    __syncthreads();
    float off = inc - v[KPT - 1];
    for (int ww = 0; ww < w; ++ww) off += ldsf[ww];
#pragma unroll
    for (int i = 0; i < KPT; ++i) F[tid * KPT + i] = v[i] + off;
    __syncthreads();
}
__device__ __forceinline__ void phase_prep(const Params& p, int l, float* ldsf) {
    if ((int)blockIdx.x < NFOX) fcum_block(p, (int)blockIdx.x, ldsf);
    const int wave = p.wid;
    lds_u8* wl = (lds_u8*)ldsf + wave * RET_WAVE_LDS;
    for (int it = blockIdx.x * NW + wave; it < NRET * NCHUNK; it += gridDim.x * NW) ret_prep_item(p, it / NCHUNK, it % NCHUNK, wl);
}

constexpr int NQ32 = S / 32;
constexpr int MIX_WAVE_LDS = 32 * VROWB;
__device__ __forceinline__ void ret_scan_wave(const Params& p, int item) {
    const float* U = (const float*)(p.ws + WS_U);
    bf16_t* SP = (bf16_t*)(p.ws + WS_SP);
    const int e = item * 64 + lane_id();
    const int h = e >> 12, de = e & 4095;
    const float c = expf(ret_log_gamma(h) * (float)CH);
    float st = 0.f;
    const size_t base = (size_t)h * NCHUNK * 4096 + de;
#pragma unroll 1
    for (int n0 = 0; n0 < NCHUNK; n0 += 32) {
        float u[32];
#pragma unroll
        for (int i = 0; i < 32; ++i) u[i] = (n0 + i < NCHUNK) ? U[base + (size_t)(n0 + i) * 4096] : 0.f;
#pragma unroll
        for (int i = 0; i < 32; ++i) if (n0 + i < NCHUNK) { SP[base + (size_t)(n0 + i) * 4096] = f2bf(st); st = st * c + u[i]; }
    }
}
template <bool FOX>
__device__ __forceinline__ void attn_item(const Params& p, int l, int h, int qb, lds_u8* wl) {
    const bf16_t* P = (const bf16_t*)(p.ws + WS_PROJ);
    const float* Fh = (const float*)(p.ws + WS_FCUM) + (size_t)h * S;
    bf16_t* MG = (bf16_t*)(p.ws + WS_MERGED);
    const int lane = lane_id(), r32 = lane & 31, hi = lane >> 5;
    const int q0 = qb * 32, t = q0 + r32;
    constexpr int oq = FOX ? OQF : OQS, ok = FOX ? OKF : OKS, ov = FOX ? OVF : OVS;
    bf16x8 qf[4];
    { const bf16_t* qp = P + (size_t)t * PW + oq + h * HD + 8 * hi;
#pragma unroll
      for (int ks = 0; ks < 4; ++ks) qf[ks] = *(const bf16x8*)(qp + 16 * ks); }
    float Bt = 0.f;
    if (FOX) {
        float qq = 0.f;
#pragma unroll
        for (int ks = 0; ks < 4; ++ks)
#pragma unroll
            for (int j = 0; j < 8; ++j) { const float v = bf2f((bf16_t)qf[ks][j]); qq += v * v; }
        qq += __shfl_xor(qq, 32);
        const float kmax = sqrtf(u2f(((const unsigned*)(p.ws + WS_CTL))[CTL_KMAX + l * 8 + h]));
        Bt = sqrtf(qq) * kmax * 1.0001f + 1e-6f;
    }
    const float fq = FOX ? Fh[t] : 0.f;
    float m = -1e30f, lsum = 0.f, carry = 0.f;
    f32x16 o0, o1;
#pragma unroll
    for (int r = 0; r < 16; ++r) { o0[r] = 0.f; o1[r] = 0.f; }
    const lds_u8* vb = wl + (4 * hi + ((lane & 15) >> 2)) * VROWB + (16 * ((lane >> 4) & 1) + 4 * (lane & 3)) * 2;
    bf16x8 kf1[4], kf2[4]; u32x4 vr1[4], vr2[4];
#define ATTN_LOAD(KF, VR, kt_) do { const int k0_ = (kt_) * 32; const bf16_t* kp_ = P + (size_t)(k0_ + r32) * PW + ok + h * HD + 8 * hi; \
        _Pragma("unroll") for (int ks = 0; ks < 4; ++ks) KF[ks] = *(const bf16x8*)(kp_ + 16 * ks); \
        _Pragma("unroll") for (int i = 0; i < 4; ++i) { const int c = lane + 64 * i; VR[i] = *(const u32x4*)(P + (size_t)(k0_ + (c >> 3)) * PW + ov + h * HD + 8 * (c & 7)); } \
        } while (0)
    ATTN_LOAD(kf1, vr1, qb);
    ATTN_LOAD(kf2, vr2, qb > 0 ? qb - 1 : 0);
    for (int kt = qb; kt >= 0; --kt) {
        const int key0 = kt * 32;
        const bool diag = (kt == qb);
        bf16x8 kf[4]; u32x4 vr[4];
#pragma unroll
        for (int ks = 0; ks < 4; ++ks) { kf[ks] = kf1[ks]; kf1[ks] = kf2[ks]; }
#pragma unroll
        for (int i = 0; i < 4; ++i) { vr[i] = vr1[i]; vr1[i] = vr2[i]; }
        ATTN_LOAD(kf2, vr2, kt > 1 ? kt - 2 : 0);
        f32x4 fk[4]; float fkm1 = 0.f;
        if (FOX) {
#pragma unroll
            for (int g4 = 0; g4 < 4; ++g4) fk[g4] = *(const f32x4*)(Fh + key0 + 8 * g4 + 4 * hi);
            fkm1 = Fh[key0 > 0 ? key0 - 1 : 0];
        }
        f32x16 st;
#pragma unroll
        for (int r = 0; r < 16; ++r) st[r] = 0.f;
#pragma unroll
        for (int ks = 0; ks < 4; ++ks) st = mfma32(kf[ks], qf[ks], st);
        wave_barrier();
#pragma unroll
        for (int i = 0; i < 4; ++i) { const int c = lane + 64 * i; *(LAS u32x4*)(wl + (c >> 3) * VROWB + (c & 7) * 16) = vr[i]; }
        if (FOX) {
            float tmax = -1e30f;
#pragma unroll
            for (int g4 = 0; g4 < 4; ++g4)
#pragma unroll
                for (int i = 0; i < 4; ++i) { const int r = 4 * g4 + i; st[r] = st[r] + (fq - fk[g4][i]); }
            if (diag) {
#pragma unroll
                for (int r = 0; r < 16; ++r) if (crow(r, hi) > r32) st[r] = -1e30f;
            }
#pragma unroll
            for (int r = 0; r < 16; ++r) tmax = fmaxf(tmax, st[r]);
            tmax = fmaxf(tmax, partner32(tmax, hi));
            const float mn = fmaxf(m, tmax), f = fast_exp(m - mn);
            m = mn; lsum *= f;
#pragma unroll
            for (int r = 0; r < 16; ++r) { o0[r] *= f; o1[r] *= f; }
            float ps = 0.f;
#pragma unroll
            for (int r = 0; r < 16; ++r) { const float pr = fast_exp(st[r] - mn); st[r] = pr; ps += pr; }
            lsum += ps;
        } else {
            float l1m[16];
#pragma unroll
            for (int r = 0; r < 16; ++r) {
                const float z = st[r], sp = fast_log(1.0f + fast_exp(-fabsf(z)));
                const float lb = fminf(z, 0.f) - sp;
                l1m[r] = lb - z;
                st[r] = lb;
            }
            if (diag) {
#pragma unroll
                for (int r = 0; r < 16; ++r) if (crow(r, hi) >= r32) { l1m[r] = 0.f; st[r] = -1e30f; }
            }
            float gs[4], pg[4], T[4];
#pragma unroll
            for (int k = 0; k < 4; ++k) { gs[k] = (l1m[4 * k] + l1m[4 * k + 1]) + (l1m[4 * k + 2] + l1m[4 * k + 3]); pg[k] = partner32(gs[k], hi); }
            float run = 0.f;
#pragma unroll
            for (int k = 3; k >= 0; --k) { T[k] = run + (hi == 0 ? pg[k] : 0.f); run += gs[k] + pg[k]; }
#pragma unroll
            for (int k = 0; k < 4; ++k) {
                float w = T[k] + carry;
#pragma unroll
                for (int i = 3; i >= 0; --i) { const int r = 4 * k + i; st[r] = fast_exp(st[r] + w); w += l1m[r]; }
            }
            carry += run;
        }
        u32x4 pw0, pw1;
#pragma unroll
        for (int j = 0; j < 4; ++j) { pw0[j] = pk2(st[2 * j], st[2 * j + 1]); pw1[j] = pk2(st[8 + 2 * j], st[9 + 2 * j]); }
        const bf16x8 pf0 = __builtin_bit_cast(bf16x8, pw0), pf1 = __builtin_bit_cast(bf16x8, pw1);
        wave_barrier();
#pragma unroll
        for (int s = 0; s < 2; ++s) {
#pragma unroll
            for (int db = 0; db < 2; ++db) {
                const s16x4 lo = tr16(vb + (16 * s) * VROWB + db * 64), hi4 = tr16(vb + (16 * s + 8) * VROWB + db * 64);
                bf16x8 vf; vf[0] = lo[0]; vf[1] = lo[1]; vf[2] = lo[2]; vf[3] = lo[3]; vf[4] = hi4[0]; vf[5] = hi4[1]; vf[6] = hi4[2]; vf[7] = hi4[3];
                if (db == 0) o0 = mfma32(vf, s == 0 ? pf0 : pf1, o0); else o1 = mfma32(vf, s == 0 ? pf0 : pf1, o1);
            }
        }
        const bool done = FOX ? (Bt + (fq - fkm1) - m + logf((float)(key0 + 1)) < -EXIT_T) : (carry < -EXIT_T);
        if (ballot64(done) == ~0ull) break;
    }
#undef ATTN_LOAD
    if (FOX) { lsum += __shfl_xor(lsum, 32); const float il = 1.0f / lsum;
#pragma unroll
        for (int r = 0; r < 16; ++r) { o0[r] *= il; o1[r] *= il; } }
    float ss = 0.f;
#pragma unroll
    for (int r = 0; r < 16; ++r) ss += o0[r] * o0[r] + o1[r] * o1[r];
    ss += __shfl_xor(ss, 32);
    const float ri = 1.0f / sqrtf(ss * (1.0f / HD) + EPS);
    const float* g = (FOX ? p.g_fox + l * WFOX : p.g_sb + l * WSB) + h * HD;
    bf16_t* dst = MG + (size_t)t * MIXW + (FOX ? WRET + WSB : WRET) + h * HD;
#pragma unroll
    for (int db = 0; db < 2; ++db)
#pragma unroll
        for (int g4 = 0; g4 < 4; ++g4) {
            const int d0 = db * 32 + 8 * g4 + 4 * hi;
            const f32x4 gg = *(const f32x4*)(g + d0);
            float v[4];
#pragma unroll
            for (int i = 0; i < 4; ++i) v[i] = (db == 0 ? o0[4 * g4 + i] : o1[4 * g4 + i]) * ri * gg[i];
            u32x2 o; o[0] = pk2(v[0], v[1]); o[1] = pk2(v[2], v[3]);
            *(u32x2*)(dst + d0) = o;
        }
}
constexpr int WCH = 2, NWCH = (NE * WI_EXPERT + WCH - 1) / WCH;
__device__ __forceinline__ bool mix_weight_step(const Params& p, int l, lds_u8* wl, int shard0, int& wsk) {
    unsigned* wbase = (unsigned*)(p.ws + WS_CTL) + CTL_WQ + 64 * (l * 8);
    const int lane = lane_id();
#pragma unroll 1
    while (wsk < 8) {
        const int shard = (shard0 + wsk) & 7;
        unsigned* head = wbase + 64 * shard;
        unsigned c = 0x0fffffffu;
        if (lane == 0) { if (!(wsk > 0 && (int)ld_relaxed(head) * 8 + shard >= NWCH)) c = atomicAdd(head, 1u); }
        const int chunk = uni((int)__shfl(c, 0)) * 8 + shard;
        if (chunk >= NWCH) { ++wsk; continue; }
        static_assert(WCH == 2 && (NE * WI_EXPERT) % 2 == 0, "two tiles per dequeue");
        weight_item2(p, l, WI_DENSE + chunk * 2, WI_DENSE + chunk * 2 + 1, wl, lane);
        return true;
    }
    return false;
}
__device__ __forceinline__ void phase_mix(const Params& p, int l, float* ldsf) {
    constexpr int NSCANW = NRET * 4096 / 64, NFXI = NFOX * NQ32, NSBI = NSB * NQ32;
    const int wave = p.wid;
    lds_u8* wl = (lds_u8*)ldsf + wave * RET_WAVE_LDS;
    static_assert(MIX_WAVE_LDS <= RET_WAVE_LDS, "per-wave LDS region");
    const int shard0 = xcc_shard();
    int wsk = 0;
    unsigned* qbase = (unsigned*)(p.ws + WS_CTL) + CTL_MQ + 64 * (l * 8);
    const float* bfg = p.b_forget + l * NFOX;
    constexpr int NMIX = NSCANW + NFXI + NSBI;
#pragma unroll 1
    for (int sk = 0; sk < 8; ++sk) {
      const int shard = (shard0 + sk) & 7;
      unsigned* qhead = qbase + 64 * shard;
#pragma unroll 1
      for (;;) {
        unsigned itu = 0;
        if (lane_id() == 0) { if (sk > 0 && (int)ld_relaxed(qhead) * 8 + shard >= NMIX) itu = 0x0fffffffu; else itu = atomicAdd(qhead, 1u); }
        const int it = uni((int)__shfl(itu, 0)) * 8 + shard;
        if (it >= NMIX) break;
        if (it < NSCANW) ret_scan_wave(p, it);
        else if (it < NSCANW + NFXI) {
            const int j = it - NSCANW, rank = j / NQ32;
            int h = 0;
#pragma unroll
            for (int c = 0; c < NFOX; ++c) { int rk = 0;
#pragma unroll
                for (int o = 0; o < NFOX; ++o) rk += (bfg[o] > bfg[c] || (bfg[o] == bfg[c] && o < c)) ? 1 : 0;
                if (rk == rank) h = c; }
            attn_item<true>(p, l, h, NQ32 - 1 - j % NQ32, wl);
        }
        else { const int j = it - NSCANW - NFXI; attn_item<false>(p, l, j % NSB, NQ32 - 1 - j / NSB, wl); }
        (void)mix_weight_step(p, l, wl, shard0, wsk);
      }
    }
    while (mix_weight_step(p, l, wl, shard0, wsk)) {}
}

__device__ __forceinline__ void ret_out_item(const Params& p, int l, int h, int n, int cb, lds_u8* wl) {
    const bf16_t* P = (const bf16_t*)(p.ws + WS_PROJ);
    const bf16_t* SPT = (const bf16_t*)(p.ws + WS_SP) + (size_t)(h * NCHUNK + n) * 4096;
    bf16_t* MG = (bf16_t*)(p.ws + WS_MERGED);
    const int lane = lane_id(), r32 = lane & 31, hi = lane >> 5;
    const float lg = ret_log_gamma(h);
    const size_t rowb = (size_t)(n * CH) * PW + h * HD;
    const int c = 32 * cb + r32;
    wave_barrier();
    {
        u32x4 vv[8];
#pragma unroll
        for (int i = 0; i < 8; ++i) { const int q = lane + 64 * i; vv[i] = *(const u32x4*)(P + rowb + (size_t)(q >> 3) * PW + OVR + 8 * (q & 7)); }
#pragma unroll
        for (int i = 0; i < 8; ++i) { const int q = lane + 64 * i; *(LAS u32x4*)(wl + (q >> 3) * VROWB + (q & 7) * 16) = vv[i]; }
    }
    sched_fence();
    bf16x8 qf[4];
#pragma unroll
    for (int ks = 0; ks < 4; ++ks) qf[ks] = *(const bf16x8*)(P + rowb + (size_t)c * PW + OQR + 16 * ks + 8 * hi);
    f32x16 o[2];
#pragma unroll
    for (int a = 0; a < 2; ++a)
#pragma unroll
        for (int r = 0; r < 16; ++r) o[a][r] = 0.f;
#pragma unroll
    for (int ks = 0; ks < 4; ++ks)
#pragma unroll
        for (int eb = 0; eb < 2; ++eb) { const bf16x8 sf = *(const bf16x8*)(SPT + (32 * eb + r32) * 64 + 16 * ks + 8 * hi); o[eb] = mfma32(sf, qf[ks], o[eb]); }
    { const float qd = fast_exp(lg * (float)(c + 1));
#pragma unroll
      for (int eb = 0; eb < 2; ++eb)
#pragma unroll
          for (int r = 0; r < 16; ++r) o[eb][r] *= qd; }
    wave_barrier();
    const lds_u8* vb = wl + (4 * hi + ((lane & 15) >> 2)) * VROWB + (16 * ((lane >> 4) & 1) + 4 * (lane & 3)) * 2;
#pragma unroll
    for (int kb = 0; kb < 2; ++kb) {
        f32x16 st;
#pragma unroll
        for (int r = 0; r < 16; ++r) st[r] = 0.f;
#pragma unroll
        for (int ks = 0; ks < 4; ++ks) { const bf16x8 kf = *(const bf16x8*)(P + rowb + (size_t)(32 * kb + r32) * PW + OKR + 16 * ks + 8 * hi); st = mfma32(kf, qf[ks], st); }
        bf16x8 pf[2];
#pragma unroll
        for (int r = 0; r < 16; ++r) { const int dist = c - (32 * kb + crow(r, hi)); st[r] *= fast_exp(lg * fabsf((float)dist)); }
        { u32x4 w0, w1;
#pragma unroll
          for (int j = 0; j < 4; ++j) { w0[j] = pk2(st[2 * j], st[2 * j + 1]); w1[j] = pk2(st[8 + 2 * j], st[9 + 2 * j]); }
          pf[0] = __builtin_bit_cast(bf16x8, w0); pf[1] = __builtin_bit_cast(bf16x8, w1); }
#pragma unroll
        for (int s = 0; s < 2; ++s)
#pragma unroll
            for (int eb = 0; eb < 2; ++eb) o[eb] = mfma32(tr_frag(vb, 32 * kb + 16 * s, 32 * kb + 16 * s + 8, eb * 64), pf[s], o[eb]);
    }
    float sm = 0.f;
#pragma unroll
    for (int eb = 0; eb < 2; ++eb)
#pragma unroll
        for (int r = 0; r < 16; ++r) sm += o[eb][r];
    sm += __shfl_xor(sm, 32);
    const float mu = sm * (1.0f / HD);
    float vs = 0.f;
#pragma unroll
    for (int eb = 0; eb < 2; ++eb)
#pragma unroll
        for (int r = 0; r < 16; ++r) { const float dlt = o[eb][r] - mu; o[eb][r] = dlt; vs += dlt * dlt; }
    vs += __shfl_xor(vs, 32);
    const float ri = 1.0f / sqrtf(vs * (1.0f / HD) + EPS);
    const int row = n * CH + c;
#pragma unroll
    for (int eb = 0; eb < 2; ++eb)
#pragma unroll
        for (int g4 = 0; g4 < 4; ++g4) {
            const int e0 = 32 * eb + 8 * g4 + 4 * hi;
            const f32x4 gg = *(const f32x4*)(p.g_ret + l * WRET + h * HD + e0);
            const u32x2 gt = *(const u32x2*)(P + (size_t)row * PW + OGR + h * HD + e0);
            const float ga[4] = {u2f(gt[0] << 16), u2f(gt[0] & 0xffff0000u), u2f(gt[1] << 16), u2f(gt[1] & 0xffff0000u)};
            float v[4];
#pragma unroll
            for (int i = 0; i < 4; ++i) v[i] = o[eb][4 * g4 + i] * ri * gg[i] * ga[i];
            u32x2 ov; ov[0] = pk2(v[0], v[1]); ov[1] = pk2(v[2], v[3]);
            *(u32x2*)(MG + (size_t)row * MIXW + h * HD + e0) = ov;
        }
}
__device__ __forceinline__ void phase_retout(const Params& p, int l, float* ldsf) {
    const int wave = p.wid;
    lds_u8* wl = (lds_u8*)ldsf + wave * RET_WAVE_LDS;
    for (int it = blockIdx.x * NW + wave; it < NRET * NCHUNK * 2; it += gridDim.x * NW) ret_out_item(p, l, (it >> 1) / NCHUNK, (it >> 1) % NCHUNK, it & 1, wl);
}

struct OutprojSched {
    static constexpr bool GATHER = false;
    int wid;
    unsigned ao[4]; int vcu, G;
    static constexpr int NPM = S / GBM, NPN = D / GBM;
    __device__ __forceinline__ bool next(int i, GUnit& u) const {
        const int L = uni(i * G + vcu); if (L >= NPM * NPN) return false;
        const int pm = L / NPN, pn = L % NPN;
        u.A = (unsigned)(pm * GBM * MIXW * 2); u.B = (unsigned)(pn * GBM * MIXW * 2); u.ao[0] = u.ao[1] = u.ao[2] = u.ao[3] = 0u;
        u.i0 = pm; u.i1 = pn; u.i2 = 0; u.i3 = 0; return true;
    }
};
struct OutprojEpi {
    const float* xin32; const bf16_t* xin16; bf16_t* X;
    __device__ __forceinline__ void operator()(f32x4 (&acc)[2][2][4][2], const GUnit& u, int wr, int wc, int fr, int fq) const {
        const size_t o0 = (size_t)(u.i0 * GBM + wr * 64 + fr) * D + u.i1 * GBM + wc * 32 + 8 * fq;
#pragma unroll
        for (int ai = 0; ai < 2; ++ai)
#pragma unroll
            for (int mh = 0; mh < 2; ++mh) {
                f32x4 r[2][2][2];
#pragma unroll
                for (int mm = 0; mm < 2; ++mm)
#pragma unroll
                    for (int bj = 0; bj < 2; ++bj) { const size_t o = o0 + (size_t)(ai * 128 + (2 * mh + mm) * 16) * D + bj * 128;
                        if (xin32) { r[mm][bj][0] = *(const f32x4*)(xin32 + o); r[mm][bj][1] = *(const f32x4*)(xin32 + o + 4); }
                        else { const u32x4 w = *(const u32x4*)(xin16 + o);
                            r[mm][bj][0] = (f32x4){u2f(w[0] << 16), u2f(w[0] & 0xffff0000u), u2f(w[1] << 16), u2f(w[1] & 0xffff0000u)};
                            r[mm][bj][1] = (f32x4){u2f(w[2] << 16), u2f(w[2] & 0xffff0000u), u2f(w[3] << 16), u2f(w[3] & 0xffff0000u)}; } }
#pragma unroll
                for (int mm = 0; mm < 2; ++mm)
#pragma unroll
                    for (int bj = 0; bj < 2; ++bj) { u32x4 ov;
#pragma unroll
                        for (int n = 0; n < 2; ++n) { const f32x4 v = r[mm][bj][n] + acc[ai][bj][2 * mh + mm][n]; ov[2 * n] = pk2(v[0], v[1]); ov[2 * n + 1] = pk2(v[2], v[3]); }
                        *(u32x4*)(X + o0 + (size_t)(ai * 128 + (2 * mh + mm) * 16) * D + bj * 128) = ov; }
                sched_fence();
            }
    }
};
__device__ __forceinline__ void phase_outproj(const Params& p, int l, float* ldsf) {
    OutprojSched S; S.wid = p.wid; plain_ao(S.ao, MIXW, TIDX(p)); S.vcu = vcu_id(); S.G = gridDim.x;
    OutprojEpi E; E.X = (bf16_t*)(p.ws + WS_X); E.xin32 = l == 0 ? p.x : nullptr; E.xin16 = E.X;
    gemm_stream((lds_u8*)ldsf, (const char*)(p.ws + WS_MERGED), (const char*)(p.ws + WS_WOUT) + (size_t)l * D * MIXW * 2, MIXW, S, E);
}

constexpr int RW = D + 4;
constexpr int ROUTE_LDS = NROUTE * RW * 4 + 2 * NE * 4 + 2 * 256 * 4;
template <bool DRY = false>
__device__ __forceinline__ void phase_route(const Params& p, int l, float* lds) {
    const bf16_t* X = (const bf16_t*)(p.ws + WS_X);
    bf16_t* H = (bf16_t*)(p.ws + WS_H);
    unsigned* ctl = (unsigned*)(p.ws + WS_CTL);
    int* LIST = (int*)(p.ws + WS_LIST);
    float* GATE = (float*)(p.ws + WS_GATE);
    const float* gn = p.norm_ffn + l * D;
    const float* wg = p.w_group + (size_t)l * D * NG; const float* wr = p.w_router + (size_t)l * D * NE;
    const float* bg = p.b_group + l * NG; const float* br = p.b_router + l * NE;
    const int lane = lane_id(), wave = p.wid;
    const int tidx = TIDX(p);
    unsigned* lcnt = (unsigned*)(lds + NROUTE * RW); unsigned* lbase = lcnt + NE; unsigned* lrec = lbase + NE;
    __syncthreads();
    if (tidx < NE) lcnt[tidx] = 0u;
    {
        constexpr int NV4 = D * NE / 4 / NT;
        f32x4 t[NV4];
#pragma unroll
        for (int k = 0; k < NV4; ++k) t[k] = *(const f32x4*)(wr + (size_t)(tidx + k * NT) * 4);
        for (int i = tidx; i < D * NG; i += NT) lds[(i % NG) * RW + i / NG] = wg[i];
#pragma unroll
        for (int k = 0; k < NV4; ++k) { const int i = (tidx + k * NT) * 4, c = i / NE, e = i % NE;
#pragma unroll
            for (int j = 0; j < 4; ++j) lds[(NG + e + j) * RW + c] = t[k][j]; }
    }
    __syncthreads();
    f32x4 vn[RJ]; { const int r0 = blockIdx.x * NW + wave; if (r0 < S) row_load_bf16(X + (size_t)r0 * D, vn, lane); }
    for (int r = blockIdx.x * NW + wave; r < S; r += gridDim.x * NW) {
        f32x4 v[RJ];
#pragma unroll
        for (int j = 0; j < RJ; ++j) v[j] = vn[j];
        { const int rn = r + gridDim.x * NW; if (rn < S) row_load_bf16(X + (size_t)rn * D, vn, lane); }
        const float ri = row_rinv(v);
#pragma unroll
        for (int j = 0; j < RJ; ++j) {
            const f32x4 g = *(const f32x4*)(gn + 256 * j + lane * 4);
            v[j] = v[j] * ri * g;
            u32x2 o; o[0] = pk2(v[j][0], v[j][1]); o[1] = pk2(v[j][2], v[j][3]);
            *(u32x2*)(H + (size_t)r * D + 256 * j + lane * 4) = o;
        }
        float gl[NG];
#pragma unroll
        for (int g = 0; g < NG; ++g) { float s = 0.f;
#pragma unroll
            for (int j = 0; j < RJ; ++j) { const f32x4 w = *(const f32x4*)(lds + g * RW + 256 * j + lane * 4); s += (v[j][0] * w[0] + v[j][1] * w[1]) + (v[j][2] * w[2] + v[j][3] * w[3]); }
            gl[g] = s; }
#pragma unroll
        for (int g = 0; g < NG; ++g) gl[g] = wave_sum(gl[g]) + bg[g];
        int grp = 0; float gm = gl[0];
#pragma unroll
        for (int g = 1; g < NG; ++g) if (gl[g] > gm) { gm = gl[g]; grp = g; }
        float den = 0.f;
#pragma unroll
        for (int g = 0; g < NG; ++g) den += fast_exp(gl[g] - gm);
        const float pg = 1.0f / den;
        float el[EPG];
        const float* wl = lds + (NG + grp * EPG) * RW + lane * 4;
#pragma unroll
        for (int e = 0; e < EPG; ++e) { float s = 0.f;
#pragma unroll
            for (int j = 0; j < RJ; ++j) { const f32x4 w = *(const f32x4*)(wl + e * RW + 256 * j); s += (v[j][0] * w[0] + v[j][1] * w[1]) + (v[j][2] * w[2] + v[j][3] * w[3]); }
            el[e] = s; }
#pragma unroll
        for (int e = 0; e < EPG; ++e) el[e] = wave_sum(el[e]) + br[grp * EPG + e];
        if (lane == 0 && !(DRY && el[0] != 12345.f)) {
            int i1 = 0; float v1 = -INFINITY; int i2 = 0; float v2 = -INFINITY;
#pragma unroll
            for (int e = 0; e < EPG; ++e) { const float x = el[e];
                if (x > v1) { v2 = v1; i2 = i1; v1 = x; i1 = e; } else if (x > v2) { v2 = x; i2 = e; } }
            const float e2 = fast_exp(v2 - v1), g1 = pg / (1.f + e2), g2 = pg * e2 / (1.f + e2);
            const int ea = grp * EPG + i1, eb = grp * EPG + i2;
            GATE[(size_t)r * 2] = g1; GATE[(size_t)r * 2 + 1] = g2;
            const int li = (r - blockIdx.x * NW) / (gridDim.x * NW) * NW + wave;
            const unsigned ra = atomicAdd(lcnt + ea, 1u), rb = atomicAdd(lcnt + eb, 1u);
            lrec[2 * li] = (unsigned)ea | (ra << 8); lrec[2 * li + 1] = (unsigned)eb | (rb << 8);
        }
    }
    if (!DRY) {
        __syncthreads();
        if (tidx < NE) lbase[tidx] = atomicAdd(ctl + CTL_CNT + l * NE + tidx, lcnt[tidx]);
        __syncthreads();
        const int nrows = (S - blockIdx.x * NW + gridDim.x * NW - 1) / (gridDim.x * NW) * NW;
        for (int i = tidx; i < 2 * nrows; i += NT) {
            const int li = i >> 1, r = blockIdx.x * NW + (li / NW) * (gridDim.x * NW) + (li % NW);
            if (r < S) { const unsigned rec = lrec[i]; const int e = rec & 255u; LIST[(size_t)e * S + lbase[e] + (rec >> 8)] = r * 2 + (i & 1); }
        }
    }
}

__device__ __forceinline__ void moe_table(const unsigned* cnt, volatile LAS unsigned* tab, int tid) {
    __syncthreads();
    if (tid < 64) {
        const unsigned c = tid < NE ? cnt[tid] : 0u;
        unsigned nt = (c + GBM - 1) / GBM, inc = nt;
#pragma unroll
        for (int d = 1; d < 64; d <<= 1) { const unsigned o = (unsigned)__shfl_up((int)inc, d); if ((tid & 63) >= d) inc += o; }
        if (tid < NE) { tab[tid + 1] = inc; tab[64 + tid] = c; }
        if (tid == 0) tab[0] = 0u;
    }
    __syncthreads();
}
__device__ __forceinline__ bool moe_unit(volatile LAS unsigned* tab, int u, int npn, int& e, int& rt, int& pn, int& base, int& count) {
    const int tile = uni(u / npn); pn = uni(u % npn);
    if (tile >= (int)tab[NE]) return false;
    int lo = 0;
#pragma unroll
    for (int s = NE / 2; s >= 1; s >>= 1) if ((int)tab[lo + s] <= tile) lo += s;
    e = uni(lo); rt = tile - (int)tab[e]; base = (int)tab[e] * GBM; count = (int)tab[64 + e];
    rt = uni(rt); base = uni(base); count = uni(count);
    return true;
}
struct Moe1Sched {
    static constexpr bool GATHER = true;
    int wid;
    unsigned ao[4];
    volatile LAS unsigned* tab; const int* LIST; int vcu, G;
    static constexpr int NPN = 2 * DE / GBM;
    __device__ __forceinline__ bool next(int i, GUnit& u) const {
        int e, rt, pn, base, count; if (!moe_unit(tab, i * G + vcu, NPN, e, rt, pn, base, count)) return false;
        const int nvalid = count - rt * GBM;
        u.A = 0u; u.B = (unsigned)((e * 2 * DE + pn * GBM) * D * 2);
#pragma unroll
        for (int k = 0; k < 4; ++k) { int R, C; stage_rc(((wid << 6) | lane_id()) * 16 + (k & 1) * 8192, R, C); const int r = R + 128 * (k >> 1);
            const int tok = r < nvalid ? (LIST[(size_t)e * S + rt * GBM + r] >> 1) : 0; u.ao[k] = (unsigned)((tok * D + C) * 2); }
        u.i0 = base + rt * GBM; u.i1 = pn; u.i2 = nvalid; u.i3 = e * S + rt * GBM; return true;
    }
};
struct Moe1Epi {
    bf16_t* HID;
    __device__ __forceinline__ void operator()(f32x4 (&acc)[2][2][4][2], const GUnit& u, int wr, int wc, int fr, int fq) const {
#pragma unroll
        for (int ai = 0; ai < 2; ++ai)
#pragma unroll
            for (int m = 0; m < 4; ++m)
{ u32x4 o;
#pragma unroll
                for (int n = 0; n < 2; ++n) { f32x4 v;
#pragma unroll
                    for (int j = 0; j < 4; ++j) v[j] = silu(acc[ai][0][m][n][j]) * acc[ai][1][m][n][j];
                    o[2 * n] = pk2(v[0], v[1]); o[2 * n + 1] = pk2(v[2], v[3]); }
                *(u32x4*)(HID + (size_t)(u.i0 + ai * 128 + wr * 64 + m * 16 + fr) * DE + u.i1 * 128 + wc * 32 + 8 * fq) = o; }
    }
};
__device__ __forceinline__ void phase_moe1(const Params& p, int l, float* ldsf) {
    Moe1Sched S; S.wid = p.wid; S.tab = (volatile LAS unsigned*)((LAS unsigned char*)ldsf + GEMM_LDS);
    moe_table((const unsigned*)(p.ws + WS_CTL) + CTL_CNT + l * NE, S.tab, TIDX(p));
    S.LIST = (const int*)(p.ws + WS_LIST); S.vcu = vcu_id(); S.G = gridDim.x;
    Moe1Epi E; E.HID = (bf16_t*)(p.ws + WS_HID);
    gemm_stream((lds_u8*)ldsf, (const char*)(p.ws + WS_H), (const char*)(p.ws + WS_WGU) + (size_t)l * NE * 2 * DE * D * 2, D, S, E);
}
struct Moe2Sched {
    static constexpr bool GATHER = false;
    int wid;
    volatile LAS unsigned* tab; unsigned ao[4]; int vcu, G;
    static constexpr int NPN = D / GBM;
    __device__ __forceinline__ bool next(int i, GUnit& u) const {
        int e, rt, pn, base, count; if (!moe_unit(tab, i * G + vcu, NPN, e, rt, pn, base, count)) return false;
        u.A = (unsigned)((base + rt * GBM) * DE * 2); u.B = (unsigned)((e * D + pn * GBM) * DE * 2); u.ao[0] = u.ao[1] = u.ao[2] = u.ao[3] = 0u;
        u.i0 = 0; u.i1 = pn; u.i2 = count - rt * GBM; u.i3 = e * S + rt * GBM; return true;
    }
};
struct Moe2Epi {
    bf16_t* Y; const int* LIST; const float* GATE;
    __device__ __forceinline__ void operator()(f32x4 (&acc)[2][2][4][2], const GUnit& u, int wr, int wc, int fr, int fq) const {
        int a[2][4]; float g[2][4];
#pragma unroll
        for (int ai = 0; ai < 2; ++ai)
#pragma unroll
            for (int m = 0; m < 4; ++m) { const int r = ai * 128 + wr * 64 + m * 16 + fr; a[ai][m] = r < u.i2 ? LIST[(size_t)u.i3 + r] : -1; }
#pragma unroll
        for (int ai = 0; ai < 2; ++ai)
#pragma unroll
            for (int m = 0; m < 4; ++m) g[ai][m] = a[ai][m] >= 0 ? GATE[a[ai][m]] : 0.f;
#pragma unroll
        for (int ai = 0; ai < 2; ++ai)
#pragma unroll
            for (int m = 0; m < 4; ++m) {
                if (a[ai][m] >= 0) {
#pragma unroll
                    for (int bj = 0; bj < 2; ++bj) { u32x4 o;
#pragma unroll
                        for (int n = 0; n < 2; ++n) { const f32x4 v = acc[ai][bj][m][n] * g[ai][m]; o[2 * n] = pk2(v[0], v[1]); o[2 * n + 1] = pk2(v[2], v[3]); }
                        *(u32x4*)(Y + (size_t)a[ai][m] * D + u.i1 * GBM + bj * 128 + wc * 32 + 8 * fq) = o; }
                }
            }
    }
};
__device__ __forceinline__ void phase_moe2(const Params& p, int l, float* ldsf) {
    Moe2Sched S; S.wid = p.wid; S.tab = (volatile LAS unsigned*)((LAS unsigned char*)ldsf + GEMM_LDS);
    moe_table((const unsigned*)(p.ws + WS_CTL) + CTL_CNT + l * NE, S.tab, TIDX(p));
    plain_ao(S.ao, DE, TIDX(p)); S.vcu = vcu_id(); S.G = gridDim.x;
    Moe2Epi E; E.Y = (bf16_t*)(p.ws + WS_Y); E.LIST = (const int*)(p.ws + WS_LIST); E.GATE = (const float*)(p.ws + WS_GATE);
    gemm_stream((lds_u8*)ldsf, (const char*)(p.ws + WS_HID), (const char*)(p.ws + WS_WDN) + (size_t)l * NE * D * DE * 2, DE, S, E);
}

__device__ __forceinline__ void phase_combine(const Params& p, int l) {
    bf16_t* X = (bf16_t*)(p.ws + WS_X);
    const bf16_t* Y = (const bf16_t*)(p.ws + WS_Y);
    bf16_t* H = (bf16_t*)(p.ws + WS_H);
    const bool last = (l == DEPTH - 1);
    float probe_scale = 1.0f;
#if !defined(CPU_EMU)
    if (PROBE_T >= 0) { const unsigned long long* ts = (const unsigned long long*)(p.ws + WS_CTL + 4 * 8000); const float us = (float)(ts[PROBE_T + 1] - ts[PROBE_T]) * 0.01f; probe_scale = 1.0f + sqrtf(us * 1e-6f); }
#endif
    const float* gn = last ? p.norm_final : p.norm_mix + (l + 1) * D;
    const int lane = lane_id(), wave = p.wid;
    for (int r = blockIdx.x * NW + wave; r < S; r += gridDim.x * NW) {
        f32x4 v[RJ]; row_load_bf16(X + (size_t)r * D, v, lane);
#pragma unroll
        for (int j = 0; j < RJ; ++j) {
            const u32x2 a = *(const u32x2*)(Y + (size_t)(2 * r) * D + 256 * j + lane * 4), b = *(const u32x2*)(Y + (size_t)(2 * r + 1) * D + 256 * j + lane * 4);
            v[j][0] += u2f(a[0] << 16) + u2f(b[0] << 16); v[j][1] += u2f(a[0] & 0xffff0000u) + u2f(b[0] & 0xffff0000u);
            v[j][2] += u2f(a[1] << 16) + u2f(b[1] << 16); v[j][3] += u2f(a[1] & 0xffff0000u) + u2f(b[1] & 0xffff0000u);
        }
        const float ri = row_rinv(v);
#pragma unroll
        for (int j = 0; j < RJ; ++j) {
            const f32x4 g = *(const f32x4*)(gn + 256 * j + lane * 4);
            if (last) *(f32x4*)(p.out + (size_t)r * D + 256 * j + lane * 4) = v[j] * ri * g * probe_scale;
            else {
                { u32x2 xo; xo[0] = pk2(v[j][0], v[j][1]); xo[1] = pk2(v[j][2], v[j][3]); *(u32x2*)(X + (size_t)r * D + 256 * j + lane * 4) = xo; }
                u32x2 o; o[0] = pk2(v[j][0] * ri * g[0], v[j][1] * ri * g[1]); o[1] = pk2(v[j][2] * ri * g[2], v[j][3] * ri * g[3]);
                *(u32x2*)(H + (size_t)r * D + 256 * j + lane * 4) = o;
            }
        }
    }
}

constexpr int PH_PER_LAYER = 9, NPHASE = 1 + DEPTH * PH_PER_LAYER;
constexpr int imax_c(int a, int b) { return a > b ? a : b; }
constexpr int LDS_MAIN = imax_c(imax_c(GEMM_LDS + 1024, ROUTE_LDS), imax_c(NW * RET_WAVE_LDS, NW * MIX_WAVE_LDS));
constexpr int LDS_MISC = (LDS_MAIN + 255) / 256 * 256;
constexpr int LDS_BYTES = LDS_MISC + 256;

__device__ __forceinline__ void run_phase(const Params& p, int ph, float* lds) {
    if (ph == 0) { phase_init(p, lds); return; }
    const int l = (ph - 1) / PH_PER_LAYER, q = (ph - 1) % PH_PER_LAYER;
    switch (q) {
        case 0: phase_inproj(p, l, lds); break;
        case 1: phase_prep(p, l, lds); break;
        case 2: phase_mix(p, l, lds); break;
        case 3: phase_retout(p, l, lds); break;
        case 4: phase_outproj(p, l, lds); break;
        case 5: phase_route(p, l, lds); break;
        case 6: phase_moe1(p, l, lds); break;
        case 7: phase_moe2(p, l, lds); break;
        default: phase_combine(p, l); break;
    }
}

#ifndef CPU_EMU
#define XB_TMO      128
#define XB_XCNT(j)  (256  + 64 * (j))
#define XB_XSUB(j)  (1280 + 64 * (j))
#define XB_XGEN(j)  (2304 + 64 * (j))
#define XB_TOP      3328
#define XB_TOPGEN   3392
#define XCD_BAR_WORDS 3456
#define XB_SPIN_CAP (1u << 22)
__device__ __forceinline__ unsigned xb_ld(unsigned* p)              { return __hip_atomic_load(p, __ATOMIC_RELAXED, __HIP_MEMORY_SCOPE_AGENT); }
__device__ __forceinline__ unsigned xb_add(unsigned* p, unsigned v) { return __hip_atomic_fetch_add(p, v, __ATOMIC_RELAXED, __HIP_MEMORY_SCOPE_AGENT); }
__device__ __forceinline__ unsigned xb_xcc_id() { return (unsigned)__builtin_amdgcn_s_getreg((3 << 11) | 20) & 0xFu; }
#define XB_SPIN(cond, bar) do { unsigned _sp = 0; while (cond) { __builtin_amdgcn_s_sleep(1); \
    if ((++_sp & 255u) == 0u) { if (xb_ld(&(bar)[XB_TMO])) break; if (_sp > XB_SPIN_CAP) { atomicAdd(&(bar)[XB_TMO], 1u); break; } } } } while (0)
struct XcdBarrier { unsigned* bar; unsigned x; volatile LAS unsigned* st; };
__device__ __forceinline__ XcdBarrier xcd_barrier_post(unsigned* bar, volatile LAS unsigned* st, bool t0) {
    XcdBarrier b; b.bar = bar; b.x = xb_xcc_id(); b.st = st;
    if (t0) (void)xb_add(&bar[XB_XCNT(b.x)], 1u);
    return b;
}
__device__ __forceinline__ void xcd_barrier_complete(unsigned* bar, unsigned x, unsigned& nloc, unsigned& nx) {
    const unsigned G = gridDim.x * gridDim.y * gridDim.z;
    unsigned sum, cnt, mine, sp = 0u;
    for (;;) {
        sum = 0u; cnt = 0u; mine = 0u;
#pragma unroll
        for (unsigned j = 0; j < 16; ++j) { const unsigned c = xb_ld(&bar[XB_XCNT(j)]); sum += c; cnt += (c > 0u) ? 1u : 0u; mine = (j == x) ? c : mine; }
        if (sum == G) break;
        __builtin_amdgcn_s_sleep(1);
        if ((++sp & 255u) == 0u) { if (xb_ld(&bar[XB_TMO])) break; if (sp > XB_SPIN_CAP) { atomicAdd(&bar[XB_TMO], 1u); break; } }
    }
    nloc = mine > 0u ? mine : 1u; nx = cnt > 0u ? cnt : 1u;
}
__device__ __forceinline__ void xcd_barrier(const XcdBarrier& b, bool t0) {
    asm volatile("s_waitcnt vmcnt(0)" ::: "memory");
    __syncthreads();
    if (t0) {
        unsigned* bar = b.bar;
        __builtin_amdgcn_s_waitcnt(0);
        unsigned nloc = b.st[0], nx = b.st[1];
        if (nloc == 0u) { xcd_barrier_complete(bar, b.x, nloc, nx); b.st[0] = nloc; b.st[1] = nx; }
        const unsigned old = xb_add(&bar[XB_XSUB(b.x)], 1u);
        const unsigned gen = old / nloc;
        if (old + 1u == (gen + 1u) * nloc) {
            __builtin_amdgcn_fence(__ATOMIC_RELEASE, "agent");
            asm volatile("s_waitcnt vmcnt(0)" ::: "memory");
            const unsigned og = xb_add(&bar[XB_TOP], 1u);
            const unsigned tg = og / nx;
            if (og + 1u == (tg + 1u) * nx) xb_add(&bar[XB_TOPGEN], 1u);
            else XB_SPIN(xb_ld(&bar[XB_TOPGEN]) == tg, bar);
            __builtin_amdgcn_fence(__ATOMIC_ACQUIRE, "agent");
            xb_add(&bar[XB_XGEN(b.x)], 1u);
            asm volatile("s_waitcnt vmcnt(0)" ::: "memory");
        } else {
            XB_SPIN(xb_ld(&bar[XB_XGEN(b.x)]) == gen, bar);
            __builtin_amdgcn_fence(__ATOMIC_ACQUIRE, "agent");
            asm volatile("s_waitcnt vmcnt(0)" ::: "memory");
        }
    }
    __syncthreads();
}
#endif
#ifndef CPU_EMU
__global__ void __launch_bounds__(NT) fwd_kernel(Params pin, int ph_lo, int ph_hi) {
    extern __shared__ __attribute__((aligned(16))) float lds[];
    cg::grid_group grid = cg::this_grid();
    Params p = pin; p.wid = uni((int)(threadIdx.x >> 6));
    volatile LAS unsigned* misc = (volatile LAS unsigned*)((LAS unsigned char*)lds + LDS_MISC);
    if (p.wid == 0) misc[lane_id()] = 0u;
    __syncthreads();
    XcdBarrier xb; xb.bar = (unsigned*)(p.ws + WS_CTL) + CTL_BAR; xb.x = 0; xb.st = misc;
    const bool use_xb = (ph_lo == 0);
#define T0() (p.wid == 0 && lane_id() == 0)
    if (use_xb) xb = xcd_barrier_post((unsigned*)(p.ws + WS_CTL) + CTL_BAR, misc, T0());
#define SEAM(k) do { if (!use_xb) grid.sync(); else xcd_barrier(xb, T0()); } while (0)
#define PHASE(k, call) do { if (ph_lo <= (k) && (k) < ph_hi) { if (PROBE_T >= 0 && blockIdx.x == 0 && T0()) ((unsigned long long*)(p.ws + WS_CTL + 4 * 8000))[k] = __builtin_amdgcn_s_memrealtime(); call; if ((k) + 1 < ph_hi) SEAM(k); } } while (0)
#ifndef PROBE_DUP
#define PROBE_DUP 0
#endif
#define DUP(bit, call) do { if ((PROBE_DUP & (bit)) && l_ == 0) { __syncthreads(); call; } } while (0)
#define LAYER(l) do { const int b_ = 1 + (l) * PH_PER_LAYER; const int l_ = (l); \
        PHASE(b_ + 0, phase_inproj(p, l, lds); DUP(1, phase_inproj(p, l, lds))); PHASE(b_ + 1, phase_prep(p, l, lds); DUP(2, phase_prep(p, l, lds))); PHASE(b_ + 2, phase_mix(p, l, lds); DUP(4, phase_mix(p, l, lds))); \
        PHASE(b_ + 3, phase_retout(p, l, lds); DUP(8, phase_retout(p, l, lds))); PHASE(b_ + 4, phase_outproj(p, l, lds); DUP(16, phase_outproj(p, l, lds))); PHASE(b_ + 5, phase_route(p, l, lds); DUP(128, phase_route<true>(p, l, lds))); \
        PHASE(b_ + 6, phase_moe1(p, l, lds); DUP(32, phase_moe1(p, l, lds))); PHASE(b_ + 7, phase_moe2(p, l, lds); DUP(64, phase_moe2(p, l, lds))); PHASE(b_ + 8, phase_combine(p, l); if ((PROBE_DUP & 256) && l_ == 1) phase_combine(p, l)); } while (0)
    PHASE(0, phase_init(p, lds); if (PROBE_DUP & 512) { __syncthreads(); phase_init(p, lds); });
    LAYER(0);
    LAYER(1);
    static_assert(DEPTH == 2, "phase program written for two layers");
#undef LAYER
#undef PHASE
#undef SEAM
}

#ifndef N_LAUNCH_PER_PHASE
#define N_LAUNCH_PER_PHASE 0
#endif
extern "C" void kernel_launch(void* const* d_in, const int* in_sizes, int n_in, void* d_out, int out_size, void* d_ws, size_t ws_size, hipStream_t stream) {
    static int grid = 0;
    if (grid == 0) {
        if (ws_size < WS_END) { fprintf(stderr, "kernel_launch: workspace too small (%zu < %zu)\n", ws_size, (size_t)WS_END); grid = -1; return; }
        int dev = 0, cus = 0, per_cu = 0;
        hipGetDevice(&dev);
        hipDeviceGetAttribute(&cus, hipDeviceAttributeMultiprocessorCount, dev);
        hipFuncSetAttribute((const void*)fwd_kernel, hipFuncAttributeMaxDynamicSharedMemorySize, LDS_BYTES);
        hipOccupancyMaxActiveBlocksPerMultiprocessor(&per_cu, (const void*)fwd_kernel, NT, LDS_BYTES);
        if (per_cu < 1) { fprintf(stderr, "kernel_launch: occupancy query says %d blocks per CU\n", per_cu); grid = -1; return; }
        grid = cus;
    }
    if (grid < 0) return;
    Params p{};
    p.x = (const float*)d_in[0]; p.norm_mix = (const float*)d_in[1]; p.w_in = (const float*)d_in[2]; p.b_forget = (const float*)d_in[3];
    p.g_ret = (const float*)d_in[4]; p.g_sb = (const float*)d_in[5]; p.g_fox = (const float*)d_in[6]; p.w_out = (const float*)d_in[7];
    p.norm_ffn = (const float*)d_in[8]; p.w_group = (const float*)d_in[9]; p.b_group = (const float*)d_in[10]; p.w_router = (const float*)d_in[11];
    p.b_router = (const float*)d_in[12]; p.w_gate = (const float*)d_in[13]; p.w_up = (const float*)d_in[14]; p.w_down = (const float*)d_in[15];
    p.norm_final = (const float*)d_in[16]; p.out = (float*)d_out; p.ws = (unsigned char*)d_ws;
#if N_LAUNCH_PER_PHASE
    for (int ph = 0; ph < NPHASE; ++ph) {
        int lo = ph, hi = ph + 1; void* args[] = {&p, &lo, &hi};
        hipLaunchCooperativeKernel((const void*)fwd_kernel, dim3(grid), dim3(NT), args, LDS_BYTES, stream);
    }
#else
    (void)hipMemsetAsync((char*)d_ws + WS_CTL + (size_t)CTL_BAR * 4, 0, 3456 * 4, stream);
    int lo = 0, hi = NPHASE; void* args[] = {&p, &lo, &hi};
    hipError_t e = hipLaunchCooperativeKernel((const void*)fwd_kernel, dim3(grid), dim3(NT), args, LDS_BYTES, stream);
    if (e != hipSuccess) fprintf(stderr, "cooperative launch failed: %s (grid %d)\n", hipGetErrorString(e), grid);
#endif
}
#endif
```

```cpp
#ifndef CPU_EMU
#include <hip/hip_runtime.h>
#include <hip/hip_cooperative_groups.h>
#include <cstdio>
#include <cstdint>
#include <cmath>
namespace cg = cooperative_groups;
#define VEC(T, N) T __attribute__((ext_vector_type(N)))
__device__ __forceinline__ void wave_barrier() { __builtin_amdgcn_wave_barrier(); }
__device__ __forceinline__ float sin2pi(float x) { return __builtin_amdgcn_sinf(x); }
__device__ __forceinline__ float cos2pi(float x) { return __builtin_amdgcn_cosf(x); }
__device__ __forceinline__ unsigned long long ballot64(bool p) { return __ballot(p); }
#define LAS __attribute__((address_space(3)))
typedef VEC(short, 8) bf16x8;
typedef VEC(float, 4) f32x4_;
__device__ __forceinline__ void glds16(const void* g, LAS unsigned char* l) { __builtin_amdgcn_global_load_lds((const unsigned*)g, (LAS unsigned*)l, 16, 0, 0); }
__device__ __forceinline__ void vm_wait0() { asm volatile("s_waitcnt vmcnt(0)" ::: "memory"); }
__device__ __forceinline__ void lds_wait0() { asm volatile("s_waitcnt lgkmcnt(0)" ::: "memory"); }
__device__ __forceinline__ void sched_fence() { __builtin_amdgcn_sched_barrier(0); }
__device__ __forceinline__ int uni(int x) { return __builtin_amdgcn_readfirstlane(x); }
__device__ __forceinline__ unsigned ld_relaxed(const unsigned* p) { return __hip_atomic_load(p, __ATOMIC_RELAXED, __HIP_MEMORY_SCOPE_AGENT); }
__device__ __forceinline__ int xcc_shard() { return (int)(__builtin_amdgcn_s_getreg((3 << 11) | 20) & 7u); }
__device__ __forceinline__ int lane_id() { int l; asm volatile("v_mbcnt_lo_u32_b32 %0, -1, 0\n\tv_mbcnt_hi_u32_b32 %0, -1, %0" : "=v"(l)); return l; }
__device__ __forceinline__ f32x4_ mfma16(bf16x8 a, bf16x8 b, f32x4_ c) { return __builtin_amdgcn_mfma_f32_16x16x32_bf16(a, b, c, 0, 0, 0); }
typedef VEC(float, 16) f32x16;
typedef VEC(short, 4) s16x4;
__device__ __forceinline__ f32x16 mfma32(bf16x8 a, bf16x8 b, f32x16 c) { return __builtin_amdgcn_mfma_f32_32x32x16_bf16(a, b, c, 0, 0, 0); }
__device__ __forceinline__ s16x4 tr16(const LAS unsigned char* p) { return __builtin_amdgcn_ds_read_tr16_b64_v4i16((LAS s16x4*)p); }
__device__ __forceinline__ float fast_exp(float x) { return __expf(x); }
__device__ __forceinline__ float fast_log(float x) { return __logf(x); }
__device__ __forceinline__ float partner32(float x, int hi) { const auto rr = __builtin_amdgcn_permlane32_swap(__builtin_bit_cast(unsigned, x), __builtin_bit_cast(unsigned, x), false, false); return __builtin_bit_cast(float, hi ? rr[0] : rr[1]); }
template <int N> __device__ __forceinline__ float row_shl_add(float x) { return x + __builtin_bit_cast(float, __builtin_amdgcn_update_dpp(0, __builtin_bit_cast(int, x), 0x100 + N, 0xf, 0xf, true)); }
__device__ __forceinline__ float read_lane(float x, int l) { return __builtin_bit_cast(float, __builtin_amdgcn_readlane(__builtin_bit_cast(int, x), l)); }
#else
#define VEC(T, N) T __attribute__((vector_size(sizeof(T) * N)))
inline float sin2pi(float x) { return (float)sin(6.283185307179586 * (double)x); }
inline float cos2pi(float x) { return (float)cos(6.283185307179586 * (double)x); }
inline unsigned long long ballot64(bool p) { return emu_ballot(p); }
#define LAS
typedef VEC(short, 8) bf16x8;
inline void glds16(const void* g, unsigned char* l) { memcpy(l + (threadIdx.x & 63) * 16, g, 16); }
inline void vm_wait0() {}
inline void lds_wait0() {}
inline void sched_fence() {}
inline int uni(int x) { return x; }
inline int xcc_shard() { return (int)(blockIdx.x & 7u); }
inline unsigned ld_relaxed(const unsigned* p) { return __atomic_load_n(p, __ATOMIC_RELAXED); }
inline int lane_id() { return threadIdx.x & 63; }
inline emu_f32x4 mfma16(bf16x8 a, bf16x8 b, emu_f32x4 c) { return emu_mfma16(a, b, c); }
typedef VEC(float, 16) f32x16;
typedef VEC(short, 4) s16x4;
inline f32x16 mfma32(bf16x8 a, bf16x8 b, f32x16 c) { return emu_mfma32(a, b, c); }
inline s16x4 tr16(const unsigned char* p) { return emu_tr16(p); }
inline float fast_exp(float x) { return expf(x); }
inline float fast_log(float x) { return logf(x); }
inline float partner32(float x, int hi) { return __shfl_xor(x, 32); }
template <int N> inline float row_shl_add(float x) { const int l = threadIdx.x & 63; const float o = emu_shfl_idx(x, (l + N) & 63); return x + (((l & 15) + N < 16) ? o : 0.f); }
inline float read_lane(float x, int l) { return emu_shfl_idx(x, l); }
#endif

typedef unsigned short bf16_t;
typedef VEC(float, 4) f32x4;
typedef VEC(float, 2) f32x2;
typedef VEC(unsigned, 2) u32x2;
typedef VEC(unsigned, 4) u32x4;
typedef LAS unsigned char lds_u8;

#ifdef SMALL_CFG
constexpr int D = 256, S = 512, DEPTH = 2, NRET = 2, NSB = 1, NFOX = 1, NG = 2, EPG = 4, DE = 128;
#else
constexpr int D = 1024, S = 16384, DEPTH = 2, NRET = 6, NSB = 5, NFOX = 5, NG = 4, EPG = 8, DE = 512;
#endif
constexpr int CH = 64, HD = 64, NE = NG * EPG;
constexpr int WRET = NRET * HD, WSB = NSB * HD, WFOX = NFOX * HD, MIXW = WRET + WSB + WFOX;
constexpr int IN_W = 4 * WRET + 3 * WSB + 3 * WFOX + NFOX;
constexpr int PW = (IN_W + 255) / 256 * 256;
constexpr int OQR = 0, OKR = WRET, OVR = 2 * WRET, OGR = 3 * WRET, OQS = 4 * WRET, OKS = OQS + WSB, OVS = OKS + WSB;
constexpr int OQF = OVS + WSB, OKF = OQF + WFOX, OVF = OKF + WFOX, OFL = OVF + WFOX;
constexpr int NCHUNK = S / CH;
constexpr float EPS = 1e-6f;
constexpr int NT = 512, NW = NT / 64;
constexpr int NROUTE = NG + NE;
constexpr float EXIT_T = 18.0f;

constexpr size_t al256(size_t x) { return (x + 255) / 256 * 256; }
constexpr size_t WS_CTL = 0;
constexpr int CTL_CNT = 0;
constexpr int CTL_KMAX = 256;
constexpr int CTL_MQ = 4608, CTL_WQ = 4608 + DEPTH * 8 * 64;
constexpr int CTL_BAR = 1024;
constexpr int CTL_WORDS = 8192;
static_assert(CTL_BAR + 3456 <= CTL_MQ && CTL_WQ + DEPTH * 8 * 64 <= CTL_WORDS, "control-word map");
constexpr size_t WS_ROT = 32768;
constexpr size_t WS_X = al256(WS_ROT + (size_t)S * 32 * 8);
constexpr size_t WS_H = al256(WS_X + (size_t)S * D * 4);
constexpr size_t WS_LOGF = al256(WS_H + (size_t)S * D * 2);
constexpr size_t WS_FCUM = al256(WS_LOGF + (size_t)S * 8 * 4);
constexpr size_t WS_MERGED = al256(WS_FCUM + (size_t)S * 8 * 4);
constexpr size_t WS_U = al256(WS_MERGED + (size_t)S * MIXW * 2);
constexpr size_t WS_SP = al256(WS_U + (size_t)NRET * NCHUNK * 4096 * 4);
constexpr size_t WS_LIST = al256(WS_SP + (size_t)NRET * NCHUNK * 4096 * 4);
constexpr size_t WS_GATE = al256(WS_LIST + (size_t)NE * S * 4);
constexpr size_t WS_WIN = al256(WS_GATE + (size_t)S * 2 * 4);
constexpr size_t WS_WOUT = al256(WS_WIN + (size_t)DEPTH * PW * D * 2);
constexpr size_t WS_WGU = al256(WS_WOUT + (size_t)DEPTH * D * MIXW * 2);
constexpr size_t WS_WDN = al256(WS_WGU + (size_t)DEPTH * NE * 2 * DE * D * 2);
constexpr size_t WS_PROJ = al256(WS_WDN + (size_t)DEPTH * NE * D * DE * 2);
constexpr int HID_ROWS = 2 * S + NE * 256;
constexpr size_t WS_HID = WS_PROJ;
constexpr size_t WS_Y = al256(WS_HID + (size_t)HID_ROWS * DE * 2);
constexpr size_t WS_END0 = al256(WS_PROJ + (size_t)S * PW * 2), WS_END1 = al256(WS_Y + (size_t)2 * S * D * 2);
constexpr size_t WS_END = WS_END0 > WS_END1 ? WS_END0 : WS_END1;
#ifndef SMALL_CFG
static_assert(WS_END <= (size_t)512 * 1024 * 1024, "workspace map exceeds the guaranteed 512 MiB");
#endif

struct Params {
    const float* x; const float* norm_mix; const float* w_in; const float* b_forget; const float* g_ret; const float* g_sb; const float* g_fox;
    const float* w_out; const float* norm_ffn; const float* w_group; const float* b_group; const float* w_router; const float* b_router;
    const float* w_gate; const float* w_up; const float* w_down; const float* norm_final;
    float* out; unsigned char* ws;
    int wid, pad;
};

#define TIDX(p) (((p).wid << 6) | lane_id())
__device__ __forceinline__ int imin(int a, int b) { return a < b ? a : b; }
__device__ __forceinline__ float u2f(unsigned u) { return __builtin_bit_cast(float, u); }
__device__ __forceinline__ unsigned f2u(float f) { return __builtin_bit_cast(unsigned, f); }
__device__ __forceinline__ float bf2f(bf16_t b) { return u2f((unsigned)b << 16); }
__device__ __forceinline__ bf16_t f2bf(float f) { unsigned u = f2u(f); return (bf16_t)((u + 0x7fffu + ((u >> 16) & 1u)) >> 16); }
#ifndef CPU_EMU
typedef float pk_f32x2 __attribute__((ext_vector_type(2))); typedef __bf16 pk_bf16x2 __attribute__((ext_vector_type(2)));
__device__ __forceinline__ unsigned pk2(float lo, float hi) { const pk_f32x2 v = {lo, hi}; return __builtin_bit_cast(unsigned, __builtin_convertvector(v, pk_bf16x2)); }
#else
__device__ __forceinline__ unsigned pk2(float lo, float hi) { return (unsigned)f2bf(lo) | ((unsigned)f2bf(hi) << 16); }
#endif
__device__ __forceinline__ float log_sigmoid(float x) { return fminf(x, 0.f) - log1pf(expf(-fabsf(x))); }
#ifndef CPU_EMU
__device__ __forceinline__ float silu(float x) { return x * __builtin_amdgcn_rcpf(1.f + __expf(-x)); }
#else
__device__ __forceinline__ float silu(float x) { return x / (1.f + expf(-x)); }
#endif
#ifndef CPU_EMU
template <int CTRL> __device__ __forceinline__ float dpp_mov(float x) { return __builtin_bit_cast(float, __builtin_amdgcn_update_dpp(0, __builtin_bit_cast(int, x), CTRL, 0xf, 0xf, false)); }
__device__ __forceinline__ float wave_sum(float v) {
    v += dpp_mov<0xB1>(v); v += dpp_mov<0x4E>(v); v += dpp_mov<0x141>(v); v += dpp_mov<0x140>(v);
    return (read_lane(v, 0) + read_lane(v, 16)) + (read_lane(v, 32) + read_lane(v, 48));
}
__device__ __forceinline__ float wave_max(float v) {
    v = fmaxf(v, dpp_mov<0xB1>(v)); v = fmaxf(v, dpp_mov<0x4E>(v)); v = fmaxf(v, dpp_mov<0x141>(v)); v = fmaxf(v, dpp_mov<0x140>(v));
    return fmaxf(fmaxf(read_lane(v, 0), read_lane(v, 16)), fmaxf(read_lane(v, 32), read_lane(v, 48)));
}
#else
__device__ __forceinline__ float wave_sum(float v) {
#pragma unroll
    for (int o = 1; o < 64; o <<= 1) v += __shfl_xor(v, o);
    return v;
}
__device__ __forceinline__ float wave_max(float v) {
#pragma unroll
    for (int o = 1; o < 64; o <<= 1) v = fmaxf(v, __shfl_xor(v, o));
    return v;
}
#endif
__device__ __forceinline__ double inv_turns(int j) {
    static constexpr double T[32] = {
        1.59154943091895346e-01, 1.19349370211248862e-01, 8.94994016088910133e-02, 6.71150830052272551e-02, 5.03292121044870353e-02, 3.77415847174197711e-02, 2.83021958306233987e-02, 2.12236527647776604e-02,
        1.59154943091895339e-02, 1.19349370211248862e-02, 8.94994016088910237e-03, 6.71150830052272534e-03, 5.03292121044870370e-03, 3.77415847174197719e-03, 2.83021958306233987e-03, 2.12236527647776622e-03,
        1.59154943091895356e-03, 1.19349370211248849e-03, 8.94994016088910237e-04, 6.71150830052272599e-04, 5.03292121044870326e-04, 3.77415847174197741e-04, 2.83021958306233954e-04, 2.12236527647776605e-04,
        1.59154943091895351e-04, 1.19349370211248862e-04, 8.94994016088910182e-05, 6.71150830052272545e-05, 5.03292121044870354e-05, 3.77415847174197768e-05, 2.83021958306233961e-05, 2.12236527647776592e-05};
    return T[j];
}

constexpr int VROWB = 144;
constexpr int IMG64 = 64 * VROWB;
constexpr int RET_WAVE_LDS = 2 * IMG64;
__device__ __forceinline__ int crow(int reg, int hi) { return (reg & 3) + 8 * (reg >> 2) + 4 * hi; }
__device__ __forceinline__ bf16x8 tr_frag(const lds_u8* base, int rowoff0, int rowoff1, int coloff) {
    const s16x4 lo = tr16(base + rowoff0 * VROWB + coloff), hi4 = tr16(base + rowoff1 * VROWB + coloff);
    bf16x8 f; f[0] = lo[0]; f[1] = lo[1]; f[2] = lo[2]; f[3] = lo[3]; f[4] = hi4[0]; f[5] = hi4[1]; f[6] = hi4[2]; f[7] = hi4[3]; return f;
}

constexpr int RJ = D / 256;
__device__ __forceinline__ void row_load(const float* row, f32x4* v, int lane) {
#pragma unroll
    for (int j = 0; j < RJ; ++j) v[j] = *(const f32x4*)(row + 256 * j + lane * 4);
}
__device__ __forceinline__ void row_load_bf16(const bf16_t* row, f32x4* v, int lane) {
#pragma unroll
    for (int j = 0; j < RJ; ++j) { const u32x2 w = *(const u32x2*)(row + 256 * j + lane * 4); v[j][0] = u2f(w[0] << 16); v[j][1] = u2f(w[0] & 0xffff0000u); v[j][2] = u2f(w[1] << 16); v[j][3] = u2f(w[1] & 0xffff0000u); }
}
__device__ __forceinline__ float row_rinv(const f32x4* v) {
    float s = 0.f;
#pragma unroll
    for (int j = 0; j < RJ; ++j) s += (v[j][0] * v[j][0] + v[j][1] * v[j][1]) + (v[j][2] * v[j][2] + v[j][3] * v[j][3]);
    s = wave_sum(s);
    return 1.0f / sqrtf(s * (1.0f / D) + EPS);
}

#ifndef CPU_EMU
typedef float f32x4_u __attribute__((ext_vector_type(4), aligned(4)));
#else
typedef float f32x4_u __attribute__((vector_size(16), aligned(4)));
#endif
#ifndef CPU_EMU
__device__ __forceinline__ f32x4_u nt_load4(const f32x4_u* p) { return __builtin_nontemporal_load(p); }
#else
inline f32x4_u nt_load4(const f32x4_u* p) { return *p; }
#endif
struct TrDesc { const float* Wa; const float* Wb; int ldw, ncols, c0, cb0, k0; bf16_t* WT; int ldt, r0, r1; };
__device__ __forceinline__ void tr_load(const TrDesc& d, f32x4 (&v)[16], int lane) {
    const int n = 4 * (lane & 15), kr = lane >> 4;
    const float* src = (n < 32 ? d.Wa + d.c0 + n : d.Wb + d.cb0 + (n - 32)) + (size_t)(d.k0 + kr) * d.ldw;
    const int col = (n < 32 ? d.c0 + n : d.cb0 + n - 32);
    if (col + 3 < d.ncols) {
#pragma unroll
        for (int i = 0; i < 16; ++i) { const f32x4_u t = nt_load4((const f32x4_u*)(src + (size_t)(4 * i) * d.ldw)); v[i][0] = t[0]; v[i][1] = t[1]; v[i][2] = t[2]; v[i][3] = t[3]; }
    } else {
#pragma unroll
        for (int i = 0; i < 16; ++i)
#pragma unroll
            for (int j = 0; j < 4; ++j) v[i][j] = (col + j < d.ncols) ? src[(size_t)(4 * i) * d.ldw + j] : 0.f;
    }
}
__device__ __forceinline__ void tr_store(const TrDesc& d, const f32x4 (&v)[16], lds_u8* img, int lane) {
    const int n = 4 * (lane & 15), kr = lane >> 4;
    wave_barrier();
#pragma unroll
    for (int i = 0; i < 16; ++i) { u32x2 o; o[0] = pk2(v[i][0], v[i][1]); o[1] = pk2(v[i][2], v[i][3]); *(LAS u32x2*)(img + (4 * i + kr) * VROWB + n * 2) = o; }
    wave_barrier();
    const lds_u8* tb = img + ((lane & 15) >> 2) * VROWB + (16 * (lane >> 4) + 4 * (lane & 3)) * 2;
    const int x32 = lane & 31, pos32 = 16 * ((x32 >> 2) & 1) + 4 * (x32 >> 3) + (x32 & 3);
    bf16_t* dst = d.WT + (size_t)((lane < 32 ? d.r0 : d.r1) + pos32) * d.ldt + d.k0;
#pragma unroll
    for (int kc = 0; kc < 8; ++kc) {
        const s16x4 lo = tr16(tb + (8 * kc) * VROWB), hi4 = tr16(tb + (8 * kc + 4) * VROWB);
        u32x4 o; o[0] = (unsigned)(unsigned short)lo[0] | ((unsigned)(unsigned short)lo[1] << 16); o[1] = (unsigned)(unsigned short)lo[2] | ((unsigned)(unsigned short)lo[3] << 16);
        o[2] = (unsigned)(unsigned short)hi4[0] | ((unsigned)(unsigned short)hi4[1] << 16); o[3] = (unsigned)(unsigned short)hi4[2] | ((unsigned)(unsigned short)hi4[3] << 16);
        *(u32x4*)(dst + 8 * kc) = o;
    }
}
constexpr int WI_IN = (D / 64) * ((IN_W + 63) / 64), WI_OUT = (MIXW / 64) * (D / 64), WI_GU = (D / 64) * (DE / 32), WI_DN = (DE / 64) * (D / 64);
constexpr int WI_DENSE = WI_IN + WI_OUT, WI_EXPERT = WI_GU + WI_DN, WI_LAYER = WI_DENSE + NE * WI_EXPERT;
__device__ __forceinline__ TrDesc weight_desc(const Params& p, int l, int r) {
    if (r < WI_IN) { const int nb = (IN_W + 63) / 64, c0 = (r % nb) * 64; const float* W = p.w_in + (size_t)l * D * IN_W;
        const int r0 = (c0 / 256) * 256 + ((c0 % 256) / 64) * 32;
        return TrDesc{W, W, IN_W, IN_W, c0, c0 + 32, (r / nb) * 64, (bf16_t*)(p.ws + WS_WIN) + (size_t)l * PW * D, D, r0, r0 + 128}; }
    r -= WI_IN;
    if (r < WI_OUT) { const int nb = D / 64, c0 = (r % nb) * 64; const float* W = p.w_out + (size_t)l * MIXW * D;
        return TrDesc{W, W, D, D, c0, c0 + 32, (r / nb) * 64, (bf16_t*)(p.ws + WS_WOUT) + (size_t)l * D * MIXW, MIXW, c0, c0 + 32}; }
    r -= WI_OUT;
    const int e = r / WI_EXPERT; r %= WI_EXPERT;
    if (r < WI_GU) { const int nb = DE / 32, c0 = (r % nb) * 32;
        const int r0 = (c0 / 128) * 256 + (c0 % 128);
        return TrDesc{p.w_gate + (size_t)(l * NE + e) * D * DE, p.w_up + (size_t)(l * NE + e) * D * DE, DE, DE, c0, c0, (r / nb) * 64, (bf16_t*)(p.ws + WS_WGU) + (size_t)(l * NE + e) * 2 * DE * D, D, r0, r0 + 128}; }
    r -= WI_GU;
    { const int nb = D / 64, c0 = (r % nb) * 64; const float* W = p.w_down + (size_t)(l * NE + e) * DE * D;
        return TrDesc{W, W, D, D, c0, c0 + 32, (r / nb) * 64, (bf16_t*)(p.ws + WS_WDN) + (size_t)(l * NE + e) * D * DE, DE, c0, c0 + 32}; }
}
__device__ __forceinline__ void weight_item(const Params& p, int l, int r, lds_u8* img, int lane) { const TrDesc d = weight_desc(p, l, r); f32x4 v[16]; tr_load(d, v, lane); tr_store(d, v, img, lane); }
__device__ __forceinline__ void weight_item2(const Params& p, int l, int ra, int rb, lds_u8* img, int lane) {
    const TrDesc da = weight_desc(p, l, ra), db = weight_desc(p, l, rb); f32x4 va[16], vb[16];
    tr_load(da, va, lane); tr_load(db, vb, lane); tr_store(da, va, img, lane); tr_store(db, vb, img + IMG64, lane);
}
__device__ __forceinline__ void phase_init(const Params& p, float* lds) {
    unsigned* ctl = (unsigned*)(p.ws + WS_CTL);
    if (blockIdx.x == 0) for (int i = TIDX(p); i < CTL_WORDS; i += NT) if (i < CTL_BAR || i >= CTL_BAR + 3456) ctl[i] = 0u;
    f32x2* rot = (f32x2*)(p.ws + WS_ROT);
    for (int i = blockIdx.x * NT + TIDX(p); i < S * 32; i += gridDim.x * NT) {
        const int pos = i >> 5, j = i & 31;
        const double turns = (double)pos * inv_turns(j);
        const double fr = turns - floor(turns);
        f32x2 cs; cs[0] = cos2pi((float)fr); cs[1] = sin2pi((float)fr);
        rot[i] = cs;
    }
    const int lane = lane_id(), wave = p.wid;
    {
        lds_u8* img = (lds_u8*)lds + wave * RET_WAVE_LDS;
        for (int it = blockIdx.x * NW + wave; it < DEPTH * WI_DENSE; it += gridDim.x * NW) weight_item(p, it / WI_DENSE, it % WI_DENSE, img, lane);
    }
    bf16_t* H = (bf16_t*)(p.ws + WS_H);
    for (int r = blockIdx.x * NW + wave; r < S; r += gridDim.x * NW) {
        f32x4 v[RJ]; row_load(p.x + (size_t)r * D, v, lane);
        const float ri = row_rinv(v);
#pragma unroll
        for (int j = 0; j < RJ; ++j) {
            const f32x4 g = *(const f32x4*)(p.norm_mix + 256 * j + lane * 4);
            u32x2 o; o[0] = pk2(v[j][0] * ri * g[0], v[j][1] * ri * g[1]); o[1] = pk2(v[j][2] * ri * g[2], v[j][3] * ri * g[3]);
            *(u32x2*)(H + (size_t)r * D + 256 * j + lane * 4) = o;
        }
    }
}

constexpr int GBM = 256, GBK = 64, TILE_B = GBM * GBK * 2, STAGE_B = 2 * TILE_B, GEMM_LDS = 2 * STAGE_B;
__device__ __forceinline__ int lds_byte(int r, int c) { const int st = (r >> 4) * 2 + (c >> 5), ob = (r & 15) * 64 + (c & 31) * 2; return st * 1024 + (ob ^ (((ob >> 9) & 1) << 5)); }
__device__ __forceinline__ void stage_rc(int b, int& R, int& C) { const int st = b >> 10, sb = b & 1023, swz = sb ^ (((sb >> 9) & 1) << 5); R = (st >> 1) * 16 + swz / 64; C = (st & 1) * 32 + (swz % 64) / 2; }
__device__ __forceinline__ int vcu_id() { const int G = gridDim.x, b = blockIdx.x; return (G % 8 == 0) ? (b % 8) * (G / 8) + b / 8 : b; }

constexpr int HTB = 128 * GBK * 2;
struct GUnit { unsigned A, B; unsigned ao[4]; int i0, i1, i2, i3; };
#ifndef CPU_EMU
#define G8_WAIT_V(n) asm volatile("s_waitcnt vmcnt(" #n ")" ::: "memory")
#define G8_WAIT_L0() asm volatile("s_waitcnt lgkmcnt(0)" ::: "memory")
#define G8_BAR() __builtin_amdgcn_s_barrier()
#define G8_PRIO(x) __builtin_amdgcn_s_setprio(x)
#else
#define G8_WAIT_V(n) do {} while (0)
#define G8_WAIT_L0() do {} while (0)
#define G8_BAR() __syncthreads()
#define G8_PRIO(x) do {} while (0)
#endif
template <class Sched, class Epi>
__device__ __forceinline__ void gemm_stream(lds_u8* lds, const char* Abase, const char* Bbase, const int K, Sched& S, const Epi& E) {
    const int wid = S.wid, lane = lane_id(), tid = (wid << 6) | lane, wr = wid >> 2, wc = wid & 3, fr = lane & 15, fq = lane >> 4;
    const int nt = K / GBK;
    unsigned voffB[2];
    { int R, C; stage_rc(tid * 16, R, C); voffB[0] = (unsigned)((R * K + C) * 2); stage_rc(tid * 16 + 8192, R, C); voffB[1] = (unsigned)((R * K + C) * 2); }
    const unsigned hstepB = (unsigned)(128 * K * 2);
    lds_u8* ldsw = lds + wid * 1024;
    const int aoff = lds_byte(wr * 64 + fr, fq * 8), boff = lds_byte(wc * 32 + fr, fq * 8);
#define G8_SA(b, h) (((b) * 2 + (h)) * HTB)
#define G8_SB(b, h) ((4 + (b) * 2 + (h)) * HTB)
#define G8_STAGE_A(b, h, U, kt) do { _Pragma("unroll") for (int i_ = 0; i_ < 2; ++i_) glds16(Abase + ((size_t)(U).A + (size_t)((kt) * (GBK * 2))) + (Sched::GATHER ? (U).ao[2 * (h) + i_] : S.ao[2 * (h) + i_]), ldsw + G8_SA(b, h) + i_ * 8192); } while (0)
#define G8_STAGE_B(b, h, U, kt) do { _Pragma("unroll") for (int i_ = 0; i_ < 2; ++i_) glds16(Bbase + ((size_t)(U).B + (size_t)((kt) * (GBK * 2)) + (size_t)(h) * hstepB) + voffB[i_], ldsw + G8_SB(b, h) + i_ * 8192); } while (0)
#define G8_LDA(dst, b, h) do { _Pragma("unroll") for (int m = 0; m < 4; ++m) _Pragma("unroll") for (int k = 0; k < 2; ++k) dst[m][k] = *(const LAS bf16x8*)(lds + G8_SA(b, h) + aoff + m * 2048 + k * 1024); } while (0)
#define G8_LDB(dst, b, h) do { _Pragma("unroll") for (int n = 0; n < 2; ++n) _Pragma("unroll") for (int k = 0; k < 2; ++k) dst[n][k] = *(const LAS bf16x8*)(lds + G8_SB(b, h) + boff + n * 2048 + k * 1024); } while (0)
#define G8_MMA(ai, bj, At_, Bt_) do { G8_PRIO(1); _Pragma("unroll") for (int m = 0; m < 4; ++m) _Pragma("unroll") for (int n = 0; n < 2; ++n) _Pragma("unroll") for (int k = 0; k < 2; ++k) \
        acc[ai][bj][m][n] = mfma16(Bt_[n][k], At_[m][k], acc[ai][bj][m][n]); G8_PRIO(0); } while (0)
    GUnit cur, nxt; int ui = 0;
    if (!S.next(0, cur)) return;
    f32x4 acc[2][2][4][2];
#pragma unroll
    for (int a = 0; a < 2; ++a)
#pragma unroll
        for (int b = 0; b < 2; ++b)
#pragma unroll
            for (int m = 0; m < 4; ++m)
#pragma unroll
                for (int n = 0; n < 2; ++n) acc[a][b][m][n] = (f32x4){0.f, 0.f, 0.f, 0.f};
    bf16x8 At[4][2], B0[2][2], B1[2][2];
    G8_STAGE_B(0, 0, cur, 0); G8_STAGE_B(0, 1, cur, 0); G8_STAGE_A(0, 0, cur, 0); G8_STAGE_A(0, 1, cur, 0);
    if (wr == 1) G8_BAR();
    G8_WAIT_V(2); G8_BAR();
    G8_STAGE_B(1, 0, cur, 1); G8_STAGE_A(1, 0, cur, 1); G8_STAGE_B(1, 1, cur, 1);
    G8_WAIT_V(6); G8_BAR();
    for (;;) {
        const bool has_next = S.next(ui + 1, nxt);
        if (!has_next) nxt = cur;
        for (int t = 0; t < nt; t += 2) {
            const bool last = (t == nt - 2);
            const GUnit& U2 = last ? nxt : cur;
            const int k2 = last ? 0 : t + 2, k3 = k2 + 1;
            G8_LDB(B0, 0, 0); G8_LDB(B1, 0, 1); sched_fence(); G8_LDA(At, 0, 0); G8_STAGE_A(1, 1, cur, t + 1);
            G8_WAIT_V(8); G8_WAIT_L0(); G8_BAR(); G8_MMA(0, 0, At, B0); G8_MMA(0, 1, At, B1); G8_BAR(); sched_fence();
            G8_LDA(At, 0, 1); G8_STAGE_B(0, 0, U2, k2); G8_STAGE_B(0, 1, U2, k2); G8_STAGE_A(0, 0, U2, k2);
            G8_WAIT_V(8); G8_WAIT_L0(); G8_BAR(); G8_MMA(1, 0, At, B0); G8_MMA(1, 1, At, B1); G8_BAR(); sched_fence();
            G8_LDB(B0, 1, 0); G8_LDB(B1, 1, 1); sched_fence(); G8_LDA(At, 1, 0); G8_STAGE_A(0, 1, U2, k2);
            G8_WAIT_V(8); G8_WAIT_L0(); G8_BAR(); G8_MMA(0, 0, At, B0); G8_MMA(0, 1, At, B1); G8_BAR(); sched_fence();
            G8_LDA(At, 1, 1); G8_STAGE_B(1, 0, U2, k3); G8_STAGE_B(1, 1, U2, k3); G8_STAGE_A(1, 0, U2, k3);
            G8_WAIT_V(8); G8_WAIT_L0(); G8_BAR(); G8_MMA(1, 0, At, B0); G8_MMA(1, 1, At, B1); G8_BAR(); sched_fence();
        }
        if (wr == 0) G8_BAR();
        E(acc, cur, wr, wc, fr, fq);
        if (!has_next) break;
#pragma unroll
        for (int a = 0; a < 2; ++a)
#pragma unroll
            for (int b = 0; b < 2; ++b)
#pragma unroll
                for (int m = 0; m < 4; ++m)
#pragma unroll
                    for (int n = 0; n < 2; ++n) acc[a][b][m][n] = (f32x4){0.f, 0.f, 0.f, 0.f};
        cur = nxt; ++ui;
        if (wr == 1) G8_BAR();
    }
    G8_WAIT_V(0);
    G8_BAR();
#undef G8_SA
#undef G8_SB
#undef G8_STAGE_A
#undef G8_STAGE_B
#undef G8_LDA
#undef G8_LDB
#undef G8_MMA
}
__device__ __forceinline__ void plain_ao(unsigned (&ao)[4], int K, int tid) {
    int R, C; stage_rc(tid * 16, R, C); ao[0] = (unsigned)((R * K + C) * 2); ao[2] = ao[0] + (unsigned)(128 * K * 2);
    stage_rc(tid * 16 + 8192, R, C); ao[1] = (unsigned)((R * K + C) * 2); ao[3] = ao[1] + (unsigned)(128 * K * 2);
}

struct InprojSched {
    static constexpr bool GATHER = false;
    int wid;
    unsigned ao[4]; int vcu, G;
    static constexpr int NPM = S / GBM, NPN = PW / GBM;
    __device__ __forceinline__ bool next(int i, GUnit& u) const {
        const int L = uni(i * G + vcu); if (L >= NPM * NPN) return false;
        constexpr int WGM = 8, nig = WGM * NPN;
        const int gid = L / nig, fm = gid * WGM, gsz = (NPM - fm) < WGM ? (NPM - fm) : WGM;
        const int pm = fm + (L % nig) % gsz, pn = (L % nig) / gsz;
        u.A = (unsigned)(pm * GBM * D * 2); u.B = (unsigned)(pn * GBM * D * 2); u.ao[0] = u.ao[1] = u.ao[2] = u.ao[3] = 0u;
        u.i0 = pm; u.i1 = pn; u.i2 = 0; u.i3 = 0; return true;
    }
};
struct InprojEpi {
    bf16_t* P; float* LOGF; unsigned* kmaxw; const f32x2* rot; const float* bfg;
    __device__ __forceinline__ void operator()(f32x4 (&acc)[2][2][4][2], const GUnit& u, int wr, int wc, int fr, int fq) const {
        const int gc0 = u.i1 * GBM + wc * 64;
        if (gc0 >= IN_W) return;
        const int row0 = u.i0 * GBM + wr * 64 + fr;
        if (gc0 >= OFL) {
#pragma unroll
            for (int ai = 0; ai < 2; ++ai)
#pragma unroll
                for (int m = 0; m < 4; ++m)
#pragma unroll
                    for (int n = 0; n < 2; ++n)
#pragma unroll
                        for (int j = 0; j < 4; ++j) { const int h = 4 * n + j; if (fq == 0 && h < NFOX) LOGF[(size_t)h * S + row0 + ai * 128 + m * 16] = log_sigmoid(acc[ai][0][m][n][j] + bfg[h]); }
            return;
        }
        const bool rotary = gc0 < OVR, is_gate = (gc0 >= OGR && gc0 < OQS), is_kf = (gc0 >= OKF && gc0 < OVF);
        const float scale = (gc0 < OKR || (gc0 >= OQS && gc0 < OKS) || (gc0 >= OQF && gc0 < OKF)) ? 0.125f : 1.0f;
        float kmx = 0.f;
        if (rotary) {
#pragma unroll
            for (int am = 0; am < 4; ++am) {
                const int ai = am >> 1, m0 = (am & 1) * 2;
                f32x4 c01[2][2], c23[2][2];
#pragma unroll
                for (int mm = 0; mm < 2; ++mm)
#pragma unroll
                    for (int n = 0; n < 2; ++n) { const f32x2* rp = rot + (size_t)(row0 + ai * 128 + (m0 + mm) * 16) * 32 + 8 * fq + 4 * n; c01[mm][n] = *(const f32x4*)rp; c23[mm][n] = *(const f32x4*)(rp + 2); }
#pragma unroll
                for (int mm = 0; mm < 2; ++mm)
#pragma unroll
                    for (int n = 0; n < 2; ++n) {
                        const int m = m0 + mm;
                        const float cs[4] = {c01[mm][n][0], c01[mm][n][2], c23[mm][n][0], c23[mm][n][2]}, sn[4] = {c01[mm][n][1], c01[mm][n][3], c23[mm][n][1], c23[mm][n][3]};
#pragma unroll
                        for (int j = 0; j < 4; ++j) { const float x1 = acc[ai][0][m][n][j], x2 = acc[ai][1][m][n][j]; acc[ai][0][m][n][j] = x1 * cs[j] - x2 * sn[j]; acc[ai][1][m][n][j] = x1 * sn[j] + x2 * cs[j]; }
                    }
                sched_fence();
            }
        }
#pragma unroll
        for (int ai = 0; ai < 2; ++ai)
#pragma unroll
            for (int m = 0; m < 4; ++m) {
                const int row = row0 + ai * 128 + m * 16;
                float ss = 0.f;
#pragma unroll
                for (int bj = 0; bj < 2; ++bj) {
                    u32x4 o;
#pragma unroll
                    for (int n = 0; n < 2; ++n) {
                        f32x4 v = acc[ai][bj][m][n] * scale;
                        if (is_gate) {
#pragma unroll
                            for (int j = 0; j < 4; ++j) v[j] = silu(v[j]);
                        }
                        o[2 * n] = pk2(v[0], v[1]); o[2 * n + 1] = pk2(v[2], v[3]);
                        if (is_kf) {
#pragma unroll
                            for (int j = 0; j < 4; ++j) { const float r = bf2f(f2bf(v[j])); ss += r * r; }
                        }
                    }
                    *(u32x4*)(P + (size_t)row * PW + gc0 + 32 * bj + 8 * fq) = o;
                }
                if (is_kf) { ss += __shfl_xor(ss, 16); ss += __shfl_xor(ss, 32); kmx = fmaxf(kmx, ss); }
            }
        if (is_kf) { kmx = wave_max(kmx); if (lane_id() == 0) atomicMax(kmaxw + (gc0 - OKF) / HD, f2u(kmx)); }
    }
};
__device__ __forceinline__ void phase_inproj(const Params& p, int l, float* ldsf) {
    InprojSched S; S.wid = p.wid; plain_ao(S.ao, D, TIDX(p)); S.vcu = vcu_id(); S.G = gridDim.x;
    InprojEpi E; E.P = (bf16_t*)(p.ws + WS_PROJ); E.LOGF = (float*)(p.ws + WS_LOGF); E.kmaxw = (unsigned*)(p.ws + WS_CTL) + CTL_KMAX + l * 8; E.rot = (const f32x2*)(p.ws + WS_ROT); E.bfg = p.b_forget + l * NFOX;
    gemm_stream((lds_u8*)ldsf, (const char*)(p.ws + WS_H), (const char*)(p.ws + WS_WIN) + (size_t)l * PW * D * 2, D, S, E);
}

__device__ __forceinline__ float ret_log_gamma(int h) { return logf(1.0f - exp2f(-5.0f - (float)h)); }
__device__ __forceinline__ void ret_prep_item(const Params& p, int h, int n, lds_u8* wl) {
    const bf16_t* P = (const bf16_t*)(p.ws + WS_PROJ);
    float* UT = (float*)(p.ws + WS_U);
    const int lane = lane_id(), r32 = lane & 31, hi = lane >> 5;
    const float lg = ret_log_gamma(h);
    wave_barrier();
#pragma unroll
    for (int i = 0; i < 8; ++i) {
        const int c = lane + 64 * i, row = c >> 3, ch = c & 7;
        const bf16_t* src = P + (size_t)(n * CH + row) * PW + h * HD + 8 * ch;
        const u32x4 kv = *(const u32x4*)(src + OKR), vv = *(const u32x4*)(src + OVR);
        const float dk = fast_exp(lg * (float)(CH - 1 - row));
        u32x4 ko;
#pragma unroll
        for (int w = 0; w < 4; ++w) ko[w] = pk2(u2f(kv[w] << 16) * dk, u2f(kv[w] & 0xffff0000u) * dk);
        *(LAS u32x4*)(wl + row * VROWB + ch * 16) = ko;
        *(LAS u32x4*)(wl + IMG64 + row * VROWB + ch * 16) = vv;
    }
    wave_barrier();
    const lds_u8* tb = wl + (8 * hi + ((lane & 15) >> 2)) * VROWB + (16 * ((lane >> 4) & 1) + 4 * (lane & 3)) * 2;
    f32x16 acc[2][2];
#pragma unroll
    for (int a = 0; a < 2; ++a)
#pragma unroll
        for (int b = 0; b < 2; ++b)
#pragma unroll
            for (int r = 0; r < 16; ++r) acc[a][b][r] = 0.f;
#pragma unroll
    for (int s = 0; s < 4; ++s) {
        bf16x8 vf[2], kf[2];
#pragma unroll
        for (int x = 0; x < 2; ++x) { kf[x] = tr_frag(tb, 16 * s, 16 * s + 4, x * 64); vf[x] = tr_frag(tb + IMG64, 16 * s, 16 * s + 4, x * 64); }
#pragma unroll
        for (int eb = 0; eb < 2; ++eb)
#pragma unroll
            for (int db = 0; db < 2; ++db) acc[eb][db] = mfma32(vf[eb], kf[db], acc[eb][db]);
    }
    float* dst = UT + (size_t)(h * NCHUNK + n) * 4096;
#pragma unroll
    for (int eb = 0; eb < 2; ++eb)
#pragma unroll
        for (int db = 0; db < 2; ++db)
#pragma unroll
            for (int r = 0; r < 16; ++r) dst[(32 * eb + crow(r, hi)) * 64 + 32 * db + r32] = acc[eb][db][r];
}
__device__ __forceinline__ void fcum_block(const Params& p, int h, float* ldsf) {
    const float* LF = (const float*)(p.ws + WS_LOGF) + (size_t)h * S;
    float* F = (float*)(p.ws + WS_FCUM) + (size_t)h * S;
    constexpr int KPT = S / NT;
    const int tid = TIDX(p), lane = lane_id(), w = p.wid;
    float v[KPT];
#pragma unroll
    for (int i = 0; i < KPT; ++i) v[i] = LF[tid * KPT + i];
#pragma unroll
    for (int i = 1; i < KPT; ++i) v[i] += v[i - 1];
    float inc = v[KPT - 1];
#pragma unroll
    for (int d = 1; d < 64; d <<= 1) { const float o = __shfl_up(inc, d); if (lane >= d) inc += o; }
    __syncthreads();
    if (lane == 63) ldsf[w] = inc;
    __syncthreads();
    float off = inc - v[KPT - 1];
    for (int ww = 0; ww < w; ++ww) off += ldsf[ww];
#pragma unroll
    for (int i = 0; i < KPT; ++i) F[tid * KPT + i] = v[i] + off;
    __syncthreads();
}
__device__ __forceinline__ void phase_prep(const Params& p, int l, float* ldsf) {
    if ((int)blockIdx.x < NFOX) fcum_block(p, (int)blockIdx.x, ldsf);
    const int wave = p.wid;
    lds_u8* wl = (lds_u8*)ldsf + wave * RET_WAVE_LDS;
    for (int it = blockIdx.x * NW + wave; it < NRET * NCHUNK; it += gridDim.x * NW) ret_prep_item(p, it / NCHUNK, it % NCHUNK, wl);
}

constexpr int NQ32 = S / 32;
constexpr int MIX_WAVE_LDS = 32 * VROWB;
__device__ __forceinline__ void ret_scan_wave(const Params& p, int item) {
    const float* U = (const float*)(p.ws + WS_U);
    bf16_t* SP = (bf16_t*)(p.ws + WS_SP);
    const int e = item * 64 + lane_id();
    const int h = e >> 12, de = e & 4095;
    const float c = expf(ret_log_gamma(h) * (float)CH);
    float st = 0.f;
    const size_t base = (size_t)h * NCHUNK * 4096 + de;
#pragma unroll 1
    for (int n0 = 0; n0 < NCHUNK; n0 += 32) {
        float u[32];
#pragma unroll
        for (int i = 0; i < 32; ++i) u[i] = (n0 + i < NCHUNK) ? U[base + (size_t)(n0 + i) * 4096] : 0.f;
#pragma unroll
        for (int i = 0; i < 32; ++i) if (n0 + i < NCHUNK) { SP[base + (size_t)(n0 + i) * 4096] = f2bf(st); st = st * c + u[i]; }
    }
}
template <bool FOX>
__device__ __forceinline__ void attn_item(const Params& p, int l, int h, int qb, lds_u8* wl) {
    const bf16_t* P = (const bf16_t*)(p.ws + WS_PROJ);
    const float* Fh = (const float*)(p.ws + WS_FCUM) + (size_t)h * S;
    bf16_t* MG = (bf16_t*)(p.ws + WS_MERGED);
    const int lane = lane_id(), r32 = lane & 31, hi = lane >> 5;
    const int q0 = qb * 32, t = q0 + r32;
    constexpr int oq = FOX ? OQF : OQS, ok = FOX ? OKF : OKS, ov = FOX ? OVF : OVS;
    bf16x8 qf[4];
    { const bf16_t* qp = P + (size_t)t * PW + oq + h * HD + 8 * hi;
#pragma unroll
      for (int ks = 0; ks < 4; ++ks) qf[ks] = *(const bf16x8*)(qp + 16 * ks); }
    float Bt = 0.f;
    if (FOX) {
        float qq = 0.f;
#pragma unroll
        for (int ks = 0; ks < 4; ++ks)
#pragma unroll
            for (int j = 0; j < 8; ++j) { const float v = bf2f((bf16_t)qf[ks][j]); qq += v * v; }
        qq += __shfl_xor(qq, 32);
        const float kmax = sqrtf(u2f(((const unsigned*)(p.ws + WS_CTL))[CTL_KMAX + l * 8 + h]));
        Bt = sqrtf(qq) * kmax * 1.0001f + 1e-6f;
    }
    const float fq = FOX ? Fh[t] : 0.f;
    float m = -1e30f, lsum = 0.f, carry = 0.f;
    f32x16 o0, o1;
#pragma unroll
    for (int r = 0; r < 16; ++r) { o0[r] = 0.f; o1[r] = 0.f; }
    const lds_u8* vb = wl + (4 * hi + ((lane & 15) >> 2)) * VROWB + (16 * ((lane >> 4) & 1) + 4 * (lane & 3)) * 2;
    bf16x8 kf1[4], kf2[4]; u32x4 vr1[4], vr2[4];
#define ATTN_LOAD(KF, VR, kt_) do { const int k0_ = (kt_) * 32; const bf16_t* kp_ = P + (size_t)(k0_ + r32) * PW + ok + h * HD + 8 * hi; \
        _Pragma("unroll") for (int ks = 0; ks < 4; ++ks) KF[ks] = *(const bf16x8*)(kp_ + 16 * ks); \
        _Pragma("unroll") for (int i = 0; i < 4; ++i) { const int c = lane + 64 * i; VR[i] = *(const u32x4*)(P + (size_t)(k0_ + (c >> 3)) * PW + ov + h * HD + 8 * (c & 7)); } \
        } while (0)
    ATTN_LOAD(kf1, vr1, qb);
    ATTN_LOAD(kf2, vr2, qb > 0 ? qb - 1 : 0);
    for (int kt = qb; kt >= 0; --kt) {
        const int key0 = kt * 32;
        const bool diag = (kt == qb);
        bf16x8 kf[4]; u32x4 vr[4];
#pragma unroll
        for (int ks = 0; ks < 4; ++ks) { kf[ks] = kf1[ks]; kf1[ks] = kf2[ks]; }
#pragma unroll
        for (int i = 0; i < 4; ++i) { vr[i] = vr1[i]; vr1[i] = vr2[i]; }
        ATTN_LOAD(kf2, vr2, kt > 1 ? kt - 2 : 0);
        f32x4 fk[4]; float fkm1 = 0.f;
        if (FOX) {
#pragma unroll
            for (int g4 = 0; g4 < 4; ++g4) fk[g4] = *(const f32x4*)(Fh + key0 + 8 * g4 + 4 * hi);
            fkm1 = Fh[key0 > 0 ? key0 - 1 : 0];
        }
        f32x16 st;
#pragma unroll
        for (int r = 0; r < 16; ++r) st[r] = 0.f;
#pragma unroll
        for (int ks = 0; ks < 4; ++ks) st = mfma32(kf[ks], qf[ks], st);
        wave_barrier();
#pragma unroll
        for (int i = 0; i < 4; ++i) { const int c = lane + 64 * i; *(LAS u32x4*)(wl + (c >> 3) * VROWB + (c & 7) * 16) = vr[i]; }
        if (FOX) {
            float tmax = -1e30f;
#pragma unroll
            for (int g4 = 0; g4 < 4; ++g4)
#pragma unroll
                for (int i = 0; i < 4; ++i) { const int r = 4 * g4 + i; st[r] = st[r] + (fq - fk[g4][i]); }
            if (diag) {
#pragma unroll
                for (int r = 0; r < 16; ++r) if (crow(r, hi) > r32) st[r] = -1e30f;
            }
#pragma unroll
            for (int r = 0; r < 16; ++r) tmax = fmaxf(tmax, st[r]);
            tmax = fmaxf(tmax, partner32(tmax, hi));
            const float mn = fmaxf(m, tmax), f = fast_exp(m - mn);
            m = mn; lsum *= f;
#pragma unroll
            for (int r = 0; r < 16; ++r) { o0[r] *= f; o1[r] *= f; }
            float ps = 0.f;
#pragma unroll
            for (int r = 0; r < 16; ++r) { const float pr = fast_exp(st[r] - mn); st[r] = pr; ps += pr; }
            lsum += ps;
        } else {
            float l1m[16];
#pragma unroll
            for (int r = 0; r < 16; ++r) {
                const float z = st[r], sp = fast_log(1.0f + fast_exp(-fabsf(z)));
                const float lb = fminf(z, 0.f) - sp;
                l1m[r] = lb - z;
                st[r] = lb;
            }
            if (diag) {
#pragma unroll
                for (int r = 0; r < 16; ++r) if (crow(r, hi) >= r32) { l1m[r] = 0.f; st[r] = -1e30f; }
            }
            float gs[4], pg[4], T[4];
#pragma unroll
            for (int k = 0; k < 4; ++k) { gs[k] = (l1m[4 * k] + l1m[4 * k + 1]) + (l1m[4 * k + 2] + l1m[4 * k + 3]); pg[k] = partner32(gs[k], hi); }
            float run = 0.f;
#pragma unroll
            for (int k = 3; k >= 0; --k) { T[k] = run + (hi == 0 ? pg[k] : 0.f); run += gs[k] + pg[k]; }
#pragma unroll
            for (int k = 0; k < 4; ++k) {
                float w = T[k] + carry;
#pragma unroll
                for (int i = 3; i >= 0; --i) { const int r = 4 * k + i; st[r] = fast_exp(st[r] + w); w += l1m[r]; }
            }
            carry += run;
        }
        u32x4 pw0, pw1;
#pragma unroll
        for (int j = 0; j < 4; ++j) { pw0[j] = pk2(st[2 * j], st[2 * j + 1]); pw1[j] = pk2(st[8 + 2 * j], st[9 + 2 * j]); }
        const bf16x8 pf0 = __builtin_bit_cast(bf16x8, pw0), pf1 = __builtin_bit_cast(bf16x8, pw1);
        wave_barrier();
#pragma unroll
        for (int s = 0; s < 2; ++s) {
#pragma unroll
            for (int db = 0; db < 2; ++db) {
                const s16x4 lo = tr16(vb + (16 * s) * VROWB + db * 64), hi4 = tr16(vb + (16 * s + 8) * VROWB + db * 64);
                bf16x8 vf; vf[0] = lo[0]; vf[1] = lo[1]; vf[2] = lo[2]; vf[3] = lo[3]; vf[4] = hi4[0]; vf[5] = hi4[1]; vf[6] = hi4[2]; vf[7] = hi4[3];
                if (db == 0) o0 = mfma32(vf, s == 0 ? pf0 : pf1, o0); else o1 = mfma32(vf, s == 0 ? pf0 : pf1, o1);
            }
        }
        const bool done = FOX ? (Bt + (fq - fkm1) - m + logf((float)(key0 + 1)) < -EXIT_T) : (carry < -EXIT_T);
        if (ballot64(done) == ~0ull) break;
    }
#undef ATTN_LOAD
    if (FOX) { lsum += __shfl_xor(lsum, 32); const float il = 1.0f / lsum;
#pragma unroll
        for (int r = 0; r < 16; ++r) { o0[r] *= il; o1[r] *= il; } }
    float ss = 0.f;
#pragma unroll
    for (int r = 0; r < 16; ++r) ss += o0[r] * o0[r] + o1[r] * o1[r];
    ss += __shfl_xor(ss, 32);
    const float ri = 1.0f / sqrtf(ss * (1.0f / HD) + EPS);
    const float* g = (FOX ? p.g_fox + l * WFOX : p.g_sb + l * WSB) + h * HD;
    bf16_t* dst = MG + (size_t)t * MIXW + (FOX ? WRET + WSB : WRET) + h * HD;
#pragma unroll
    for (int db = 0; db < 2; ++db)
#pragma unroll
        for (int g4 = 0; g4 < 4; ++g4) {
            const int d0 = db * 32 + 8 * g4 + 4 * hi;
            const f32x4 gg = *(const f32x4*)(g + d0);
            float v[4];
#pragma unroll
            for (int i = 0; i < 4; ++i) v[i] = (db == 0 ? o0[4 * g4 + i] : o1[4 * g4 + i]) * ri * gg[i];
            u32x2 o; o[0] = pk2(v[0], v[1]); o[1] = pk2(v[2], v[3]);
            *(u32x2*)(dst + d0) = o;
        }
}
constexpr int WCH = 2, NWCH = (NE * WI_EXPERT + WCH - 1) / WCH;
__device__ __forceinline__ bool mix_weight_step(const Params& p, int l, lds_u8* wl, int shard0, int& wsk) {
    unsigned* wbase = (unsigned*)(p.ws + WS_CTL) + CTL_WQ + 64 * (l * 8);
    const int lane = lane_id();
#pragma unroll 1
    while (wsk < 8) {
        const int shard = (shard0 + wsk) & 7;
        unsigned* head = wbase + 64 * shard;
        unsigned c = 0x0fffffffu;
        if (lane == 0) { if (!(wsk > 0 && (int)ld_relaxed(head) * 8 + shard >= NWCH)) c = atomicAdd(head, 1u); }
        const int chunk = uni((int)__shfl(c, 0)) * 8 + shard;
        if (chunk >= NWCH) { ++wsk; continue; }
        static_assert(WCH == 2 && (NE * WI_EXPERT) % 2 == 0, "two tiles per dequeue");
        weight_item2(p, l, WI_DENSE + chunk * 2, WI_DENSE + chunk * 2 + 1, wl, lane);
        return true;
    }
    return false;
}
__device__ __forceinline__ void phase_mix(const Params& p, int l, float* ldsf) {
    constexpr int NSCANW = NRET * 4096 / 64, NFXI = NFOX * NQ32, NSBI = NSB * NQ32;
    const int wave = p.wid;
    lds_u8* wl = (lds_u8*)ldsf + wave * RET_WAVE_LDS;
    static_assert(MIX_WAVE_LDS <= RET_WAVE_LDS, "per-wave LDS region");
    const int shard0 = xcc_shard();
    int wsk = 0;
    unsigned* qbase = (unsigned*)(p.ws + WS_CTL) + CTL_MQ + 64 * (l * 8);
    const float* bfg = p.b_forget + l * NFOX;
    constexpr int NMIX = NSCANW + NFXI + NSBI;
#pragma unroll 1
    for (int sk = 0; sk < 8; ++sk) {
      const int shard = (shard0 + sk) & 7;
      unsigned* qhead = qbase + 64 * shard;
#pragma unroll 1
      for (;;) {
        unsigned itu = 0;
        if (lane_id() == 0) { if (sk > 0 && (int)ld_relaxed(qhead) * 8 + shard >= NMIX) itu = 0x0fffffffu; else itu = atomicAdd(qhead, 1u); }
        const int it = uni((int)__shfl(itu, 0)) * 8 + shard;
        if (it >= NMIX) break;
        if (it < NSCANW) ret_scan_wave(p, it);
        else if (it < NSCANW + NFXI) {
            const int j = it - NSCANW, rank = j / NQ32;
            int h = 0;
#pragma unroll
            for (int c = 0; c < NFOX; ++c) { int rk = 0;
#pragma unroll
                for (int o = 0; o < NFOX; ++o) rk += (bfg[o] > bfg[c] || (bfg[o] == bfg[c] && o < c)) ? 1 : 0;
                if (rk == rank) h = c; }
            attn_item<true>(p, l, h, NQ32 - 1 - j % NQ32, wl);
        }
        else { const int j = it - NSCANW - NFXI; attn_item<false>(p, l, j % NSB, NQ32 - 1 - j / NSB, wl); }
        (void)mix_weight_step(p, l, wl, shard0, wsk);
      }
    }
    while (mix_weight_step(p, l, wl, shard0, wsk)) {}
}

__device__ __forceinline__ void ret_out_item(const Params& p, int l, int h, int n, int cb, lds_u8* wl) {
    const bf16_t* P = (const bf16_t*)(p.ws + WS_PROJ);
    const bf16_t* SPT = (const bf16_t*)(p.ws + WS_SP) + (size_t)(h * NCHUNK + n) * 4096;
    bf16_t* MG = (bf16_t*)(p.ws + WS_MERGED);
    const int lane = lane_id(), r32 = lane & 31, hi = lane >> 5;
    const float lg = ret_log_gamma(h);
    const size_t rowb = (size_t)(n * CH) * PW + h * HD;
    const int c = 32 * cb + r32;
    wave_barrier();
    {
        u32x4 vv[8];
#pragma unroll
        for (int i = 0; i < 8; ++i) { const int q = lane + 64 * i; vv[i] = *(const u32x4*)(P + rowb + (size_t)(q >> 3) * PW + OVR + 8 * (q & 7)); }
#pragma unroll
        for (int i = 0; i < 8; ++i) { const int q = lane + 64 * i; *(LAS u32x4*)(wl + (q >> 3) * VROWB + (q & 7) * 16) = vv[i]; }
    }
    sched_fence();
    bf16x8 qf[4];
#pragma unroll
    for (int ks = 0; ks < 4; ++ks) qf[ks] = *(const bf16x8*)(P + rowb + (size_t)c * PW + OQR + 16 * ks + 8 * hi);
    f32x16 o[2];
#pragma unroll
    for (int a = 0; a < 2; ++a)
#pragma unroll
        for (int r = 0; r < 16; ++r) o[a][r] = 0.f;
#pragma unroll
    for (int ks = 0; ks < 4; ++ks)
#pragma unroll
        for (int eb = 0; eb < 2; ++eb) { const bf16x8 sf = *(const bf16x8*)(SPT + (32 * eb + r32) * 64 + 16 * ks + 8 * hi); o[eb] = mfma32(sf, qf[ks], o[eb]); }
    { const float qd = fast_exp(lg * (float)(c + 1));
#pragma unroll
      for (int eb = 0; eb < 2; ++eb)
#pragma unroll
          for (int r = 0; r < 16; ++r) o[eb][r] *= qd; }
    wave_barrier();
    const lds_u8* vb = wl + (4 * hi + ((lane & 15) >> 2)) * VROWB + (16 * ((lane >> 4) & 1) + 4 * (lane & 3)) * 2;
#pragma unroll
    for (int kb = 0; kb < 2; ++kb) {
        f32x16 st;
#pragma unroll
        for (int r = 0; r < 16; ++r) st[r] = 0.f;
#pragma unroll
        for (int ks = 0; ks < 4; ++ks) { const bf16x8 kf = *(const bf16x8*)(P + rowb + (size_t)(32 * kb + r32) * PW + OKR + 16 * ks + 8 * hi); st = mfma32(kf, qf[ks], st); }
        bf16x8 pf[2];
#pragma unroll
        for (int r = 0; r < 16; ++r) { const int dist = c - (32 * kb + crow(r, hi)); st[r] *= fast_exp(lg * fabsf((float)dist)); }
        { u32x4 w0, w1;
#pragma unroll
          for (int j = 0; j < 4; ++j) { w0[j] = pk2(st[2 * j], st[2 * j + 1]); w1[j] = pk2(st[8 + 2 * j], st[9 + 2 * j]); }
          pf[0] = __builtin_bit_cast(bf16x8, w0); pf[1] = __builtin_bit_cast(bf16x8, w1); }
#pragma unroll
        for (int s = 0; s < 2; ++s)
#pragma unroll
            for (int eb = 0; eb < 2; ++eb) o[eb] = mfma32(tr_frag(vb, 32 * kb + 16 * s, 32 * kb + 16 * s + 8, eb * 64), pf[s], o[eb]);
    }
    float sm = 0.f;
#pragma unroll
    for (int eb = 0; eb < 2; ++eb)
#pragma unroll
        for (int r = 0; r < 16; ++r) sm += o[eb][r];
    sm += __shfl_xor(sm, 32);
    const float mu = sm * (1.0f / HD);
    float vs = 0.f;
#pragma unroll
    for (int eb = 0; eb < 2; ++eb)
#pragma unroll
        for (int r = 0; r < 16; ++r) { const float dlt = o[eb][r] - mu; o[eb][r] = dlt; vs += dlt * dlt; }
    vs += __shfl_xor(vs, 32);
    const float ri = 1.0f / sqrtf(vs * (1.0f / HD) + EPS);
    const int row = n * CH + c;
#pragma unroll
    for (int eb = 0; eb < 2; ++eb)
#pragma unroll
        for (int g4 = 0; g4 < 4; ++g4) {
            const int e0 = 32 * eb + 8 * g4 + 4 * hi;
            const f32x4 gg = *(const f32x4*)(p.g_ret + l * WRET + h * HD + e0);
            const u32x2 gt = *(const u32x2*)(P + (size_t)row * PW + OGR + h * HD + e0);
            const float ga[4] = {u2f(gt[0] << 16), u2f(gt[0] & 0xffff0000u), u2f(gt[1] << 16), u2f(gt[1] & 0xffff0000u)};
            float v[4];
#pragma unroll
            for (int i = 0; i < 4; ++i) v[i] = o[eb][4 * g4 + i] * ri * gg[i] * ga[i];
            u32x2 ov; ov[0] = pk2(v[0], v[1]); ov[1] = pk2(v[2], v[3]);
            *(u32x2*)(MG + (size_t)row * MIXW + h * HD + e0) = ov;
        }
}
__device__ __forceinline__ void phase_retout(const Params& p, int l, float* ldsf) {
    const int wave = p.wid;
    lds_u8* wl = (lds_u8*)ldsf + wave * RET_WAVE_LDS;
    for (int it = blockIdx.x * NW + wave; it < NRET * NCHUNK * 2; it += gridDim.x * NW) ret_out_item(p, l, (it >> 1) / NCHUNK, (it >> 1) % NCHUNK, it & 1, wl);
}

struct OutprojSched {
    static constexpr bool GATHER = false;
    int wid;
    unsigned ao[4]; int vcu, G;
    static constexpr int NPM = S / GBM, NPN = D / GBM;
    __device__ __forceinline__ bool next(int i, GUnit& u) const {
        const int L = uni(i * G + vcu); if (L >= NPM * NPN) return false;
        const int pm = L / NPN, pn = L % NPN;
        u.A = (unsigned)(pm * GBM * MIXW * 2); u.B = (unsigned)(pn * GBM * MIXW * 2); u.ao[0] = u.ao[1] = u.ao[2] = u.ao[3] = 0u;
        u.i0 = pm; u.i1 = pn; u.i2 = 0; u.i3 = 0; return true;
    }
};
struct OutprojEpi {
    const float* xin32; const bf16_t* xin16; bf16_t* X;
    __device__ __forceinline__ void operator()(f32x4 (&acc)[2][2][4][2], const GUnit& u, int wr, int wc, int fr, int fq) const {
        const size_t o0 = (size_t)(u.i0 * GBM + wr * 64 + fr) * D + u.i1 * GBM + wc * 32 + 8 * fq;
#pragma unroll
        for (int ai = 0; ai < 2; ++ai)
#pragma unroll
            for (int mh = 0; mh < 2; ++mh) {
                f32x4 r[2][2][2];
#pragma unroll
                for (int mm = 0; mm < 2; ++mm)
#pragma unroll
                    for (int bj = 0; bj < 2; ++bj) { const size_t o = o0 + (size_t)(ai * 128 + (2 * mh + mm) * 16) * D + bj * 128;
                        if (xin32) { r[mm][bj][0] = *(const f32x4*)(xin32 + o); r[mm][bj][1] = *(const f32x4*)(xin32 + o + 4); }
                        else { const u32x4 w = *(const u32x4*)(xin16 + o);
                            r[mm][bj][0] = (f32x4){u2f(w[0] << 16), u2f(w[0] & 0xffff0000u), u2f(w[1] << 16), u2f(w[1] & 0xffff0000u)};
                            r[mm][bj][1] = (f32x4){u2f(w[2] << 16), u2f(w[2] & 0xffff0000u), u2f(w[3] << 16), u2f(w[3] & 0xffff0000u)}; } }
#pragma unroll
                for (int mm = 0; mm < 2; ++mm)
#pragma unroll
                    for (int bj = 0; bj < 2; ++bj) { u32x4 ov;
#pragma unroll
                        for (int n = 0; n < 2; ++n) { const f32x4 v = r[mm][bj][n] + acc[ai][bj][2 * mh + mm][n]; ov[2 * n] = pk2(v[0], v[1]); ov[2 * n + 1] = pk2(v[2], v[3]); }
                        *(u32x4*)(X + o0 + (size_t)(ai * 128 + (2 * mh + mm) * 16) * D + bj * 128) = ov; }
                sched_fence();
            }
    }
};
__device__ __forceinline__ void phase_outproj(const Params& p, int l, float* ldsf) {
    OutprojSched S; S.wid = p.wid; plain_ao(S.ao, MIXW, TIDX(p)); S.vcu = vcu_id(); S.G = gridDim.x;
    OutprojEpi E; E.X = (bf16_t*)(p.ws + WS_X); E.xin32 = l == 0 ? p.x : nullptr; E.xin16 = E.X;
    gemm_stream((lds_u8*)ldsf, (const char*)(p.ws + WS_MERGED), (const char*)(p.ws + WS_WOUT) + (size_t)l * D * MIXW * 2, MIXW, S, E);
}

constexpr int RW = D + 4;
constexpr int ROUTE_LDS = NROUTE * RW * 4 + 2 * NE * 4 + 2 * 256 * 4;
__device__ __forceinline__ void phase_route(const Params& p, int l, float* lds) {
    const bf16_t* X = (const bf16_t*)(p.ws + WS_X);
    bf16_t* H = (bf16_t*)(p.ws + WS_H);
    unsigned* ctl = (unsigned*)(p.ws + WS_CTL);
    int* LIST = (int*)(p.ws + WS_LIST);
    float* GATE = (float*)(p.ws + WS_GATE);
    const float* gn = p.norm_ffn + l * D;
    const float* wg = p.w_group + (size_t)l * D * NG; const float* wr = p.w_router + (size_t)l * D * NE;
    const float* bg = p.b_group + l * NG; const float* br = p.b_router + l * NE;
    const int lane = lane_id(), wave = p.wid;
    const int tidx = TIDX(p);
    unsigned* lcnt = (unsigned*)(lds + NROUTE * RW); unsigned* lbase = lcnt + NE; unsigned* lrec = lbase + NE;
    __syncthreads();
    if (tidx < NE) lcnt[tidx] = 0u;
    {
        constexpr int NV4 = D * NE / 4 / NT;
        f32x4 t[NV4];
#pragma unroll
        for (int k = 0; k < NV4; ++k) t[k] = *(const f32x4*)(wr + (size_t)(tidx + k * NT) * 4);
        for (int i = tidx; i < D * NG; i += NT) lds[(i % NG) * RW + i / NG] = wg[i];
#pragma unroll
        for (int k = 0; k < NV4; ++k) { const int i = (tidx + k * NT) * 4, c = i / NE, e = i % NE;
#pragma unroll
            for (int j = 0; j < 4; ++j) lds[(NG + e + j) * RW + c] = t[k][j]; }
    }
    __syncthreads();
    f32x4 vn[RJ]; { const int r0 = blockIdx.x * NW + wave; if (r0 < S) row_load_bf16(X + (size_t)r0 * D, vn, lane); }
    for (int r = blockIdx.x * NW + wave; r < S; r += gridDim.x * NW) {
        f32x4 v[RJ];
#pragma unroll
        for (int j = 0; j < RJ; ++j) v[j] = vn[j];
        { const int rn = r + gridDim.x * NW; if (rn < S) row_load_bf16(X + (size_t)rn * D, vn, lane); }
        const float ri = row_rinv(v);
#pragma unroll
        for (int j = 0; j < RJ; ++j) {
            const f32x4 g = *(const f32x4*)(gn + 256 * j + lane * 4);
            v[j] = v[j] * ri * g;
            u32x2 o; o[0] = pk2(v[j][0], v[j][1]); o[1] = pk2(v[j][2], v[j][3]);
            *(u32x2*)(H + (size_t)r * D + 256 * j + lane * 4) = o;
        }
        float gl[NG];
#pragma unroll
        for (int g = 0; g < NG; ++g) { float s = 0.f;
#pragma unroll
            for (int j = 0; j < RJ; ++j) { const f32x4 w = *(const f32x4*)(lds + g * RW + 256 * j + lane * 4); s += (v[j][0] * w[0] + v[j][1] * w[1]) + (v[j][2] * w[2] + v[j][3] * w[3]); }
            gl[g] = s; }
#pragma unroll
        for (int g = 0; g < NG; ++g) gl[g] = wave_sum(gl[g]) + bg[g];
        int grp = 0; float gm = gl[0];
#pragma unroll
        for (int g = 1; g < NG; ++g) if (gl[g] > gm) { gm = gl[g]; grp = g; }
        float den = 0.f;
#pragma unroll
        for (int g = 0; g < NG; ++g) den += fast_exp(gl[g] - gm);
        const float pg = 1.0f / den;
        float el[EPG];
        const float* wl = lds + (NG + grp * EPG) * RW + lane * 4;
#pragma unroll
        for (int e = 0; e < EPG; ++e) { float s = 0.f;
#pragma unroll
            for (int j = 0; j < RJ; ++j) { const f32x4 w = *(const f32x4*)(wl + e * RW + 256 * j); s += (v[j][0] * w[0] + v[j][1] * w[1]) + (v[j][2] * w[2] + v[j][3] * w[3]); }
            el[e] = s; }
#pragma unroll
        for (int e = 0; e < EPG; ++e) el[e] = wave_sum(el[e]) + br[grp * EPG + e];
        if (lane == 0) {
            int i1 = 0; float v1 = -INFINITY; int i2 = 0; float v2 = -INFINITY;
#pragma unroll
            for (int e = 0; e < EPG; ++e) { const float x = el[e];
                if (x > v1) { v2 = v1; i2 = i1; v1 = x; i1 = e; } else if (x > v2) { v2 = x; i2 = e; } }
            const float e2 = fast_exp(v2 - v1), g1 = pg / (1.f + e2), g2 = pg * e2 / (1.f + e2);
            const int ea = grp * EPG + i1, eb = grp * EPG + i2;
            GATE[(size_t)r * 2] = g1; GATE[(size_t)r * 2 + 1] = g2;
            const int li = (r - blockIdx.x * NW) / (gridDim.x * NW) * NW + wave;
            const unsigned ra = atomicAdd(lcnt + ea, 1u), rb = atomicAdd(lcnt + eb, 1u);
            lrec[2 * li] = (unsigned)ea | (ra << 8); lrec[2 * li + 1] = (unsigned)eb | (rb << 8);
        }
    }
    {
        __syncthreads();
        if (tidx < NE) lbase[tidx] = atomicAdd(ctl + CTL_CNT + l * NE + tidx, lcnt[tidx]);
        __syncthreads();
        const int nrows = (S - blockIdx.x * NW + gridDim.x * NW - 1) / (gridDim.x * NW) * NW;
        for (int i = tidx; i < 2 * nrows; i += NT) {
            const int li = i >> 1, r = blockIdx.x * NW + (li / NW) * (gridDim.x * NW) + (li % NW);
            if (r < S) { const unsigned rec = lrec[i]; const int e = rec & 255u; LIST[(size_t)e * S + lbase[e] + (rec >> 8)] = r * 2 + (i & 1); }
        }
    }
}

__device__ __forceinline__ void moe_table(const unsigned* cnt, volatile LAS unsigned* tab, int tid) {
    __syncthreads();
    if (tid < 64) {
        const unsigned c = tid < NE ? cnt[tid] : 0u;
        unsigned nt = (c + GBM - 1) / GBM, inc = nt;
#pragma unroll
        for (int d = 1; d < 64; d <<= 1) { const unsigned o = (unsigned)__shfl_up((int)inc, d); if ((tid & 63) >= d) inc += o; }
        if (tid < NE) { tab[tid + 1] = inc; tab[64 + tid] = c; }
        if (tid == 0) tab[0] = 0u;
    }
    __syncthreads();
}
__device__ __forceinline__ bool moe_unit(volatile LAS unsigned* tab, int u, int npn, int& e, int& rt, int& pn, int& base, int& count) {
    const int tile = uni(u / npn); pn = uni(u % npn);
    if (tile >= (int)tab[NE]) return false;
    int lo = 0;
#pragma unroll
    for (int s = NE / 2; s >= 1; s >>= 1) if ((int)tab[lo + s] <= tile) lo += s;
    e = uni(lo); rt = tile - (int)tab[e]; base = (int)tab[e] * GBM; count = (int)tab[64 + e];
    rt = uni(rt); base = uni(base); count = uni(count);
    return true;
}
struct Moe1Sched {
    static constexpr bool GATHER = true;
    int wid;
    unsigned ao[4];
    volatile LAS unsigned* tab; const int* LIST; int vcu, G;
    static constexpr int NPN = 2 * DE / GBM;
    __device__ __forceinline__ bool next(int i, GUnit& u) const {
        int e, rt, pn, base, count; if (!moe_unit(tab, i * G + vcu, NPN, e, rt, pn, base, count)) return false;
        const int nvalid = count - rt * GBM;
        u.A = 0u; u.B = (unsigned)((e * 2 * DE + pn * GBM) * D * 2);
#pragma unroll
        for (int k = 0; k < 4; ++k) { int R, C; stage_rc(((wid << 6) | lane_id()) * 16 + (k & 1) * 8192, R, C); const int r = R + 128 * (k >> 1);
            const int tok = r < nvalid ? (LIST[(size_t)e * S + rt * GBM + r] >> 1) : 0; u.ao[k] = (unsigned)((tok * D + C) * 2); }
        u.i0 = base + rt * GBM; u.i1 = pn; u.i2 = nvalid; u.i3 = e * S + rt * GBM; return true;
    }
};
struct Moe1Epi {
    bf16_t* HID;
    __device__ __forceinline__ void operator()(f32x4 (&acc)[2][2][4][2], const GUnit& u, int wr, int wc, int fr, int fq) const {
#pragma unroll
        for (int ai = 0; ai < 2; ++ai)
#pragma unroll
            for (int m = 0; m < 4; ++m)
{ u32x4 o;
#pragma unroll
                for (int n = 0; n < 2; ++n) { f32x4 v;
#pragma unroll
                    for (int j = 0; j < 4; ++j) v[j] = silu(acc[ai][0][m][n][j]) * acc[ai][1][m][n][j];
                    o[2 * n] = pk2(v[0], v[1]); o[2 * n + 1] = pk2(v[2], v[3]); }
                *(u32x4*)(HID + (size_t)(u.i0 + ai * 128 + wr * 64 + m * 16 + fr) * DE + u.i1 * 128 + wc * 32 + 8 * fq) = o; }
    }
};
__device__ __forceinline__ void phase_moe1(const Params& p, int l, float* ldsf) {
    Moe1Sched S; S.wid = p.wid; S.tab = (volatile LAS unsigned*)((LAS unsigned char*)ldsf + GEMM_LDS);
    moe_table((const unsigned*)(p.ws + WS_CTL) + CTL_CNT + l * NE, S.tab, TIDX(p));
    S.LIST = (const int*)(p.ws + WS_LIST); S.vcu = vcu_id(); S.G = gridDim.x;
    Moe1Epi E; E.HID = (bf16_t*)(p.ws + WS_HID);
    gemm_stream((lds_u8*)ldsf, (const char*)(p.ws + WS_H), (const char*)(p.ws + WS_WGU) + (size_t)l * NE * 2 * DE * D * 2, D, S, E);
}
struct Moe2Sched {
    static constexpr bool GATHER = false;
    int wid;
    volatile LAS unsigned* tab; unsigned ao[4]; int vcu, G;
    static constexpr int NPN = D / GBM;
    __device__ __forceinline__ bool next(int i, GUnit& u) const {
        int e, rt, pn, base, count; if (!moe_unit(tab, i * G + vcu, NPN, e, rt, pn, base, count)) return false;
        u.A = (unsigned)((base + rt * GBM) * DE * 2); u.B = (unsigned)((e * D + pn * GBM) * DE * 2); u.ao[0] = u.ao[1] = u.ao[2] = u.ao[3] = 0u;
        u.i0 = 0; u.i1 = pn; u.i2 = count - rt * GBM; u.i3 = e * S + rt * GBM; return true;
    }
};
struct Moe2Epi {
    bf16_t* Y; const int* LIST; const float* GATE;
    __device__ __forceinline__ void operator()(f32x4 (&acc)[2][2][4][2], const GUnit& u, int wr, int wc, int fr, int fq) const {
        int a[2][4]; float g[2][4];
#pragma unroll
        for (int ai = 0; ai < 2; ++ai)
#pragma unroll
            for (int m = 0; m < 4; ++m) { const int r = ai * 128 + wr * 64 + m * 16 + fr; a[ai][m] = r < u.i2 ? LIST[(size_t)u.i3 + r] : -1; }
#pragma unroll
        for (int ai = 0; ai < 2; ++ai)
#pragma unroll
            for (int m = 0; m < 4; ++m) g[ai][m] = a[ai][m] >= 0 ? GATE[a[ai][m]] : 0.f;
#pragma unroll
        for (int ai = 0; ai < 2; ++ai)
#pragma unroll
            for (int m = 0; m < 4; ++m) {
                if (a[ai][m] >= 0) {
#pragma unroll
                    for (int bj = 0; bj < 2; ++bj) { u32x4 o;
#pragma unroll
                        for (int n = 0; n < 2; ++n) { const f32x4 v = acc[ai][bj][m][n] * g[ai][m]; o[2 * n] = pk2(v[0], v[1]); o[2 * n + 1] = pk2(v[2], v[3]); }
                        *(u32x4*)(Y + (size_t)a[ai][m] * D + u.i1 * GBM + bj * 128 + wc * 32 + 8 * fq) = o; }
                }
            }
    }
};
__device__ __forceinline__ void phase_moe2(const Params& p, int l, float* ldsf) {
    Moe2Sched S; S.wid = p.wid; S.tab = (volatile LAS unsigned*)((LAS unsigned char*)ldsf + GEMM_LDS);
    moe_table((const unsigned*)(p.ws + WS_CTL) + CTL_CNT + l * NE, S.tab, TIDX(p));
    plain_ao(S.ao, DE, TIDX(p)); S.vcu = vcu_id(); S.G = gridDim.x;
    Moe2Epi E; E.Y = (bf16_t*)(p.ws + WS_Y); E.LIST = (const int*)(p.ws + WS_LIST); E.GATE = (const float*)(p.ws + WS_GATE);
    gemm_stream((lds_u8*)ldsf, (const char*)(p.ws + WS_HID), (const char*)(p.ws + WS_WDN) + (size_t)l * NE * D * DE * 2, DE, S, E);
}

__device__ __forceinline__ void phase_combine(const Params& p, int l) {
    bf16_t* X = (bf16_t*)(p.ws + WS_X);
    const bf16_t* Y = (const bf16_t*)(p.ws + WS_Y);
    bf16_t* H = (bf16_t*)(p.ws + WS_H);
    const bool last = (l == DEPTH - 1);
    const float* gn = last ? p.norm_final : p.norm_mix + (l + 1) * D;
    const int lane = lane_id(), wave = p.wid;
    for (int r = blockIdx.x * NW + wave; r < S; r += gridDim.x * NW) {
        f32x4 v[RJ]; row_load_bf16(X + (size_t)r * D, v, lane);
#pragma unroll
        for (int j = 0; j < RJ; ++j) {
            const u32x2 a = *(const u32x2*)(Y + (size_t)(2 * r) * D + 256 * j + lane * 4), b = *(const u32x2*)(Y + (size_t)(2 * r + 1) * D + 256 * j + lane * 4);
            v[j][0] += u2f(a[0] << 16) + u2f(b[0] << 16); v[j][1] += u2f(a[0] & 0xffff0000u) + u2f(b[0] & 0xffff0000u);
            v[j][2] += u2f(a[1] << 16) + u2f(b[1] << 16); v[j][3] += u2f(a[1] & 0xffff0000u) + u2f(b[1] & 0xffff0000u);
        }
        const float ri = row_rinv(v);
#pragma unroll
        for (int j = 0; j < RJ; ++j) {
            const f32x4 g = *(const f32x4*)(gn + 256 * j + lane * 4);
            if (last) *(f32x4*)(p.out + (size_t)r * D + 256 * j + lane * 4) = v[j] * ri * g;
            else {
                { u32x2 xo; xo[0] = pk2(v[j][0], v[j][1]); xo[1] = pk2(v[j][2], v[j][3]); *(u32x2*)(X + (size_t)r * D + 256 * j + lane * 4) = xo; }
                u32x2 o; o[0] = pk2(v[j][0] * ri * g[0], v[j][1] * ri * g[1]); o[1] = pk2(v[j][2] * ri * g[2], v[j][3] * ri * g[3]);
                *(u32x2*)(H + (size_t)r * D + 256 * j + lane * 4) = o;
            }
        }
    }
}

constexpr int PH_PER_LAYER = 9, NPHASE = 1 + DEPTH * PH_PER_LAYER;
constexpr int imax_c(int a, int b) { return a > b ? a : b; }
constexpr int LDS_MAIN = imax_c(imax_c(GEMM_LDS + 1024, ROUTE_LDS), imax_c(NW * RET_WAVE_LDS, NW * MIX_WAVE_LDS));
constexpr int LDS_MISC = (LDS_MAIN + 255) / 256 * 256;
constexpr int LDS_BYTES = LDS_MISC + 256;

__device__ __forceinline__ void run_phase(const Params& p, int ph, float* lds) {
    if (ph == 0) { phase_init(p, lds); return; }
    const int l = (ph - 1) / PH_PER_LAYER, q = (ph - 1) % PH_PER_LAYER;
    switch (q) {
        case 0: phase_inproj(p, l, lds); break;
        case 1: phase_prep(p, l, lds); break;
        case 2: phase_mix(p, l, lds); break;
        case 3: phase_retout(p, l, lds); break;
        case 4: phase_outproj(p, l, lds); break;
        case 5: phase_route(p, l, lds); break;
        case 6: phase_moe1(p, l, lds); break;
        case 7: phase_moe2(p, l, lds); break;
        default: phase_combine(p, l); break;
    }
}

#ifndef CPU_EMU
#define XB_TMO      128
#define XB_XCNT(j)  (256  + 64 * (j))
#define XB_XSUB(j)  (1280 + 64 * (j))
#define XB_XGEN(j)  (2304 + 64 * (j))
#define XB_TOP      3328
#define XB_TOPGEN   3392
#define XCD_BAR_WORDS 3456
#define XB_SPIN_CAP (1u << 22)
__device__ __forceinline__ unsigned xb_ld(unsigned* p)              { return __hip_atomic_load(p, __ATOMIC_RELAXED, __HIP_MEMORY_SCOPE_AGENT); }
__device__ __forceinline__ unsigned xb_add(unsigned* p, unsigned v) { return __hip_atomic_fetch_add(p, v, __ATOMIC_RELAXED, __HIP_MEMORY_SCOPE_AGENT); }
__device__ __forceinline__ unsigned xb_xcc_id() { return (unsigned)__builtin_amdgcn_s_getreg((3 << 11) | 20) & 0xFu; }
#define XB_SPIN(cond, bar) do { unsigned _sp = 0; while (cond) { __builtin_amdgcn_s_sleep(1); \
    if ((++_sp & 255u) == 0u) { if (xb_ld(&(bar)[XB_TMO])) break; if (_sp > XB_SPIN_CAP) { atomicAdd(&(bar)[XB_TMO], 1u); break; } } } } while (0)
struct XcdBarrier { unsigned* bar; unsigned x; volatile LAS unsigned* st; };
__device__ __forceinline__ XcdBarrier xcd_barrier_post(unsigned* bar, volatile LAS unsigned* st, bool t0) {
    XcdBarrier b; b.bar = bar; b.x = xb_xcc_id(); b.st = st;
    if (t0) (void)xb_add(&bar[XB_XCNT(b.x)], 1u);
    return b;
}
__device__ __forceinline__ void xcd_barrier_complete(unsigned* bar, unsigned x, unsigned& nloc, unsigned& nx) {
    const unsigned G = gridDim.x * gridDim.y * gridDim.z;
    unsigned sum, cnt, mine, sp = 0u;
    for (;;) {
        sum = 0u; cnt = 0u; mine = 0u;
#pragma unroll
        for (unsigned j = 0; j < 16; ++j) { const unsigned c = xb_ld(&bar[XB_XCNT(j)]); sum += c; cnt += (c > 0u) ? 1u : 0u; mine = (j == x) ? c : mine; }
        if (sum == G) break;
        __builtin_amdgcn_s_sleep(1);
        if ((++sp & 255u) == 0u) { if (xb_ld(&bar[XB_TMO])) break; if (sp > XB_SPIN_CAP) { atomicAdd(&bar[XB_TMO], 1u); break; } }
    }
    nloc = mine > 0u ? mine : 1u; nx = cnt > 0u ? cnt : 1u;
}
__device__ __forceinline__ void xcd_barrier(const XcdBarrier& b, bool t0) {
    asm volatile("s_waitcnt vmcnt(0)" ::: "memory");
    __syncthreads();
    if (t0) {
        unsigned* bar = b.bar;
        __builtin_amdgcn_s_waitcnt(0);
        unsigned nloc = b.st[0], nx = b.st[1];
        if (nloc == 0u) { xcd_barrier_complete(bar, b.x, nloc, nx); b.st[0] = nloc; b.st[1] = nx; }
        const unsigned old = xb_add(&bar[XB_XSUB(b.x)], 1u);
        const unsigned gen = old / nloc;
        if (old + 1u == (gen + 1u) * nloc) {
            __builtin_amdgcn_fence(__ATOMIC_RELEASE, "agent");
            asm volatile("s_waitcnt vmcnt(0)" ::: "memory");
            const unsigned og = xb_add(&bar[XB_TOP], 1u);
            const unsigned tg = og / nx;
            if (og + 1u == (tg + 1u) * nx) xb_add(&bar[XB_TOPGEN], 1u);
            else XB_SPIN(xb_ld(&bar[XB_TOPGEN]) == tg, bar);
            __builtin_amdgcn_fence(__ATOMIC_ACQUIRE, "agent");
            xb_add(&bar[XB_XGEN(b.x)], 1u);
            asm volatile("s_waitcnt vmcnt(0)" ::: "memory");
        } else {
            XB_SPIN(xb_ld(&bar[XB_XGEN(b.x)]) == gen, bar);
            __builtin_amdgcn_fence(__ATOMIC_ACQUIRE, "agent");
            asm volatile("s_waitcnt vmcnt(0)" ::: "memory");
        }
    }
    __syncthreads();
}
#endif
#ifndef CPU_EMU
__global__ void __launch_bounds__(NT) fwd_kernel(Params pin, int ph_lo, int ph_hi) {
    extern __shared__ __attribute__((aligned(16))) float lds[];
    cg::grid_group grid = cg::this_grid();
    Params p = pin; p.wid = uni((int)(threadIdx.x >> 6));
    volatile LAS unsigned* misc = (volatile LAS unsigned*)((LAS unsigned char*)lds + LDS_MISC);
    if (p.wid == 0) misc[lane_id()] = 0u;
    __syncthreads();
    XcdBarrier xb; xb.bar = (unsigned*)(p.ws + WS_CTL) + CTL_BAR; xb.x = 0; xb.st = misc;
    const bool use_xb = (ph_lo == 0);
#define T0() (p.wid == 0 && lane_id() == 0)
    if (use_xb) xb = xcd_barrier_post((unsigned*)(p.ws + WS_CTL) + CTL_BAR, misc, T0());
#define SEAM(k) do { if (!use_xb) grid.sync(); else xcd_barrier(xb, T0()); } while (0)
#define PHASE(k, call) do { if (ph_lo <= (k) && (k) < ph_hi) { call; if ((k) + 1 < ph_hi) SEAM(k); } } while (0)
#define LAYER(l) do { const int b_ = 1 + (l) * PH_PER_LAYER; \
        PHASE(b_ + 0, phase_inproj(p, l, lds)); PHASE(b_ + 1, phase_prep(p, l, lds)); PHASE(b_ + 2, phase_mix(p, l, lds)); \
        PHASE(b_ + 3, phase_retout(p, l, lds)); PHASE(b_ + 4, phase_outproj(p, l, lds)); PHASE(b_ + 5, phase_route(p, l, lds)); \
        PHASE(b_ + 6, phase_moe1(p, l, lds)); PHASE(b_ + 7, phase_moe2(p, l, lds)); PHASE(b_ + 8, phase_combine(p, l)); } while (0)
    PHASE(0, phase_init(p, lds));
    LAYER(0);
    LAYER(1);
    static_assert(DEPTH == 2, "phase program written for two layers");
#undef LAYER
#undef PHASE
#undef SEAM
}

#ifndef N_LAUNCH_PER_PHASE
#define N_LAUNCH_PER_PHASE 0
#endif
extern "C" void kernel_launch(void* const* d_in, const int* in_sizes, int n_in, void* d_out, int out_size, void* d_ws, size_t ws_size, hipStream_t stream) {
    static int grid = 0;
    if (grid == 0) {
        if (ws_size < WS_END) { fprintf(stderr, "kernel_launch: workspace too small (%zu < %zu)\n", ws_size, (size_t)WS_END); grid = -1; return; }
        int dev = 0, cus = 0, per_cu = 0;
        hipGetDevice(&dev);
        hipDeviceGetAttribute(&cus, hipDeviceAttributeMultiprocessorCount, dev);
        hipFuncSetAttribute((const void*)fwd_kernel, hipFuncAttributeMaxDynamicSharedMemorySize, LDS_BYTES);
        hipOccupancyMaxActiveBlocksPerMultiprocessor(&per_cu, (const void*)fwd_kernel, NT, LDS_BYTES);
        if (per_cu < 1) { fprintf(stderr, "kernel_launch: occupancy query says %d blocks per CU\n", per_cu); grid = -1; return; }
        grid = cus;
    }
    if (grid < 0) return;
    Params p{};
    p.x = (const float*)d_in[0]; p.norm_mix = (const float*)d_in[1]; p.w_in = (const float*)d_in[2]; p.b_forget = (const float*)d_in[3];
    p.g_ret = (const float*)d_in[4]; p.g_sb = (const float*)d_in[5]; p.g_fox = (const float*)d_in[6]; p.w_out = (const float*)d_in[7];
    p.norm_ffn = (const float*)d_in[8]; p.w_group = (const float*)d_in[9]; p.b_group = (const float*)d_in[10]; p.w_router = (const float*)d_in[11];
    p.b_router = (const float*)d_in[12]; p.w_gate = (const float*)d_in[13]; p.w_up = (const float*)d_in[14]; p.w_down = (const float*)d_in[15];
    p.norm_final = (const float*)d_in[16]; p.out = (float*)d_out; p.ws = (unsigned char*)d_ws;
#if N_LAUNCH_PER_PHASE
    for (int ph = 0; ph < NPHASE; ++ph) {
        int lo = ph, hi = ph + 1; void* args[] = {&p, &lo, &hi};
        hipLaunchCooperativeKernel((const void*)fwd_kernel, dim3(grid), dim3(NT), args, LDS_BYTES, stream);
    }
#else
    (void)hipMemsetAsync((char*)d_ws + WS_CTL + (size_t)CTL_BAR * 4, 0, 3456 * 4, stream);
    int lo = 0, hi = NPHASE; void* args[] = {&p, &lo, &hi};
    hipError_t e = hipLaunchCooperativeKernel((const void*)fwd_kernel, dim3(grid), dim3(NT), args, LDS_BYTES, stream);
    if (e != hipSuccess) fprintf(stderr, "cooperative launch failed: %s (grid %d)\n", hipGetErrorString(e), grid);
#endif
}
#endif
```

```cpp
#ifndef CPU_EMU
#include <hip/hip_runtime.h>
#include <hip/hip_cooperative_groups.h>
#include <cstdio>
#include <cstdint>
#include <cmath>
namespace cg = cooperative_groups;
#define VEC(T, N) T __attribute__((ext_vector_type(N)))
__device__ __forceinline__ void wave_barrier() { __builtin_amdgcn_wave_barrier(); }
__device__ __forceinline__ float sin2pi(float x) { return __builtin_amdgcn_sinf(x); }
__device__ __forceinline__ float cos2pi(float x) { return __builtin_amdgcn_cosf(x); }
__device__ __forceinline__ unsigned long long ballot64(bool p) { return __ballot(p); }
#define LAS __attribute__((address_space(3)))
typedef VEC(short, 8) bf16x8;
typedef VEC(float, 4) f32x4_;
__device__ __forceinline__ void glds16(const void* g, LAS unsigned char* l) { __builtin_amdgcn_global_load_lds((const unsigned*)g, (LAS unsigned*)l, 16, 0, 0); }
__device__ __forceinline__ void vm_wait0() { asm volatile("s_waitcnt vmcnt(0)" ::: "memory"); }
__device__ __forceinline__ void lds_wait0() { asm volatile("s_waitcnt lgkmcnt(0)" ::: "memory"); }
__device__ __forceinline__ void sched_fence() { __builtin_amdgcn_sched_barrier(0); }
__device__ __forceinline__ int uni(int x) { return __builtin_amdgcn_readfirstlane(x); }
__device__ __forceinline__ unsigned ld_relaxed(const unsigned* p) { return __hip_atomic_load(p, __ATOMIC_RELAXED, __HIP_MEMORY_SCOPE_AGENT); }
__device__ __forceinline__ int xcc_shard() { return (int)(__builtin_amdgcn_s_getreg((3 << 11) | 20) & 7u); }
__device__ __forceinline__ int lane_id() { int l; asm volatile("v_mbcnt_lo_u32_b32 %0, -1, 0\n\tv_mbcnt_hi_u32_b32 %0, -1, %0" : "=v"(l)); return l; }
__device__ __forceinline__ f32x4_ mfma16(bf16x8 a, bf16x8 b, f32x4_ c) { return __builtin_amdgcn_mfma_f32_16x16x32_bf16(a, b, c, 0, 0, 0); }
typedef VEC(float, 16) f32x16;
typedef VEC(short, 4) s16x4;
__device__ __forceinline__ f32x16 mfma32(bf16x8 a, bf16x8 b, f32x16 c) { return __builtin_amdgcn_mfma_f32_32x32x16_bf16(a, b, c, 0, 0, 0); }
__device__ __forceinline__ s16x4 tr16(const LAS unsigned char* p) { return __builtin_amdgcn_ds_read_tr16_b64_v4i16((LAS s16x4*)p); }
__device__ __forceinline__ float fast_exp(float x) { return __expf(x); }
__device__ __forceinline__ float fast_log(float x) { return __logf(x); }
__device__ __forceinline__ float partner32(float x, int hi) { const auto rr = __builtin_amdgcn_permlane32_swap(__builtin_bit_cast(unsigned, x), __builtin_bit_cast(unsigned, x), false, false); return __builtin_bit_cast(float, hi ? rr[0] : rr[1]); }
template <int N> __device__ __forceinline__ float row_shl_add(float x) { return x + __builtin_bit_cast(float, __builtin_amdgcn_update_dpp(0, __builtin_bit_cast(int, x), 0x100 + N, 0xf, 0xf, true)); }
__device__ __forceinline__ float read_lane(float x, int l) { return __builtin_bit_cast(float, __builtin_amdgcn_readlane(__builtin_bit_cast(int, x), l)); }
#else
#define VEC(T, N) T __attribute__((vector_size(sizeof(T) * N)))
inline float sin2pi(float x) { return (float)sin(6.283185307179586 * (double)x); }
inline float cos2pi(float x) { return (float)cos(6.283185307179586 * (double)x); }
inline unsigned long long ballot64(bool p) { return emu_ballot(p); }
#define LAS
typedef VEC(short, 8) bf16x8;
inline void glds16(const void* g, unsigned char* l) { memcpy(l + (threadIdx.x & 63) * 16, g, 16); }
inline void vm_wait0() {}
inline void lds_wait0() {}
inline void sched_fence() {}
inline int uni(int x) { return x; }
inline int xcc_shard() { return (int)(blockIdx.x & 7u); }
inline unsigned ld_relaxed(const unsigned* p) { return __atomic_load_n(p, __ATOMIC_RELAXED); }
inline int lane_id() { return threadIdx.x & 63; }
inline emu_f32x4 mfma16(bf16x8 a, bf16x8 b, emu_f32x4 c) { return emu_mfma16(a, b, c); }
typedef VEC(float, 16) f32x16;
typedef VEC(short, 4) s16x4;
inline f32x16 mfma32(bf16x8 a, bf16x8 b, f32x16 c) { return emu_mfma32(a, b, c); }
inline s16x4 tr16(const unsigned char* p) { return emu_tr16(p); }
inline float fast_exp(float x) { return expf(x); }
inline float fast_log(float x) { return logf(x); }
inline float partner32(float x, int hi) { return __shfl_xor(x, 32); }
template <int N> inline float row_shl_add(float x) { const int l = threadIdx.x & 63; const float o = emu_shfl_idx(x, (l + N) & 63); return x + (((l & 15) + N < 16) ? o : 0.f); }
inline float read_lane(float x, int l) { return emu_shfl_idx(x, l); }
#endif

typedef unsigned short bf16_t;
typedef VEC(float, 4) f32x4;
typedef VEC(float, 2) f32x2;
typedef VEC(unsigned, 2) u32x2;
typedef VEC(unsigned, 4) u32x4;
typedef LAS unsigned char lds_u8;

#ifdef SMALL_CFG
constexpr int D = 256, S = 512, DEPTH = 2, NRET = 2, NSB = 1, NFOX = 1, NG = 2, EPG = 4, DE = 128;
#else
constexpr int D = 1024, S = 16384, DEPTH = 2, NRET = 6, NSB = 5, NFOX = 5, NG = 4, EPG = 8, DE = 512;
#endif
constexpr int CH = 64, HD = 64, NE = NG * EPG;
constexpr int WRET = NRET * HD, WSB = NSB * HD, WFOX = NFOX * HD, MIXW = WRET + WSB + WFOX;
constexpr int IN_W = 4 * WRET + 3 * WSB + 3 * WFOX + NFOX;
constexpr int PW = (IN_W + 255) / 256 * 256;
constexpr int OQR = 0, OKR = WRET, OVR = 2 * WRET, OGR = 3 * WRET, OQS = 4 * WRET, OKS = OQS + WSB, OVS = OKS + WSB;
constexpr int OQF = OVS + WSB, OKF = OQF + WFOX, OVF = OKF + WFOX, OFL = OVF + WFOX;
constexpr int NCHUNK = S / CH;
constexpr float EPS = 1e-6f;
constexpr int NT = 512, NW = NT / 64;
constexpr int NROUTE = NG + NE;
constexpr float EXIT_T = 18.0f;

constexpr size_t al256(size_t x) { return (x + 255) / 256 * 256; }
constexpr size_t WS_CTL = 0;
constexpr int CTL_CNT = 0;
constexpr int CTL_KMAX = 256;
constexpr int CTL_MQ = 4608, CTL_WQ = 4608 + DEPTH * 8 * 64;
constexpr int CTL_BAR = 1024;
constexpr int CTL_WORDS = 8192;
static_assert(CTL_BAR + 3456 <= CTL_MQ && CTL_WQ + DEPTH * 8 * 64 <= CTL_WORDS, "control-word map");
constexpr size_t WS_ROT = 32768;
constexpr size_t WS_X = al256(WS_ROT + (size_t)S * 32 * 8);
constexpr size_t WS_H = al256(WS_X + (size_t)S * D * 4);
constexpr size_t WS_LOGF = al256(WS_H + (size_t)S * D * 2);
constexpr size_t WS_FCUM = al256(WS_LOGF + (size_t)S * 8 * 4);
constexpr size_t WS_LC = al256(WS_FCUM + (size_t)S * 8 * 4);
constexpr size_t WS_MERGED = al256(WS_LC + (size_t)S * 8 * 4);
constexpr size_t WS_U = al256(WS_MERGED + (size_t)S * MIXW * 2);
constexpr size_t WS_SP = al256(WS_U + (size_t)NRET * NCHUNK * 4096 * 4);
constexpr size_t WS_LIST = al256(WS_SP + (size_t)NRET * NCHUNK * 4096 * 4);
constexpr size_t WS_GATE = al256(WS_LIST + (size_t)NE * S * 4);
constexpr size_t WS_WIN = al256(WS_GATE + (size_t)S * 2 * 4);
constexpr size_t WS_WOUT = al256(WS_WIN + (size_t)DEPTH * PW * D * 2);
constexpr size_t WS_WGU = al256(WS_WOUT + (size_t)DEPTH * D * MIXW * 2);
constexpr size_t WS_WDN = al256(WS_WGU + (size_t)DEPTH * NE * 2 * DE * D * 2);
constexpr size_t WS_PROJ = al256(WS_WDN + (size_t)DEPTH * NE * D * DE * 2);
constexpr int HID_ROWS = 2 * S + NE * 256;
constexpr size_t WS_HID = WS_PROJ;
constexpr size_t WS_Y = al256(WS_HID + (size_t)HID_ROWS * DE * 2);
constexpr size_t WS_END0 = al256(WS_PROJ + (size_t)S * PW * 2), WS_END1 = al256(WS_Y + (size_t)2 * S * D * 2);
constexpr size_t WS_END = WS_END0 > WS_END1 ? WS_END0 : WS_END1;
#ifndef SMALL_CFG
static_assert(WS_END <= (size_t)512 * 1024 * 1024, "workspace map exceeds the guaranteed 512 MiB");
#endif

struct Params {
    const float* x; const float* norm_mix; const float* w_in; const float* b_forget; const float* g_ret; const float* g_sb; const float* g_fox;
    const float* w_out; const float* norm_ffn; const float* w_group; const float* b_group; const float* w_router; const float* b_router;
    const float* w_gate; const float* w_up; const float* w_down; const float* norm_final;
    float* out; unsigned char* ws;
    int wid, pad;
};

#define TIDX(p) (((p).wid << 6) | lane_id())
__device__ __forceinline__ int imin(int a, int b) { return a < b ? a : b; }
__device__ __forceinline__ float u2f(unsigned u) { return __builtin_bit_cast(float, u); }
__device__ __forceinline__ unsigned f2u(float f) { return __builtin_bit_cast(unsigned, f); }
__device__ __forceinline__ float bf2f(bf16_t b) { return u2f((unsigned)b << 16); }
__device__ __forceinline__ bf16_t f2bf(float f) { unsigned u = f2u(f); return (bf16_t)((u + 0x7fffu + ((u >> 16) & 1u)) >> 16); }
#ifndef CPU_EMU
typedef float pk_f32x2 __attribute__((ext_vector_type(2))); typedef __bf16 pk_bf16x2 __attribute__((ext_vector_type(2)));
__device__ __forceinline__ unsigned pk2(float lo, float hi) { const pk_f32x2 v = {lo, hi}; return __builtin_bit_cast(unsigned, __builtin_convertvector(v, pk_bf16x2)); }
#else
__device__ __forceinline__ unsigned pk2(float lo, float hi) { return (unsigned)f2bf(lo) | ((unsigned)f2bf(hi) << 16); }
#endif
__device__ __forceinline__ float log_sigmoid(float x) { return fminf(x, 0.f) - log1pf(expf(-fabsf(x))); }
#ifndef CPU_EMU
__device__ __forceinline__ float silu(float x) { return x * __builtin_amdgcn_rcpf(1.f + __expf(-x)); }
#else
__device__ __forceinline__ float silu(float x) { return x / (1.f + expf(-x)); }
#endif
#ifndef CPU_EMU
template <int CTRL> __device__ __forceinline__ float dpp_mov(float x) { return __builtin_bit_cast(float, __builtin_amdgcn_update_dpp(0, __builtin_bit_cast(int, x), CTRL, 0xf, 0xf, false)); }
__device__ __forceinline__ float wave_sum(float v) {
    v += dpp_mov<0xB1>(v); v += dpp_mov<0x4E>(v); v += dpp_mov<0x141>(v); v += dpp_mov<0x140>(v);
    return (read_lane(v, 0) + read_lane(v, 16)) + (read_lane(v, 32) + read_lane(v, 48));
}
__device__ __forceinline__ float wave_max(float v) {
    v = fmaxf(v, dpp_mov<0xB1>(v)); v = fmaxf(v, dpp_mov<0x4E>(v)); v = fmaxf(v, dpp_mov<0x141>(v)); v = fmaxf(v, dpp_mov<0x140>(v));
    return fmaxf(fmaxf(read_lane(v, 0), read_lane(v, 16)), fmaxf(read_lane(v, 32), read_lane(v, 48)));
}
#else
__device__ __forceinline__ float wave_sum(float v) {
#pragma unroll
    for (int o = 1; o < 64; o <<= 1) v += __shfl_xor(v, o);
    return v;
}
__device__ __forceinline__ float wave_max(float v) {
#pragma unroll
    for (int o = 1; o < 64; o <<= 1) v = fmaxf(v, __shfl_xor(v, o));
    return v;
}
#endif
__device__ __forceinline__ double inv_turns(int j) {
    static constexpr double T[32] = {
        1.59154943091895346e-01, 1.19349370211248862e-01, 8.94994016088910133e-02, 6.71150830052272551e-02, 5.03292121044870353e-02, 3.77415847174197711e-02, 2.83021958306233987e-02, 2.12236527647776604e-02,
        1.59154943091895339e-02, 1.19349370211248862e-02, 8.94994016088910237e-03, 6.71150830052272534e-03, 5.03292121044870370e-03, 3.77415847174197719e-03, 2.83021958306233987e-03, 2.12236527647776622e-03,
        1.59154943091895356e-03, 1.19349370211248849e-03, 8.94994016088910237e-04, 6.71150830052272599e-04, 5.03292121044870326e-04, 3.77415847174197741e-04, 2.83021958306233954e-04, 2.12236527647776605e-04,
        1.59154943091895351e-04, 1.19349370211248862e-04, 8.94994016088910182e-05, 6.71150830052272545e-05, 5.03292121044870354e-05, 3.77415847174197768e-05, 2.83021958306233961e-05, 2.12236527647776592e-05};
    return T[j];
}

constexpr int VROWB = 144;
constexpr int IMG64 = 64 * VROWB;
constexpr int RET_WAVE_LDS = 2 * IMG64;
__device__ __forceinline__ int crow(int reg, int hi) { return (reg & 3) + 8 * (reg >> 2) + 4 * hi; }
__device__ __forceinline__ bf16x8 tr_frag(const lds_u8* base, int rowoff0, int rowoff1, int coloff) {
    const s16x4 lo = tr16(base + rowoff0 * VROWB + coloff), hi4 = tr16(base + rowoff1 * VROWB + coloff);
    bf16x8 f; f[0] = lo[0]; f[1] = lo[1]; f[2] = lo[2]; f[3] = lo[3]; f[4] = hi4[0]; f[5] = hi4[1]; f[6] = hi4[2]; f[7] = hi4[3]; return f;
}

constexpr int RJ = D / 256;
__device__ __forceinline__ void row_load(const float* row, f32x4* v, int lane) {
#pragma unroll
    for (int j = 0; j < RJ; ++j) v[j] = *(const f32x4*)(row + 256 * j + lane * 4);
}
__device__ __forceinline__ void row_load_bf16(const bf16_t* row, f32x4* v, int lane) {
#pragma unroll
    for (int j = 0; j < RJ; ++j) { const u32x2 w = *(const u32x2*)(row + 256 * j + lane * 4); v[j][0] = u2f(w[0] << 16); v[j][1] = u2f(w[0] & 0xffff0000u); v[j][2] = u2f(w[1] << 16); v[j][3] = u2f(w[1] & 0xffff0000u); }
}
__device__ __forceinline__ float row_rinv(const f32x4* v) {
    float s = 0.f;
#pragma unroll
    for (int j = 0; j < RJ; ++j) s += (v[j][0] * v[j][0] + v[j][1] * v[j][1]) + (v[j][2] * v[j][2] + v[j][3] * v[j][3]);
    s = wave_sum(s);
    return 1.0f / sqrtf(s * (1.0f / D) + EPS);
}

#ifndef CPU_EMU
typedef float f32x4_u __attribute__((ext_vector_type(4), aligned(4)));
#else
typedef float f32x4_u __attribute__((vector_size(16), aligned(4)));
#endif
#ifndef CPU_EMU
__device__ __forceinline__ f32x4_u nt_load4(const f32x4_u* p) { return __builtin_nontemporal_load(p); }
#else
inline f32x4_u nt_load4(const f32x4_u* p) { return *p; }
#endif
struct TrDesc { const float* Wa; const float* Wb; int ldw, ncols, c0, cb0, k0; bf16_t* WT; int ldt, r0, r1; };
__device__ __forceinline__ void tr_load(const TrDesc& d, f32x4 (&v)[16], int lane) {
    const int n = 4 * (lane & 15), kr = lane >> 4;
    const float* src = (n < 32 ? d.Wa + d.c0 + n : d.Wb + d.cb0 + (n - 32)) + (size_t)(d.k0 + kr) * d.ldw;
    const int col = (n < 32 ? d.c0 + n : d.cb0 + n - 32);
    if (col + 3 < d.ncols) {
#pragma unroll
        for (int i = 0; i < 16; ++i) { const f32x4_u t = nt_load4((const f32x4_u*)(src + (size_t)(4 * i) * d.ldw)); v[i][0] = t[0]; v[i][1] = t[1]; v[i][2] = t[2]; v[i][3] = t[3]; }
    } else {
#pragma unroll
        for (int i = 0; i < 16; ++i)
#pragma unroll
            for (int j = 0; j < 4; ++j) v[i][j] = (col + j < d.ncols) ? src[(size_t)(4 * i) * d.ldw + j] : 0.f;
    }
}
__device__ __forceinline__ void tr_store(const TrDesc& d, const f32x4 (&v)[16], lds_u8* img, int lane) {
    const int n = 4 * (lane & 15), kr = lane >> 4;
    wave_barrier();
#pragma unroll
    for (int i = 0; i < 16; ++i) { u32x2 o; o[0] = pk2(v[i][0], v[i][1]); o[1] = pk2(v[i][2], v[i][3]); *(LAS u32x2*)(img + (4 * i + kr) * VROWB + n * 2) = o; }
    wave_barrier();
    const lds_u8* tb = img + ((lane & 15) >> 2) * VROWB + (16 * (lane >> 4) + 4 * (lane & 3)) * 2;
    u32x4 o[8];
#pragma unroll
    for (int kc = 0; kc < 8; ++kc) {
        const s16x4 lo = tr16(tb + (8 * kc) * VROWB), hi4 = tr16(tb + (8 * kc + 4) * VROWB);
        o[kc][0] = (unsigned)(unsigned short)lo[0] | ((unsigned)(unsigned short)lo[1] << 16); o[kc][1] = (unsigned)(unsigned short)lo[2] | ((unsigned)(unsigned short)lo[3] << 16);
        o[kc][2] = (unsigned)(unsigned short)hi4[0] | ((unsigned)(unsigned short)hi4[1] << 16); o[kc][3] = (unsigned)(unsigned short)hi4[2] | ((unsigned)(unsigned short)hi4[3] << 16);
    }
    wave_barrier();
#pragma unroll
    for (int kc = 0; kc < 8; ++kc) *(LAS u32x4*)(img + lane * VROWB + kc * 16) = o[kc];
    wave_barrier();
#pragma unroll
    for (int j = 0; j < 8; ++j) {
        const int n = (lane >> 3) + 8 * j, kc = lane & 7;
        const int xx = n & 31, pos32 = 16 * ((xx >> 2) & 1) + 4 * (xx >> 3) + (xx & 3);
        const u32x4 v4 = *(const LAS u32x4*)(img + n * VROWB + kc * 16);
        *(u32x4*)(d.WT + (size_t)((n < 32 ? d.r0 : d.r1) + pos32) * d.ldt + d.k0 + 8 * kc) = v4;
    }
}
constexpr int WI_IN = (D / 64) * ((IN_W + 63) / 64), WI_OUT = (MIXW / 64) * (D / 64), WI_GU = (D / 64) * (DE / 32), WI_DN = (DE / 64) * (D / 64);
constexpr int WI_DENSE = WI_IN + WI_OUT, WI_EXPERT = WI_GU + WI_DN, WI_LAYER = WI_DENSE + NE * WI_EXPERT;
__device__ __forceinline__ TrDesc weight_desc(const Params& p, int l, int r) {
    if (r < WI_IN) { const int nb = (IN_W + 63) / 64, c0 = (r % nb) * 64; const float* W = p.w_in + (size_t)l * D * IN_W;
        const int r0 = (c0 / 256) * 256 + ((c0 % 256) / 64) * 32;
        return TrDesc{W, W, IN_W, IN_W, c0, c0 + 32, (r / nb) * 64, (bf16_t*)(p.ws + WS_WIN) + (size_t)l * PW * D, D, r0, r0 + 128}; }
    r -= WI_IN;
    if (r < WI_OUT) { const int nb = D / 64, c0 = (r % nb) * 64; const float* W = p.w_out + (size_t)l * MIXW * D;
        return TrDesc{W, W, D, D, c0, c0 + 32, (r / nb) * 64, (bf16_t*)(p.ws + WS_WOUT) + (size_t)l * D * MIXW, MIXW, c0, c0 + 32}; }
    r -= WI_OUT;
    const int e = r / WI_EXPERT; r %= WI_EXPERT;
    if (r < WI_GU) { const int nb = DE / 32, c0 = (r % nb) * 32;
        const int r0 = (c0 / 128) * 256 + (c0 % 128);
        return TrDesc{p.w_gate + (size_t)(l * NE + e) * D * DE, p.w_up + (size_t)(l * NE + e) * D * DE, DE, DE, c0, c0, (r / nb) * 64, (bf16_t*)(p.ws + WS_WGU) + (size_t)(l * NE + e) * 2 * DE * D, D, r0, r0 + 128}; }
    r -= WI_GU;
    { const int nb = D / 64, c0 = (r % nb) * 64; const float* W = p.w_down + (size_t)(l * NE + e) * DE * D;
        return TrDesc{W, W, D, D, c0, c0 + 32, (r / nb) * 64, (bf16_t*)(p.ws + WS_WDN) + (size_t)(l * NE + e) * D * DE, DE, c0, c0 + 32}; }
}
__device__ __forceinline__ void weight_item(const Params& p, int l, int r, lds_u8* img, int lane) { const TrDesc d = weight_desc(p, l, r); f32x4 v[16]; tr_load(d, v, lane); tr_store(d, v, img, lane); }
__device__ __forceinline__ void weight_item2(const Params& p, int l, int ra, int rb, lds_u8* img, int lane) {
    const TrDesc da = weight_desc(p, l, ra), db = weight_desc(p, l, rb); f32x4 va[16], vb[16];
    tr_load(da, va, lane); tr_load(db, vb, lane); tr_store(da, va, img, lane); tr_store(db, vb, img + IMG64, lane);
}
__device__ __forceinline__ void phase_init(const Params& p, float* lds) {
    unsigned* ctl = (unsigned*)(p.ws + WS_CTL);
    if (blockIdx.x == 0) for (int i = TIDX(p); i < CTL_WORDS; i += NT) if (i < CTL_BAR || i >= CTL_BAR + 3456) ctl[i] = 0u;
    f32x2* rot = (f32x2*)(p.ws + WS_ROT);
    for (int i = blockIdx.x * NT + TIDX(p); i < S * 32; i += gridDim.x * NT) {
        const int pos = i >> 5, j = i & 31;
        const double turns = (double)pos * inv_turns(j);
        const double fr = turns - floor(turns);
        f32x2 cs; cs[0] = cos2pi((float)fr); cs[1] = sin2pi((float)fr);
        rot[i] = cs;
    }
    const int lane = lane_id(), wave = p.wid;
    {
        lds_u8* img = (lds_u8*)lds + wave * RET_WAVE_LDS;
        for (int it = blockIdx.x * NW + wave; it < DEPTH * WI_DENSE; it += gridDim.x * NW) weight_item(p, it / WI_DENSE, it % WI_DENSE, img, lane);
    }
    bf16_t* H = (bf16_t*)(p.ws + WS_H);
    for (int r = blockIdx.x * NW + wave; r < S; r += gridDim.x * NW) {
        f32x4 v[RJ]; row_load(p.x + (size_t)r * D, v, lane);
        const float ri = row_rinv(v);
#pragma unroll
        for (int j = 0; j < RJ; ++j) {
            const f32x4 g = *(const f32x4*)(p.norm_mix + 256 * j + lane * 4);
            u32x2 o; o[0] = pk2(v[j][0] * ri * g[0], v[j][1] * ri * g[1]); o[1] = pk2(v[j][2] * ri * g[2], v[j][3] * ri * g[3]);
            *(u32x2*)(H + (size_t)r * D + 256 * j + lane * 4) = o;
        }
    }
}

constexpr int GBM = 256, GBK = 64, TILE_B = GBM * GBK * 2, STAGE_B = 2 * TILE_B, GEMM_LDS = 2 * STAGE_B;
__device__ __forceinline__ int lds_byte(int r, int c) { const int st = (r >> 4) * 2 + (c >> 5), ob = (r & 15) * 64 + (c & 31) * 2; return st * 1024 + (ob ^ (((ob >> 9) & 1) << 5)); }
__device__ __forceinline__ void stage_rc(int b, int& R, int& C) { const int st = b >> 10, sb = b & 1023, swz = sb ^ (((sb >> 9) & 1) << 5); R = (st >> 1) * 16 + swz / 64; C = (st & 1) * 32 + (swz % 64) / 2; }
__device__ __forceinline__ int vcu_id() { const int G = gridDim.x, b = blockIdx.x; return (G % 8 == 0) ? (b % 8) * (G / 8) + b / 8 : b; }

constexpr int HTB = 128 * GBK * 2;
struct GUnit { unsigned A, B; unsigned ao[4]; int i0, i1, i2, i3; };
#ifndef CPU_EMU
#define G8_WAIT_V(n) asm volatile("s_waitcnt vmcnt(" #n ")" ::: "memory")
#define G8_WAIT_L0() asm volatile("s_waitcnt lgkmcnt(0)" ::: "memory")
#define G8_BAR() __builtin_amdgcn_s_barrier()
#define G8_PRIO(x) __builtin_amdgcn_s_setprio(x)
#else
#define G8_WAIT_V(n) do {} while (0)
#define G8_WAIT_L0() do {} while (0)
#define G8_BAR() __syncthreads()
#define G8_PRIO(x) do {} while (0)
#endif
template <class Sched, class Epi>
__device__ __forceinline__ void gemm_stream(lds_u8* lds, const char* Abase, const char* Bbase, const int K, Sched& S, const Epi& E) {
    const int wid = S.wid, lane = lane_id(), tid = (wid << 6) | lane, wr = wid >> 2, wc = wid & 3, fr = lane & 15, fq = lane >> 4;
    const int nt = K / GBK;
    unsigned voffB[2];
    { int R, C; stage_rc(tid * 16, R, C); voffB[0] = (unsigned)((R * K + C) * 2); stage_rc(tid * 16 + 8192, R, C); voffB[1] = (unsigned)((R * K + C) * 2); }
    const unsigned hstepB = (unsigned)(128 * K * 2);
    lds_u8* ldsw = lds + wid * 1024;
    const int aoff = lds_byte(wr * 64 + fr, fq * 8), boff = lds_byte(wc * 32 + fr, fq * 8);
#define G8_SA(b, h) (((b) * 2 + (h)) * HTB)
#define G8_SB(b, h) ((4 + (b) * 2 + (h)) * HTB)
#define G8_STAGE_A(b, h, U, kt) do { _Pragma("unroll") for (int i_ = 0; i_ < 2; ++i_) glds16(Abase + ((size_t)(U).A + (size_t)((kt) * (GBK * 2))) + (Sched::GATHER ? (U).ao[2 * (h) + i_] : S.ao[2 * (h) + i_]), ldsw + G8_SA(b, h) + i_ * 8192); } while (0)
#define G8_STAGE_B(b, h, U, kt) do { _Pragma("unroll") for (int i_ = 0; i_ < 2; ++i_) glds16(Bbase + ((size_t)(U).B + (size_t)((kt) * (GBK * 2)) + (size_t)(h) * hstepB) + voffB[i_], ldsw + G8_SB(b, h) + i_ * 8192); } while (0)
#define G8_LDA(dst, b, h) do { _Pragma("unroll") for (int m = 0; m < 4; ++m) _Pragma("unroll") for (int k = 0; k < 2; ++k) dst[m][k] = *(const LAS bf16x8*)(lds + G8_SA(b, h) + aoff + m * 2048 + k * 1024); } while (0)
#define G8_LDB(dst, b, h) do { _Pragma("unroll") for (int n = 0; n < 2; ++n) _Pragma("unroll") for (int k = 0; k < 2; ++k) dst[n][k] = *(const LAS bf16x8*)(lds + G8_SB(b, h) + boff + n * 2048 + k * 1024); } while (0)
#define G8_MMA(ai, bj, At_, Bt_) do { G8_PRIO(1); _Pragma("unroll") for (int m = 0; m < 4; ++m) _Pragma("unroll") for (int n = 0; n < 2; ++n) _Pragma("unroll") for (int k = 0; k < 2; ++k) \
        acc[ai][bj][m][n] = mfma16(Bt_[n][k], At_[m][k], acc[ai][bj][m][n]); G8_PRIO(0); } while (0)
    GUnit cur, nxt; int ui = 0;
    if (!S.next(0, cur)) return;
    f32x4 acc[2][2][4][2];
#pragma unroll
    for (int a = 0; a < 2; ++a)
#pragma unroll
        for (int b = 0; b < 2; ++b)
#pragma unroll
            for (int m = 0; m < 4; ++m)
#pragma unroll
                for (int n = 0; n < 2; ++n) acc[a][b][m][n] = (f32x4){0.f, 0.f, 0.f, 0.f};
    bf16x8 At[4][2], B0[2][2], B1[2][2];
    G8_STAGE_B(0, 0, cur, 0); G8_STAGE_B(0, 1, cur, 0); G8_STAGE_A(0, 0, cur, 0); G8_STAGE_A(0, 1, cur, 0);
    if (wr == 1) G8_BAR();
    G8_WAIT_V(2); G8_BAR();
    G8_STAGE_B(1, 0, cur, 1); G8_STAGE_A(1, 0, cur, 1); G8_STAGE_B(1, 1, cur, 1);
    G8_WAIT_V(6); G8_BAR();
    for (;;) {
        const bool has_next = S.next(ui + 1, nxt);
        if (!has_next) nxt = cur;
        for (int t = 0; t < nt; t += 2) {
            const bool last = (t == nt - 2);
            const GUnit& U2 = last ? nxt : cur;
            const int k2 = last ? 0 : t + 2, k3 = k2 + 1;
            G8_LDB(B0, 0, 0); G8_LDB(B1, 0, 1); sched_fence(); G8_LDA(At, 0, 0); G8_STAGE_A(1, 1, cur, t + 1);
            G8_WAIT_V(8); G8_WAIT_L0(); G8_BAR(); G8_MMA(0, 0, At, B0); G8_MMA(0, 1, At, B1); G8_BAR(); sched_fence();
            G8_LDA(At, 0, 1); G8_STAGE_B(0, 0, U2, k2); G8_STAGE_B(0, 1, U2, k2); G8_STAGE_A(0, 0, U2, k2);
            G8_WAIT_V(8); G8_WAIT_L0(); G8_BAR(); G8_MMA(1, 0, At, B0); G8_MMA(1, 1, At, B1); G8_BAR(); sched_fence();
            G8_LDB(B0, 1, 0); G8_LDB(B1, 1, 1); sched_fence(); G8_LDA(At, 1, 0); G8_STAGE_A(0, 1, U2, k2);
            G8_WAIT_V(8); G8_WAIT_L0(); G8_BAR(); G8_MMA(0, 0, At, B0); G8_MMA(0, 1, At, B1); G8_BAR(); sched_fence();
            G8_LDA(At, 1, 1); G8_STAGE_B(1, 0, U2, k3); G8_STAGE_B(1, 1, U2, k3); G8_STAGE_A(1, 0, U2, k3);
            G8_WAIT_V(8); G8_WAIT_L0(); G8_BAR(); G8_MMA(1, 0, At, B0); G8_MMA(1, 1, At, B1); G8_BAR(); sched_fence();
        }
        if (wr == 0) G8_BAR();
        E(acc, cur, wr, wc, fr, fq);
        if (!has_next) break;
#pragma unroll
        for (int a = 0; a < 2; ++a)
#pragma unroll
            for (int b = 0; b < 2; ++b)
#pragma unroll
                for (int m = 0; m < 4; ++m)
#pragma unroll
                    for (int n = 0; n < 2; ++n) acc[a][b][m][n] = (f32x4){0.f, 0.f, 0.f, 0.f};
        cur = nxt; ++ui;
        if (wr == 1) G8_BAR();
    }
    G8_WAIT_V(0);
    G8_BAR();
#undef G8_SA
#undef G8_SB
#undef G8_STAGE_A
#undef G8_STAGE_B
#undef G8_LDA
#undef G8_LDB
#undef G8_MMA
}
__device__ __forceinline__ void plain_ao(unsigned (&ao)[4], int K, int tid) {
    int R, C; stage_rc(tid * 16, R, C); ao[0] = (unsigned)((R * K + C) * 2); ao[2] = ao[0] + (unsigned)(128 * K * 2);
    stage_rc(tid * 16 + 8192, R, C); ao[1] = (unsigned)((R * K + C) * 2); ao[3] = ao[1] + (unsigned)(128 * K * 2);
}

struct InprojSched {
    static constexpr bool GATHER = false;
    int wid;
    unsigned ao[4]; int vcu, G;
    static constexpr int NPM = S / GBM, NPN = PW / GBM;
    __device__ __forceinline__ bool next(int i, GUnit& u) const {
        const int L = uni(i * G + vcu); if (L >= NPM * NPN) return false;
        constexpr int WGM = 8, nig = WGM * NPN;
        const int gid = L / nig, fm = gid * WGM, gsz = (NPM - fm) < WGM ? (NPM - fm) : WGM;
        const int pm = fm + (L % nig) % gsz, pn = (L % nig) / gsz;
        u.A = (unsigned)(pm * GBM * D * 2); u.B = (unsigned)(pn * GBM * D * 2); u.ao[0] = u.ao[1] = u.ao[2] = u.ao[3] = 0u;
        u.i0 = pm; u.i1 = pn; u.i2 = 0; u.i3 = 0; return true;
    }
};
struct InprojEpi {
    bf16_t* P; float* LOGF; unsigned* kmaxw; const f32x2* rot; const float* bfg;
    __device__ __forceinline__ void operator()(f32x4 (&acc)[2][2][4][2], const GUnit& u, int wr, int wc, int fr, int fq) const {
        const int gc0 = u.i1 * GBM + wc * 64;
        if (gc0 >= IN_W) return;
        const int row0 = u.i0 * GBM + wr * 64 + fr;
        if (gc0 >= OFL) {
#pragma unroll
            for (int ai = 0; ai < 2; ++ai)
#pragma unroll
                for (int m = 0; m < 4; ++m)
#pragma unroll
                    for (int n = 0; n < 2; ++n)
#pragma unroll
                        for (int j = 0; j < 4; ++j) { const int h = 4 * n + j; if (fq == 0 && h < NFOX) LOGF[(size_t)h * S + row0 + ai * 128 + m * 16] = log_sigmoid(acc[ai][0][m][n][j] + bfg[h]); }
            return;
        }
        const bool rotary = gc0 < OVR, is_gate = (gc0 >= OGR && gc0 < OQS), is_kf = (gc0 >= OKF && gc0 < OVF);
        const float scale = (gc0 < OKR || (gc0 >= OQS && gc0 < OKS) || (gc0 >= OQF && gc0 < OKF)) ? 0.125f : 1.0f;
        float kmx = 0.f;
        if (rotary) {
#pragma unroll
            for (int am = 0; am < 4; ++am) {
                const int ai = am >> 1, m0 = (am & 1) * 2;
                f32x4 c01[2][2], c23[2][2];
#pragma unroll
                for (int mm = 0; mm < 2; ++mm)
#pragma unroll
                    for (int n = 0; n < 2; ++n) { const f32x2* rp = rot + (size_t)(row0 + ai * 128 + (m0 + mm) * 16) * 32 + 8 * fq + 4 * n; c01[mm][n] = *(const f32x4*)rp; c23[mm][n] = *(const f32x4*)(rp + 2); }
#pragma unroll
                for (int mm = 0; mm < 2; ++mm)
#pragma unroll
                    for (int n = 0; n < 2; ++n) {
                        const int m = m0 + mm;
                        const float cs[4] = {c01[mm][n][0], c01[mm][n][2], c23[mm][n][0], c23[mm][n][2]}, sn[4] = {c01[mm][n][1], c01[mm][n][3], c23[mm][n][1], c23[mm][n][3]};
#pragma unroll
                        for (int j = 0; j < 4; ++j) { const float x1 = acc[ai][0][m][n][j], x2 = acc[ai][1][m][n][j]; acc[ai][0][m][n][j] = x1 * cs[j] - x2 * sn[j]; acc[ai][1][m][n][j] = x1 * sn[j] + x2 * cs[j]; }
                    }
                sched_fence();
            }
        }
#pragma unroll
        for (int ai = 0; ai < 2; ++ai)
#pragma unroll
            for (int m = 0; m < 4; ++m) {
                const int row = row0 + ai * 128 + m * 16;
                float ss = 0.f;
#pragma unroll
                for (int bj = 0; bj < 2; ++bj) {
                    u32x4 o;
#pragma unroll
                    for (int n = 0; n < 2; ++n) {
                        f32x4 v = acc[ai][bj][m][n] * scale;
                        if (is_gate) {
#pragma unroll
                            for (int j = 0; j < 4; ++j) v[j] = silu(v[j]);
                        }
                        o[2 * n] = pk2(v[0], v[1]); o[2 * n + 1] = pk2(v[2], v[3]);
                        if (is_kf) {
#pragma unroll
                            for (int j = 0; j < 4; ++j) { const float r = bf2f(f2bf(v[j])); ss += r * r; }
                        }
                    }
                    *(u32x4*)(P + (size_t)row * PW + gc0 + 32 * bj + 8 * fq) = o;
                }
                if (is_kf) { ss += __shfl_xor(ss, 16); ss += __shfl_xor(ss, 32); kmx = fmaxf(kmx, ss); }
            }
        if (is_kf) { kmx = wave_max(kmx); if (lane_id() == 0) atomicMax(kmaxw + (gc0 - OKF) / HD, f2u(kmx)); }
    }
};
__device__ __forceinline__ void phase_inproj(const Params& p, int l, float* ldsf) {
    InprojSched S; S.wid = p.wid; plain_ao(S.ao, D, TIDX(p)); S.vcu = vcu_id(); S.G = gridDim.x;
    InprojEpi E; E.P = (bf16_t*)(p.ws + WS_PROJ); E.LOGF = (float*)(p.ws + WS_LOGF); E.kmaxw = (unsigned*)(p.ws + WS_CTL) + CTL_KMAX + l * 8; E.rot = (const f32x2*)(p.ws + WS_ROT); E.bfg = p.b_forget + l * NFOX;
    gemm_stream((lds_u8*)ldsf, (const char*)(p.ws + WS_H), (const char*)(p.ws + WS_WIN) + (size_t)l * PW * D * 2, D, S, E);
}

__device__ __forceinline__ float ret_log_gamma(int h) { return logf(1.0f - exp2f(-5.0f - (float)h)); }
__device__ __forceinline__ void ret_prep_item(const Params& p, int h, int n, lds_u8* wl) {
    const bf16_t* P = (const bf16_t*)(p.ws + WS_PROJ);
    float* UT = (float*)(p.ws + WS_U);
    const int lane = lane_id(), r32 = lane & 31, hi = lane >> 5;
    const float lg = ret_log_gamma(h);
    wave_barrier();
#pragma unroll
    for (int i = 0; i < 8; ++i) {
        const int c = lane + 64 * i, row = c >> 3, ch = c & 7;
        const bf16_t* src = P + (size_t)(n * CH + row) * PW + h * HD + 8 * ch;
        const u32x4 kv = *(const u32x4*)(src + OKR), vv = *(const u32x4*)(src + OVR);
        const float dk = fast_exp(lg * (float)(CH - 1 - row));
        u32x4 ko;
#pragma unroll
        for (int w = 0; w < 4; ++w) ko[w] = pk2(u2f(kv[w] << 16) * dk, u2f(kv[w] & 0xffff0000u) * dk);
        *(LAS u32x4*)(wl + row * VROWB + ch * 16) = ko;
        *(LAS u32x4*)(wl + IMG64 + row * VROWB + ch * 16) = vv;
    }
    wave_barrier();
    const lds_u8* tb = wl + (8 * hi + ((lane & 15) >> 2)) * VROWB + (16 * ((lane >> 4) & 1) + 4 * (lane & 3)) * 2;
    f32x16 acc[2][2];
#pragma unroll
    for (int a = 0; a < 2; ++a)
#pragma unroll
        for (int b = 0; b < 2; ++b)
#pragma unroll
            for (int r = 0; r < 16; ++r) acc[a][b][r] = 0.f;
#pragma unroll
    for (int s = 0; s < 4; ++s) {
        bf16x8 vf[2], kf[2];
#pragma unroll
        for (int x = 0; x < 2; ++x) { kf[x] = tr_frag(tb, 16 * s, 16 * s + 4, x * 64); vf[x] = tr_frag(tb + IMG64, 16 * s, 16 * s + 4, x * 64); }
#pragma unroll
        for (int eb = 0; eb < 2; ++eb)
#pragma unroll
            for (int db = 0; db < 2; ++db) acc[eb][db] = mfma32(vf[eb], kf[db], acc[eb][db]);
    }
    float* dst = UT + (size_t)(h * NCHUNK + n) * 4096;
#pragma unroll
    for (int eb = 0; eb < 2; ++eb)
#pragma unroll
        for (int db = 0; db < 2; ++db)
#pragma unroll
            for (int r = 0; r < 16; ++r) dst[(32 * eb + crow(r, hi)) * 64 + 32 * db + r32] = acc[eb][db][r];
}
__device__ __forceinline__ void fcum_block(const Params& p, int h, float* ldsf) {
    const float* LF = (const float*)(p.ws + WS_LOGF) + (size_t)h * S;
    float* F = (float*)(p.ws + WS_FCUM) + (size_t)h * S;
    float* LC = (float*)(p.ws + WS_LC) + (size_t)h * S;
    constexpr int KPT = S / NT;
    const int tid = TIDX(p), lane = lane_id(), w = p.wid;
    float v[KPT], a[KPT];
#pragma unroll
    for (int i = 0; i < KPT; ++i) { v[i] = LF[tid * KPT + i]; a[i] = expf(v[i]); }
    float A = 1.f, B = 0.f;
#pragma unroll
    for (int i = 0; i < KPT; ++i) { A *= a[i]; B = a[i] * B + 1.f; }
#pragma unroll
    for (int i = 1; i < KPT; ++i) v[i] += v[i - 1];
    float inc = v[KPT - 1];
    float Ai = A, Bi = B;
#pragma unroll
    for (int d = 1; d < 64; d <<= 1) {
        const float o = __shfl_up(inc, d), Ao = __shfl_up(Ai, d), Bo = __shfl_up(Bi, d);
        if (lane >= d) { inc += o; Bi = Ai * Bo + Bi; Ai = Ai * Ao; }
    }
    __syncthreads();
    if (lane == 63) { ldsf[w] = inc; ldsf[16 + w] = Ai; ldsf[32 + w] = Bi; }
    __syncthreads();
    float off = inc - v[KPT - 1];
    float x = 0.f;
    for (int ww = 0; ww < w; ++ww) { off += ldsf[ww]; x = ldsf[16 + ww] * x + ldsf[32 + ww]; }
    { const float Ae = __shfl_up(Ai, 1), Be = __shfl_up(Bi, 1); if (lane > 0) x = Ae * x + Be; }
#pragma unroll
    for (int i = 0; i < KPT; ++i) { F[tid * KPT + i] = v[i] + off; LC[tid * KPT + i] = x > 0.f ? logf(x) : -1e30f; x = a[i] * x + 1.f; }
    __syncthreads();
}
__device__ __forceinline__ void phase_prep(const Params& p, int l, float* ldsf) {
    if ((int)blockIdx.x < NFOX) fcum_block(p, (int)blockIdx.x, ldsf);
    const int wave = p.wid;
    lds_u8* wl = (lds_u8*)ldsf + wave * RET_WAVE_LDS;
    for (int it = blockIdx.x * NW + wave; it < NRET * NCHUNK; it += gridDim.x * NW) ret_prep_item(p, it / NCHUNK, it % NCHUNK, wl);
}

constexpr int NQ32 = S / 32;
constexpr int MIX_WAVE_LDS = 32 * VROWB;
__device__ __forceinline__ void ret_scan_wave(const Params& p, int item) {
    const float* U = (const float*)(p.ws + WS_U);
    bf16_t* SP = (bf16_t*)(p.ws + WS_SP);
    const int e = item * 64 + lane_id();
    const int h = e >> 12, de = e & 4095;
    const float c = expf(ret_log_gamma(h) * (float)CH);
    float st = 0.f;
    const size_t base = (size_t)h * NCHUNK * 4096 + de;
#pragma unroll 1
    for (int n0 = 0; n0 < NCHUNK; n0 += 32) {
        float u[32];
#pragma unroll
        for (int i = 0; i < 32; ++i) u[i] = (n0 + i < NCHUNK) ? U[base + (size_t)(n0 + i) * 4096] : 0.f;
#pragma unroll
        for (int i = 0; i < 32; ++i) if (n0 + i < NCHUNK) { SP[base + (size_t)(n0 + i) * 4096] = f2bf(st); st = st * c + u[i]; }
    }
}
template <bool FOX>
__device__ __forceinline__ void attn_item(const Params& p, int l, int h, int qb, lds_u8* wl) {
    const bf16_t* P = (const bf16_t*)(p.ws + WS_PROJ);
    const float* Fh = (const float*)(p.ws + WS_FCUM) + (size_t)h * S;
    const float* LCh = (const float*)(p.ws + WS_LC) + (size_t)h * S;
    bf16_t* MG = (bf16_t*)(p.ws + WS_MERGED);
    const int lane = lane_id(), r32 = lane & 31, hi = lane >> 5;
    const int q0 = qb * 32, t = q0 + r32;
    constexpr int oq = FOX ? OQF : OQS, ok = FOX ? OKF : OKS, ov = FOX ? OVF : OVS;
    bf16x8 qf[4];
    { const bf16_t* qp = P + (size_t)t * PW + oq + h * HD + 8 * hi;
#pragma unroll
      for (int ks = 0; ks < 4; ++ks) qf[ks] = *(const bf16x8*)(qp + 16 * ks); }
    float Bt = 0.f;
    if (FOX) {
        float qq = 0.f;
#pragma unroll
        for (int ks = 0; ks < 4; ++ks)
#pragma unroll
            for (int j = 0; j < 8; ++j) { const float v = bf2f((bf16_t)qf[ks][j]); qq += v * v; }
        qq += __shfl_xor(qq, 32);
        const float kmax = sqrtf(u2f(((const unsigned*)(p.ws + WS_CTL))[CTL_KMAX + l * 8 + h]));
        Bt = sqrtf(qq) * kmax * 1.0001f + 1e-6f;
    }
    const float fq = FOX ? Fh[t] : 0.f;
    float m = -1e30f, lsum = 0.f, carry = 0.f;
    f32x16 o0, o1;
#pragma unroll
    for (int r = 0; r < 16; ++r) { o0[r] = 0.f; o1[r] = 0.f; }
    const lds_u8* vb = wl + (4 * hi + ((lane & 15) >> 2)) * VROWB + (16 * ((lane >> 4) & 1) + 4 * (lane & 3)) * 2;
    bf16x8 kf1[4], kf2[4]; u32x4 vr1[4], vr2[4];
#define ATTN_LOAD(KF, VR, kt_) do { const int k0_ = (kt_) * 32; const bf16_t* kp_ = P + (size_t)(k0_ + r32) * PW + ok + h * HD + 8 * hi; \
        _Pragma("unroll") for (int ks = 0; ks < 4; ++ks) KF[ks] = *(const bf16x8*)(kp_ + 16 * ks); \
        _Pragma("unroll") for (int i = 0; i < 4; ++i) { const int c = lane + 64 * i; VR[i] = *(const u32x4*)(P + (size_t)(k0_ + (c >> 3)) * PW + ov + h * HD + 8 * (c & 7)); } \
        } while (0)
    ATTN_LOAD(kf1, vr1, qb);
    ATTN_LOAD(kf2, vr2, qb > 0 ? qb - 1 : 0);
    for (int kt = qb; kt >= 0; --kt) {
        const int key0 = kt * 32;
        const bool diag = (kt == qb);
        bf16x8 kf[4]; u32x4 vr[4];
#pragma unroll
        for (int ks = 0; ks < 4; ++ks) { kf[ks] = kf1[ks]; kf1[ks] = kf2[ks]; }
#pragma unroll
        for (int i = 0; i < 4; ++i) { vr[i] = vr1[i]; vr1[i] = vr2[i]; }
        ATTN_LOAD(kf2, vr2, kt > 1 ? kt - 2 : 0);
        f32x4 fk[4]; float fkm1 = 0.f, lck = 0.f;
        if (FOX) {
#pragma unroll
            for (int g4 = 0; g4 < 4; ++g4) fk[g4] = *(const f32x4*)(Fh + key0 + 8 * g4 + 4 * hi);
            fkm1 = Fh[key0 > 0 ? key0 - 1 : 0]; lck = LCh[key0];
        }
        f32x16 st;
#pragma unroll
        for (int r = 0; r < 16; ++r) st[r] = 0.f;
#pragma unroll
        for (int ks = 0; ks < 4; ++ks) st = mfma32(kf[ks], qf[ks], st);
        wave_barrier();
#pragma unroll
        for (int i = 0; i < 4; ++i) { const int c = lane + 64 * i; *(LAS u32x4*)(wl + (c >> 3) * VROWB + (c & 7) * 16) = vr[i]; }
        if (FOX) {
            float tmax = -1e30f;
#pragma unroll
            for (int g4 = 0; g4 < 4; ++g4)
#pragma unroll
                for (int i = 0; i < 4; ++i) { const int r = 4 * g4 + i; st[r] = st[r] + (fq - fk[g4][i]); }
            if (diag) {
#pragma unroll
                for (int r = 0; r < 16; ++r) if (crow(r, hi) > r32) st[r] = -1e30f;
            }
#pragma unroll
            for (int r = 0; r < 16; ++r) tmax = fmaxf(tmax, st[r]);
            tmax = fmaxf(tmax, partner32(tmax, hi));
            const float mn = fmaxf(m, tmax), f = fast_exp(m - mn);
            m = mn; lsum *= f;
#pragma unroll
            for (int r = 0; r < 16; ++r) { o0[r] *= f; o1[r] *= f; }
            float ps = 0.f;
#pragma unroll
            for (int r = 0; r < 16; ++r) { const float pr = fast_exp(st[r] - mn); st[r] = pr; ps += pr; }
            lsum += ps;
        } else {
            float l1m[16];
#pragma unroll
            for (int r = 0; r < 16; ++r) {
                const float z = st[r], sp = fast_log(1.0f + fast_exp(-fabsf(z)));
                const float lb = fminf(z, 0.f) - sp;
                l1m[r] = lb - z;
                st[r] = lb;
            }
            if (diag) {
#pragma unroll
                for (int r = 0; r < 16; ++r) if (crow(r, hi) >= r32) { l1m[r] = 0.f; st[r] = -1e30f; }
            }
            float gs[4], pg[4], T[4];
#pragma unroll
            for (int k = 0; k < 4; ++k) { gs[k] = (l1m[4 * k] + l1m[4 * k + 1]) + (l1m[4 * k + 2] + l1m[4 * k + 3]); pg[k] = partner32(gs[k], hi); }
            float run = 0.f;
#pragma unroll
            for (int k = 3; k >= 0; --k) { T[k] = run + (hi == 0 ? pg[k] : 0.f); run += gs[k] + pg[k]; }
#pragma unroll
            for (int k = 0; k < 4; ++k) {
                float w = T[k] + carry;
#pragma unroll
                for (int i = 3; i >= 0; --i) { const int r = 4 * k + i; st[r] = fast_exp(st[r] + w); w += l1m[r]; }
            }
            carry += run;
        }
        u32x4 pw0, pw1;
#pragma unroll
        for (int j = 0; j < 4; ++j) { pw0[j] = pk2(st[2 * j], st[2 * j + 1]); pw1[j] = pk2(st[8 + 2 * j], st[9 + 2 * j]); }
        const bf16x8 pf0 = __builtin_bit_cast(bf16x8, pw0), pf1 = __builtin_bit_cast(bf16x8, pw1);
        wave_barrier();
#pragma unroll
        for (int s = 0; s < 2; ++s) {
#pragma unroll
            for (int db = 0; db < 2; ++db) {
                const s16x4 lo = tr16(vb + (16 * s) * VROWB + db * 64), hi4 = tr16(vb + (16 * s + 8) * VROWB + db * 64);
                bf16x8 vf; vf[0] = lo[0]; vf[1] = lo[1]; vf[2] = lo[2]; vf[3] = lo[3]; vf[4] = hi4[0]; vf[5] = hi4[1]; vf[6] = hi4[2]; vf[7] = hi4[3];
                if (db == 0) o0 = mfma32(vf, s == 0 ? pf0 : pf1, o0); else o1 = mfma32(vf, s == 0 ? pf0 : pf1, o1);
            }
        }
        const bool done = FOX ? (Bt + (fq - fkm1) - m + (lck * 1.00001f + 1e-4f) < -EXIT_T) : (carry < -EXIT_T);
        if (ballot64(done) == ~0ull) break;
    }
#undef ATTN_LOAD
    if (FOX) { lsum += __shfl_xor(lsum, 32); const float il = 1.0f / lsum;
#pragma unroll
        for (int r = 0; r < 16; ++r) { o0[r] *= il; o1[r] *= il; } }
    float ss = 0.f;
#pragma unroll
    for (int r = 0; r < 16; ++r) ss += o0[r] * o0[r] + o1[r] * o1[r];
    ss += __shfl_xor(ss, 32);
    const float ri = 1.0f / sqrtf(ss * (1.0f / HD) + EPS);
    const float* g = (FOX ? p.g_fox + l * WFOX : p.g_sb + l * WSB) + h * HD;
    bf16_t* dst = MG + (size_t)t * MIXW + (FOX ? WRET + WSB : WRET) + h * HD;
#pragma unroll
    for (int db = 0; db < 2; ++db)
#pragma unroll
        for (int g4 = 0; g4 < 4; ++g4) {
            const int d0 = db * 32 + 8 * g4 + 4 * hi;
            const f32x4 gg = *(const f32x4*)(g + d0);
            float v[4];
#pragma unroll
            for (int i = 0; i < 4; ++i) v[i] = (db == 0 ? o0[4 * g4 + i] : o1[4 * g4 + i]) * ri * gg[i];
            u32x2 o; o[0] = pk2(v[0], v[1]); o[1] = pk2(v[2], v[3]);
            *(u32x2*)(dst + d0) = o;
        }
}
constexpr int WCH = 2, NWCH = (NE * WI_EXPERT + WCH - 1) / WCH;
__device__ __forceinline__ bool mix_weight_step(const Params& p, int l, lds_u8* wl, int shard0, int& wsk) {
    unsigned* wbase = (unsigned*)(p.ws + WS_CTL) + CTL_WQ + 64 * (l * 8);
    const int lane = lane_id();
#pragma unroll 1
    while (wsk < 8) {
        const int shard = (shard0 + wsk) & 7;
        unsigned* head = wbase + 64 * shard;
        unsigned c = 0x0fffffffu;
        if (lane == 0) { if (!(wsk > 0 && (int)ld_relaxed(head) * 8 + shard >= NWCH)) c = atomicAdd(head, 1u); }
        const int chunk = uni((int)__shfl(c, 0)) * 8 + shard;
        if (chunk >= NWCH) { ++wsk; continue; }
        static_assert(WCH == 2 && (NE * WI_EXPERT) % 2 == 0, "two tiles per dequeue");
        weight_item2(p, l, WI_DENSE + chunk * 2, WI_DENSE + chunk * 2 + 1, wl, lane);
        return true;
    }
    return false;
}
__device__ __forceinline__ void phase_mix(const Params& p, int l, float* ldsf) {
    constexpr int NSCANW = NRET * 4096 / 64, NFXI = NFOX * NQ32, NSBI = NSB * NQ32;
    const int wave = p.wid;
    lds_u8* wl = (lds_u8*)ldsf + wave * RET_WAVE_LDS;
    static_assert(MIX_WAVE_LDS <= RET_WAVE_LDS, "per-wave LDS region");
    const int shard0 = xcc_shard();
    int wsk = 0;
    unsigned* qbase = (unsigned*)(p.ws + WS_CTL) + CTL_MQ + 64 * (l * 8);
    const float* bfg = p.b_forget + l * NFOX;
    constexpr int NMIX = NSCANW + NFXI + NSBI;
#pragma unroll 1
    for (int sk = 0; sk < 8; ++sk) {
      const int shard = (shard0 + sk) & 7;
      unsigned* qhead = qbase + 64 * shard;
#pragma unroll 1
      for (;;) {
        unsigned itu = 0;
        if (lane_id() == 0) { if (sk > 0 && (int)ld_relaxed(qhead) * 8 + shard >= NMIX) itu = 0x0fffffffu; else itu = atomicAdd(qhead, 1u); }
        const int it = uni((int)__shfl(itu, 0)) * 8 + shard;
        if (it >= NMIX) break;
        if (it < NSCANW) ret_scan_wave(p, it);
        else if (it < NSCANW + NFXI) {
            const int j = it - NSCANW, rank = j / NQ32;
            int h = 0;
#pragma unroll
            for (int c = 0; c < NFOX; ++c) { int rk = 0;
#pragma unroll
                for (int o = 0; o < NFOX; ++o) rk += (bfg[o] > bfg[c] || (bfg[o] == bfg[c] && o < c)) ? 1 : 0;
                if (rk == rank) h = c; }
            attn_item<true>(p, l, h, NQ32 - 1 - j % NQ32, wl);
        }
        else { const int j = it - NSCANW - NFXI; attn_item<false>(p, l, j % NSB, NQ32 - 1 - j / NSB, wl); }
        (void)mix_weight_step(p, l, wl, shard0, wsk);
      }
    }
    while (mix_weight_step(p, l, wl, shard0, wsk)) {}
}

__device__ __forceinline__ void ret_out_item(const Params& p, int l, int h, int n, int cb, lds_u8* wl) {
    const bf16_t* P = (const bf16_t*)(p.ws + WS_PROJ);
    const bf16_t* SPT = (const bf16_t*)(p.ws + WS_SP) + (size_t)(h * NCHUNK + n) * 4096;
    bf16_t* MG = (bf16_t*)(p.ws + WS_MERGED);
    const int lane = lane_id(), r32 = lane & 31, hi = lane >> 5;
    const float lg = ret_log_gamma(h);
    const size_t rowb = (size_t)(n * CH) * PW + h * HD;
    const int c = 32 * cb + r32;
    wave_barrier();
    {
        u32x4 vv[8];
#pragma unroll
        for (int i = 0; i < 8; ++i) { const int q = lane + 64 * i; vv[i] = *(const u32x4*)(P + rowb + (size_t)(q >> 3) * PW + OVR + 8 * (q & 7)); }
#pragma unroll
        for (int i = 0; i < 8; ++i) { const int q = lane + 64 * i; *(LAS u32x4*)(wl + (q >> 3) * VROWB + (q & 7) * 16) = vv[i]; }
    }
    sched_fence();
    bf16x8 qf[4];
#pragma unroll
    for (int ks = 0; ks < 4; ++ks) qf[ks] = *(const bf16x8*)(P + rowb + (size_t)c * PW + OQR + 16 * ks + 8 * hi);
    f32x16 o[2];
#pragma unroll
    for (int a = 0; a < 2; ++a)
#pragma unroll
        for (int r = 0; r < 16; ++r) o[a][r] = 0.f;
#pragma unroll
    for (int ks = 0; ks < 4; ++ks)
#pragma unroll
        for (int eb = 0; eb < 2; ++eb) { const bf16x8 sf = *(const bf16x8*)(SPT + (32 * eb + r32) * 64 + 16 * ks + 8 * hi); o[eb] = mfma32(sf, qf[ks], o[eb]); }
    { const float qd = fast_exp(lg * (float)(c + 1));
#pragma unroll
      for (int eb = 0; eb < 2; ++eb)
#pragma unroll
          for (int r = 0; r < 16; ++r) o[eb][r] *= qd; }
    wave_barrier();
    const lds_u8* vb = wl + (4 * hi + ((lane & 15) >> 2)) * VROWB + (16 * ((lane >> 4) & 1) + 4 * (lane & 3)) * 2;
#pragma unroll
    for (int kb = 0; kb < 2; ++kb) {
        f32x16 st;
#pragma unroll
        for (int r = 0; r < 16; ++r) st[r] = 0.f;
#pragma unroll
        for (int ks = 0; ks < 4; ++ks) { const bf16x8 kf = *(const bf16x8*)(P + rowb + (size_t)(32 * kb + r32) * PW + OKR + 16 * ks + 8 * hi); st = mfma32(kf, qf[ks], st); }
        bf16x8 pf[2];
#pragma unroll
        for (int r = 0; r < 16; ++r) { const int dist = c - (32 * kb + crow(r, hi)); st[r] *= fast_exp(lg * fabsf((float)dist)); }
        { u32x4 w0, w1;
#pragma unroll
          for (int j = 0; j < 4; ++j) { w0[j] = pk2(st[2 * j], st[2 * j + 1]); w1[j] = pk2(st[8 + 2 * j], st[9 + 2 * j]); }
          pf[0] = __builtin_bit_cast(bf16x8, w0); pf[1] = __builtin_bit_cast(bf16x8, w1); }
#pragma unroll
        for (int s = 0; s < 2; ++s)
#pragma unroll
            for (int eb = 0; eb < 2; ++eb) o[eb] = mfma32(tr_frag(vb, 32 * kb + 16 * s, 32 * kb + 16 * s + 8, eb * 64), pf[s], o[eb]);
    }
    float sm = 0.f;
#pragma unroll
    for (int eb = 0; eb < 2; ++eb)
#pragma unroll
        for (int r = 0; r < 16; ++r) sm += o[eb][r];
    sm += __shfl_xor(sm, 32);
    const float mu = sm * (1.0f / HD);
    float vs = 0.f;
#pragma unroll
    for (int eb = 0; eb < 2; ++eb)
#pragma unroll
        for (int r = 0; r < 16; ++r) { const float dlt = o[eb][r] - mu; o[eb][r] = dlt; vs += dlt * dlt; }
    vs += __shfl_xor(vs, 32);
    const float ri = 1.0f / sqrtf(vs * (1.0f / HD) + EPS);
    const int row = n * CH + c;
#pragma unroll
    for (int eb = 0; eb < 2; ++eb)
#pragma unroll
        for (int g4 = 0; g4 < 4; ++g4) {
            const int e0 = 32 * eb + 8 * g4 + 4 * hi;
            const f32x4 gg = *(const f32x4*)(p.g_ret + l * WRET + h * HD + e0);
            const u32x2 gt = *(const u32x2*)(P + (size_t)row * PW + OGR + h * HD + e0);
            const float ga[4] = {u2f(gt[0] << 16), u2f(gt[0] & 0xffff0000u), u2f(gt[1] << 16), u2f(gt[1] & 0xffff0000u)};
            float v[4];
#pragma unroll
            for (int i = 0; i < 4; ++i) v[i] = o[eb][4 * g4 + i] * ri * gg[i] * ga[i];
            u32x2 ov; ov[0] = pk2(v[0], v[1]); ov[1] = pk2(v[2], v[3]);
            *(u32x2*)(MG + (size_t)row * MIXW + h * HD + e0) = ov;
        }
}
__device__ __forceinline__ void phase_retout(const Params& p, int l, float* ldsf) {
    const int wave = p.wid;
    lds_u8* wl = (lds_u8*)ldsf + wave * RET_WAVE_LDS;
    for (int it = blockIdx.x * NW + wave; it < NRET * NCHUNK * 2; it += gridDim.x * NW) ret_out_item(p, l, (it >> 1) / NCHUNK, (it >> 1) % NCHUNK, it & 1, wl);
}

struct OutprojSched {
    static constexpr bool GATHER = false;
    int wid;
    unsigned ao[4]; int vcu, G;
    static constexpr int NPM = S / GBM, NPN = D / GBM;
    __device__ __forceinline__ bool next(int i, GUnit& u) const {
        const int L = uni(i * G + vcu); if (L >= NPM * NPN) return false;
        const int pm = L / NPN, pn = L % NPN;
        u.A = (unsigned)(pm * GBM * MIXW * 2); u.B = (unsigned)(pn * GBM * MIXW * 2); u.ao[0] = u.ao[1] = u.ao[2] = u.ao[3] = 0u;
        u.i0 = pm; u.i1 = pn; u.i2 = 0; u.i3 = 0; return true;
    }
};
struct OutprojEpi {
    const float* xin32; const bf16_t* xin16; bf16_t* X;
    __device__ __forceinline__ void operator()(f32x4 (&acc)[2][2][4][2], const GUnit& u, int wr, int wc, int fr, int fq) const {
        const size_t o0 = (size_t)(u.i0 * GBM + wr * 64 + fr) * D + u.i1 * GBM + wc * 32 + 8 * fq;
#pragma unroll
        for (int ai = 0; ai < 2; ++ai)
#pragma unroll
            for (int mh = 0; mh < 2; ++mh) {
                f32x4 r[2][2][2];
#pragma unroll
                for (int mm = 0; mm < 2; ++mm)
#pragma unroll
                    for (int bj = 0; bj < 2; ++bj) { const size_t o = o0 + (size_t)(ai * 128 + (2 * mh + mm) * 16) * D + bj * 128;
                        if (xin32) { r[mm][bj][0] = *(const f32x4*)(xin32 + o); r[mm][bj][1] = *(const f32x4*)(xin32 + o + 4); }
                        else { const u32x4 w = *(const u32x4*)(xin16 + o);
                            r[mm][bj][0] = (f32x4){u2f(w[0] << 16), u2f(w[0] & 0xffff0000u), u2f(w[1] << 16), u2f(w[1] & 0xffff0000u)};
                            r[mm][bj][1] = (f32x4){u2f(w[2] << 16), u2f(w[2] & 0xffff0000u), u2f(w[3] << 16), u2f(w[3] & 0xffff0000u)}; } }
#pragma unroll
                for (int mm = 0; mm < 2; ++mm)
#pragma unroll
                    for (int bj = 0; bj < 2; ++bj) { u32x4 ov;
#pragma unroll
                        for (int n = 0; n < 2; ++n) { const f32x4 v = r[mm][bj][n] + acc[ai][bj][2 * mh + mm][n]; ov[2 * n] = pk2(v[0], v[1]); ov[2 * n + 1] = pk2(v[2], v[3]); }
                        *(u32x4*)(X + o0 + (size_t)(ai * 128 + (2 * mh + mm) * 16) * D + bj * 128) = ov; }
                sched_fence();
            }
    }
};
__device__ __forceinline__ void phase_outproj(const Params& p, int l, float* ldsf) {
    OutprojSched S; S.wid = p.wid; plain_ao(S.ao, MIXW, TIDX(p)); S.vcu = vcu_id(); S.G = gridDim.x;
    OutprojEpi E; E.X = (bf16_t*)(p.ws + WS_X); E.xin32 = l == 0 ? p.x : nullptr; E.xin16 = E.X;
    gemm_stream((lds_u8*)ldsf, (const char*)(p.ws + WS_MERGED), (const char*)(p.ws + WS_WOUT) + (size_t)l * D * MIXW * 2, MIXW, S, E);
}

constexpr int RW = D + 4;
constexpr int ROUTE_LDS = NROUTE * RW * 4 + 2 * NE * 4 + 2 * 256 * 4;
__device__ __forceinline__ void phase_route(const Params& p, int l, float* lds) {
    const bf16_t* X = (const bf16_t*)(p.ws + WS_X);
    bf16_t* H = (bf16_t*)(p.ws + WS_H);
    unsigned* ctl = (unsigned*)(p.ws + WS_CTL);
    int* LIST = (int*)(p.ws + WS_LIST);
    float* GATE = (float*)(p.ws + WS_GATE);
    const float* gn = p.norm_ffn + l * D;
    const float* wg = p.w_group + (size_t)l * D * NG; const float* wr = p.w_router + (size_t)l * D * NE;
    const float* bg = p.b_group + l * NG; const float* br = p.b_router + l * NE;
    const int lane = lane_id(), wave = p.wid;
    const int tidx = TIDX(p);
    unsigned* lcnt = (unsigned*)(lds + NROUTE * RW); unsigned* lbase = lcnt + NE; unsigned* lrec = lbase + NE;
    __syncthreads();
    if (tidx < NE) lcnt[tidx] = 0u;
    {
        constexpr int NV4 = D * NE / 4 / NT;
        f32x4 t[NV4];
#pragma unroll
        for (int k = 0; k < NV4; ++k) t[k] = *(const f32x4*)(wr + (size_t)(tidx + k * NT) * 4);
        for (int i = tidx; i < D * NG; i += NT) lds[(i % NG) * RW + i / NG] = wg[i];
#pragma unroll
        for (int k = 0; k < NV4; ++k) { const int i = (tidx + k * NT) * 4, c = i / NE, e = i % NE;
#pragma unroll
            for (int j = 0; j < 4; ++j) lds[(NG + e + j) * RW + c] = t[k][j]; }
    }
    __syncthreads();
    f32x4 vn[RJ]; { const int r0 = blockIdx.x * NW + wave; if (r0 < S) row_load_bf16(X + (size_t)r0 * D, vn, lane); }
    for (int r = blockIdx.x * NW + wave; r < S; r += gridDim.x * NW) {
        f32x4 v[RJ];
#pragma unroll
        for (int j = 0; j < RJ; ++j) v[j] = vn[j];
        { const int rn = r + gridDim.x * NW; if (rn < S) row_load_bf16(X + (size_t)rn * D, vn, lane); }
        const float ri = row_rinv(v);
#pragma unroll
        for (int j = 0; j < RJ; ++j) {
            const f32x4 g = *(const f32x4*)(gn + 256 * j + lane * 4);
            v[j] = v[j] * ri * g;
            u32x2 o; o[0] = pk2(v[j][0], v[j][1]); o[1] = pk2(v[j][2], v[j][3]);
            *(u32x2*)(H + (size_t)r * D + 256 * j + lane * 4) = o;
        }
        float gl[NG];
#pragma unroll
        for (int g = 0; g < NG; ++g) { float s = 0.f;
#pragma unroll
            for (int j = 0; j < RJ; ++j) { const f32x4 w = *(const f32x4*)(lds + g * RW + 256 * j + lane * 4); s += (v[j][0] * w[0] + v[j][1] * w[1]) + (v[j][2] * w[2] + v[j][3] * w[3]); }
            gl[g] = s; }
#pragma unroll
        for (int g = 0; g < NG; ++g) gl[g] = wave_sum(gl[g]) + bg[g];
        int grp = 0; float gm = gl[0];
#pragma unroll
        for (int g = 1; g < NG; ++g) if (gl[g] > gm) { gm = gl[g]; grp = g; }
        float den = 0.f;
#pragma unroll
        for (int g = 0; g < NG; ++g) den += fast_exp(gl[g] - gm);
        const float pg = 1.0f / den;
        float el[EPG];
        const float* wl = lds + (NG + grp * EPG) * RW + lane * 4;
#pragma unroll
        for (int e = 0; e < EPG; ++e) { float s = 0.f;
#pragma unroll
            for (int j = 0; j < RJ; ++j) { const f32x4 w = *(const f32x4*)(wl + e * RW + 256 * j); s += (v[j][0] * w[0] + v[j][1] * w[1]) + (v[j][2] * w[2] + v[j][3] * w[3]); }
            el[e] = s; }
#pragma unroll
        for (int e = 0; e < EPG; ++e) el[e] = wave_sum(el[e]) + br[grp * EPG + e];
        if (lane == 0) {
            int i1 = 0; float v1 = -INFINITY; int i2 = 0; float v2 = -INFINITY;
#pragma unroll
            for (int e = 0; e < EPG; ++e) { const float x = el[e];
                if (x > v1) { v2 = v1; i2 = i1; v1 = x; i1 = e; } else if (x > v2) { v2 = x; i2 = e; } }
            const float e2 = fast_exp(v2 - v1), g1 = pg / (1.f + e2), g2 = pg * e2 / (1.f + e2);
            const int ea = grp * EPG + i1, eb = grp * EPG + i2;
            GATE[(size_t)r * 2] = g1; GATE[(size_t)r * 2 + 1] = g2;
            const int li = (r - blockIdx.x * NW) / (gridDim.x * NW) * NW + wave;
            const unsigned ra = atomicAdd(lcnt + ea, 1u), rb = atomicAdd(lcnt + eb, 1u);
            lrec[2 * li] = (unsigned)ea | (ra << 8); lrec[2 * li + 1] = (unsigned)eb | (rb << 8);
        }
    }
    {
        __syncthreads();
        if (tidx < NE) lbase[tidx] = atomicAdd(ctl + CTL_CNT + l * NE + tidx, lcnt[tidx]);
        __syncthreads();
        const int nrows = (S - blockIdx.x * NW + gridDim.x * NW - 1) / (gridDim.x * NW) * NW;
        for (int i = tidx; i < 2 * nrows; i += NT) {
            const int li = i >> 1, r = blockIdx.x * NW + (li / NW) * (gridDim.x * NW) + (li % NW);
            if (r < S) { const unsigned rec = lrec[i]; const int e = rec & 255u; LIST[(size_t)e * S + lbase[e] + (rec >> 8)] = r * 2 + (i & 1); }
        }
    }
}

__device__ __forceinline__ void moe_table(const unsigned* cnt, volatile LAS unsigned* tab, int tid) {
    __syncthreads();
    if (tid < 64) {
        const unsigned c = tid < NE ? cnt[tid] : 0u;
        unsigned nt = (c + GBM - 1) / GBM, inc = nt;
#pragma unroll
        for (int d = 1; d < 64; d <<= 1) { const unsigned o = (unsigned)__shfl_up((int)inc, d); if ((tid & 63) >= d) inc += o; }
        if (tid < NE) { tab[tid + 1] = inc; tab[64 + tid] = c; }
        if (tid == 0) tab[0] = 0u;
    }
    __syncthreads();
}
__device__ __forceinline__ bool moe_unit(volatile LAS unsigned* tab, int u, int npn, int& e, int& rt, int& pn, int& base, int& count) {
    const int tile = uni(u / npn); pn = uni(u % npn);
    if (tile >= (int)tab[NE]) return false;
    int lo = 0;
#pragma unroll
    for (int s = NE / 2; s >= 1; s >>= 1) if ((int)tab[lo + s] <= tile) lo += s;
    e = uni(lo); rt = tile - (int)tab[e]; base = (int)tab[e] * GBM; count = (int)tab[64 + e];
    rt = uni(rt); base = uni(base); count = uni(count);
    return true;
}
struct Moe1Sched {
    static constexpr bool GATHER = true;
    int wid;
    unsigned ao[4];
    volatile LAS unsigned* tab; const int* LIST; int vcu, G;
    static constexpr int NPN = 2 * DE / GBM;
    __device__ __forceinline__ bool next(int i, GUnit& u) const {
        int e, rt, pn, base, count; if (!moe_unit(tab, i * G + vcu, NPN, e, rt, pn, base, count)) return false;
        const int nvalid = count - rt * GBM;
        u.A = 0u; u.B = (unsigned)((e * 2 * DE + pn * GBM) * D * 2);
#pragma unroll
        for (int k = 0; k < 4; ++k) { int R, C; stage_rc(((wid << 6) | lane_id()) * 16 + (k & 1) * 8192, R, C); const int r = R + 128 * (k >> 1);
            const int tok = r < nvalid ? (LIST[(size_t)e * S + rt * GBM + r] >> 1) : 0; u.ao[k] = (unsigned)((tok * D + C) * 2); }
        u.i0 = base + rt * GBM; u.i1 = pn; u.i2 = nvalid; u.i3 = e * S + rt * GBM; return true;
    }
};
struct Moe1Epi {
    bf16_t* HID;
    __device__ __forceinline__ void operator()(f32x4 (&acc)[2][2][4][2], const GUnit& u, int wr, int wc, int fr, int fq) const {
#pragma unroll
        for (int ai = 0; ai < 2; ++ai)
#pragma unroll
            for (int m = 0; m < 4; ++m)
{ u32x4 o;
#pragma unroll
                for (int n = 0; n < 2; ++n) { f32x4 v;
#pragma unroll
                    for (int j = 0; j < 4; ++j) v[j] = silu(acc[ai][0][m][n][j]) * acc[ai][1][m][n][j];
                    o[2 * n] = pk2(v[0], v[1]); o[2 * n + 1] = pk2(v[2], v[3]); }
                *(u32x4*)(HID + (size_t)(u.i0 + ai * 128 + wr * 64 + m * 16 + fr) * DE + u.i1 * 128 + wc * 32 + 8 * fq) = o; }
    }
};
__device__ __forceinline__ void phase_moe1(const Params& p, int l, float* ldsf) {
    Moe1Sched S; S.wid = p.wid; S.tab = (volatile LAS unsigned*)((LAS unsigned char*)ldsf + GEMM_LDS);
    moe_table((const unsigned*)(p.ws + WS_CTL) + CTL_CNT + l * NE, S.tab, TIDX(p));
    S.LIST = (const int*)(p.ws + WS_LIST); S.vcu = vcu_id(); S.G = gridDim.x;
    Moe1Epi E; E.HID = (bf16_t*)(p.ws + WS_HID);
    gemm_stream((lds_u8*)ldsf, (const char*)(p.ws + WS_H), (const char*)(p.ws + WS_WGU) + (size_t)l * NE * 2 * DE * D * 2, D, S, E);
}
struct Moe2Sched {
    static constexpr bool GATHER = false;
    int wid;
    volatile LAS unsigned* tab; unsigned ao[4]; int vcu, G;
    static constexpr int NPN = D / GBM;
    __device__ __forceinline__ bool next(int i, GUnit& u) const {
        int e, rt, pn, base, count; if (!moe_unit(tab, i * G + vcu, NPN, e, rt, pn, base, count)) return false;
        u.A = (unsigned)((base + rt * GBM) * DE * 2); u.B = (unsigned)((e * D + pn * GBM) * DE * 2); u.ao[0] = u.ao[1] = u.ao[2] = u.ao[3] = 0u;
        u.i0 = 0; u.i1 = pn; u.i2 = count - rt * GBM; u.i3 = e * S + rt * GBM; return true;
    }
};
struct Moe2Epi {
    bf16_t* Y; const int* LIST; const float* GATE;
    __device__ __forceinline__ void operator()(f32x4 (&acc)[2][2][4][2], const GUnit& u, int wr, int wc, int fr, int fq) const {
        int a[2][4]; float g[2][4];
#pragma unroll
        for (int ai = 0; ai < 2; ++ai)
#pragma unroll
            for (int m = 0; m < 4; ++m) { const int r = ai * 128 + wr * 64 + m * 16 + fr; a[ai][m] = r < u.i2 ? LIST[(size_t)u.i3 + r] : -1; }
#pragma unroll
        for (int ai = 0; ai < 2; ++ai)
#pragma unroll
            for (int m = 0; m < 4; ++m) g[ai][m] = a[ai][m] >= 0 ? GATE[a[ai][m]] : 0.f;
#pragma unroll
        for (int ai = 0; ai < 2; ++ai)
#pragma unroll
            for (int m = 0; m < 4; ++m) {
                if (a[ai][m] >= 0) {
#pragma unroll
                    for (int bj = 0; bj < 2; ++bj) { u32x4 o;
#pragma unroll
                        for (int n = 0; n < 2; ++n) { const f32x4 v = acc[ai][bj][m][n] * g[ai][m]; o[2 * n] = pk2(v[0], v[1]); o[2 * n + 1] = pk2(v[2], v[3]); }
                        *(u32x4*)(Y + (size_t)a[ai][m] * D + u.i1 * GBM + bj * 128 + wc * 32 + 8 * fq) = o; }
                }
            }
    }
};
__device__ __forceinline__ void phase_moe2(const Params& p, int l, float* ldsf) {
    Moe2Sched S; S.wid = p.wid; S.tab = (volatile LAS unsigned*)((LAS unsigned char*)ldsf + GEMM_LDS);
    moe_table((const unsigned*)(p.ws + WS_CTL) + CTL_CNT + l * NE, S.tab, TIDX(p));
    plain_ao(S.ao, DE, TIDX(p)); S.vcu = vcu_id(); S.G = gridDim.x;
    Moe2Epi E; E.Y = (bf16_t*)(p.ws + WS_Y); E.LIST = (const int*)(p.ws + WS_LIST); E.GATE = (const float*)(p.ws + WS_GATE);
    gemm_stream((lds_u8*)ldsf, (const char*)(p.ws + WS_HID), (const char*)(p.ws + WS_WDN) + (size_t)l * NE * D * DE * 2, DE, S, E);
}

__device__ __forceinline__ void phase_combine(const Params& p, int l) {
    bf16_t* X = (bf16_t*)(p.ws + WS_X);
    const bf16_t* Y = (const bf16_t*)(p.ws + WS_Y);
    bf16_t* H = (bf16_t*)(p.ws + WS_H);
    const bool last = (l == DEPTH - 1);
    const float* gn = last ? p.norm_final : p.norm_mix + (l + 1) * D;
    const int lane = lane_id(), wave = p.wid;
    for (int r = blockIdx.x * NW + wave; r < S; r += gridDim.x * NW) {
        f32x4 v[RJ]; row_load_bf16(X + (size_t)r * D, v, lane);
#pragma unroll
        for (int j = 0; j < RJ; ++j) {
            const u32x2 a = *(const u32x2*)(Y + (size_t)(2 * r) * D + 256 * j + lane * 4), b = *(const u32x2*)(Y + (size_t)(2 * r + 1) * D + 256 * j + lane * 4);
            v[j][0] += u2f(a[0] << 16) + u2f(b[0] << 16); v[j][1] += u2f(a[0] & 0xffff0000u) + u2f(b[0] & 0xffff0000u);
            v[j][2] += u2f(a[1] << 16) + u2f(b[1] << 16); v[j][3] += u2f(a[1] & 0xffff0000u) + u2f(b[1] & 0xffff0000u);
        }
        const float ri = row_rinv(v);
#pragma unroll
        for (int j = 0; j < RJ; ++j) {
            const f32x4 g = *(const f32x4*)(gn + 256 * j + lane * 4);
            if (last) *(f32x4*)(p.out + (size_t)r * D + 256 * j + lane * 4) = v[j] * ri * g;
            else {
                { u32x2 xo; xo[0] = pk2(v[j][0], v[j][1]); xo[1] = pk2(v[j][2], v[j][3]); *(u32x2*)(X + (size_t)r * D + 256 * j + lane * 4) = xo; }
                u32x2 o; o[0] = pk2(v[j][0] * ri * g[0], v[j][1] * ri * g[1]); o[1] = pk2(v[j][2] * ri * g[2], v[j][3] * ri * g[3]);
                *(u32x2*)(H + (size_t)r * D + 256 * j + lane * 4) = o;
            }
        }
    }
}

constexpr int PH_PER_LAYER = 9, NPHASE = 1 + DEPTH * PH_PER_LAYER;
constexpr int imax_c(int a, int b) { return a > b ? a : b; }
constexpr int LDS_MAIN = imax_c(imax_c(GEMM_LDS + 1024, ROUTE_LDS), imax_c(NW * RET_WAVE_LDS, NW * MIX_WAVE_LDS));
constexpr int LDS_MISC = (LDS_MAIN + 255) / 256 * 256;
constexpr int LDS_BYTES = LDS_MISC + 256;

__device__ __forceinline__ void run_phase(const Params& p, int ph, float* lds) {
    if (ph == 0) { phase_init(p, lds); return; }
    const int l = (ph - 1) / PH_PER_LAYER, q = (ph - 1) % PH_PER_LAYER;
    switch (q) {
        case 0: phase_inproj(p, l, lds); break;
        case 1: phase_prep(p, l, lds); break;
        case 2: phase_mix(p, l, lds); break;
        case 3: phase_retout(p, l, lds); break;
        case 4: phase_outproj(p, l, lds); break;
        case 5: phase_route(p, l, lds); break;
        case 6: phase_moe1(p, l, lds); break;
        case 7: phase_moe2(p, l, lds); break;
        default: phase_combine(p, l); break;
    }
}

#ifndef CPU_EMU
#define XB_TMO      128
#define XB_XCNT(j)  (256  + 64 * (j))
#define XB_XSUB(j)  (1280 + 64 * (j))
#define XB_XGEN(j)  (2304 + 64 * (j))
#define XB_TOP      3328
#define XB_TOPGEN   3392
#define XCD_BAR_WORDS 3456
#define XB_SPIN_CAP (1u << 22)
__device__ __forceinline__ unsigned xb_ld(unsigned* p)              { return __hip_atomic_load(p, __ATOMIC_RELAXED, __HIP_MEMORY_SCOPE_AGENT); }
__device__ __forceinline__ unsigned xb_add(unsigned* p, unsigned v) { return __hip_atomic_fetch_add(p, v, __ATOMIC_RELAXED, __HIP_MEMORY_SCOPE_AGENT); }
__device__ __forceinline__ unsigned xb_xcc_id() { return (unsigned)__builtin_amdgcn_s_getreg((3 << 11) | 20) & 0xFu; }
#define XB_SPIN(cond, bar) do { unsigned _sp = 0; while (cond) { __builtin_amdgcn_s_sleep(1); \
    if ((++_sp & 255u) == 0u) { if (xb_ld(&(bar)[XB_TMO])) break; if (_sp > XB_SPIN_CAP) { atomicAdd(&(bar)[XB_TMO], 1u); break; } } } } while (0)
struct XcdBarrier { unsigned* bar; unsigned x; volatile LAS unsigned* st; };
__device__ __forceinline__ XcdBarrier xcd_barrier_post(unsigned* bar, volatile LAS unsigned* st, bool t0) {
    XcdBarrier b; b.bar = bar; b.x = xb_xcc_id(); b.st = st;
    if (t0) (void)xb_add(&bar[XB_XCNT(b.x)], 1u);
    return b;
}
__device__ __forceinline__ void xcd_barrier_complete(unsigned* bar, unsigned x, unsigned& nloc, unsigned& nx) {
    const unsigned G = gridDim.x * gridDim.y * gridDim.z;
    unsigned sum, cnt, mine, sp = 0u;
    for (;;) {
        sum = 0u; cnt = 0u; mine = 0u;
#pragma unroll
        for (unsigned j = 0; j < 16; ++j) { const unsigned c = xb_ld(&bar[XB_XCNT(j)]); sum += c; cnt += (c > 0u) ? 1u : 0u; mine = (j == x) ? c : mine; }
        if (sum == G) break;
        __builtin_amdgcn_s_sleep(1);
        if ((++sp & 255u) == 0u) { if (xb_ld(&bar[XB_TMO])) break; if (sp > XB_SPIN_CAP) { atomicAdd(&bar[XB_TMO], 1u); break; } }
    }
    nloc = mine > 0u ? mine : 1u; nx = cnt > 0u ? cnt : 1u;
}
__device__ __forceinline__ void xcd_barrier(const XcdBarrier& b, bool t0) {
    asm volatile("s_waitcnt vmcnt(0)" ::: "memory");
    __syncthreads();
    if (t0) {
        unsigned* bar = b.bar;
        __builtin_amdgcn_s_waitcnt(0);
        unsigned nloc = b.st[0], nx = b.st[1];
        if (nloc == 0u) { xcd_barrier_complete(bar, b.x, nloc, nx); b.st[0] = nloc; b.st[1] = nx; }
        const unsigned old = xb_add(&bar[XB_XSUB(b.x)], 1u);
        const unsigned gen = old / nloc;
        if (old + 1u == (gen + 1u) * nloc) {
            __builtin_amdgcn_fence(__ATOMIC_RELEASE, "agent");
            asm volatile("s_waitcnt vmcnt(0)" ::: "memory");
            const unsigned og = xb_add(&bar[XB_TOP], 1u);
            const unsigned tg = og / nx;
            if (og + 1u == (tg + 1u) * nx) xb_add(&bar[XB_TOPGEN], 1u);
            else XB_SPIN(xb_ld(&bar[XB_TOPGEN]) == tg, bar);
            __builtin_amdgcn_fence(__ATOMIC_ACQUIRE, "agent");
            xb_add(&bar[XB_XGEN(b.x)], 1u);
            asm volatile("s_waitcnt vmcnt(0)" ::: "memory");
        } else {
            XB_SPIN(xb_ld(&bar[XB_XGEN(b.x)]) == gen, bar);
            __builtin_amdgcn_fence(__ATOMIC_ACQUIRE, "agent");
            asm volatile("s_waitcnt vmcnt(0)" ::: "memory");
        }
    }
    __syncthreads();
}
#endif
#ifndef CPU_EMU
__global__ void __launch_bounds__(NT) fwd_kernel(Params pin, int ph_lo, int ph_hi) {
    extern __shared__ __attribute__((aligned(16))) float lds[];
    cg::grid_group grid = cg::this_grid();
    Params p = pin; p.wid = uni((int)(threadIdx.x >> 6));
    volatile LAS unsigned* misc = (volatile LAS unsigned*)((LAS unsigned char*)lds + LDS_MISC);
    if (p.wid == 0) misc[lane_id()] = 0u;
    __syncthreads();
    XcdBarrier xb; xb.bar = (unsigned*)(p.ws + WS_CTL) + CTL_BAR; xb.x = 0; xb.st = misc;
    const bool use_xb = (ph_lo == 0);
#define T0() (p.wid == 0 && lane_id() == 0)
    if (use_xb) xb = xcd_barrier_post((unsigned*)(p.ws + WS_CTL) + CTL_BAR, misc, T0());
#define SEAM(k) do { if (!use_xb) grid.sync(); else xcd_barrier(xb, T0()); } while (0)
#define PHASE(k, call) do { if (ph_lo <= (k) && (k) < ph_hi) { call; if ((k) + 1 < ph_hi) SEAM(k); } } while (0)
#define LAYER(l) do { const int b_ = 1 + (l) * PH_PER_LAYER; \
        PHASE(b_ + 0, phase_inproj(p, l, lds)); PHASE(b_ + 1, phase_prep(p, l, lds)); PHASE(b_ + 2, phase_mix(p, l, lds)); \
        PHASE(b_ + 3, phase_retout(p, l, lds)); PHASE(b_ + 4, phase_outproj(p, l, lds)); PHASE(b_ + 5, phase_route(p, l, lds)); \
        PHASE(b_ + 6, phase_moe1(p, l, lds)); PHASE(b_ + 7, phase_moe2(p, l, lds)); PHASE(b_ + 8, phase_combine(p, l)); } while (0)
    PHASE(0, phase_init(p, lds));
    LAYER(0);
    LAYER(1);
    static_assert(DEPTH == 2, "phase program written for two layers");
#undef LAYER
#undef PHASE
#undef SEAM
}

#ifndef N_LAUNCH_PER_PHASE
#define N_LAUNCH_PER_PHASE 0
#endif
extern "C" void kernel_launch(void* const* d_in, const int* in_sizes, int n_in, void* d_out, int out_size, void* d_ws, size_t ws_size, hipStream_t stream) {
    static int grid = 0;
    if (grid == 0) {
        if (ws_size < WS_END) { fprintf(stderr, "kernel_launch: workspace too small (%zu < %zu)\n", ws_size, (size_t)WS_END); grid = -1; return; }
        int dev = 0, cus = 0, per_cu = 0;
        hipGetDevice(&dev);
        hipDeviceGetAttribute(&cus, hipDeviceAttributeMultiprocessorCount, dev);
        hipFuncSetAttribute((const void*)fwd_kernel, hipFuncAttributeMaxDynamicSharedMemorySize, LDS_BYTES);
        hipOccupancyMaxActiveBlocksPerMultiprocessor(&per_cu, (const void*)fwd_kernel, NT, LDS_BYTES);
        if (per_cu < 1) { fprintf(stderr, "kernel_launch: occupancy query says %d blocks per CU\n", per_cu); grid = -1; return; }
        grid = cus;
    }
    if (grid < 0) return;
    Params p{};
    p.x = (const float*)d_in[0]; p.norm_mix = (const float*)d_in[1]; p.w_in = (const float*)d_in[2]; p.b_forget = (const float*)d_in[3];
    p.g_ret = (const float*)d_in[4]; p.g_sb = (const float*)d_in[5]; p.g_fox = (const float*)d_in[6]; p.w_out = (const float*)d_in[7];
    p.norm_ffn = (const float*)d_in[8]; p.w_group = (const float*)d_in[9]; p.b_group = (const float*)d_in[10]; p.w_router = (const float*)d_in[11];
    p.b_router = (const float*)d_in[12]; p.w_gate = (const float*)d_in[13]; p.w_up = (const float*)d_in[14]; p.w_down = (const float*)d_in[15];
    p.norm_final = (const float*)d_in[16]; p.out = (float*)d_out; p.ws = (unsigned char*)d_ws;
#if N_LAUNCH_PER_PHASE
    for (int ph = 0; ph < NPHASE; ++ph) {
        int lo = ph, hi = ph + 1; void* args[] = {&p, &lo, &hi};
        hipLaunchCooperativeKernel((const void*)fwd_kernel, dim3(grid), dim3(NT), args, LDS_BYTES, stream);
    }
#else
    (void)hipMemsetAsync((char*)d_ws + WS_CTL + (size_t)CTL_BAR * 4, 0, 3456 * 4, stream);
    int lo = 0, hi = NPHASE; void* args[] = {&p, &lo, &hi};
    hipError_t e = hipLaunchCooperativeKernel((const void*)fwd_kernel, dim3(grid), dim3(NT), args, LDS_BYTES, stream);
    if (e != hipSuccess) fprintf(stderr, "cooperative launch failed: %s (grid %d)\n", hipGetErrorString(e), grid);
#endif
}
#endif
```

```cpp
#ifndef CPU_EMU
#include <hip/hip_runtime.h>
#include <hip/hip_cooperative_groups.h>
#include <cstdio>
#include <cstdint>
#include <cmath>
namespace cg = cooperative_groups;
#define VEC(T, N) T __attribute__((ext_vector_type(N)))
__device__ __forceinline__ void wave_barrier() { __builtin_amdgcn_wave_barrier(); }
__device__ __forceinline__ float sin2pi(float x) { return __builtin_amdgcn_sinf(x); }
__device__ __forceinline__ float cos2pi(float x) { return __builtin_amdgcn_cosf(x); }
__device__ __forceinline__ unsigned long long ballot64(bool p) { return __ballot(p); }
#define LAS __attribute__((address_space(3)))
typedef VEC(short, 8) bf16x8;
typedef VEC(float, 4) f32x4_;
__device__ __forceinline__ void glds16(const void* g, LAS unsigned char* l) { __builtin_amdgcn_global_load_lds((const unsigned*)g, (LAS unsigned*)l, 16, 0, 0); }
__device__ __forceinline__ void vm_wait0() { asm volatile("s_waitcnt vmcnt(0)" ::: "memory"); }
__device__ __forceinline__ void lds_wait0() { asm volatile("s_waitcnt lgkmcnt(0)" ::: "memory"); }
__device__ __forceinline__ void sched_fence() { __builtin_amdgcn_sched_barrier(0); }
__device__ __forceinline__ int uni(int x) { return __builtin_amdgcn_readfirstlane(x); }
__device__ __forceinline__ unsigned ld_relaxed(const unsigned* p) { return __hip_atomic_load(p, __ATOMIC_RELAXED, __HIP_MEMORY_SCOPE_AGENT); }
__device__ __forceinline__ int xcc_shard() { return (int)(__builtin_amdgcn_s_getreg((3 << 11) | 20) & 7u); }
__device__ __forceinline__ int lane_id() { int l; asm volatile("v_mbcnt_lo_u32_b32 %0, -1, 0\n\tv_mbcnt_hi_u32_b32 %0, -1, %0" : "=v"(l)); return l; }
__device__ __forceinline__ f32x4_ mfma16(bf16x8 a, bf16x8 b, f32x4_ c) { return __builtin_amdgcn_mfma_f32_16x16x32_bf16(a, b, c, 0, 0, 0); }
typedef VEC(float, 16) f32x16;
typedef VEC(short, 4) s16x4;
__device__ __forceinline__ f32x16 mfma32(bf16x8 a, bf16x8 b, f32x16 c) { return __builtin_amdgcn_mfma_f32_32x32x16_bf16(a, b, c, 0, 0, 0); }
__device__ __forceinline__ s16x4 tr16(const LAS unsigned char* p) { return __builtin_amdgcn_ds_read_tr16_b64_v4i16((LAS s16x4*)p); }
__device__ __forceinline__ float fast_exp(float x) { return __expf(x); }
__device__ __forceinline__ float fast_log(float x) { return __logf(x); }
__device__ __forceinline__ float partner32(float x, int hi) { const auto rr = __builtin_amdgcn_permlane32_swap(__builtin_bit_cast(unsigned, x), __builtin_bit_cast(unsigned, x), false, false); return __builtin_bit_cast(float, hi ? rr[0] : rr[1]); }
template <int N> __device__ __forceinline__ float row_shl_add(float x) { return x + __builtin_bit_cast(float, __builtin_amdgcn_update_dpp(0, __builtin_bit_cast(int, x), 0x100 + N, 0xf, 0xf, true)); }
__device__ __forceinline__ float read_lane(float x, int l) { return __builtin_bit_cast(float, __builtin_amdgcn_readlane(__builtin_bit_cast(int, x), l)); }
#else
#define VEC(T, N) T __attribute__((vector_size(sizeof(T) * N)))
inline float sin2pi(float x) { return (float)sin(6.283185307179586 * (double)x); }
inline float cos2pi(float x) { return (float)cos(6.283185307179586 * (double)x); }
inline unsigned long long ballot64(bool p) { return emu_ballot(p); }
#define LAS
typedef VEC(short, 8) bf16x8;
inline void glds16(const void* g, unsigned char* l) { memcpy(l + (threadIdx.x & 63) * 16, g, 16); }
inline void vm_wait0() {}
inline void lds_wait0() {}
inline void sched_fence() {}
inline int uni(int x) { return x; }
inline int xcc_shard() { return (int)(blockIdx.x & 7u); }
inline unsigned ld_relaxed(const unsigned* p) { return __atomic_load_n(p, __ATOMIC_RELAXED); }
inline int lane_id() { return threadIdx.x & 63; }
inline emu_f32x4 mfma16(bf16x8 a, bf16x8 b, emu_f32x4 c) { return emu_mfma16(a, b, c); }
typedef VEC(float, 16) f32x16;
typedef VEC(short, 4) s16x4;
inline f32x16 mfma32(bf16x8 a, bf16x8 b, f32x16 c) { return emu_mfma32(a, b, c); }
inline s16x4 tr16(const unsigned char* p) { return emu_tr16(p); }
inline float fast_exp(float x) { return expf(x); }
inline float fast_log(float x) { return logf(x); }
inline float partner32(float x, int hi) { return __shfl_xor(x, 32); }
template <int N> inline float row_shl_add(float x) { const int l = threadIdx.x & 63; const float o = emu_shfl_idx(x, (l + N) & 63); return x + (((l & 15) + N < 16) ? o : 0.f); }
inline float read_lane(float x, int l) { return emu_shfl_idx(x, l); }
#endif

typedef unsigned short bf16_t;
typedef VEC(float, 4) f32x4;
typedef VEC(float, 2) f32x2;
typedef VEC(unsigned, 2) u32x2;
typedef VEC(unsigned, 4) u32x4;
typedef LAS unsigned char lds_u8;

#ifdef SMALL_CFG
constexpr int D = 256, S = 512, DEPTH = 2, NRET = 2, NSB = 1, NFOX = 1, NG = 2, EPG = 4, DE = 128;
#else
constexpr int D = 1024, S = 16384, DEPTH = 2, NRET = 6, NSB = 5, NFOX = 5, NG = 4, EPG = 8, DE = 512;
#endif
constexpr int CH = 64, HD = 64, NE = NG * EPG;
constexpr int WRET = NRET * HD, WSB = NSB * HD, WFOX = NFOX * HD, MIXW = WRET + WSB + WFOX;
constexpr int IN_W = 4 * WRET + 3 * WSB + 3 * WFOX + NFOX;
constexpr int PW = (IN_W + 255) / 256 * 256;
constexpr int OQR = 0, OKR = WRET, OVR = 2 * WRET, OGR = 3 * WRET, OQS = 4 * WRET, OKS = OQS + WSB, OVS = OKS + WSB;
constexpr int OQF = OVS + WSB, OKF = OQF + WFOX, OVF = OKF + WFOX, OFL = OVF + WFOX;
constexpr int NCHUNK = S / CH;
constexpr float EPS = 1e-6f;
constexpr int NT = 512, NW = NT / 64;
constexpr int NROUTE = NG + NE;
constexpr float EXIT_T = 18.0f;

constexpr size_t al256(size_t x) { return (x + 255) / 256 * 256; }
constexpr size_t WS_CTL = 0;
constexpr int CTL_CNT = 0;
constexpr int CTL_KMAX = 256;
constexpr int CTL_MQ = 4608, CTL_WQ = 4608 + DEPTH * 8 * 64;
constexpr int CTL_BAR = 1024;
constexpr int CTL_WORDS = 8192;
static_assert(CTL_BAR + 3456 <= CTL_MQ && CTL_WQ + DEPTH * 8 * 64 <= CTL_WORDS, "control-word map");
constexpr size_t WS_ROT = 32768;
constexpr size_t WS_X = al256(WS_ROT + (size_t)S * 32 * 8);
constexpr size_t WS_H = al256(WS_X + (size_t)S * D * 4);
constexpr size_t WS_LOGF = al256(WS_H + (size_t)S * D * 2);
constexpr size_t WS_FCUM = al256(WS_LOGF + (size_t)S * 8 * 4);
constexpr size_t WS_LC = al256(WS_FCUM + (size_t)S * 8 * 4);
constexpr size_t WS_MERGED = al256(WS_LC + (size_t)S * 8 * 4);
constexpr size_t WS_U = al256(WS_MERGED + (size_t)S * MIXW * 2);
constexpr size_t WS_SP = al256(WS_U + (size_t)NRET * NCHUNK * 4096 * 4);
constexpr size_t WS_LIST = al256(WS_SP + (size_t)NRET * NCHUNK * 4096 * 4);
constexpr size_t WS_GATE = al256(WS_LIST + (size_t)NE * S * 4);
constexpr size_t WS_WIN = al256(WS_GATE + (size_t)S * 2 * 4);
constexpr size_t WS_WOUT = al256(WS_WIN + (size_t)DEPTH * PW * D * 2);
constexpr size_t WS_WGU = al256(WS_WOUT + (size_t)DEPTH * D * MIXW * 2);
constexpr size_t WS_WDN = al256(WS_WGU + (size_t)DEPTH * NE * 2 * DE * D * 2);
constexpr size_t WS_PROJ = al256(WS_WDN + (size_t)DEPTH * NE * D * DE * 2);
constexpr int HID_ROWS = 2 * S + NE * 256;
constexpr size_t WS_HID = WS_PROJ;
constexpr size_t WS_Y = al256(WS_HID + (size_t)HID_ROWS * DE * 2);
constexpr size_t WS_END0 = al256(WS_PROJ + (size_t)S * PW * 2), WS_END1 = al256(WS_Y + (size_t)2 * S * D * 2);
constexpr size_t WS_END = WS_END0 > WS_END1 ? WS_END0 : WS_END1;
#ifndef SMALL_CFG
static_assert(WS_END <= (size_t)512 * 1024 * 1024, "workspace map exceeds the guaranteed 512 MiB");
#endif

struct Params {
    const float* x; const float* norm_mix; const float* w_in; const float* b_forget; const float* g_ret; const float* g_sb; const float* g_fox;
    const float* w_out; const float* norm_ffn; const float* w_group; const float* b_group; const float* w_router; const float* b_router;
    const float* w_gate; const float* w_up; const float* w_down; const float* norm_final;
    float* out; unsigned char* ws;
    int wid, pad;
};

#define TIDX(p) (((p).wid << 6) | lane_id())
__device__ __forceinline__ int imin(int a, int b) { return a < b ? a : b; }
__device__ __forceinline__ float u2f(unsigned u) { return __builtin_bit_cast(float, u); }
__device__ __forceinline__ unsigned f2u(float f) { return __builtin_bit_cast(unsigned, f); }
__device__ __forceinline__ float bf2f(bf16_t b) { return u2f((unsigned)b << 16); }
__device__ __forceinline__ bf16_t f2bf(float f) { unsigned u = f2u(f); return (bf16_t)((u + 0x7fffu + ((u >> 16) & 1u)) >> 16); }
#ifndef CPU_EMU
typedef float pk_f32x2 __attribute__((ext_vector_type(2))); typedef __bf16 pk_bf16x2 __attribute__((ext_vector_type(2)));
__device__ __forceinline__ unsigned pk2(float lo, float hi) { const pk_f32x2 v = {lo, hi}; return __builtin_bit_cast(unsigned, __builtin_convertvector(v, pk_bf16x2)); }
#else
__device__ __forceinline__ unsigned pk2(float lo, float hi) { return (unsigned)f2bf(lo) | ((unsigned)f2bf(hi) << 16); }
#endif
__device__ __forceinline__ float log_sigmoid(float x) { return fminf(x, 0.f) - log1pf(expf(-fabsf(x))); }
#ifndef CPU_EMU
__device__ __forceinline__ float silu(float x) { return x * __builtin_amdgcn_rcpf(1.f + __expf(-x)); }
#else
__device__ __forceinline__ float silu(float x) { return x / (1.f + expf(-x)); }
#endif
#ifndef CPU_EMU
template <int CTRL> __device__ __forceinline__ float dpp_mov(float x) { return __builtin_bit_cast(float, __builtin_amdgcn_update_dpp(0, __builtin_bit_cast(int, x), CTRL, 0xf, 0xf, false)); }
__device__ __forceinline__ float wave_sum(float v) {
    v += dpp_mov<0xB1>(v); v += dpp_mov<0x4E>(v); v += dpp_mov<0x141>(v); v += dpp_mov<0x140>(v);
    return (read_lane(v, 0) + read_lane(v, 16)) + (read_lane(v, 32) + read_lane(v, 48));
}
__device__ __forceinline__ float wave_max(float v) {
    v = fmaxf(v, dpp_mov<0xB1>(v)); v = fmaxf(v, dpp_mov<0x4E>(v)); v = fmaxf(v, dpp_mov<0x141>(v)); v = fmaxf(v, dpp_mov<0x140>(v));
    return fmaxf(fmaxf(read_lane(v, 0), read_lane(v, 16)), fmaxf(read_lane(v, 32), read_lane(v, 48)));
}
#else
__device__ __forceinline__ float wave_sum(float v) {
#pragma unroll
    for (int o = 1; o < 64; o <<= 1) v += __shfl_xor(v, o);
    return v;
}
__device__ __forceinline__ float wave_max(float v) {
#pragma unroll
    for (int o = 1; o < 64; o <<= 1) v = fmaxf(v, __shfl_xor(v, o));
    return v;
}
#endif
__device__ __forceinline__ double inv_turns(int j) {
    static constexpr double T[32] = {
        1.59154943091895346e-01, 1.19349370211248862e-01, 8.94994016088910133e-02, 6.71150830052272551e-02, 5.03292121044870353e-02, 3.77415847174197711e-02, 2.83021958306233987e-02, 2.12236527647776604e-02,
        1.59154943091895339e-02, 1.19349370211248862e-02, 8.94994016088910237e-03, 6.71150830052272534e-03, 5.03292121044870370e-03, 3.77415847174197719e-03, 2.83021958306233987e-03, 2.12236527647776622e-03,
        1.59154943091895356e-03, 1.19349370211248849e-03, 8.94994016088910237e-04, 6.71150830052272599e-04, 5.03292121044870326e-04, 3.77415847174197741e-04, 2.83021958306233954e-04, 2.12236527647776605e-04,
        1.59154943091895351e-04, 1.19349370211248862e-04, 8.94994016088910182e-05, 6.71150830052272545e-05, 5.03292121044870354e-05, 3.77415847174197768e-05, 2.83021958306233961e-05, 2.12236527647776592e-05};
    return T[j];
}

constexpr int VROWB = 144;
constexpr int IMG64 = 64 * VROWB;
constexpr int RET_WAVE_LDS = 2 * IMG64;
__device__ __forceinline__ int crow(int reg, int hi) { return (reg & 3) + 8 * (reg >> 2) + 4 * hi; }
__device__ __forceinline__ bf16x8 tr_frag(const lds_u8* base, int rowoff0, int rowoff1, int coloff) {
    const s16x4 lo = tr16(base + rowoff0 * VROWB + coloff), hi4 = tr16(base + rowoff1 * VROWB + coloff);
    bf16x8 f; f[0] = lo[0]; f[1] = lo[1]; f[2] = lo[2]; f[3] = lo[3]; f[4] = hi4[0]; f[5] = hi4[1]; f[6] = hi4[2]; f[7] = hi4[3]; return f;
}

constexpr int RJ = D / 256;
__device__ __forceinline__ void row_load(const float* row, f32x4* v, int lane) {
#pragma unroll
    for (int j = 0; j < RJ; ++j) v[j] = *(const f32x4*)(row + 256 * j + lane * 4);
}
__device__ __forceinline__ void row_load_bf16(const bf16_t* row, f32x4* v, int lane) {
#pragma unroll
    for (int j = 0; j < RJ; ++j) { const u32x2 w = *(const u32x2*)(row + 256 * j + lane * 4); v[j][0] = u2f(w[0] << 16); v[j][1] = u2f(w[0] & 0xffff0000u); v[j][2] = u2f(w[1] << 16); v[j][3] = u2f(w[1] & 0xffff0000u); }
}
__device__ __forceinline__ float row_rinv(const f32x4* v) {
    float s = 0.f;
#pragma unroll
    for (int j = 0; j < RJ; ++j) s += (v[j][0] * v[j][0] + v[j][1] * v[j][1]) + (v[j][2] * v[j][2] + v[j][3] * v[j][3]);
    s = wave_sum(s);
    return 1.0f / sqrtf(s * (1.0f / D) + EPS);
}

#ifndef CPU_EMU
typedef float f32x4_u __attribute__((ext_vector_type(4), aligned(4)));
#else
typedef float f32x4_u __attribute__((vector_size(16), aligned(4)));
#endif
#ifndef CPU_EMU
__device__ __forceinline__ f32x4_u nt_load4(const f32x4_u* p) { return __builtin_nontemporal_load(p); }
#else
inline f32x4_u nt_load4(const f32x4_u* p) { return *p; }
#endif
struct TrDesc { const float* Wa; const float* Wb; int ldw, ncols, c0, cb0, k0; bf16_t* WT; int ldt, r0, r1; };
__device__ __forceinline__ void tr_load(const TrDesc& d, f32x4 (&v)[16], int lane) {
    const int n = 4 * (lane & 15), kr = lane >> 4;
    const float* src = (n < 32 ? d.Wa + d.c0 + n : d.Wb + d.cb0 + (n - 32)) + (size_t)(d.k0 + kr) * d.ldw;
    const int col = (n < 32 ? d.c0 + n : d.cb0 + n - 32);
    if (col + 3 < d.ncols) {
#pragma unroll
        for (int i = 0; i < 16; ++i) { const f32x4_u t = nt_load4((const f32x4_u*)(src + (size_t)(4 * i) * d.ldw)); v[i][0] = t[0]; v[i][1] = t[1]; v[i][2] = t[2]; v[i][3] = t[3]; }
    } else {
#pragma unroll
        for (int i = 0; i < 16; ++i)
#pragma unroll
            for (int j = 0; j < 4; ++j) v[i][j] = (col + j < d.ncols) ? src[(size_t)(4 * i) * d.ldw + j] : 0.f;
    }
}
__device__ __forceinline__ void tr_store(const TrDesc& d, const f32x4 (&v)[16], lds_u8* img, int lane) {
    const int n = 4 * (lane & 15), kr = lane >> 4;
    wave_barrier();
#pragma unroll
    for (int i = 0; i < 16; ++i) { u32x2 o; o[0] = pk2(v[i][0], v[i][1]); o[1] = pk2(v[i][2], v[i][3]); *(LAS u32x2*)(img + (4 * i + kr) * VROWB + n * 2) = o; }
    wave_barrier();
    const lds_u8* tb = img + ((lane & 15) >> 2) * VROWB + (16 * (lane >> 4) + 4 * (lane & 3)) * 2;
    u32x4 o[8];
#pragma unroll
    for (int kc = 0; kc < 8; ++kc) {
        const s16x4 lo = tr16(tb + (8 * kc) * VROWB), hi4 = tr16(tb + (8 * kc + 4) * VROWB);
        o[kc][0] = (unsigned)(unsigned short)lo[0] | ((unsigned)(unsigned short)lo[1] << 16); o[kc][1] = (unsigned)(unsigned short)lo[2] | ((unsigned)(unsigned short)lo[3] << 16);
        o[kc][2] = (unsigned)(unsigned short)hi4[0] | ((unsigned)(unsigned short)hi4[1] << 16); o[kc][3] = (unsigned)(unsigned short)hi4[2] | ((unsigned)(unsigned short)hi4[3] << 16);
    }
    wave_barrier();
#pragma unroll
    for (int kc = 0; kc < 8; ++kc) *(LAS u32x4*)(img + lane * VROWB + kc * 16) = o[kc];
    wave_barrier();
#pragma unroll
    for (int j = 0; j < 8; ++j) {
        const int n = (lane >> 3) + 8 * j, kc = lane & 7;
        const int xx = n & 31, pos32 = 16 * ((xx >> 2) & 1) + 4 * (xx >> 3) + (xx & 3);
        const u32x4 v4 = *(const LAS u32x4*)(img + n * VROWB + kc * 16);
        *(u32x4*)(d.WT + (size_t)((n < 32 ? d.r0 : d.r1) + pos32) * d.ldt + d.k0 + 8 * kc) = v4;
    }
}
constexpr int WI_IN = (D / 64) * ((IN_W + 63) / 64), WI_OUT = (MIXW / 64) * (D / 64), WI_GU = (D / 64) * (DE / 32), WI_DN = (DE / 64) * (D / 64);
constexpr int WI_DENSE = WI_IN + WI_OUT, WI_EXPERT = WI_GU + WI_DN, WI_LAYER = WI_DENSE + NE * WI_EXPERT;
__device__ __forceinline__ TrDesc weight_desc(const Params& p, int l, int r) {
    if (r < WI_IN) { const int nb = (IN_W + 63) / 64, c0 = (r % nb) * 64; const float* W = p.w_in + (size_t)l * D * IN_W;
        const int r0 = (c0 / 256) * 256 + ((c0 % 256) / 64) * 32;
        return TrDesc{W, W, IN_W, IN_W, c0, c0 + 32, (r / nb) * 64, (bf16_t*)(p.ws + WS_WIN) + (size_t)l * PW * D, D, r0, r0 + 128}; }
    r -= WI_IN;
    if (r < WI_OUT) { const int nb = D / 64, c0 = (r % nb) * 64; const float* W = p.w_out + (size_t)l * MIXW * D;
        return TrDesc{W, W, D, D, c0, c0 + 32, (r / nb) * 64, (bf16_t*)(p.ws + WS_WOUT) + (size_t)l * D * MIXW, MIXW, c0, c0 + 32}; }
    r -= WI_OUT;
    const int e = r / WI_EXPERT; r %= WI_EXPERT;
    if (r < WI_GU) { const int nb = DE / 32, c0 = (r % nb) * 32;
        const int r0 = (c0 / 128) * 256 + (c0 % 128);
        return TrDesc{p.w_gate + (size_t)(l * NE + e) * D * DE, p.w_up + (size_t)(l * NE + e) * D * DE, DE, DE, c0, c0, (r / nb) * 64, (bf16_t*)(p.ws + WS_WGU) + (size_t)(l * NE + e) * 2 * DE * D, D, r0, r0 + 128}; }
    r -= WI_GU;
    { const int nb = D / 64, c0 = (r % nb) * 64; const float* W = p.w_down + (size_t)(l * NE + e) * DE * D;
        return TrDesc{W, W, D, D, c0, c0 + 32, (r / nb) * 64, (bf16_t*)(p.ws + WS_WDN) + (size_t)(l * NE + e) * D * DE, DE, c0, c0 + 32}; }
}
__device__ __forceinline__ void weight_item(const Params& p, int l, int r, lds_u8* img, int lane) { const TrDesc d = weight_desc(p, l, r); f32x4 v[16]; tr_load(d, v, lane); tr_store(d, v, img, lane); }
__device__ __forceinline__ void weight_item2(const Params& p, int l, int ra, int rb, lds_u8* img, int lane) {
    const TrDesc da = weight_desc(p, l, ra), db = weight_desc(p, l, rb); f32x4 va[16], vb[16];
    tr_load(da, va, lane); tr_load(db, vb, lane); tr_store(da, va, img, lane); tr_store(db, vb, img + IMG64, lane);
}
__device__ __forceinline__ void phase_init(const Params& p, float* lds) {
    unsigned* ctl = (unsigned*)(p.ws + WS_CTL);
    if (blockIdx.x == 0) for (int i = TIDX(p); i < CTL_WORDS; i += NT) if (i < CTL_BAR || i >= CTL_BAR + 3456) ctl[i] = 0u;
    f32x2* rot = (f32x2*)(p.ws + WS_ROT);
    for (int i = blockIdx.x * NT + TIDX(p); i < S * 32; i += gridDim.x * NT) {
        const int pos = i >> 5, j = i & 31;
        const double turns = (double)pos * inv_turns(j);
        const double fr = turns - floor(turns);
        f32x2 cs; cs[0] = cos2pi((float)fr); cs[1] = sin2pi((float)fr);
        rot[i] = cs;
    }
    const int lane = lane_id(), wave = p.wid;
    {
        lds_u8* img = (lds_u8*)lds + wave * RET_WAVE_LDS;
        for (int it = blockIdx.x * NW + wave; it < DEPTH * WI_DENSE; it += gridDim.x * NW) weight_item(p, it / WI_DENSE, it % WI_DENSE, img, lane);
    }
    bf16_t* H = (bf16_t*)(p.ws + WS_H);
    for (int r = blockIdx.x * NW + wave; r < S; r += gridDim.x * NW) {
        f32x4 v[RJ]; row_load(p.x + (size_t)r * D, v, lane);
        const float ri = row_rinv(v);
#pragma unroll
        for (int j = 0; j < RJ; ++j) {
            const f32x4 g = *(const f32x4*)(p.norm_mix + 256 * j + lane * 4);
            u32x2 o; o[0] = pk2(v[j][0] * ri * g[0], v[j][1] * ri * g[1]); o[1] = pk2(v[j][2] * ri * g[2], v[j][3] * ri * g[3]);
            *(u32x2*)(H + (size_t)r * D + 256 * j + lane * 4) = o;
        }
    }
}

constexpr int GBM = 256, GBK = 64, TILE_B = GBM * GBK * 2, STAGE_B = 2 * TILE_B, GEMM_LDS = 2 * STAGE_B;
__device__ __forceinline__ int lds_byte(int r, int c) { const int st = (r >> 4) * 2 + (c >> 5), ob = (r & 15) * 64 + (c & 31) * 2; return st * 1024 + (ob ^ (((ob >> 9) & 1) << 5)); }
__device__ __forceinline__ void stage_rc(int b, int& R, int& C) { const int st = b >> 10, sb = b & 1023, swz = sb ^ (((sb >> 9) & 1) << 5); R = (st >> 1) * 16 + swz / 64; C = (st & 1) * 32 + (swz % 64) / 2; }
__device__ __forceinline__ int vcu_id() { const int G = gridDim.x, b = blockIdx.x; return (G % 8 == 0) ? (b % 8) * (G / 8) + b / 8 : b; }

constexpr int HTB = 128 * GBK * 2;
struct GUnit { unsigned A, B; unsigned ao[4]; int i0, i1, i2, i3; };
#ifndef CPU_EMU
#define G8_WAIT_V(n) asm volatile("s_waitcnt vmcnt(" #n ")" ::: "memory")
#define G8_WAIT_L0() asm volatile("s_waitcnt lgkmcnt(0)" ::: "memory")
#define G8_BAR() __builtin_amdgcn_s_barrier()
#define G8_PRIO(x) __builtin_amdgcn_s_setprio(x)
#else
#define G8_WAIT_V(n) do {} while (0)
#define G8_WAIT_L0() do {} while (0)
#define G8_BAR() __syncthreads()
#define G8_PRIO(x) do {} while (0)
#endif
template <class Sched, class Epi>
__device__ __forceinline__ void gemm_stream(lds_u8* lds, const char* Abase, const char* Bbase, const int K, Sched& S, const Epi& E) {
    const int wid = S.wid, lane = lane_id(), tid = (wid << 6) | lane, wr = wid >> 2, wc = wid & 3, fr = lane & 15, fq = lane >> 4;
    const int nt = K / GBK;
    unsigned voffB[2];
    { int R, C; stage_rc(tid * 16, R, C); voffB[0] = (unsigned)((R * K + C) * 2); stage_rc(tid * 16 + 8192, R, C); voffB[1] = (unsigned)((R * K + C) * 2); }
    const unsigned hstepB = (unsigned)(128 * K * 2);
    lds_u8* ldsw = lds + wid * 1024;
    const int aoff = lds_byte(wr * 64 + fr, fq * 8), boff = lds_byte(wc * 32 + fr, fq * 8);
#define G8_SA(b, h) (((b) * 2 + (h)) * HTB)
#define G8_SB(b, h) ((4 + (b) * 2 + (h)) * HTB)
#define G8_STAGE_A(b, h, U, kt) do { _Pragma("unroll") for (int i_ = 0; i_ < 2; ++i_) glds16(Abase + ((size_t)(U).A + (size_t)((kt) * (GBK * 2))) + (Sched::GATHER ? (U).ao[2 * (h) + i_] : S.ao[2 * (h) + i_]), ldsw + G8_SA(b, h) + i_ * 8192); } while (0)
#define G8_STAGE_B(b, h, U, kt) do { _Pragma("unroll") for (int i_ = 0; i_ < 2; ++i_) glds16(Bbase + ((size_t)(U).B + (size_t)((kt) * (GBK * 2)) + (size_t)(h) * hstepB) + voffB[i_], ldsw + G8_SB(b, h) + i_ * 8192); } while (0)
#define G8_LDA(dst, b, h) do { _Pragma("unroll") for (int m = 0; m < 4; ++m) _Pragma("unroll") for (int k = 0; k < 2; ++k) dst[m][k] = *(const LAS bf16x8*)(lds + G8_SA(b, h) + aoff + m * 2048 + k * 1024); } while (0)
#define G8_LDB(dst, b, h) do { _Pragma("unroll") for (int n = 0; n < 2; ++n) _Pragma("unroll") for (int k = 0; k < 2; ++k) dst[n][k] = *(const LAS bf16x8*)(lds + G8_SB(b, h) + boff + n * 2048 + k * 1024); } while (0)
#define G8_MMA(ai, bj, At_, Bt_) do { G8_PRIO(1); _Pragma("unroll") for (int m = 0; m < 4; ++m) _Pragma("unroll") for (int n = 0; n < 2; ++n) _Pragma("unroll") for (int k = 0; k < 2; ++k) \
        acc[ai][bj][m][n] = mfma16(Bt_[n][k], At_[m][k], acc[ai][bj][m][n]); G8_PRIO(0); } while (0)
    GUnit cur, nxt; int ui = 0;
    if (!S.next(0, cur)) return;
    f32x4 acc[2][2][4][2];
#pragma unroll
    for (int a = 0; a < 2; ++a)
#pragma unroll
        for (int b = 0; b < 2; ++b)
#pragma unroll
            for (int m = 0; m < 4; ++m)
#pragma unroll
                for (int n = 0; n < 2; ++n) acc[a][b][m][n] = (f32x4){0.f, 0.f, 0.f, 0.f};
    bf16x8 At[4][2], B0[2][2], B1[2][2];
    G8_STAGE_B(0, 0, cur, 0); G8_STAGE_B(0, 1, cur, 0); G8_STAGE_A(0, 0, cur, 0); G8_STAGE_A(0, 1, cur, 0);
    if (wr == 1) G8_BAR();
    G8_WAIT_V(2); G8_BAR();
    G8_STAGE_B(1, 0, cur, 1); G8_STAGE_A(1, 0, cur, 1); G8_STAGE_B(1, 1, cur, 1);
    G8_WAIT_V(6); G8_BAR();
    for (;;) {
        const bool has_next = S.next(ui + 1, nxt);
        if (!has_next) nxt = cur;
        for (int t = 0; t < nt; t += 2) {
            const bool last = (t == nt - 2);
            const GUnit& U2 = last ? nxt : cur;
            const int k2 = last ? 0 : t + 2, k3 = k2 + 1;
            G8_LDB(B0, 0, 0); G8_LDB(B1, 0, 1); sched_fence(); G8_LDA(At, 0, 0); G8_STAGE_A(1, 1, cur, t + 1);
            G8_WAIT_V(8); G8_WAIT_L0(); G8_BAR(); G8_MMA(0, 0, At, B0); G8_MMA(0, 1, At, B1); G8_BAR(); sched_fence();
            G8_LDA(At, 0, 1); G8_STAGE_B(0, 0, U2, k2); G8_STAGE_B(0, 1, U2, k2); G8_STAGE_A(0, 0, U2, k2);
            G8_WAIT_V(8); G8_WAIT_L0(); G8_BAR(); G8_MMA(1, 0, At, B0); G8_MMA(1, 1, At, B1); G8_BAR(); sched_fence();
            G8_LDB(B0, 1, 0); G8_LDB(B1, 1, 1); sched_fence(); G8_LDA(At, 1, 0); G8_STAGE_A(0, 1, U2, k2);
            G8_WAIT_V(8); G8_WAIT_L0(); G8_BAR(); G8_MMA(0, 0, At, B0); G8_MMA(0, 1, At, B1); G8_BAR(); sched_fence();
            G8_LDA(At, 1, 1); G8_STAGE_B(1, 0, U2, k3); G8_STAGE_B(1, 1, U2, k3); G8_STAGE_A(1, 0, U2, k3);
            G8_WAIT_V(8); G8_WAIT_L0(); G8_BAR(); G8_MMA(1, 0, At, B0); G8_MMA(1, 1, At, B1); G8_BAR(); sched_fence();
        }
        if (wr == 0) G8_BAR();
        E(acc, cur, wr, wc, fr, fq);
        if (!has_next) break;
#pragma unroll
        for (int a = 0; a < 2; ++a)
#pragma unroll
            for (int b = 0; b < 2; ++b)
#pragma unroll
                for (int m = 0; m < 4; ++m)
#pragma unroll
                    for (int n = 0; n < 2; ++n) acc[a][b][m][n] = (f32x4){0.f, 0.f, 0.f, 0.f};
        cur = nxt; ++ui;
        if (wr == 1) G8_BAR();
    }
    G8_WAIT_V(0);
    G8_BAR();
#undef G8_SA
#undef G8_SB
#undef G8_STAGE_A
#undef G8_STAGE_B
#undef G8_LDA
#undef G8_LDB
#undef G8_MMA
}
__device__ __forceinline__ void plain_ao(unsigned (&ao)[4], int K, int tid) {
    int R, C; stage_rc(tid * 16, R, C); ao[0] = (unsigned)((R * K + C) * 2); ao[2] = ao[0] + (unsigned)(128 * K * 2);
    stage_rc(tid * 16 + 8192, R, C); ao[1] = (unsigned)((R * K + C) * 2); ao[3] = ao[1] + (unsigned)(128 * K * 2);
}

struct InprojSched {
    static constexpr bool GATHER = false;
    int wid;
    unsigned ao[4]; int vcu, G;
    static constexpr int NPM = S / GBM, NPN = PW / GBM;
    __device__ __forceinline__ bool next(int i, GUnit& u) const {
        const int L = uni(i * G + vcu); if (L >= NPM * NPN) return false;
        constexpr int WGM = 8, nig = WGM * NPN;
        const int gid = L / nig, fm = gid * WGM, gsz = (NPM - fm) < WGM ? (NPM - fm) : WGM;
        const int pm = fm + (L % nig) % gsz, pn = (L % nig) / gsz;
        u.A = (unsigned)(pm * GBM * D * 2); u.B = (unsigned)(pn * GBM * D * 2); u.ao[0] = u.ao[1] = u.ao[2] = u.ao[3] = 0u;
        u.i0 = pm; u.i1 = pn; u.i2 = 0; u.i3 = 0; return true;
    }
};
struct InprojEpi {
    bf16_t* P; float* LOGF; unsigned* kmaxw; const f32x2* rot; const float* bfg;
    __device__ __forceinline__ void operator()(f32x4 (&acc)[2][2][4][2], const GUnit& u, int wr, int wc, int fr, int fq) const {
        const int gc0 = u.i1 * GBM + wc * 64;
        if (gc0 >= IN_W) return;
        const int row0 = u.i0 * GBM + wr * 64 + fr;
        if (gc0 >= OFL) {
#pragma unroll
            for (int ai = 0; ai < 2; ++ai)
#pragma unroll
                for (int m = 0; m < 4; ++m)
#pragma unroll
                    for (int n = 0; n < 2; ++n)
#pragma unroll
                        for (int j = 0; j < 4; ++j) { const int h = 4 * n + j; if (fq == 0 && h < NFOX) LOGF[(size_t)h * S + row0 + ai * 128 + m * 16] = log_sigmoid(acc[ai][0][m][n][j] + bfg[h]); }
            return;
        }
        const bool rotary = gc0 < OVR, is_gate = (gc0 >= OGR && gc0 < OQS), is_kf = (gc0 >= OKF && gc0 < OVF);
        const float scale = (gc0 < OKR || (gc0 >= OQS && gc0 < OKS) || (gc0 >= OQF && gc0 < OKF)) ? 0.125f : 1.0f;
        float kmx = 0.f;
        if (rotary) {
#pragma unroll
            for (int am = 0; am < 4; ++am) {
                const int ai = am >> 1, m0 = (am & 1) * 2;
                f32x4 c01[2][2], c23[2][2];
#pragma unroll
                for (int mm = 0; mm < 2; ++mm)
#pragma unroll
                    for (int n = 0; n < 2; ++n) { const f32x2* rp = rot + (size_t)(row0 + ai * 128 + (m0 + mm) * 16) * 32 + 8 * fq + 4 * n; c01[mm][n] = *(const f32x4*)rp; c23[mm][n] = *(const f32x4*)(rp + 2); }
#pragma unroll
                for (int mm = 0; mm < 2; ++mm)
#pragma unroll
                    for (int n = 0; n < 2; ++n) {
                        const int m = m0 + mm;
                        const float cs[4] = {c01[mm][n][0], c01[mm][n][2], c23[mm][n][0], c23[mm][n][2]}, sn[4] = {c01[mm][n][1], c01[mm][n][3], c23[mm][n][1], c23[mm][n][3]};
#pragma unroll
                        for (int j = 0; j < 4; ++j) { const float x1 = acc[ai][0][m][n][j], x2 = acc[ai][1][m][n][j]; acc[ai][0][m][n][j] = x1 * cs[j] - x2 * sn[j]; acc[ai][1][m][n][j] = x1 * sn[j] + x2 * cs[j]; }
                    }
                sched_fence();
            }
        }
#pragma unroll
        for (int ai = 0; ai < 2; ++ai)
#pragma unroll
            for (int m = 0; m < 4; ++m) {
                const int row = row0 + ai * 128 + m * 16;
                float ss = 0.f;
#pragma unroll
                for (int bj = 0; bj < 2; ++bj) {
                    u32x4 o;
#pragma unroll
                    for (int n = 0; n < 2; ++n) {
                        f32x4 v = acc[ai][bj][m][n] * scale;
                        if (is_gate) {
#pragma unroll
                            for (int j = 0; j < 4; ++j) v[j] = silu(v[j]);
                        }
                        o[2 * n] = pk2(v[0], v[1]); o[2 * n + 1] = pk2(v[2], v[3]);
                        if (is_kf) {
#pragma unroll
                            for (int j = 0; j < 4; ++j) { const float r = bf2f(f2bf(v[j])); ss += r * r; }
                        }
                    }
                    *(u32x4*)(P + (size_t)row * PW + gc0 + 32 * bj + 8 * fq) = o;
                }
                if (is_kf) { ss += __shfl_xor(ss, 16); ss += __shfl_xor(ss, 32); kmx = fmaxf(kmx, ss); }
            }
        if (is_kf) { kmx = wave_max(kmx); if (lane_id() == 0) atomicMax(kmaxw + (gc0 - OKF) / HD, f2u(kmx)); }
    }
};
__device__ __forceinline__ void phase_inproj(const Params& p, int l, float* ldsf) {
    InprojSched S; S.wid = p.wid; plain_ao(S.ao, D, TIDX(p)); S.vcu = vcu_id(); S.G = gridDim.x;
    InprojEpi E; E.P = (bf16_t*)(p.ws + WS_PROJ); E.LOGF = (float*)(p.ws + WS_LOGF); E.kmaxw = (unsigned*)(p.ws + WS_CTL) + CTL_KMAX + l * 8; E.rot = (const f32x2*)(p.ws + WS_ROT); E.bfg = p.b_forget + l * NFOX;
    gemm_stream((lds_u8*)ldsf, (const char*)(p.ws + WS_H), (const char*)(p.ws + WS_WIN) + (size_t)l * PW * D * 2, D, S, E);
}

__device__ __forceinline__ float ret_log_gamma(int h) { return logf(1.0f - exp2f(-5.0f - (float)h)); }
__device__ __forceinline__ void ret_prep_item(const Params& p, int h, int n, lds_u8* wl) {
    const bf16_t* P = (const bf16_t*)(p.ws + WS_PROJ);
    float* UT = (float*)(p.ws + WS_U);
    const int lane = lane_id(), r32 = lane & 31, hi = lane >> 5;
    const float lg = ret_log_gamma(h);
    wave_barrier();
#pragma unroll
    for (int i = 0; i < 8; ++i) {
        const int c = lane + 64 * i, row = c >> 3, ch = c & 7;
        const bf16_t* src = P + (size_t)(n * CH + row) * PW + h * HD + 8 * ch;
        const u32x4 kv = *(const u32x4*)(src + OKR), vv = *(const u32x4*)(src + OVR);
        const float dk = fast_exp(lg * (float)(CH - 1 - row));
        u32x4 ko;
#pragma unroll
        for (int w = 0; w < 4; ++w) ko[w] = pk2(u2f(kv[w] << 16) * dk, u2f(kv[w] & 0xffff0000u) * dk);
        *(LAS u32x4*)(wl + row * VROWB + ch * 16) = ko;
        *(LAS u32x4*)(wl + IMG64 + row * VROWB + ch * 16) = vv;
    }
    wave_barrier();
    const lds_u8* tb = wl + (8 * hi + ((lane & 15) >> 2)) * VROWB + (16 * ((lane >> 4) & 1) + 4 * (lane & 3)) * 2;
    f32x16 acc[2][2];
#pragma unroll
    for (int a = 0; a < 2; ++a)
#pragma unroll
        for (int b = 0; b < 2; ++b)
#pragma unroll
            for (int r = 0; r < 16; ++r) acc[a][b][r] = 0.f;
#pragma unroll
    for (int s = 0; s < 4; ++s) {
        bf16x8 vf[2], kf[2];
#pragma unroll
        for (int x = 0; x < 2; ++x) { kf[x] = tr_frag(tb, 16 * s, 16 * s + 4, x * 64); vf[x] = tr_frag(tb + IMG64, 16 * s, 16 * s + 4, x * 64); }
#pragma unroll
        for (int eb = 0; eb < 2; ++eb)
#pragma unroll
            for (int db = 0; db < 2; ++db) acc[eb][db] = mfma32(vf[eb], kf[db], acc[eb][db]);
    }
    float* dst = UT + (size_t)(h * NCHUNK + n) * 4096;
#pragma unroll
    for (int eb = 0; eb < 2; ++eb)
#pragma unroll
        for (int db = 0; db < 2; ++db)
#pragma unroll
            for (int r = 0; r < 16; ++r) dst[(32 * eb + crow(r, hi)) * 64 + 32 * db + r32] = acc[eb][db][r];
}
__device__ __forceinline__ void fcum_block(const Params& p, int h, float* ldsf) {
    const float* LF = (const float*)(p.ws + WS_LOGF) + (size_t)h * S;
    float* F = (float*)(p.ws + WS_FCUM) + (size_t)h * S;
    float* LC = (float*)(p.ws + WS_LC) + (size_t)h * S;
    constexpr int KPT = S / NT;
    const int tid = TIDX(p), lane = lane_id(), w = p.wid;
    float v[KPT], a[KPT];
#pragma unroll
    for (int i = 0; i < KPT; ++i) { v[i] = LF[tid * KPT + i]; a[i] = expf(v[i]); }
    float A = 1.f, B = 0.f;
#pragma unroll
    for (int i = 0; i < KPT; ++i) { A *= a[i]; B = a[i] * B + 1.f; }
#pragma unroll
    for (int i = 1; i < KPT; ++i) v[i] += v[i - 1];
    float inc = v[KPT - 1];
    float Ai = A, Bi = B;
#pragma unroll
    for (int d = 1; d < 64; d <<= 1) {
        const float o = __shfl_up(inc, d), Ao = __shfl_up(Ai, d), Bo = __shfl_up(Bi, d);
        if (lane >= d) { inc += o; Bi = Ai * Bo + Bi; Ai = Ai * Ao; }
    }
    __syncthreads();
    if (lane == 63) { ldsf[w] = inc; ldsf[16 + w] = Ai; ldsf[32 + w] = Bi; }
    __syncthreads();
    float off = inc - v[KPT - 1];
    float x = 0.f;
    for (int ww = 0; ww < w; ++ww) { off += ldsf[ww]; x = ldsf[16 + ww] * x + ldsf[32 + ww]; }
    { const float Ae = __shfl_up(Ai, 1), Be = __shfl_up(Bi, 1); if (lane > 0) x = Ae * x + Be; }
#pragma unroll
    for (int i = 0; i < KPT; ++i) { F[tid * KPT + i] = v[i] + off; LC[tid * KPT + i] = x > 0.f ? logf(x) : -1e30f; x = a[i] * x + 1.f; }
    __syncthreads();
}
__device__ __forceinline__ void phase_prep(const Params& p, int l, float* ldsf) {
    if ((int)blockIdx.x < NFOX) fcum_block(p, (int)blockIdx.x, ldsf);
    const int wave = p.wid;
    lds_u8* wl = (lds_u8*)ldsf + wave * RET_WAVE_LDS;
    for (int it = blockIdx.x * NW + wave; it < NRET * NCHUNK; it += gridDim.x * NW) ret_prep_item(p, it / NCHUNK, it % NCHUNK, wl);
}

constexpr int NQ32 = S / 32;
constexpr int MIX_WAVE_LDS = 32 * VROWB;
__device__ __forceinline__ void ret_scan_wave(const Params& p, int item) {
    const float* U = (const float*)(p.ws + WS_U);
    bf16_t* SP = (bf16_t*)(p.ws + WS_SP);
    const int e = item * 64 + lane_id();
    const int h = e >> 12, de = e & 4095;
    const float c = expf(ret_log_gamma(h) * (float)CH);
    float st = 0.f;
    const size_t base = (size_t)h * NCHUNK * 4096 + de;
#pragma unroll 1
    for (int n0 = 0; n0 < NCHUNK; n0 += 32) {
        float u[32];
#pragma unroll
        for (int i = 0; i < 32; ++i) u[i] = (n0 + i < NCHUNK) ? U[base + (size_t)(n0 + i) * 4096] : 0.f;
#pragma unroll
        for (int i = 0; i < 32; ++i) if (n0 + i < NCHUNK) { SP[base + (size_t)(n0 + i) * 4096] = f2bf(st); st = st * c + u[i]; }
    }
}
template <bool FOX>
__device__ __forceinline__ void attn_item(const Params& p, int l, int h, int qb, lds_u8* wl) {
    const bf16_t* P = (const bf16_t*)(p.ws + WS_PROJ);
    const float* Fh = (const float*)(p.ws + WS_FCUM) + (size_t)h * S;
    const float* LCh = (const float*)(p.ws + WS_LC) + (size_t)h * S;
    bf16_t* MG = (bf16_t*)(p.ws + WS_MERGED);
    const int lane = lane_id(), r32 = lane & 31, hi = lane >> 5;
    const int q0 = qb * 32, t = q0 + r32;
    constexpr int oq = FOX ? OQF : OQS, ok = FOX ? OKF : OKS, ov = FOX ? OVF : OVS;
    bf16x8 qf[4];
    { const bf16_t* qp = P + (size_t)t * PW + oq + h * HD + 8 * hi;
#pragma unroll
      for (int ks = 0; ks < 4; ++ks) qf[ks] = *(const bf16x8*)(qp + 16 * ks); }
    float Bt = 0.f;
    if (FOX) {
        float qq = 0.f;
#pragma unroll
        for (int ks = 0; ks < 4; ++ks)
#pragma unroll
            for (int j = 0; j < 8; ++j) { const float v = bf2f((bf16_t)qf[ks][j]); qq += v * v; }
        qq += __shfl_xor(qq, 32);
        const float kmax = sqrtf(u2f(((const unsigned*)(p.ws + WS_CTL))[CTL_KMAX + l * 8 + h]));
        Bt = sqrtf(qq) * kmax * 1.0001f + 1e-6f;
    }
    const float fq = FOX ? Fh[t] : 0.f;
    float m = -1e30f, lsum = 0.f, carry = 0.f;
    f32x16 o0, o1;
#pragma unroll
    for (int r = 0; r < 16; ++r) { o0[r] = 0.f; o1[r] = 0.f; }
    const lds_u8* vb = wl + (4 * hi + ((lane & 15) >> 2)) * VROWB + (16 * ((lane >> 4) & 1) + 4 * (lane & 3)) * 2;
    bf16x8 kf1[4], kf2[4]; u32x4 vr1[4], vr2[4];
#define ATTN_LOAD(KF, VR, kt_) do { const int k0_ = (kt_) * 32; const bf16_t* kp_ = P + (size_t)(k0_ + r32) * PW + ok + h * HD + 8 * hi; \
        _Pragma("unroll") for (int ks = 0; ks < 4; ++ks) KF[ks] = *(const bf16x8*)(kp_ + 16 * ks); \
        _Pragma("unroll") for (int i = 0; i < 4; ++i) { const int c = lane + 64 * i; VR[i] = *(const u32x4*)(P + (size_t)(k0_ + (c >> 3)) * PW + ov + h * HD + 8 * (c & 7)); } \
        } while (0)
    ATTN_LOAD(kf1, vr1, qb);
    ATTN_LOAD(kf2, vr2, qb > 0 ? qb - 1 : 0);
    for (int kt = qb; kt >= 0; --kt) {
        const int key0 = kt * 32;
        const bool diag = (kt == qb);
        bf16x8 kf[4]; u32x4 vr[4];
#pragma unroll
        for (int ks = 0; ks < 4; ++ks) { kf[ks] = kf1[ks]; kf1[ks] = kf2[ks]; }
#pragma unroll
        for (int i = 0; i < 4; ++i) { vr[i] = vr1[i]; vr1[i] = vr2[i]; }
        ATTN_LOAD(kf2, vr2, kt > 1 ? kt - 2 : 0);
        f32x4 fk[4]; float fkm1 = 0.f, lck = 0.f;
        if (FOX) {
#pragma unroll
            for (int g4 = 0; g4 < 4; ++g4) fk[g4] = *(const f32x4*)(Fh + key0 + 8 * g4 + 4 * hi);
            fkm1 = Fh[key0 > 0 ? key0 - 1 : 0]; lck = LCh[key0];
        }
        f32x16 st;
#pragma unroll
        for (int r = 0; r < 16; ++r) st[r] = 0.f;
#pragma unroll
        for (int ks = 0; ks < 4; ++ks) st = mfma32(kf[ks], qf[ks], st);
        wave_barrier();
#pragma unroll
        for (int i = 0; i < 4; ++i) { const int c = lane + 64 * i; *(LAS u32x4*)(wl + (c >> 3) * VROWB + (c & 7) * 16) = vr[i]; }
        if (FOX) {
            float tmax = -1e30f;
#pragma unroll
            for (int g4 = 0; g4 < 4; ++g4)
#pragma unroll
                for (int i = 0; i < 4; ++i) { const int r = 4 * g4 + i; st[r] = st[r] + (fq - fk[g4][i]); }
            if (diag) {
#pragma unroll
                for (int r = 0; r < 16; ++r) if (crow(r, hi) > r32) st[r] = -1e30f;
            }
#pragma unroll
            for (int r = 0; r < 16; ++r) tmax = fmaxf(tmax, st[r]);
            tmax = fmaxf(tmax, partner32(tmax, hi));
            const float mn = fmaxf(m, tmax), f = fast_exp(m - mn);
            m = mn; lsum *= f;
#pragma unroll
            for (int r = 0; r < 16; ++r) { o0[r] *= f; o1[r] *= f; }
            float ps = 0.f;
#pragma unroll
            for (int r = 0; r < 16; ++r) { const float pr = fast_exp(st[r] - mn); st[r] = pr; ps += pr; }
            lsum += ps;
        } else {
            float l1m[16];
#pragma unroll
            for (int r = 0; r < 16; ++r) {
                const float z = st[r], sp = fast_log(1.0f + fast_exp(-fabsf(z)));
                const float lb = fminf(z, 0.f) - sp;
                l1m[r] = lb - z;
                st[r] = lb;
            }
            if (diag) {
#pragma unroll
                for (int r = 0; r < 16; ++r) if (crow(r, hi) >= r32) { l1m[r] = 0.f; st[r] = -1e30f; }
            }
            float gs[4], pg[4], T[4];
#pragma unroll
            for (int k = 0; k < 4; ++k) { gs[k] = (l1m[4 * k] + l1m[4 * k + 1]) + (l1m[4 * k + 2] + l1m[4 * k + 3]); pg[k] = partner32(gs[k], hi); }
            float run = 0.f;
#pragma unroll
            for (int k = 3; k >= 0; --k) { T[k] = run + (hi == 0 ? pg[k] : 0.f); run += gs[k] + pg[k]; }
#pragma unroll
            for (int k = 0; k < 4; ++k) {
                float w = T[k] + carry;
#pragma unroll
                for (int i = 3; i >= 0; --i) { const int r = 4 * k + i; st[r] = fast_exp(st[r] + w); w += l1m[r]; }
            }
            carry += run;
        }
        u32x4 pw0, pw1;
#pragma unroll
        for (int j = 0; j < 4; ++j) { pw0[j] = pk2(st[2 * j], st[2 * j + 1]); pw1[j] = pk2(st[8 + 2 * j], st[9 + 2 * j]); }
        const bf16x8 pf0 = __builtin_bit_cast(bf16x8, pw0), pf1 = __builtin_bit_cast(bf16x8, pw1);
        wave_barrier();
#pragma unroll
        for (int s = 0; s < 2; ++s) {
#pragma unroll
            for (int db = 0; db < 2; ++db) {
                const s16x4 lo = tr16(vb + (16 * s) * VROWB + db * 64), hi4 = tr16(vb + (16 * s + 8) * VROWB + db * 64);
                bf16x8 vf; vf[0] = lo[0]; vf[1] = lo[1]; vf[2] = lo[2]; vf[3] = lo[3]; vf[4] = hi4[0]; vf[5] = hi4[1]; vf[6] = hi4[2]; vf[7] = hi4[3];
                if (db == 0) o0 = mfma32(vf, s == 0 ? pf0 : pf1, o0); else o1 = mfma32(vf, s == 0 ? pf0 : pf1, o1);
            }
        }
        const bool done = FOX ? (Bt + (fq - fkm1) - m + (lck * 1.00001f + 1e-4f) < -EXIT_T) : (carry < -EXIT_T);
        if (ballot64(done) == ~0ull) break;
    }
#undef ATTN_LOAD
    if (FOX) { lsum += __shfl_xor(lsum, 32); const float il = 1.0f / lsum;
#pragma unroll
        for (int r = 0; r < 16; ++r) { o0[r] *= il; o1[r] *= il; } }
    float ss = 0.f;
#pragma unroll
    for (int r = 0; r < 16; ++r) ss += o0[r] * o0[r] + o1[r] * o1[r];
    ss += __shfl_xor(ss, 32);
    const float ri = 1.0f / sqrtf(ss * (1.0f / HD) + EPS);
    const float* g = (FOX ? p.g_fox + l * WFOX : p.g_sb + l * WSB) + h * HD;
    wave_barrier();
#pragma unroll
    for (int db = 0; db < 2; ++db)
#pragma unroll
        for (int g4 = 0; g4 < 4; ++g4) {
            const int d0 = db * 32 + 8 * g4 + 4 * hi;
            const f32x4 gg = *(const f32x4*)(g + d0);
            float v[4];
#pragma unroll
            for (int i = 0; i < 4; ++i) v[i] = (db == 0 ? o0[4 * g4 + i] : o1[4 * g4 + i]) * ri * gg[i];
            u32x2 o; o[0] = pk2(v[0], v[1]); o[1] = pk2(v[2], v[3]);
            *(LAS u32x2*)(wl + r32 * VROWB + d0 * 2) = o;
        }
    wave_barrier();
    bf16_t* dst = MG + (size_t)q0 * MIXW + (FOX ? WRET + WSB : WRET) + h * HD;
#pragma unroll
    for (int j = 0; j < 4; ++j) { const int row = (lane >> 3) + 8 * j, ch = lane & 7;
        *(u32x4*)(dst + (size_t)row * MIXW + 8 * ch) = *(const LAS u32x4*)(wl + row * VROWB + ch * 16); }
    wave_barrier();
}
constexpr int WCH = 2, NWCH = (NE * WI_EXPERT + WCH - 1) / WCH;
__device__ __forceinline__ bool mix_weight_step(const Params& p, int l, lds_u8* wl, int shard0, int& wsk) {
    unsigned* wbase = (unsigned*)(p.ws + WS_CTL) + CTL_WQ + 64 * (l * 8);
    const int lane = lane_id();
#pragma unroll 1
    while (wsk < 8) {
        const int shard = (shard0 + wsk) & 7;
        unsigned* head = wbase + 64 * shard;
        unsigned c = 0x0fffffffu;
        if (lane == 0) { if (!(wsk > 0 && (int)ld_relaxed(head) * 8 + shard >= NWCH)) c = atomicAdd(head, 1u); }
        const int chunk = uni((int)__shfl(c, 0)) * 8 + shard;
        if (chunk >= NWCH) { ++wsk; continue; }
        static_assert(WCH == 2 && (NE * WI_EXPERT) % 2 == 0, "two tiles per dequeue");
        weight_item2(p, l, WI_DENSE + chunk * 2, WI_DENSE + chunk * 2 + 1, wl, lane);
        return true;
    }
    return false;
}
__device__ __forceinline__ void phase_mix(const Params& p, int l, float* ldsf) {
    constexpr int NSCANW = NRET * 4096 / 64, NFXI = NFOX * NQ32, NSBI = NSB * NQ32;
    const int wave = p.wid;
    lds_u8* wl = (lds_u8*)ldsf + wave * RET_WAVE_LDS;
    static_assert(MIX_WAVE_LDS <= RET_WAVE_LDS, "per-wave LDS region");
    const int shard0 = xcc_shard();
    int wsk = 0;
    unsigned* qbase = (unsigned*)(p.ws + WS_CTL) + CTL_MQ + 64 * (l * 8);
    const float* bfg = p.b_forget + l * NFOX;
    constexpr int NMIX = NSCANW + NFXI + NSBI;
#pragma unroll 1
    for (int sk = 0; sk < 8; ++sk) {
      const int shard = (shard0 + sk) & 7;
      unsigned* qhead = qbase + 64 * shard;
#pragma unroll 1
      for (;;) {
        unsigned itu = 0;
        if (lane_id() == 0) { if (sk > 0 && (int)ld_relaxed(qhead) * 8 + shard >= NMIX) itu = 0x0fffffffu; else itu = atomicAdd(qhead, 1u); }
        const int it = uni((int)__shfl(itu, 0)) * 8 + shard;
        if (it >= NMIX) break;
        if (it < NSCANW) ret_scan_wave(p, it);
        else if (it < NSCANW + NFXI) {
            const int j = it - NSCANW, rank = j / NQ32;
            int h = 0;
#pragma unroll
            for (int c = 0; c < NFOX; ++c) { int rk = 0;
#pragma unroll
                for (int o = 0; o < NFOX; ++o) rk += (bfg[o] > bfg[c] || (bfg[o] == bfg[c] && o < c)) ? 1 : 0;
                if (rk == rank) h = c; }
            attn_item<true>(p, l, h, NQ32 - 1 - j % NQ32, wl);
        }
        else { const int j = it - NSCANW - NFXI; attn_item<false>(p, l, j % NSB, NQ32 - 1 - j / NSB, wl); }
        (void)mix_weight_step(p, l, wl, shard0, wsk);
      }
    }
    while (mix_weight_step(p, l, wl, shard0, wsk)) {}
}

__device__ __forceinline__ void ret_out_item(const Params& p, int l, int h, int n, int cb, lds_u8* wl) {
    const bf16_t* P = (const bf16_t*)(p.ws + WS_PROJ);
    const bf16_t* SPT = (const bf16_t*)(p.ws + WS_SP) + (size_t)(h * NCHUNK + n) * 4096;
    bf16_t* MG = (bf16_t*)(p.ws + WS_MERGED);
    const int lane = lane_id(), r32 = lane & 31, hi = lane >> 5;
    const float lg = ret_log_gamma(h);
    const size_t rowb = (size_t)(n * CH) * PW + h * HD;
    const int c = 32 * cb + r32;
    wave_barrier();
    {
        u32x4 vv[8];
#pragma unroll
        for (int i = 0; i < 8; ++i) { const int q = lane + 64 * i; vv[i] = *(const u32x4*)(P + rowb + (size_t)(q >> 3) * PW + OVR + 8 * (q & 7)); }
#pragma unroll
        for (int i = 0; i < 8; ++i) { const int q = lane + 64 * i; *(LAS u32x4*)(wl + (q >> 3) * VROWB + (q & 7) * 16) = vv[i]; }
    }
    sched_fence();
    bf16x8 qf[4];
#pragma unroll
    for (int ks = 0; ks < 4; ++ks) qf[ks] = *(const bf16x8*)(P + rowb + (size_t)c * PW + OQR + 16 * ks + 8 * hi);
    f32x16 o[2];
#pragma unroll
    for (int a = 0; a < 2; ++a)
#pragma unroll
        for (int r = 0; r < 16; ++r) o[a][r] = 0.f;
#pragma unroll
    for (int ks = 0; ks < 4; ++ks)
#pragma unroll
        for (int eb = 0; eb < 2; ++eb) { const bf16x8 sf = *(const bf16x8*)(SPT + (32 * eb + r32) * 64 + 16 * ks + 8 * hi); o[eb] = mfma32(sf, qf[ks], o[eb]); }
    { const float qd = fast_exp(lg * (float)(c + 1));
#pragma unroll
      for (int eb = 0; eb < 2; ++eb)
#pragma unroll
          for (int r = 0; r < 16; ++r) o[eb][r] *= qd; }
    wave_barrier();
    const lds_u8* vb = wl + (4 * hi + ((lane & 15) >> 2)) * VROWB + (16 * ((lane >> 4) & 1) + 4 * (lane & 3)) * 2;
#pragma unroll
    for (int kb = 0; kb < 2; ++kb) {
        f32x16 st;
#pragma unroll
        for (int r = 0; r < 16; ++r) st[r] = 0.f;
#pragma unroll
        for (int ks = 0; ks < 4; ++ks) { const bf16x8 kf = *(const bf16x8*)(P + rowb + (size_t)(32 * kb + r32) * PW + OKR + 16 * ks + 8 * hi); st = mfma32(kf, qf[ks], st); }
        bf16x8 pf[2];
#pragma unroll
        for (int r = 0; r < 16; ++r) { const int dist = c - (32 * kb + crow(r, hi)); st[r] *= fast_exp(lg * fabsf((float)dist)); }
        { u32x4 w0, w1;
#pragma unroll
          for (int j = 0; j < 4; ++j) { w0[j] = pk2(st[2 * j], st[2 * j + 1]); w1[j] = pk2(st[8 + 2 * j], st[9 + 2 * j]); }
          pf[0] = __builtin_bit_cast(bf16x8, w0); pf[1] = __builtin_bit_cast(bf16x8, w1); }
#pragma unroll
        for (int s = 0; s < 2; ++s)
#pragma unroll
            for (int eb = 0; eb < 2; ++eb) o[eb] = mfma32(tr_frag(vb, 32 * kb + 16 * s, 32 * kb + 16 * s + 8, eb * 64), pf[s], o[eb]);
    }
    float sm = 0.f;
#pragma unroll
    for (int eb = 0; eb < 2; ++eb)
#pragma unroll
        for (int r = 0; r < 16; ++r) sm += o[eb][r];
    sm += __shfl_xor(sm, 32);
    const float mu = sm * (1.0f / HD);
    float vs = 0.f;
#pragma unroll
    for (int eb = 0; eb < 2; ++eb)
#pragma unroll
        for (int r = 0; r < 16; ++r) { const float dlt = o[eb][r] - mu; o[eb][r] = dlt; vs += dlt * dlt; }
    vs += __shfl_xor(vs, 32);
    const float ri = 1.0f / sqrtf(vs * (1.0f / HD) + EPS);
    const int row = n * CH + c;
#pragma unroll
    for (int eb = 0; eb < 2; ++eb)
#pragma unroll
        for (int g4 = 0; g4 < 4; ++g4) {
            const int e0 = 32 * eb + 8 * g4 + 4 * hi;
            const f32x4 gg = *(const f32x4*)(p.g_ret + l * WRET + h * HD + e0);
            const u32x2 gt = *(const u32x2*)(P + (size_t)row * PW + OGR + h * HD + e0);
            const float ga[4] = {u2f(gt[0] << 16), u2f(gt[0] & 0xffff0000u), u2f(gt[1] << 16), u2f(gt[1] & 0xffff0000u)};
            float v[4];
#pragma unroll
            for (int i = 0; i < 4; ++i) v[i] = o[eb][4 * g4 + i] * ri * gg[i] * ga[i];
            u32x2 ov; ov[0] = pk2(v[0], v[1]); ov[1] = pk2(v[2], v[3]);
            *(u32x2*)(MG + (size_t)row * MIXW + h * HD + e0) = ov;
        }
}
__device__ __forceinline__ void phase_retout(const Params& p, int l, float* ldsf) {
    const int wave = p.wid;
    lds_u8* wl = (lds_u8*)ldsf + wave * RET_WAVE_LDS;
    for (int it = blockIdx.x * NW + wave; it < NRET * NCHUNK * 2; it += gridDim.x * NW) ret_out_item(p, l, (it >> 1) / NCHUNK, (it >> 1) % NCHUNK, it & 1, wl);
}

struct OutprojSched {
    static constexpr bool GATHER = false;
    int wid;
    unsigned ao[4]; int vcu, G;
    static constexpr int NPM = S / GBM, NPN = D / GBM;
    __device__ __forceinline__ bool next(int i, GUnit& u) const {
        const int L = uni(i * G + vcu); if (L >= NPM * NPN) return false;
        const int pm = L / NPN, pn = L % NPN;
        u.A = (unsigned)(pm * GBM * MIXW * 2); u.B = (unsigned)(pn * GBM * MIXW * 2); u.ao[0] = u.ao[1] = u.ao[2] = u.ao[3] = 0u;
        u.i0 = pm; u.i1 = pn; u.i2 = 0; u.i3 = 0; return true;
    }
};
struct OutprojEpi {
    const float* xin32; const bf16_t* xin16; bf16_t* X;
    __device__ __forceinline__ void operator()(f32x4 (&acc)[2][2][4][2], const GUnit& u, int wr, int wc, int fr, int fq) const {
        const size_t o0 = (size_t)(u.i0 * GBM + wr * 64 + fr) * D + u.i1 * GBM + wc * 32 + 8 * fq;
#pragma unroll
        for (int ai = 0; ai < 2; ++ai)
#pragma unroll
            for (int mh = 0; mh < 2; ++mh) {
                f32x4 r[2][2][2];
#pragma unroll
                for (int mm = 0; mm < 2; ++mm)
#pragma unroll
                    for (int bj = 0; bj < 2; ++bj) { const size_t o = o0 + (size_t)(ai * 128 + (2 * mh + mm) * 16) * D + bj * 128;
                        if (xin32) { r[mm][bj][0] = *(const f32x4*)(xin32 + o); r[mm][bj][1] = *(const f32x4*)(xin32 + o + 4); }
                        else { const u32x4 w = *(const u32x4*)(xin16 + o);
                            r[mm][bj][0] = (f32x4){u2f(w[0] << 16), u2f(w[0] & 0xffff0000u), u2f(w[1] << 16), u2f(w[1] & 0xffff0000u)};
                            r[mm][bj][1] = (f32x4){u2f(w[2] << 16), u2f(w[2] & 0xffff0000u), u2f(w[3] << 16), u2f(w[3] & 0xffff0000u)}; } }
#pragma unroll
                for (int mm = 0; mm < 2; ++mm)
#pragma unroll
                    for (int bj = 0; bj < 2; ++bj) { u32x4 ov;
#pragma unroll
                        for (int n = 0; n < 2; ++n) { const f32x4 v = r[mm][bj][n] + acc[ai][bj][2 * mh + mm][n]; ov[2 * n] = pk2(v[0], v[1]); ov[2 * n + 1] = pk2(v[2], v[3]); }
                        *(u32x4*)(X + o0 + (size_t)(ai * 128 + (2 * mh + mm) * 16) * D + bj * 128) = ov; }
                sched_fence();
            }
    }
};
__device__ __forceinline__ void phase_outproj(const Params& p, int l, float* ldsf) {
    OutprojSched S; S.wid = p.wid; plain_ao(S.ao, MIXW, TIDX(p)); S.vcu = vcu_id(); S.G = gridDim.x;
    OutprojEpi E; E.X = (bf16_t*)(p.ws + WS_X); E.xin32 = l == 0 ? p.x : nullptr; E.xin16 = E.X;
    gemm_stream((lds_u8*)ldsf, (const char*)(p.ws + WS_MERGED), (const char*)(p.ws + WS_WOUT) + (size_t)l * D * MIXW * 2, MIXW, S, E);
}

constexpr int RW = D + 4;
constexpr int ROUTE_LDS = NROUTE * RW * 4 + 2 * NE * 4 + 2 * 256 * 4;
__device__ __forceinline__ void phase_route(const Params& p, int l, float* lds) {
    const bf16_t* X = (const bf16_t*)(p.ws + WS_X);
    bf16_t* H = (bf16_t*)(p.ws + WS_H);
    unsigned* ctl = (unsigned*)(p.ws + WS_CTL);
    int* LIST = (int*)(p.ws + WS_LIST);
    float* GATE = (float*)(p.ws + WS_GATE);
    const float* gn = p.norm_ffn + l * D;
    const float* wg = p.w_group + (size_t)l * D * NG; const float* wr = p.w_router + (size_t)l * D * NE;
    const float* bg = p.b_group + l * NG; const float* br = p.b_router + l * NE;
    const int lane = lane_id(), wave = p.wid;
    const int tidx = TIDX(p);
    unsigned* lcnt = (unsigned*)(lds + NROUTE * RW); unsigned* lbase = lcnt + NE; unsigned* lrec = lbase + NE;
    __syncthreads();
    if (tidx < NE) lcnt[tidx] = 0u;
    {
        constexpr int NV4 = D * NE / 4 / NT;
        f32x4 t[NV4];
#pragma unroll
        for (int k = 0; k < NV4; ++k) t[k] = *(const f32x4*)(wr + (size_t)(tidx + k * NT) * 4);
        for (int i = tidx; i < D * NG; i += NT) lds[(i % NG) * RW + i / NG] = wg[i];
#pragma unroll
        for (int k = 0; k < NV4; ++k) { const int i = (tidx + k * NT) * 4, c = i / NE, e = i % NE;
#pragma unroll
            for (int j = 0; j < 4; ++j) lds[(NG + e + j) * RW + c] = t[k][j]; }
    }
    __syncthreads();
    f32x4 vn[RJ]; { const int r0 = blockIdx.x * NW + wave; if (r0 < S) row_load_bf16(X + (size_t)r0 * D, vn, lane); }
    for (int r = blockIdx.x * NW + wave; r < S; r += gridDim.x * NW) {
        f32x4 v[RJ];
#pragma unroll
        for (int j = 0; j < RJ; ++j) v[j] = vn[j];
        { const int rn = r + gridDim.x * NW; if (rn < S) row_load_bf16(X + (size_t)rn * D, vn, lane); }
        const float ri = row_rinv(v);
#pragma unroll
        for (int j = 0; j < RJ; ++j) {
            const f32x4 g = *(const f32x4*)(gn + 256 * j + lane * 4);
            v[j] = v[j] * ri * g;
            u32x2 o; o[0] = pk2(v[j][0], v[j][1]); o[1] = pk2(v[j][2], v[j][3]);
            *(u32x2*)(H + (size_t)r * D + 256 * j + lane * 4) = o;
        }
        float gl[NG];
#pragma unroll
        for (int g = 0; g < NG; ++g) { float s = 0.f;
#pragma unroll
            for (int j = 0; j < RJ; ++j) { const f32x4 w = *(const f32x4*)(lds + g * RW + 256 * j + lane * 4); s += (v[j][0] * w[0] + v[j][1] * w[1]) + (v[j][2] * w[2] + v[j][3] * w[3]); }
            gl[g] = s; }
#pragma unroll
        for (int g = 0; g < NG; ++g) gl[g] = wave_sum(gl[g]) + bg[g];
        int grp = 0; float gm = gl[0];
#pragma unroll
        for (int g = 1; g < NG; ++g) if (gl[g] > gm) { gm = gl[g]; grp = g; }
        float den = 0.f;
#pragma unroll
        for (int g = 0; g < NG; ++g) den += fast_exp(gl[g] - gm);
        const float pg = 1.0f / den;
        float el[EPG];
        const float* wl = lds + (NG + grp * EPG) * RW + lane * 4;
#pragma unroll
        for (int e = 0; e < EPG; ++e) { float s = 0.f;
#pragma unroll
            for (int j = 0; j < RJ; ++j) { const f32x4 w = *(const f32x4*)(wl + e * RW + 256 * j); s += (v[j][0] * w[0] + v[j][1] * w[1]) + (v[j][2] * w[2] + v[j][3] * w[3]); }
            el[e] = s; }
#pragma unroll
        for (int e = 0; e < EPG; ++e) el[e] = wave_sum(el[e]) + br[grp * EPG + e];
        if (lane == 0) {
            int i1 = 0; float v1 = -INFINITY; int i2 = 0; float v2 = -INFINITY;
#pragma unroll
            for (int e = 0; e < EPG; ++e) { const float x = el[e];
                if (x > v1) { v2 = v1; i2 = i1; v1 = x; i1 = e; } else if (x > v2) { v2 = x; i2 = e; } }
            const float e2 = fast_exp(v2 - v1), g1 = pg / (1.f + e2), g2 = pg * e2 / (1.f + e2);
            const int ea = grp * EPG + i1, eb = grp * EPG + i2;
            GATE[(size_t)r * 2] = g1; GATE[(size_t)r * 2 + 1] = g2;
            const int li = (r - blockIdx.x * NW) / (gridDim.x * NW) * NW + wave;
            const unsigned ra = atomicAdd(lcnt + ea, 1u), rb = atomicAdd(lcnt + eb, 1u);
            lrec[2 * li] = (unsigned)ea | (ra << 8); lrec[2 * li + 1] = (unsigned)eb | (rb << 8);
        }
    }
    {
        __syncthreads();
        if (tidx < NE) lbase[tidx] = atomicAdd(ctl + CTL_CNT + l * NE + tidx, lcnt[tidx]);
        __syncthreads();
        const int nrows = (S - blockIdx.x * NW + gridDim.x * NW - 1) / (gridDim.x * NW) * NW;
        for (int i = tidx; i < 2 * nrows; i += NT) {
            const int li = i >> 1, r = blockIdx.x * NW + (li / NW) * (gridDim.x * NW) + (li % NW);
            if (r < S) { const unsigned rec = lrec[i]; const int e = rec & 255u; LIST[(size_t)e * S + lbase[e] + (rec >> 8)] = r * 2 + (i & 1); }
        }
    }
}

__device__ __forceinline__ void moe_table(const unsigned* cnt, volatile LAS unsigned* tab, int tid) {
    __syncthreads();
    if (tid < 64) {
        const unsigned c = tid < NE ? cnt[tid] : 0u;
        unsigned nt = (c + GBM - 1) / GBM, inc = nt;
#pragma unroll
        for (int d = 1; d < 64; d <<= 1) { const unsigned o = (unsigned)__shfl_up((int)inc, d); if ((tid & 63) >= d) inc += o; }
        if (tid < NE) { tab[tid + 1] = inc; tab[64 + tid] = c; }
        if (tid == 0) tab[0] = 0u;
    }
    __syncthreads();
}
__device__ __forceinline__ bool moe_unit(volatile LAS unsigned* tab, int u, int npn, int& e, int& rt, int& pn, int& base, int& count) {
    const int tile = uni(u / npn); pn = uni(u % npn);
    if (tile >= (int)tab[NE]) return false;
    int lo = 0;
#pragma unroll
    for (int s = NE / 2; s >= 1; s >>= 1) if ((int)tab[lo + s] <= tile) lo += s;
    e = uni(lo); rt = tile - (int)tab[e]; base = (int)tab[e] * GBM; count = (int)tab[64 + e];
    rt = uni(rt); base = uni(base); count = uni(count);
    return true;
}
struct Moe1Sched {
    static constexpr bool GATHER = true;
    int wid;
    unsigned ao[4];
    volatile LAS unsigned* tab; const int* LIST; int vcu, G;
    static constexpr int NPN = 2 * DE / GBM;
    __device__ __forceinline__ bool next(int i, GUnit& u) const {
        int e, rt, pn, base, count; if (!moe_unit(tab, i * G + vcu, NPN, e, rt, pn, base, count)) return false;
        const int nvalid = count - rt * GBM;
        u.A = 0u; u.B = (unsigned)((e * 2 * DE + pn * GBM) * D * 2);
#pragma unroll
        for (int k = 0; k < 4; ++k) { int R, C; stage_rc(((wid << 6) | lane_id()) * 16 + (k & 1) * 8192, R, C); const int r = R + 128 * (k >> 1);
            const int tok = r < nvalid ? (LIST[(size_t)e * S + rt * GBM + r] >> 1) : 0; u.ao[k] = (unsigned)((tok * D + C) * 2); }
        u.i0 = base + rt * GBM; u.i1 = pn; u.i2 = nvalid; u.i3 = e * S + rt * GBM; return true;
    }
};
struct Moe1Epi {
    bf16_t* HID;
    __device__ __forceinline__ void operator()(f32x4 (&acc)[2][2][4][2], const GUnit& u, int wr, int wc, int fr, int fq) const {
#pragma unroll
        for (int ai = 0; ai < 2; ++ai)
#pragma unroll
            for (int m = 0; m < 4; ++m)
{ u32x4 o;
#pragma unroll
                for (int n = 0; n < 2; ++n) { f32x4 v;
#pragma unroll
                    for (int j = 0; j < 4; ++j) v[j] = silu(acc[ai][0][m][n][j]) * acc[ai][1][m][n][j];
                    o[2 * n] = pk2(v[0], v[1]); o[2 * n + 1] = pk2(v[2], v[3]); }
                *(u32x4*)(HID + (size_t)(u.i0 + ai * 128 + wr * 64 + m * 16 + fr) * DE + u.i1 * 128 + wc * 32 + 8 * fq) = o; }
    }
};
__device__ __forceinline__ void phase_moe1(const Params& p, int l, float* ldsf) {
    Moe1Sched S; S.wid = p.wid; S.tab = (volatile LAS unsigned*)((LAS unsigned char*)ldsf + GEMM_LDS);
    moe_table((const unsigned*)(p.ws + WS_CTL) + CTL_CNT + l * NE, S.tab, TIDX(p));
    S.LIST = (const int*)(p.ws + WS_LIST); S.vcu = vcu_id(); S.G = gridDim.x;
    Moe1Epi E; E.HID = (bf16_t*)(p.ws + WS_HID);
    gemm_stream((lds_u8*)ldsf, (const char*)(p.ws + WS_H), (const char*)(p.ws + WS_WGU) + (size_t)l * NE * 2 * DE * D * 2, D, S, E);
}
struct Moe2Sched {
    static constexpr bool GATHER = false;
    int wid;
    volatile LAS unsigned* tab; unsigned ao[4]; int vcu, G;
    static constexpr int NPN = D / GBM;
    __device__ __forceinline__ bool next(int i, GUnit& u) const {
        int e, rt, pn, base, count; if (!moe_unit(tab, i * G + vcu, NPN, e, rt, pn, base, count)) return false;
        u.A = (unsigned)((base + rt * GBM) * DE * 2); u.B = (unsigned)((e * D + pn * GBM) * DE * 2); u.ao[0] = u.ao[1] = u.ao[2] = u.ao[3] = 0u;
        u.i0 = 0; u.i1 = pn; u.i2 = count - rt * GBM; u.i3 = e * S + rt * GBM; return true;
    }
};
struct Moe2Epi {
    bf16_t* Y; const int* LIST; const float* GATE;
    __device__ __forceinline__ void operator()(f32x4 (&acc)[2][2][4][2], const GUnit& u, int wr, int wc, int fr, int fq) const {
        int a[2][4]; float g[2][4];
#pragma unroll
        for (int ai = 0; ai < 2; ++ai)
#pragma unroll
            for (int m = 0; m < 4; ++m) { const int r = ai * 128 + wr * 64 + m * 16 + fr; a[ai][m] = r < u.i2 ? LIST[(size_t)u.i3 + r] : -1; }
#pragma unroll
        for (int ai = 0; ai < 2; ++ai)
#pragma unroll
            for (int m = 0; m < 4; ++m) g[ai][m] = a[ai][m] >= 0 ? GATE[a[ai][m]] : 0.f;
#pragma unroll
        for (int ai = 0; ai < 2; ++ai)
#pragma unroll
            for (int m = 0; m < 4; ++m) {
                if (a[ai][m] >= 0) {
#pragma unroll
                    for (int bj = 0; bj < 2; ++bj) { u32x4 o;
#pragma unroll
                        for (int n = 0; n < 2; ++n) { const f32x4 v = acc[ai][bj][m][n] * g[ai][m]; o[2 * n] = pk2(v[0], v[1]); o[2 * n + 1] = pk2(v[2], v[3]); }
                        *(u32x4*)(Y + (size_t)a[ai][m] * D + u.i1 * GBM + bj * 128 + wc * 32 + 8 * fq) = o; }
                }
            }
    }
};
__device__ __forceinline__ void phase_moe2(const Params& p, int l, float* ldsf) {
    Moe2Sched S; S.wid = p.wid; S.tab = (volatile LAS unsigned*)((LAS unsigned char*)ldsf + GEMM_LDS);
    moe_table((const unsigned*)(p.ws + WS_CTL) + CTL_CNT + l * NE, S.tab, TIDX(p));
    plain_ao(S.ao, DE, TIDX(p)); S.vcu = vcu_id(); S.G = gridDim.x;
    Moe2Epi E; E.Y = (bf16_t*)(p.ws + WS_Y); E.LIST = (const int*)(p.ws + WS_LIST); E.GATE = (const float*)(p.ws + WS_GATE);
    gemm_stream((lds_u8*)ldsf, (const char*)(p.ws + WS_HID), (const char*)(p.ws + WS_WDN) + (size_t)l * NE * D * DE * 2, DE, S, E);
}

__device__ __forceinline__ void phase_combine(const Params& p, int l) {
    bf16_t* X = (bf16_t*)(p.ws + WS_X);
    const bf16_t* Y = (const bf16_t*)(p.ws + WS_Y);
    bf16_t* H = (bf16_t*)(p.ws + WS_H);
    const bool last = (l == DEPTH - 1);
    const float* gn = last ? p.norm_final : p.norm_mix + (l + 1) * D;
    const int lane = lane_id(), wave = p.wid;
    for (int r = blockIdx.x * NW + wave; r < S; r += gridDim.x * NW) {
        f32x4 v[RJ]; row_load_bf16(X + (size_t)r * D, v, lane);
#pragma unroll
        for (int j = 0; j < RJ; ++j) {
            const u32x2 a = *(const u32x2*)(Y + (size_t)(2 * r) * D + 256 * j + lane * 4), b = *(const u32x2*)(Y + (size_t)(2 * r + 1) * D + 256 * j + lane * 4);
            v[j][0] += u2f(a[0] << 16) + u2f(b[0] << 16); v[j][1] += u2f(a[0] & 0xffff0000u) + u2f(b[0] & 0xffff0000u);
            v[j][2] += u2f(a[1] << 16) + u2f(b[1] << 16); v[j][3] += u2f(a[1] & 0xffff0000u) + u2f(b[1] & 0xffff0000u);
        }
        const float ri = row_rinv(v);
#pragma unroll
        for (int j = 0; j < RJ; ++j) {
            const f32x4 g = *(const f32x4*)(gn + 256 * j + lane * 4);
            if (last) *(f32x4*)(p.out + (size_t)r * D + 256 * j + lane * 4) = v[j] * ri * g;
            else {
                { u32x2 xo; xo[0] = pk2(v[j][0], v[j][1]); xo[1] = pk2(v[j][2], v[j][3]); *(u32x2*)(X + (size_t)r * D + 256 * j + lane * 4) = xo; }
                u32x2 o; o[0] = pk2(v[j][0] * ri * g[0], v[j][1] * ri * g[1]); o[1] = pk2(v[j][2] * ri * g[2], v[j][3] * ri * g[3]);
                *(u32x2*)(H + (size_t)r * D + 256 * j + lane * 4) = o;
            }
        }
    }
}

constexpr int PH_PER_LAYER = 9, NPHASE = 1 + DEPTH * PH_PER_LAYER;
constexpr int imax_c(int a, int b) { return a > b ? a : b; }
constexpr int LDS_MAIN = imax_c(imax_c(GEMM_LDS + 1024, ROUTE_LDS), imax_c(NW * RET_WAVE_LDS, NW * MIX_WAVE_LDS));
constexpr int LDS_MISC = (LDS_MAIN + 255) / 256 * 256;
constexpr int LDS_BYTES = LDS_MISC + 256;

__device__ __forceinline__ void run_phase(const Params& p, int ph, float* lds) {
    if (ph == 0) { phase_init(p, lds); return; }
    const int l = (ph - 1) / PH_PER_LAYER, q = (ph - 1) % PH_PER_LAYER;
    switch (q) {
        case 0: phase_inproj(p, l, lds); break;
        case 1: phase_prep(p, l, lds); break;
        case 2: phase_mix(p, l, lds); break;
        case 3: phase_retout(p, l, lds); break;
        case 4: phase_outproj(p, l, lds); break;
        case 5: phase_route(p, l, lds); break;
        case 6: phase_moe1(p, l, lds); break;
        case 7: phase_moe2(p, l, lds); break;
        default: phase_combine(p, l); break;
    }
}

#ifndef CPU_EMU
#define XB_TMO      128
#define XB_XCNT(j)  (256  + 64 * (j))
#define XB_XSUB(j)  (1280 + 64 * (j))
#define XB_XGEN(j)  (2304 + 64 * (j))
#define XB_TOP      3328
#define XB_TOPGEN   3392
#define XCD_BAR_WORDS 3456
#define XB_SPIN_CAP (1u << 22)
__device__ __forceinline__ unsigned xb_ld(unsigned* p)              { return __hip_atomic_load(p, __ATOMIC_RELAXED, __HIP_MEMORY_SCOPE_AGENT); }
__device__ __forceinline__ unsigned xb_add(unsigned* p, unsigned v) { return __hip_atomic_fetch_add(p, v, __ATOMIC_RELAXED, __HIP_MEMORY_SCOPE_AGENT); }
__device__ __forceinline__ unsigned xb_xcc_id() { return (unsigned)__builtin_amdgcn_s_getreg((3 << 11) | 20) & 0xFu; }
#define XB_SPIN(cond, bar) do { unsigned _sp = 0; while (cond) { __builtin_amdgcn_s_sleep(1); \
    if ((++_sp & 255u) == 0u) { if (xb_ld(&(bar)[XB_TMO])) break; if (_sp > XB_SPIN_CAP) { atomicAdd(&(bar)[XB_TMO], 1u); break; } } } } while (0)
struct XcdBarrier { unsigned* bar; unsigned x; volatile LAS unsigned* st; };
__device__ __forceinline__ XcdBarrier xcd_barrier_post(unsigned* bar, volatile LAS unsigned* st, bool t0) {
    XcdBarrier b; b.bar = bar; b.x = xb_xcc_id(); b.st = st;
    if (t0) (void)xb_add(&bar[XB_XCNT(b.x)], 1u);
    return b;
}
__device__ __forceinline__ void xcd_barrier_complete(unsigned* bar, unsigned x, unsigned& nloc, unsigned& nx) {
    const unsigned G = gridDim.x * gridDim.y * gridDim.z;
    unsigned sum, cnt, mine, sp = 0u;
    for (;;) {
        sum = 0u; cnt = 0u; mine = 0u;
#pragma unroll
        for (unsigned j = 0; j < 16; ++j) { const unsigned c = xb_ld(&bar[XB_XCNT(j)]); sum += c; cnt += (c > 0u) ? 1u : 0u; mine = (j == x) ? c : mine; }
        if (sum == G) break;
        __builtin_amdgcn_s_sleep(1);
        if ((++sp & 255u) == 0u) { if (xb_ld(&bar[XB_TMO])) break; if (sp > XB_SPIN_CAP) { atomicAdd(&bar[XB_TMO], 1u); break; } }
    }
    nloc = mine > 0u ? mine : 1u; nx = cnt > 0u ? cnt : 1u;
}
__device__ __forceinline__ void xcd_barrier(const XcdBarrier& b, bool t0) {
    asm volatile("s_waitcnt vmcnt(0)" ::: "memory");
    __syncthreads();
    if (t0) {
        unsigned* bar = b.bar;
        __builtin_amdgcn_s_waitcnt(0);
        unsigned nloc = b.st[0], nx = b.st[1];
        if (nloc == 0u) { xcd_barrier_complete(bar, b.x, nloc, nx); b.st[0] = nloc; b.st[1] = nx; }
        const unsigned old = xb_add(&bar[XB_XSUB(b.x)], 1u);
        const unsigned gen = old / nloc;
        if (old + 1u == (gen + 1u) * nloc) {
            __builtin_amdgcn_fence(__ATOMIC_RELEASE, "agent");
            asm volatile("s_waitcnt vmcnt(0)" ::: "memory");
            const unsigned og = xb_add(&bar[XB_TOP], 1u);
            const unsigned tg = og / nx;
            if (og + 1u == (tg + 1u) * nx) xb_add(&bar[XB_TOPGEN], 1u);
            else XB_SPIN(xb_ld(&bar[XB_TOPGEN]) == tg, bar);
            __builtin_amdgcn_fence(__ATOMIC_ACQUIRE, "agent");
            xb_add(&bar[XB_XGEN(b.x)], 1u);
            asm volatile("s_waitcnt vmcnt(0)" ::: "memory");
        } else {
            XB_SPIN(xb_ld(&bar[XB_XGEN(b.x)]) == gen, bar);
            __builtin_amdgcn_fence(__ATOMIC_ACQUIRE, "agent");
            asm volatile("s_waitcnt vmcnt(0)" ::: "memory");
        }
    }
    __syncthreads();
}
#endif
#ifndef CPU_EMU
__global__ void __launch_bounds__(NT) fwd_kernel(Params pin, int ph_lo, int ph_hi) {
    extern __shared__ __attribute__((aligned(16))) float lds[];
    cg::grid_group grid = cg::this_grid();
    Params p = pin; p.wid = uni((int)(threadIdx.x >> 6));
    volatile LAS unsigned* misc = (volatile LAS unsigned*)((LAS unsigned char*)lds + LDS_MISC);
    if (p.wid == 0) misc[lane_id()] = 0u;
    __syncthreads();
    XcdBarrier xb; xb.bar = (unsigned*)(p.ws + WS_CTL) + CTL_BAR; xb.x = 0; xb.st = misc;
    const bool use_xb = (ph_lo == 0);
#define T0() (p.wid == 0 && lane_id() == 0)
    if (use_xb) xb = xcd_barrier_post((unsigned*)(p.ws + WS_CTL) + CTL_BAR, misc, T0());
#define SEAM(k) do { if (!use_xb) grid.sync(); else xcd_barrier(xb, T0()); } while (0)
#define PHASE(k, call) do { if (ph_lo <= (k) && (k) < ph_hi) { call; if ((k) + 1 < ph_hi) SEAM(k); } } while (0)
#define LAYER(l) do { const int b_ = 1 + (l) * PH_PER_LAYER; \
        PHASE(b_ + 0, phase_inproj(p, l, lds)); PHASE(b_ + 1, phase_prep(p, l, lds)); PHASE(b_ + 2, phase_mix(p, l, lds)); \
        PHASE(b_ + 3, phase_retout(p, l, lds)); PHASE(b_ + 4, phase_outproj(p, l, lds)); PHASE(b_ + 5, phase_route(p, l, lds)); \
        PHASE(b_ + 6, phase_moe1(p, l, lds)); PHASE(b_ + 7, phase_moe2(p, l, lds)); PHASE(b_ + 8, phase_combine(p, l)); } while (0)
    PHASE(0, phase_init(p, lds));
    LAYER(0);
    LAYER(1);
    static_assert(DEPTH == 2, "phase program written for two layers");
#undef LAYER
#undef PHASE
#undef SEAM
}

#ifndef N_LAUNCH_PER_PHASE
#define N_LAUNCH_PER_PHASE 0
#endif
extern "C" void kernel_launch(void* const* d_in, const int* in_sizes, int n_in, void* d_out, int out_size, void* d_ws, size_t ws_size, hipStream_t stream) {
    static int grid = 0;
    if (grid == 0) {
        if (ws_size < WS_END) { fprintf(stderr, "kernel_launch: workspace too small (%zu < %zu)\n", ws_size, (size_t)WS_END); grid = -1; return; }
        int dev = 0, cus = 0, per_cu = 0;
        hipGetDevice(&dev);
        hipDeviceGetAttribute(&cus, hipDeviceAttributeMultiprocessorCount, dev);
        hipFuncSetAttribute((const void*)fwd_kernel, hipFuncAttributeMaxDynamicSharedMemorySize, LDS_BYTES);
        hipOccupancyMaxActiveBlocksPerMultiprocessor(&per_cu, (const void*)fwd_kernel, NT, LDS_BYTES);
        if (per_cu < 1) { fprintf(stderr, "kernel_launch: occupancy query says %d blocks per CU\n", per_cu); grid = -1; return; }
        grid = cus;
    }
    if (grid < 0) return;
    Params p{};
    p.x = (const float*)d_in[0]; p.norm_mix = (const float*)d_in[1]; p.w_in = (const float*)d_in[2]; p.b_forget = (const float*)d_in[3];
    p.g_ret = (const float*)d_in[4]; p.g_sb = (const float*)d_in[5]; p.g_fox = (const float*)d_in[6]; p.w_out = (const float*)d_in[7];
    p.norm_ffn = (const float*)d_in[8]; p.w_group = (const float*)d_in[9]; p.b_group = (const float*)d_in[10]; p.w_router = (const float*)d_in[11];
    p.b_router = (const float*)d_in[12]; p.w_gate = (const float*)d_in[13]; p.w_up = (const float*)d_in[14]; p.w_down = (const float*)d_in[15];
    p.norm_final = (const float*)d_in[16]; p.out = (float*)d_out; p.ws = (unsigned char*)d_ws;
#if N_LAUNCH_PER_PHASE
    for (int ph = 0; ph < NPHASE; ++ph) {
        int lo = ph, hi = ph + 1; void* args[] = {&p, &lo, &hi};
        hipLaunchCooperativeKernel((const void*)fwd_kernel, dim3(grid), dim3(NT), args, LDS_BYTES, stream);
    }
#else
    (void)hipMemsetAsync((char*)d_ws + WS_CTL + (size_t)CTL_BAR * 4, 0, 3456 * 4, stream);
    int lo = 0, hi = NPHASE; void* args[] = {&p, &lo, &hi};
    hipError_t e = hipLaunchCooperativeKernel((const void*)fwd_kernel, dim3(grid), dim3(NT), args, LDS_BYTES, stream);
    if (e != hipSuccess) fprintf(stderr, "cooperative launch failed: %s (grid %d)\n", hipGetErrorString(e), grid);
#endif
}
#endif
```

```cpp
#ifndef CPU_EMU
#include <hip/hip_runtime.h>
#include <hip/hip_cooperative_groups.h>
#include <cstdio>
#include <cstdint>
#include <cmath>
namespace cg = cooperative_groups;
#define VEC(T, N) T __attribute__((ext_vector_type(N)))
__device__ __forceinline__ void wave_barrier() { __builtin_amdgcn_wave_barrier(); }
__device__ __forceinline__ float sin2pi(float x) { return __builtin_amdgcn_sinf(x); }
__device__ __forceinline__ float cos2pi(float x) { return __builtin_amdgcn_cosf(x); }
__device__ __forceinline__ unsigned long long ballot64(bool p) { return __ballot(p); }
#define LAS __attribute__((address_space(3)))
typedef VEC(short, 8) bf16x8;
typedef VEC(float, 4) f32x4_;
__device__ __forceinline__ void glds16(const void* g, LAS unsigned char* l) { __builtin_amdgcn_global_load_lds((const unsigned*)g, (LAS unsigned*)l, 16, 0, 0); }
__device__ __forceinline__ void glds4(const void* g, LAS unsigned char* l) { __builtin_amdgcn_global_load_lds((const unsigned*)g, (LAS unsigned*)l, 4, 0, 0); }
__device__ __forceinline__ void vm_wait0() { asm volatile("s_waitcnt vmcnt(0)" ::: "memory"); }
__device__ __forceinline__ void lds_wait0() { asm volatile("s_waitcnt lgkmcnt(0)" ::: "memory"); }
__device__ __forceinline__ void sched_fence() { __builtin_amdgcn_sched_barrier(0); }
__device__ __forceinline__ int uni(int x) { return __builtin_amdgcn_readfirstlane(x); }
__device__ __forceinline__ unsigned ld_relaxed(const unsigned* p) { return __hip_atomic_load(p, __ATOMIC_RELAXED, __HIP_MEMORY_SCOPE_AGENT); }
__device__ __forceinline__ int xcc_shard() { return (int)(__builtin_amdgcn_s_getreg((3 << 11) | 20) & 7u); }
__device__ __forceinline__ int lane_id() { int l; asm volatile("v_mbcnt_lo_u32_b32 %0, -1, 0\n\tv_mbcnt_hi_u32_b32 %0, -1, %0" : "=v"(l)); return l; }
__device__ __forceinline__ f32x4_ mfma16(bf16x8 a, bf16x8 b, f32x4_ c) { return __builtin_amdgcn_mfma_f32_16x16x32_bf16(a, b, c, 0, 0, 0); }
typedef VEC(float, 16) f32x16;
typedef VEC(short, 4) s16x4;
__device__ __forceinline__ f32x16 mfma32(bf16x8 a, bf16x8 b, f32x16 c) { return __builtin_amdgcn_mfma_f32_32x32x16_bf16(a, b, c, 0, 0, 0); }
__device__ __forceinline__ s16x4 tr16(const LAS unsigned char* p) { return __builtin_amdgcn_ds_read_tr16_b64_v4i16((LAS s16x4*)p); }
__device__ __forceinline__ float fast_exp(float x) { return __expf(x); }
__device__ __forceinline__ float fast_log(float x) { return __logf(x); }
__device__ __forceinline__ float partner32(float x, int hi) { const auto rr = __builtin_amdgcn_permlane32_swap(__builtin_bit_cast(unsigned, x), __builtin_bit_cast(unsigned, x), false, false); return __builtin_bit_cast(float, hi ? rr[0] : rr[1]); }
template <int N> __device__ __forceinline__ float row_shl_add(float x) { return x + __builtin_bit_cast(float, __builtin_amdgcn_update_dpp(0, __builtin_bit_cast(int, x), 0x100 + N, 0xf, 0xf, true)); }
__device__ __forceinline__ float read_lane(float x, int l) { return __builtin_bit_cast(float, __builtin_amdgcn_readlane(__builtin_bit_cast(int, x), l)); }
#else
#define VEC(T, N) T __attribute__((vector_size(sizeof(T) * N)))
inline float sin2pi(float x) { return (float)sin(6.283185307179586 * (double)x); }
inline float cos2pi(float x) { return (float)cos(6.283185307179586 * (double)x); }
inline unsigned long long ballot64(bool p) { return emu_ballot(p); }
#define LAS
typedef VEC(short, 8) bf16x8;
inline void glds16(const void* g, unsigned char* l) { memcpy(l + (threadIdx.x & 63) * 16, g, 16); }
inline void glds4(const void* g, unsigned char* l) { memcpy(l + (threadIdx.x & 63) * 4, g, 4); }
inline void vm_wait0() {}
inline void lds_wait0() {}
inline void sched_fence() {}
inline int uni(int x) { return x; }
inline int xcc_shard() { return (int)(blockIdx.x & 7u); }
inline unsigned ld_relaxed(const unsigned* p) { return __atomic_load_n(p, __ATOMIC_RELAXED); }
inline int lane_id() { return threadIdx.x & 63; }
inline emu_f32x4 mfma16(bf16x8 a, bf16x8 b, emu_f32x4 c) { return emu_mfma16(a, b, c); }
typedef VEC(float, 16) f32x16;
typedef VEC(short, 4) s16x4;
inline f32x16 mfma32(bf16x8 a, bf16x8 b, f32x16 c) { return emu_mfma32(a, b, c); }
inline s16x4 tr16(const unsigned char* p) { return emu_tr16(p); }
inline float fast_exp(float x) { return expf(x); }
inline float fast_log(float x) { return logf(x); }
inline float partner32(float x, int hi) { return __shfl_xor(x, 32); }
template <int N> inline float row_shl_add(float x) { const int l = threadIdx.x & 63; const float o = emu_shfl_idx(x, (l + N) & 63); return x + (((l & 15) + N < 16) ? o : 0.f); }
inline float read_lane(float x, int l) { return emu_shfl_idx(x, l); }
#endif

typedef unsigned short bf16_t;
typedef VEC(float, 4) f32x4;
typedef VEC(float, 2) f32x2;
typedef VEC(unsigned, 2) u32x2;
typedef VEC(unsigned, 4) u32x4;
typedef LAS unsigned char lds_u8;

#ifdef SMALL_CFG
constexpr int D = 256, S = 512, DEPTH = 2, NRET = 2, NSB = 1, NFOX = 1, NG = 2, EPG = 4, DE = 128;
#else
constexpr int D = 1024, S = 16384, DEPTH = 2, NRET = 6, NSB = 5, NFOX = 5, NG = 4, EPG = 8, DE = 512;
#endif
constexpr int CH = 64, HD = 64, NE = NG * EPG;
constexpr int WRET = NRET * HD, WSB = NSB * HD, WFOX = NFOX * HD, MIXW = WRET + WSB + WFOX;
constexpr int IN_W = 4 * WRET + 3 * WSB + 3 * WFOX + NFOX;
constexpr int PW = (IN_W + 255) / 256 * 256;
constexpr int OQR = 0, OKR = WRET, OVR = 2 * WRET, OGR = 3 * WRET, OQS = 4 * WRET, OKS = OQS + WSB, OVS = OKS + WSB;
constexpr int OQF = OVS + WSB, OKF = OQF + WFOX, OVF = OKF + WFOX, OFL = OVF + WFOX;
constexpr int NCHUNK = S / CH;
constexpr float EPS = 1e-6f;
constexpr int NT = 512, NW = NT / 64;
constexpr int NROUTE = NG + NE;
constexpr float EXIT_T = 18.0f;

constexpr size_t al256(size_t x) { return (x + 255) / 256 * 256; }
constexpr size_t WS_CTL = 0;
constexpr int CTL_CNT = 0;
constexpr int CTL_KMAX = 256;
constexpr int CTL_MQ = 4608, CTL_WQ = 4608 + DEPTH * 8 * 64;
constexpr int CTL_BAR = 1024;
constexpr int CTL_WORDS = 8192;
static_assert(CTL_BAR + 3456 <= CTL_MQ && CTL_WQ + DEPTH * 8 * 64 <= CTL_WORDS, "control-word map");
constexpr size_t WS_ROT = 32768;
constexpr size_t WS_X = al256(WS_ROT + (size_t)S * 32 * 8);
constexpr size_t WS_H = al256(WS_X + (size_t)S * D * 4);
constexpr size_t WS_LOGF = al256(WS_H + (size_t)S * D * 2);
constexpr size_t WS_FCUM = al256(WS_LOGF + (size_t)S * 8 * 4);
constexpr size_t WS_LC = al256(WS_FCUM + (size_t)S * 8 * 4);
constexpr size_t WS_MERGED = al256(WS_LC + (size_t)S * 8 * 4);
constexpr size_t WS_U = al256(WS_MERGED + (size_t)S * MIXW * 2);
constexpr size_t WS_SP = al256(WS_U + (size_t)NRET * NCHUNK * 4096 * 4);
constexpr size_t WS_LIST = al256(WS_SP + (size_t)NRET * NCHUNK * 4096 * 4);
constexpr size_t WS_GATE = al256(WS_LIST + (size_t)NE * S * 4);
constexpr size_t WS_RSL = al256(WS_GATE + (size_t)S * 2 * 4);
constexpr size_t WS_GSL = al256(WS_RSL + (size_t)NE * S * 4);
constexpr size_t WS_RIMG = al256(WS_GSL + (size_t)NE * S * 4);
constexpr int RT_MT = (NROUTE + 15) / 16, RT_KW = D / NW, RT_KS = RT_KW / 32;
constexpr size_t WS_WIN = al256(WS_RIMG + (size_t)DEPTH * NW * RT_KS * RT_MT * 2 * 64 * 16);
constexpr size_t WS_WOUT = al256(WS_WIN + (size_t)DEPTH * PW * D * 2);
constexpr size_t WS_WGU = al256(WS_WOUT + (size_t)DEPTH * D * MIXW * 2);
constexpr size_t WS_WDN = al256(WS_WGU + (size_t)DEPTH * NE * 2 * DE * D * 2);
constexpr size_t WS_PROJ = al256(WS_WDN + (size_t)DEPTH * NE * D * DE * 2);
constexpr int HID_ROWS = 2 * S + NE * 256;
constexpr size_t WS_HID = WS_PROJ;
constexpr size_t WS_Y = al256(WS_HID + (size_t)HID_ROWS * DE * 2);
constexpr size_t WS_END0 = al256(WS_PROJ + (size_t)S * PW * 2), WS_END1 = al256(WS_Y + (size_t)2 * S * D * 2);
constexpr size_t WS_END = WS_END0 > WS_END1 ? WS_END0 : WS_END1;
#ifndef SMALL_CFG
static_assert(WS_END <= (size_t)512 * 1024 * 1024, "workspace map exceeds the guaranteed 512 MiB");
#endif

struct Params {
    const float* x; const float* norm_mix; const float* w_in; const float* b_forget; const float* g_ret; const float* g_sb; const float* g_fox;
    const float* w_out; const float* norm_ffn; const float* w_group; const float* b_group; const float* w_router; const float* b_router;
    const float* w_gate; const float* w_up; const float* w_down; const float* norm_final;
    float* out; unsigned char* ws;
    int wid, pad;
};

#define TIDX(p) (((p).wid << 6) | lane_id())
__device__ __forceinline__ int imin(int a, int b) { return a < b ? a : b; }
__device__ __forceinline__ float u2f(unsigned u) { return __builtin_bit_cast(float, u); }
__device__ __forceinline__ unsigned f2u(float f) { return __builtin_bit_cast(unsigned, f); }
__device__ __forceinline__ float bf2f(bf16_t b) { return u2f((unsigned)b << 16); }
__device__ __forceinline__ bf16_t f2bf(float f) { unsigned u = f2u(f); return (bf16_t)((u + 0x7fffu + ((u >> 16) & 1u)) >> 16); }
#ifndef CPU_EMU
typedef float pk_f32x2 __attribute__((ext_vector_type(2))); typedef __bf16 pk_bf16x2 __attribute__((ext_vector_type(2)));
__device__ __forceinline__ unsigned pk2(float lo, float hi) { const pk_f32x2 v = {lo, hi}; return __builtin_bit_cast(unsigned, __builtin_convertvector(v, pk_bf16x2)); }
#else
__device__ __forceinline__ unsigned pk2(float lo, float hi) { return (unsigned)f2bf(lo) | ((unsigned)f2bf(hi) << 16); }
#endif
__device__ __forceinline__ float log_sigmoid(float x) { return fminf(x, 0.f) - log1pf(expf(-fabsf(x))); }
__device__ __forceinline__ float log_sigmoid_fast(float x) { return fminf(x, 0.f) - fast_log(1.0f + fast_exp(-fabsf(x))); }
#ifndef CPU_EMU
__device__ __forceinline__ float silu(float x) { return x * __builtin_amdgcn_rcpf(1.f + __expf(-x)); }
#else
__device__ __forceinline__ float silu(float x) { return x / (1.f + expf(-x)); }
#endif
#ifndef CPU_EMU
template <int CTRL> __device__ __forceinline__ float dpp_mov(float x) { return __builtin_bit_cast(float, __builtin_amdgcn_update_dpp(0, __builtin_bit_cast(int, x), CTRL, 0xf, 0xf, false)); }
__device__ __forceinline__ float wave_sum(float v) {
    v += dpp_mov<0xB1>(v); v += dpp_mov<0x4E>(v); v += dpp_mov<0x141>(v); v += dpp_mov<0x140>(v);
    return (read_lane(v, 0) + read_lane(v, 16)) + (read_lane(v, 32) + read_lane(v, 48));
}
__device__ __forceinline__ float wave_max(float v) {
    v = fmaxf(v, dpp_mov<0xB1>(v)); v = fmaxf(v, dpp_mov<0x4E>(v)); v = fmaxf(v, dpp_mov<0x141>(v)); v = fmaxf(v, dpp_mov<0x140>(v));
    return fmaxf(fmaxf(read_lane(v, 0), read_lane(v, 16)), fmaxf(read_lane(v, 32), read_lane(v, 48)));
}
#else
__device__ __forceinline__ float wave_sum(float v) {
#pragma unroll
    for (int o = 1; o < 64; o <<= 1) v += __shfl_xor(v, o);
    return v;
}
__device__ __forceinline__ float wave_max(float v) {
#pragma unroll
    for (int o = 1; o < 64; o <<= 1) v = fmaxf(v, __shfl_xor(v, o));
    return v;
}
#endif
__device__ __forceinline__ double inv_turns(int j) {
    static constexpr double T[32] = {
        1.59154943091895346e-01, 1.19349370211248862e-01, 8.94994016088910133e-02, 6.71150830052272551e-02, 5.03292121044870353e-02, 3.77415847174197711e-02, 2.83021958306233987e-02, 2.12236527647776604e-02,
        1.59154943091895339e-02, 1.19349370211248862e-02, 8.94994016088910237e-03, 6.71150830052272534e-03, 5.03292121044870370e-03, 3.77415847174197719e-03, 2.83021958306233987e-03, 2.12236527647776622e-03,
        1.59154943091895356e-03, 1.19349370211248849e-03, 8.94994016088910237e-04, 6.71150830052272599e-04, 5.03292121044870326e-04, 3.77415847174197741e-04, 2.83021958306233954e-04, 2.12236527647776605e-04,
        1.59154943091895351e-04, 1.19349370211248862e-04, 8.94994016088910182e-05, 6.71150830052272545e-05, 5.03292121044870354e-05, 3.77415847174197768e-05, 2.83021958306233961e-05, 2.12236527647776592e-05};
    return T[j];
}

constexpr int VROWB = 144;
constexpr int IMG64 = 64 * VROWB;
constexpr int RET_WAVE_LDS = 2 * IMG64;
__device__ __forceinline__ int crow(int reg, int hi) { return (reg & 3) + 8 * (reg >> 2) + 4 * hi; }
__device__ __forceinline__ bf16x8 tr_frag(const lds_u8* base, int rowoff0, int rowoff1, int coloff) {
    const s16x4 lo = tr16(base + rowoff0 * VROWB + coloff), hi4 = tr16(base + rowoff1 * VROWB + coloff);
    bf16x8 f; f[0] = lo[0]; f[1] = lo[1]; f[2] = lo[2]; f[3] = lo[3]; f[4] = hi4[0]; f[5] = hi4[1]; f[6] = hi4[2]; f[7] = hi4[3]; return f;
}

constexpr int RJ = D / 256;
__device__ __forceinline__ void row_load(const float* row, f32x4* v, int lane) {
#pragma unroll
    for (int j = 0; j < RJ; ++j) v[j] = *(const f32x4*)(row + 256 * j + lane * 4);
}
__device__ __forceinline__ void row_load_bf16(const bf16_t* row, f32x4* v, int lane) {
#pragma unroll
    for (int j = 0; j < RJ; ++j) { const u32x2 w = *(const u32x2*)(row + 256 * j + lane * 4); v[j][0] = u2f(w[0] << 16); v[j][1] = u2f(w[0] & 0xffff0000u); v[j][2] = u2f(w[1] << 16); v[j][3] = u2f(w[1] & 0xffff0000u); }
}
__device__ __forceinline__ float row_rinv(const f32x4* v) {
    float s = 0.f;
#pragma unroll
    for (int j = 0; j < RJ; ++j) s += (v[j][0] * v[j][0] + v[j][1] * v[j][1]) + (v[j][2] * v[j][2] + v[j][3] * v[j][3]);
    s = wave_sum(s);
    return 1.0f / sqrtf(s * (1.0f / D) + EPS);
}

#ifndef CPU_EMU
typedef float f32x4_u __attribute__((ext_vector_type(4), aligned(4)));
#else
typedef float f32x4_u __attribute__((vector_size(16), aligned(4)));
#endif
#ifndef CPU_EMU
__device__ __forceinline__ f32x4_u nt_load4(const f32x4_u* p) { return __builtin_nontemporal_load(p); }
#else
inline f32x4_u nt_load4(const f32x4_u* p) { return *p; }
#endif
struct TrDesc { const float* Wa; const float* Wb; int ldw, ncols, c0, cb0, k0; bf16_t* WT; int ldt, r0, r1; const float* sc; };
__device__ __forceinline__ void tr_load(const TrDesc& d, f32x4 (&v)[16], int lane) {
    const int n = 4 * (lane & 15), kr = lane >> 4;
    const float* src = (n < 32 ? d.Wa + d.c0 + n : d.Wb + d.cb0 + (n - 32)) + (size_t)(d.k0 + kr) * d.ldw;
    const int col = (n < 32 ? d.c0 + n : d.cb0 + n - 32);
    if (col + 3 < d.ncols) {
#pragma unroll
        for (int i = 0; i < 16; ++i) { const f32x4_u t = nt_load4((const f32x4_u*)(src + (size_t)(4 * i) * d.ldw)); v[i][0] = t[0]; v[i][1] = t[1]; v[i][2] = t[2]; v[i][3] = t[3]; }
    } else {
#pragma unroll
        for (int i = 0; i < 16; ++i)
#pragma unroll
            for (int j = 0; j < 4; ++j) v[i][j] = (col + j < d.ncols) ? src[(size_t)(4 * i) * d.ldw + j] : 0.f;
    }
    if (d.sc) {
        float sc[16];
#pragma unroll
        for (int i = 0; i < 16; ++i) sc[i] = d.sc[d.k0 + kr + 4 * i];
#pragma unroll
        for (int i = 0; i < 16; ++i) v[i] = v[i] * sc[i];
    }
}
__device__ __forceinline__ void tr_store(const TrDesc& d, const f32x4 (&v)[16], lds_u8* img, int lane) {
    const int n = 4 * (lane & 15), kr = lane >> 4;
    wave_barrier();
#pragma unroll
    for (int i = 0; i < 16; ++i) { u32x2 o; o[0] = pk2(v[i][0], v[i][1]); o[1] = pk2(v[i][2], v[i][3]); *(LAS u32x2*)(img + (4 * i + kr) * VROWB + n * 2) = o; }
    wave_barrier();
    const lds_u8* tb = img + ((lane & 15) >> 2) * VROWB + (16 * (lane >> 4) + 4 * (lane & 3)) * 2;
    u32x4 o[8];
#pragma unroll
    for (int kc = 0; kc < 8; ++kc) {
        const s16x4 lo = tr16(tb + (8 * kc) * VROWB), hi4 = tr16(tb + (8 * kc + 4) * VROWB);
        o[kc][0] = (unsigned)(unsigned short)lo[0] | ((unsigned)(unsigned short)lo[1] << 16); o[kc][1] = (unsigned)(unsigned short)lo[2] | ((unsigned)(unsigned short)lo[3] << 16);
        o[kc][2] = (unsigned)(unsigned short)hi4[0] | ((unsigned)(unsigned short)hi4[1] << 16); o[kc][3] = (unsigned)(unsigned short)hi4[2] | ((unsigned)(unsigned short)hi4[3] << 16);
    }
    wave_barrier();
#pragma unroll
    for (int kc = 0; kc < 8; ++kc) *(LAS u32x4*)(img + lane * VROWB + kc * 16) = o[kc];
    wave_barrier();
#pragma unroll
    for (int j = 0; j < 8; ++j) {
        const int n = (lane >> 3) + 8 * j, kc = lane & 7;
        const int xx = n & 31, pos32 = 16 * ((xx >> 2) & 1) + 4 * (xx >> 3) + (xx & 3);
        const u32x4 v4 = *(const LAS u32x4*)(img + n * VROWB + kc * 16);
        *(u32x4*)(d.WT + (size_t)((n < 32 ? d.r0 : d.r1) + pos32) * d.ldt + d.k0 + 8 * kc) = v4;
    }
}
constexpr int WI_IN = (D / 64) * ((IN_W + 63) / 64), WI_OUT = (MIXW / 64) * (D / 64), WI_GU = (D / 64) * (DE / 32), WI_DN = (DE / 64) * (D / 64);
constexpr int WI_DENSE = WI_IN + WI_OUT, WI_EXPERT = WI_GU + WI_DN, WI_LAYER = WI_DENSE + NE * WI_EXPERT;
__device__ __forceinline__ TrDesc weight_desc(const Params& p, int l, int r) {
    if (r < WI_IN) { const int nb = (IN_W + 63) / 64, c0 = (r % nb) * 64; const float* W = p.w_in + (size_t)l * D * IN_W;
        const int r0 = (c0 / 256) * 256 + ((c0 % 256) / 64) * 32;
        return TrDesc{W, W, IN_W, IN_W, c0, c0 + 32, (r / nb) * 64, (bf16_t*)(p.ws + WS_WIN) + (size_t)l * PW * D, D, r0, r0 + 128, nullptr}; }
    r -= WI_IN;
    if (r < WI_OUT) { const int nb = D / 64, c0 = (r % nb) * 64; const float* W = p.w_out + (size_t)l * MIXW * D;
        return TrDesc{W, W, D, D, c0, c0 + 32, (r / nb) * 64, (bf16_t*)(p.ws + WS_WOUT) + (size_t)l * D * MIXW, MIXW, c0, c0 + 32, nullptr}; }
    r -= WI_OUT;
    const int e = r / WI_EXPERT; r %= WI_EXPERT;
    if (r < WI_GU) { const int nb = DE / 32, c0 = (r % nb) * 32;
        const int r0 = (c0 / 128) * 256 + (c0 % 128);
        return TrDesc{p.w_gate + (size_t)(l * NE + e) * D * DE, p.w_up + (size_t)(l * NE + e) * D * DE, DE, DE, c0, c0, (r / nb) * 64, (bf16_t*)(p.ws + WS_WGU) + (size_t)(l * NE + e) * 2 * DE * D, D, r0, r0 + 128, p.norm_ffn + l * D}; }
    r -= WI_GU;
    { const int nb = D / 64, c0 = (r % nb) * 64; const float* W = p.w_down + (size_t)(l * NE + e) * DE * D;
        return TrDesc{W, W, D, D, c0, c0 + 32, (r / nb) * 64, (bf16_t*)(p.ws + WS_WDN) + (size_t)(l * NE + e) * D * DE, DE, c0, c0 + 32, nullptr}; }
}
__device__ __forceinline__ void weight_item(const Params& p, int l, int r, lds_u8* img, int lane) { const TrDesc d = weight_desc(p, l, r); f32x4 v[16]; tr_load(d, v, lane); tr_store(d, v, img, lane); }
__device__ __forceinline__ void weight_item2(const Params& p, int l, int ra, int rb, lds_u8* img, int lane) {
    const TrDesc da = weight_desc(p, l, ra), db = weight_desc(p, l, rb); f32x4 va[16], vb[16];
    tr_load(da, va, lane); tr_load(db, vb, lane); tr_store(da, va, img, lane); tr_store(db, vb, img + IMG64, lane);
}
__device__ __forceinline__ void phase_init(const Params& p, float* lds) {
    unsigned* ctl = (unsigned*)(p.ws + WS_CTL);
    if (blockIdx.x == 0) for (int i = TIDX(p); i < CTL_WORDS; i += NT) if (i < CTL_BAR || i >= CTL_BAR + 3456) ctl[i] = 0u;
    f32x2* rot = (f32x2*)(p.ws + WS_ROT);
    for (int i = blockIdx.x * NT + TIDX(p); i < S * 32; i += gridDim.x * NT) {
        const int pos = i >> 5, j = i & 31;
        const double turns = (double)pos * inv_turns(j);
        const double fr = turns - floor(turns);
        f32x2 cs; cs[0] = cos2pi((float)fr); cs[1] = sin2pi((float)fr);
        rot[i] = cs;
    }
    for (int idx = blockIdx.x * NT + TIDX(p); idx < DEPTH * NW * RT_KS * RT_MT * 64; idx += gridDim.x * NT) {
        const int ln = idx & 63, f = idx >> 6, m = f % RT_MT, s = (f / RT_MT) % RT_KS, w = (f / (RT_MT * RT_KS)) % NW, l = f / (RT_MT * RT_KS * NW);
        const int row = 16 * m + (ln & 15), k0 = w * RT_KW + 32 * s + 8 * (ln >> 4);
        float v[8];
#pragma unroll
        for (int j = 0; j < 8; ++j) { const int k = k0 + j;
            const float wv = row < NG ? p.w_group[((size_t)l * D + k) * NG + row] : (row < NROUTE ? p.w_router[((size_t)l * D + k) * NE + (row - NG)] : 0.f);
            v[j] = wv * p.norm_ffn[l * D + k]; }
        u32x4 hi, lo;
#pragma unroll
        for (int j = 0; j < 4; ++j) { const unsigned h = pk2(v[2 * j], v[2 * j + 1]); hi[j] = h; lo[j] = pk2(v[2 * j] - u2f(h << 16), v[2 * j + 1] - u2f(h & 0xffff0000u)); }
        u32x4* dst = (u32x4*)(p.ws + WS_RIMG) + (size_t)f * 2 * 64 + ln;
        dst[0] = hi; dst[64] = lo;
    }
    const int lane = lane_id(), wave = p.wid;
    {
        lds_u8* img = (lds_u8*)lds + wave * RET_WAVE_LDS;
        for (int it = (int)gridDim.x * NW - 1 - ((int)blockIdx.x * NW + wave); it < WI_DENSE; it += gridDim.x * NW) weight_item(p, 0, it, img, lane);
    }
    bf16_t* H = (bf16_t*)(p.ws + WS_H);
    for (int r = blockIdx.x * NW + wave; r < S; r += gridDim.x * NW) {
        f32x4 v[RJ]; row_load(p.x + (size_t)r * D, v, lane);
        const float ri = row_rinv(v);
#pragma unroll
        for (int j = 0; j < RJ; ++j) {
            const f32x4 g = *(const f32x4*)(p.norm_mix + 256 * j + lane * 4);
            u32x2 o; o[0] = pk2(v[j][0] * ri * g[0], v[j][1] * ri * g[1]); o[1] = pk2(v[j][2] * ri * g[2], v[j][3] * ri * g[3]);
            *(u32x2*)(H + (size_t)r * D + 256 * j + lane * 4) = o;
        }
    }
}

constexpr int GBM = 256, GBK = 64, TILE_B = GBM * GBK * 2, STAGE_B = 2 * TILE_B, GEMM_LDS = 2 * STAGE_B;
__device__ __forceinline__ int lds_byte(int r, int c) { const int st = r >> 3, rr = r & 7; return st * 1024 + rr * 128 + ((((c >> 3) ^ (rr >> 1)) ^ ((st & 1) << 2)) << 4) + (c & 7) * 2; }
__device__ __forceinline__ void stage_rc(int b, int& R, int& C) { const int st = b >> 10, sb = b & 1023, rr = sb >> 7, pc = (sb >> 4) & 7; R = st * 8 + rr; C = (((pc ^ (rr >> 1)) ^ ((st & 1) << 2)) << 3) + ((sb & 15) >> 1); }
__device__ __forceinline__ int vcu_id() { const int G = gridDim.x, b = blockIdx.x; return (G % 8 == 0) ? (b % 8) * (G / 8) + b / 8 : b; }

constexpr int HTB = 128 * GBK * 2;
struct GUnit { unsigned A, B; unsigned ao[4]; int i0, i1, i2, i3; };
#ifndef CPU_EMU
#define G8_WAIT_V(n) asm volatile("s_waitcnt vmcnt(" #n ")" ::: "memory")
#define G8_WAIT_L0() asm volatile("s_waitcnt lgkmcnt(0)" ::: "memory")
#define G8_BAR() __builtin_amdgcn_s_barrier()
#define G8_PRIO(x) __builtin_amdgcn_s_setprio(x)
#else
#define G8_WAIT_V(n) do {} while (0)
#define G8_WAIT_L0() do {} while (0)
#define G8_BAR() __syncthreads()
#define G8_PRIO(x) do {} while (0)
#endif
template <class Sched, class Epi>
__device__ __forceinline__ void gemm_stream(lds_u8* lds, const char* Abase, const char* Bbase, const int K, Sched& S, const Epi& E) {
    const int wid = S.wid, lane = lane_id(), tid = (wid << 6) | lane, wr = wid >> 2, wc = wid & 3, fr = lane & 15, fq = lane >> 4;
    const int nt = K / GBK;
    unsigned voffB[2];
    { int R, C; stage_rc(tid * 16, R, C); voffB[0] = (unsigned)((R * K + C) * 2); stage_rc(tid * 16 + 8192, R, C); voffB[1] = (unsigned)((R * K + C) * 2); }
    const unsigned hstepB = (unsigned)(128 * K * 2), hstepA = hstepB;
    lds_u8* ldsw = lds + wid * 1024;
    const int aoff = lds_byte(wr * 64 + fr, fq * 8), boff = lds_byte(wc * 32 + fr, fq * 8);
#define G8_SA(b, h) (((b) * 2 + (h)) * HTB)
#define G8_SB(b, h) ((4 + (b) * 2 + (h)) * HTB)
#define G8_STAGE_A(b, h, U, kt) do { _Pragma("unroll") for (int i_ = 0; i_ < 2; ++i_) glds16(Abase + ((size_t)(U).A + (size_t)((kt) * (GBK * 2)) + (Sched::GATHER ? (size_t)0 : (size_t)(h) * hstepA)) + (Sched::GATHER ? (U).ao[2 * (h) + i_] : S.ao[i_]), ldsw + G8_SA(b, h) + i_ * 8192); } while (0)
#define G8_STAGE_B(b, h, U, kt) do { _Pragma("unroll") for (int i_ = 0; i_ < 2; ++i_) glds16(Bbase + ((size_t)(U).B + (size_t)((kt) * (GBK * 2)) + (size_t)(h) * hstepB) + voffB[i_], ldsw + G8_SB(b, h) + i_ * 8192); } while (0)
#define G8_LDA(dst, b, h) do { _Pragma("unroll") for (int m = 0; m < 4; ++m) _Pragma("unroll") for (int k = 0; k < 2; ++k) dst[m][k] = *(const LAS bf16x8*)(lds + G8_SA(b, h) + (aoff ^ (k * 64)) + m * 2048); } while (0)
#define G8_LDB(dst, b, h) do { _Pragma("unroll") for (int n = 0; n < 2; ++n) _Pragma("unroll") for (int k = 0; k < 2; ++k) dst[n][k] = *(const LAS bf16x8*)(lds + G8_SB(b, h) + (boff ^ (k * 64)) + n * 2048); } while (0)
#define G8_MMA(ai, bj, At_, Bt_) do { G8_PRIO(1); _Pragma("unroll") for (int m = 0; m < 4; ++m) _Pragma("unroll") for (int n = 0; n < 2; ++n) _Pragma("unroll") for (int k = 0; k < 2; ++k) \
        acc[ai][bj][m][n] = mfma16(Bt_[n][k], At_[m][k], acc[ai][bj][m][n]); G8_PRIO(0); } while (0)
    GUnit cur, nxt; int ui = 0;
    if (!S.next(0, cur)) return;
    if constexpr (Sched::GATHER) { vm_wait0(); S.finish(cur); }
    f32x4 acc[2][2][4][2];
#pragma unroll
    for (int a = 0; a < 2; ++a)
#pragma unroll
        for (int b = 0; b < 2; ++b)
#pragma unroll
            for (int m = 0; m < 4; ++m)
#pragma unroll
                for (int n = 0; n < 2; ++n) acc[a][b][m][n] = (f32x4){0.f, 0.f, 0.f, 0.f};
    bf16x8 At[4][2], B0[2][2], B1[2][2];
    G8_STAGE_B(0, 0, cur, 0); G8_STAGE_B(0, 1, cur, 0); G8_STAGE_A(0, 0, cur, 0); G8_STAGE_A(0, 1, cur, 0);
    if (wr == 1) G8_BAR();
    G8_WAIT_V(2); G8_BAR();
    G8_STAGE_B(1, 0, cur, 1); G8_STAGE_A(1, 0, cur, 1); G8_STAGE_B(1, 1, cur, 1);
    G8_WAIT_V(6); G8_BAR();
    for (;;) {
        const bool has_next = S.next(ui + 1, nxt);
        if (!has_next) nxt = cur;
        for (int t = 0; t < nt; t += 2) {
            const bool last = (t == nt - 2);
            if constexpr (Sched::GATHER) { if (last && has_next) S.finish(nxt); }
            const GUnit& U2 = last ? nxt : cur;
            const int k2 = last ? 0 : t + 2, k3 = k2 + 1;
            G8_LDB(B0, 0, 0); G8_LDB(B1, 0, 1); sched_fence(); G8_LDA(At, 0, 0); G8_STAGE_A(1, 1, cur, t + 1);
            G8_WAIT_V(8); G8_WAIT_L0(); G8_BAR(); G8_MMA(0, 0, At, B0); G8_MMA(0, 1, At, B1); G8_BAR(); sched_fence();
            G8_LDA(At, 0, 1); G8_STAGE_B(0, 0, U2, k2); G8_STAGE_B(0, 1, U2, k2); G8_STAGE_A(0, 0, U2, k2);
            G8_WAIT_V(8); G8_WAIT_L0(); G8_BAR(); G8_MMA(1, 0, At, B0); G8_MMA(1, 1, At, B1); G8_BAR(); sched_fence();
            G8_LDB(B0, 1, 0); G8_LDB(B1, 1, 1); sched_fence(); G8_LDA(At, 1, 0); G8_STAGE_A(0, 1, U2, k2);
            G8_WAIT_V(8); G8_WAIT_L0(); G8_BAR(); G8_MMA(0, 0, At, B0); G8_MMA(0, 1, At, B1); G8_BAR(); sched_fence();
            G8_LDA(At, 1, 1); G8_STAGE_B(1, 0, U2, k3); G8_STAGE_B(1, 1, U2, k3); G8_STAGE_A(1, 0, U2, k3);
            G8_WAIT_V(8); G8_WAIT_L0(); G8_BAR(); G8_MMA(1, 0, At, B0); G8_MMA(1, 1, At, B1); G8_BAR(); sched_fence();
        }
        if (wr == 0) G8_BAR();
        E(acc, cur, wr, wc, fr, fq);
        if (!has_next) break;
#pragma unroll
        for (int a = 0; a < 2; ++a)
#pragma unroll
            for (int b = 0; b < 2; ++b)
#pragma unroll
                for (int m = 0; m < 4; ++m)
#pragma unroll
                    for (int n = 0; n < 2; ++n) acc[a][b][m][n] = (f32x4){0.f, 0.f, 0.f, 0.f};
        cur = nxt; ++ui;
        if (wr == 1) G8_BAR();
    }
    G8_WAIT_V(0);
    G8_BAR();
#undef G8_SA
#undef G8_SB
#undef G8_STAGE_A
#undef G8_STAGE_B
#undef G8_LDA
#undef G8_LDB
#undef G8_MMA
}
__device__ __forceinline__ void plain_ao(unsigned (&ao)[4], int K, int tid) {
    int R, C; stage_rc(tid * 16, R, C); ao[0] = (unsigned)((R * K + C) * 2); ao[2] = ao[0] + (unsigned)(128 * K * 2);
    stage_rc(tid * 16 + 8192, R, C); ao[1] = (unsigned)((R * K + C) * 2); ao[3] = ao[1] + (unsigned)(128 * K * 2);
}

struct InprojSched {
    static constexpr bool GATHER = false;
    int wid;
    unsigned ao[4]; int vcu, G;
    static constexpr int NPM = S / GBM, NPN = PW / GBM;
    __device__ __forceinline__ bool next(int i, GUnit& u) const {
        constexpr int NU = NPM * NPN;
        const int full = NU / G, rem = NU % G, stride = rem > 0 ? G / rem : 1;
        int Lr;
        if (i < full || stride < 2) Lr = i * G + vcu;
        else if (i == full && vcu % stride == 0) Lr = full * G + vcu / stride;
        else return false;
        const int L = uni(Lr); if (L >= NU) return false;
        constexpr int WGM = 8, nig = WGM * NPN;
        const int gid = L / nig, fm = gid * WGM, gsz = (NPM - fm) < WGM ? (NPM - fm) : WGM;
        const int pm = fm + (L % nig) % gsz, pn = (L % nig) / gsz;
        u.A = (unsigned)(pm * GBM * D * 2); u.B = (unsigned)(pn * GBM * D * 2); u.ao[0] = u.ao[1] = u.ao[2] = u.ao[3] = 0u;
        u.i0 = pm; u.i1 = pn; u.i2 = 0; u.i3 = 0; return true;
    }
};
struct InprojEpi {
    bf16_t* P; float* LOGF; unsigned* kmaxw; const f32x2* rot; const float* bfg;
    __device__ __forceinline__ void operator()(f32x4 (&acc)[2][2][4][2], const GUnit& u, int wr, int wc, int fr, int fq) const {
        const int gc0 = u.i1 * GBM + wc * 64;
        if (gc0 >= IN_W) return;
        const int row0 = u.i0 * GBM + wr * 64 + fr;
        if (gc0 >= OFL) {
            float bfv[8];
#pragma unroll
            for (int h = 0; h < 8; ++h) bfv[h] = bfg[h < NFOX ? h : 0];
#pragma unroll
            for (int ai = 0; ai < 2; ++ai)
#pragma unroll
                for (int m = 0; m < 4; ++m)
#pragma unroll
                    for (int n = 0; n < 2; ++n)
#pragma unroll
                        for (int j = 0; j < 4; ++j) { const int h = 4 * n + j; if (fq == 0 && h < NFOX) LOGF[(size_t)h * S + row0 + ai * 128 + m * 16] = log_sigmoid_fast(acc[ai][0][m][n][j] + bfv[h]); }
            return;
        }
        const bool rotary = gc0 < OVR, is_gate = (gc0 >= OGR && gc0 < OQS), is_kf = (gc0 >= OKF && gc0 < OVF);
        const float scale = (gc0 < OKR || (gc0 >= OQS && gc0 < OKS) || (gc0 >= OQF && gc0 < OKF)) ? 0.125f : 1.0f;
        float kmx = 0.f;
        if (rotary) {
#pragma unroll
            for (int am = 0; am < 4; ++am) {
                const int ai = am >> 1, m0 = (am & 1) * 2;
                f32x4 c01[2][2], c23[2][2];
#pragma unroll
                for (int mm = 0; mm < 2; ++mm)
#pragma unroll
                    for (int n = 0; n < 2; ++n) { const f32x2* rp = rot + (size_t)(row0 + ai * 128 + (m0 + mm) * 16) * 32 + 8 * fq + 4 * n; c01[mm][n] = *(const f32x4*)rp; c23[mm][n] = *(const f32x4*)(rp + 2); }
#pragma unroll
                for (int mm = 0; mm < 2; ++mm)
#pragma unroll
                    for (int n = 0; n < 2; ++n) {
                        const int m = m0 + mm;
                        const float cs[4] = {c01[mm][n][0], c01[mm][n][2], c23[mm][n][0], c23[mm][n][2]}, sn[4] = {c01[mm][n][1], c01[mm][n][3], c23[mm][n][1], c23[mm][n][3]};
#pragma unroll
                        for (int j = 0; j < 4; ++j) { const float x1 = acc[ai][0][m][n][j], x2 = acc[ai][1][m][n][j]; acc[ai][0][m][n][j] = x1 * cs[j] - x2 * sn[j]; acc[ai][1][m][n][j] = x1 * sn[j] + x2 * cs[j]; }
                    }
                sched_fence();
            }
        }
#pragma unroll
        for (int ai = 0; ai < 2; ++ai)
#pragma unroll
            for (int m = 0; m < 4; ++m) {
                const int row = row0 + ai * 128 + m * 16;
                float ss = 0.f;
#pragma unroll
                for (int bj = 0; bj < 2; ++bj) {
                    u32x4 o;
#pragma unroll
                    for (int n = 0; n < 2; ++n) {
                        f32x4 v = acc[ai][bj][m][n] * scale;
                        if (is_gate) {
#pragma unroll
                            for (int j = 0; j < 4; ++j) v[j] = silu(v[j]);
                        }
                        o[2 * n] = pk2(v[0], v[1]); o[2 * n + 1] = pk2(v[2], v[3]);
                        if (is_kf) {
#pragma unroll
                            for (int j = 0; j < 4; ++j) { const float r = bf2f(f2bf(v[j])); ss += r * r; }
                        }
                    }
                    *(u32x4*)(P + (size_t)row * PW + gc0 + 32 * bj + 8 * fq) = o;
                }
                if (is_kf) { ss += __shfl_xor(ss, 16); ss += __shfl_xor(ss, 32); kmx = fmaxf(kmx, ss); }
            }
        if (is_kf) { kmx = wave_max(kmx); if (lane_id() == 0) atomicMax(kmaxw + (gc0 - OKF) / HD, f2u(kmx)); }
    }
};
__device__ __forceinline__ void phase_inproj(const Params& p, int l, float* ldsf) {
    InprojSched S; S.wid = p.wid; plain_ao(S.ao, D, TIDX(p)); S.vcu = vcu_id(); S.G = gridDim.x;
    InprojEpi E; E.P = (bf16_t*)(p.ws + WS_PROJ); E.LOGF = (float*)(p.ws + WS_LOGF); E.kmaxw = (unsigned*)(p.ws + WS_CTL) + CTL_KMAX + l * 8; E.rot = (const f32x2*)(p.ws + WS_ROT); E.bfg = p.b_forget + l * NFOX;
    gemm_stream((lds_u8*)ldsf, (const char*)(p.ws + WS_H), (const char*)(p.ws + WS_WIN) + (size_t)l * PW * D * 2, D, S, E);
}

__device__ __forceinline__ float ret_log_gamma(int h) { return logf(1.0f - exp2f(-5.0f - (float)h)); }
__device__ __forceinline__ void ret_prep_item(const Params& p, int h, int n, lds_u8* wl) {
    const bf16_t* P = (const bf16_t*)(p.ws + WS_PROJ);
    float* UT = (float*)(p.ws + WS_U);
    const int lane = lane_id(), r32 = lane & 31, hi = lane >> 5;
    const float lg = ret_log_gamma(h);
    wave_barrier();
#pragma unroll
    for (int i = 0; i < 8; ++i) {
        const int c = lane + 64 * i, row = c >> 3, ch = c & 7;
        const bf16_t* src = P + (size_t)(n * CH + row) * PW + h * HD + 8 * ch;
        const u32x4 kv = *(const u32x4*)(src + OKR), vv = *(const u32x4*)(src + OVR);
        const float dk = fast_exp(lg * (float)(CH - 1 - row));
        u32x4 ko;
#pragma unroll
        for (int w = 0; w < 4; ++w) ko[w] = pk2(u2f(kv[w] << 16) * dk, u2f(kv[w] & 0xffff0000u) * dk);
        *(LAS u32x4*)(wl + row * VROWB + ch * 16) = ko;
        *(LAS u32x4*)(wl + IMG64 + row * VROWB + ch * 16) = vv;
    }
    wave_barrier();
    const lds_u8* tb = wl + (8 * hi + ((lane & 15) >> 2)) * VROWB + (16 * ((lane >> 4) & 1) + 4 * (lane & 3)) * 2;
    f32x16 acc[2][2];
#pragma unroll
    for (int a = 0; a < 2; ++a)
#pragma unroll
        for (int b = 0; b < 2; ++b)
#pragma unroll
            for (int r = 0; r < 16; ++r) acc[a][b][r] = 0.f;
#pragma unroll
    for (int s = 0; s < 4; ++s) {
        bf16x8 vf[2], kf[2];
#pragma unroll
        for (int x = 0; x < 2; ++x) { kf[x] = tr_frag(tb, 16 * s, 16 * s + 4, x * 64); vf[x] = tr_frag(tb + IMG64, 16 * s, 16 * s + 4, x * 64); }
#pragma unroll
        for (int eb = 0; eb < 2; ++eb)
#pragma unroll
            for (int db = 0; db < 2; ++db) acc[eb][db] = mfma32(vf[eb], kf[db], acc[eb][db]);
    }
    float* dst = UT + (size_t)(h * NCHUNK + n) * 4096;
#pragma unroll
    for (int eb = 0; eb < 2; ++eb)
#pragma unroll
        for (int db = 0; db < 2; ++db)
#pragma unroll
            for (int r = 0; r < 16; ++r) dst[(32 * eb + crow(r, hi)) * 64 + 32 * db + r32] = acc[eb][db][r];
}
__device__ __forceinline__ void fcum_block(const Params& p, int h, float* ldsf) {
    const float* LF = (const float*)(p.ws + WS_LOGF) + (size_t)h * S;
    float* F = (float*)(p.ws + WS_FCUM) + (size_t)h * S;
    float* LC = (float*)(p.ws + WS_LC) + (size_t)h * S;
    constexpr int KPT = S / NT;
    const int tid = TIDX(p), lane = lane_id(), w = p.wid;
    float v[KPT], a[KPT];
#pragma unroll
    for (int i = 0; i < KPT; ++i) { v[i] = LF[tid * KPT + i]; a[i] = expf(v[i]); }
    float A = 1.f, B = 0.f;
#pragma unroll
    for (int i = 0; i < KPT; ++i) { A *= a[i]; B = a[i] * B + 1.f; }
#pragma unroll
    for (int i = 1; i < KPT; ++i) v[i] += v[i - 1];
    float inc = v[KPT - 1];
    float Ai = A, Bi = B;
#pragma unroll
    for (int d = 1; d < 64; d <<= 1) {
        const float o = __shfl_up(inc, d), Ao = __shfl_up(Ai, d), Bo = __shfl_up(Bi, d);
        if (lane >= d) { inc += o; Bi = Ai * Bo + Bi; Ai = Ai * Ao; }
    }
    __syncthreads();
    if (lane == 63) { ldsf[w] = inc; ldsf[16 + w] = Ai; ldsf[32 + w] = Bi; }
    __syncthreads();
    float off = inc - v[KPT - 1];
    float x = 0.f;
    for (int ww = 0; ww < w; ++ww) { off += ldsf[ww]; x = ldsf[16 + ww] * x + ldsf[32 + ww]; }
    { const float Ae = __shfl_up(Ai, 1), Be = __shfl_up(Bi, 1); if (lane > 0) x = Ae * x + Be; }
#pragma unroll
    for (int i = 0; i < KPT; ++i) { F[tid * KPT + i] = v[i] + off; LC[tid * KPT + i] = x > 0.f ? logf(x) : -1e30f; x = a[i] * x + 1.f; }
    __syncthreads();
}
__device__ __forceinline__ void phase_prep(const Params& p, int l, float* ldsf) {
    const bool split = (int)gridDim.x > 2 * NFOX;
    if ((int)blockIdx.x < NFOX) { fcum_block(p, (int)blockIdx.x, ldsf); if (split) return; }
    const int wave = p.wid;
    lds_u8* wl = (lds_u8*)ldsf + wave * RET_WAVE_LDS;
    const int b0 = split ? NFOX : 0;
    const int nb = (int)gridDim.x - b0;
    for (int it = wave * nb + ((int)blockIdx.x - b0); it < NRET * NCHUNK; it += nb * NW) ret_prep_item(p, it / NCHUNK, it % NCHUNK, wl);
}

constexpr int NQ32 = S / 32;
constexpr int MIX_WAVE_LDS = 32 * VROWB;
__device__ __forceinline__ void ret_scan_wave(const Params& p, int item) {
    const float* U = (const float*)(p.ws + WS_U);
    bf16_t* SP = (bf16_t*)(p.ws + WS_SP);
    const int e = item * 64 + lane_id();
    const int h = e >> 12, de = e & 4095;
    const float c = expf(ret_log_gamma(h) * (float)CH);
    float st = 0.f;
    const size_t base = (size_t)h * NCHUNK * 4096 + de;
#pragma unroll 1
    for (int n0 = 0; n0 < NCHUNK; n0 += 64) {
        float u[64];
#pragma unroll
        for (int i = 0; i < 64; ++i) u[i] = (n0 + i < NCHUNK) ? U[base + (size_t)(n0 + i) * 4096] : 0.f;
#pragma unroll
        for (int i = 0; i < 64; ++i) if (n0 + i < NCHUNK) { SP[base + (size_t)(n0 + i) * 4096] = f2bf(st); st = st * c + u[i]; }
    }
}
template <bool FOX>
__device__ __forceinline__ void attn_item(const Params& p, int l, int h, int qb, lds_u8* wl) {
    const bf16_t* P = (const bf16_t*)(p.ws + WS_PROJ);
    const float* Fh = (const float*)(p.ws + WS_FCUM) + (size_t)h * S;
    const float* LCh = (const float*)(p.ws + WS_LC) + (size_t)h * S;
    bf16_t* MG = (bf16_t*)(p.ws + WS_MERGED);
    const int lane = lane_id(), r32 = lane & 31, hi = lane >> 5;
    const int q0 = qb * 32, t = q0 + r32;
    constexpr int oq = FOX ? OQF : OQS, ok = FOX ? OKF : OKS, ov = FOX ? OVF : OVS;
    bf16x8 qf[4];
    { const bf16_t* qp = P + (size_t)t * PW + oq + h * HD + 8 * hi;
#pragma unroll
      for (int ks = 0; ks < 4; ++ks) qf[ks] = *(const bf16x8*)(qp + 16 * ks); }
    float Bt = 0.f;
    if (FOX) {
        float qq = 0.f;
#pragma unroll
        for (int ks = 0; ks < 4; ++ks)
#pragma unroll
            for (int j = 0; j < 8; ++j) { const float v = bf2f((bf16_t)qf[ks][j]); qq += v * v; }
        qq += __shfl_xor(qq, 32);
        const float kmax = sqrtf(u2f(((const unsigned*)(p.ws + WS_CTL))[CTL_KMAX + l * 8 + h]));
        Bt = sqrtf(qq) * kmax * 1.0001f + 1e-6f;
    }
    const float fq = FOX ? Fh[t] : 0.f;
    float m = -1e30f, lsum = 0.f, carry = 0.f;
    f32x16 o0, o1;
#pragma unroll
    for (int r = 0; r < 16; ++r) { o0[r] = 0.f; o1[r] = 0.f; }
    const lds_u8* vb = wl + (4 * hi + ((lane & 15) >> 2)) * VROWB + (16 * ((lane >> 4) & 1) + 4 * (lane & 3)) * 2;
    bf16x8 kf1[4], kf2[4]; u32x4 vr1[4], vr2[4];
#define ATTN_LOAD(KF, VR, kt_) do { const int k0_ = (kt_) * 32; const bf16_t* kp_ = P + (size_t)(k0_ + r32) * PW + ok + h * HD + 8 * hi; \
        _Pragma("unroll") for (int ks = 0; ks < 4; ++ks) KF[ks] = *(const bf16x8*)(kp_ + 16 * ks); \
        _Pragma("unroll") for (int i = 0; i < 4; ++i) { const int c = lane + 64 * i; VR[i] = *(const u32x4*)(P + (size_t)(k0_ + (c >> 3)) * PW + ov + h * HD + 8 * (c & 7)); } \
        } while (0)
    ATTN_LOAD(kf1, vr1, qb);
    if (FOX) ATTN_LOAD(kf2, vr2, qb > 0 ? qb - 1 : 0);
    for (int kt = qb; kt >= 0; --kt) {
        const int key0 = kt * 32;
        const bool diag = (kt == qb);
        bf16x8 kf[4]; u32x4 vr[4];
        if (FOX) {
#pragma unroll
            for (int ks = 0; ks < 4; ++ks) { kf[ks] = kf1[ks]; kf1[ks] = kf2[ks]; }
#pragma unroll
            for (int i = 0; i < 4; ++i) { vr[i] = vr1[i]; vr1[i] = vr2[i]; }
            ATTN_LOAD(kf2, vr2, kt > 1 ? kt - 2 : 0);
        } else {
#pragma unroll
            for (int ks = 0; ks < 4; ++ks) kf[ks] = kf1[ks];
#pragma unroll
            for (int i = 0; i < 4; ++i) vr[i] = vr1[i];
            ATTN_LOAD(kf1, vr1, kt > 0 ? kt - 1 : 0);
        }
        f32x4 fk[4]; float fkm1 = 0.f, lck = 0.f;
        if (FOX) {
#pragma unroll
            for (int g4 = 0; g4 < 4; ++g4) fk[g4] = *(const f32x4*)(Fh + key0 + 8 * g4 + 4 * hi);
            fkm1 = Fh[key0 > 0 ? key0 - 1 : 0]; lck = LCh[key0];
        }
        f32x16 st, st2;
#pragma unroll
        for (int r = 0; r < 16; ++r) { st[r] = 0.f; st2[r] = 0.f; }
        st = mfma32(kf[0], qf[0], st); st2 = mfma32(kf[1], qf[1], st2); st = mfma32(kf[2], qf[2], st); st2 = mfma32(kf[3], qf[3], st2);
#pragma unroll
        for (int r = 0; r < 16; ++r) st[r] += st2[r];
        wave_barrier();
#pragma unroll
        for (int i = 0; i < 4; ++i) { const int c = lane + 64 * i; *(LAS u32x4*)(wl + (c >> 3) * VROWB + (c & 7) * 16) = vr[i]; }
        if (FOX) {
            float tmax = -1e30f;
#pragma unroll
            for (int g4 = 0; g4 < 4; ++g4)
#pragma unroll
                for (int i = 0; i < 4; ++i) { const int r = 4 * g4 + i; st[r] = st[r] + (fq - fk[g4][i]); }
            if (diag) {
#pragma unroll
                for (int r = 0; r < 16; ++r) if (crow(r, hi) > r32) st[r] = -1e30f;
            }
#pragma unroll
            for (int r = 0; r < 16; ++r) tmax = fmaxf(tmax, st[r]);
            tmax = fmaxf(tmax, partner32(tmax, hi));
            const float mn = fmaxf(m, tmax), f = fast_exp(m - mn);
            m = mn; lsum *= f;
#pragma unroll
            for (int r = 0; r < 16; ++r) { o0[r] *= f; o1[r] *= f; }
            float ps = 0.f;
#pragma unroll
            for (int r = 0; r < 16; ++r) { const float pr = fast_exp(st[r] - mn); st[r] = pr; ps += pr; }
            lsum += ps;
        } else {
            float l1m[16];
#pragma unroll
            for (int r = 0; r < 16; ++r) {
                const float z = st[r], sp = fast_log(1.0f + fast_exp(-fabsf(z)));
                const float lb = fminf(z, 0.f) - sp;
                l1m[r] = lb - z;
                st[r] = lb;
            }
            if (diag) {
#pragma unroll
                for (int r = 0; r < 16; ++r) if (crow(r, hi) >= r32) { l1m[r] = 0.f; st[r] = -1e30f; }
            }
            float gs[4], pg[4], T[4];
#pragma unroll
            for (int k = 0; k < 4; ++k) { gs[k] = (l1m[4 * k] + l1m[4 * k + 1]) + (l1m[4 * k + 2] + l1m[4 * k + 3]); pg[k] = partner32(gs[k], hi); }
            float run = 0.f;
#pragma unroll
            for (int k = 3; k >= 0; --k) { T[k] = run + (hi == 0 ? pg[k] : 0.f); run += gs[k] + pg[k]; }
#pragma unroll
            for (int k = 0; k < 4; ++k) {
                float w = T[k] + carry;
#pragma unroll
                for (int i = 3; i >= 0; --i) { const int r = 4 * k + i; st[r] = fast_exp(st[r] + w); w += l1m[r]; }
            }
            carry += run;
        }
        u32x4 pw0, pw1;
#pragma unroll
        for (int j = 0; j < 4; ++j) { pw0[j] = pk2(st[2 * j], st[2 * j + 1]); pw1[j] = pk2(st[8 + 2 * j], st[9 + 2 * j]); }
        const bf16x8 pf0 = __builtin_bit_cast(bf16x8, pw0), pf1 = __builtin_bit_cast(bf16x8, pw1);
        wave_barrier();
#pragma unroll
        for (int s = 0; s < 2; ++s) {
#pragma unroll
            for (int db = 0; db < 2; ++db) {
                const s16x4 lo = tr16(vb + (16 * s) * VROWB + db * 64), hi4 = tr16(vb + (16 * s + 8) * VROWB + db * 64);
                bf16x8 vf; vf[0] = lo[0]; vf[1] = lo[1]; vf[2] = lo[2]; vf[3] = lo[3]; vf[4] = hi4[0]; vf[5] = hi4[1]; vf[6] = hi4[2]; vf[7] = hi4[3];
                if (db == 0) o0 = mfma32(vf, s == 0 ? pf0 : pf1, o0); else o1 = mfma32(vf, s == 0 ? pf0 : pf1, o1);
            }
        }
        const bool done = FOX ? (Bt + (fq - fkm1) - m + (lck * 1.00001f + 1e-4f) < -EXIT_T) : (carry < -EXIT_T);
        if (ballot64(done) == ~0ull) break;
    }
#undef ATTN_LOAD
    if (FOX) { lsum += __shfl_xor(lsum, 32); const float il = 1.0f / lsum;
#pragma unroll
        for (int r = 0; r < 16; ++r) { o0[r] *= il; o1[r] *= il; } }
    float ss = 0.f;
#pragma unroll
    for (int r = 0; r < 16; ++r) ss += o0[r] * o0[r] + o1[r] * o1[r];
    ss += __shfl_xor(ss, 32);
    const float ri = 1.0f / sqrtf(ss * (1.0f / HD) + EPS);
    const float* g = (FOX ? p.g_fox + l * WFOX : p.g_sb + l * WSB) + h * HD;
    f32x4 ggv[2][4];
#pragma unroll
    for (int db = 0; db < 2; ++db)
#pragma unroll
        for (int g4 = 0; g4 < 4; ++g4) ggv[db][g4] = *(const f32x4*)(g + db * 32 + 8 * g4 + 4 * hi);
    wave_barrier();
#pragma unroll
    for (int db = 0; db < 2; ++db)
#pragma unroll
        for (int g4 = 0; g4 < 4; ++g4) {
            const int d0 = db * 32 + 8 * g4 + 4 * hi;
            const f32x4 gg = ggv[db][g4];
            float v[4];
#pragma unroll
            for (int i = 0; i < 4; ++i) v[i] = (db == 0 ? o0[4 * g4 + i] : o1[4 * g4 + i]) * ri * gg[i];
            u32x2 o; o[0] = pk2(v[0], v[1]); o[1] = pk2(v[2], v[3]);
            *(LAS u32x2*)(wl + r32 * VROWB + d0 * 2) = o;
        }
    wave_barrier();
    bf16_t* dst = MG + (size_t)q0 * MIXW + (FOX ? WRET + WSB : WRET) + h * HD;
#pragma unroll
    for (int j = 0; j < 4; ++j) { const int row = (lane >> 3) + 8 * j, ch = lane & 7;
        *(u32x4*)(dst + (size_t)row * MIXW + 8 * ch) = *(const LAS u32x4*)(wl + row * VROWB + ch * 16); }
    wave_barrier();
}
constexpr int WCH = 2, NWCH = (NE * WI_EXPERT + WCH - 1) / WCH, NWCHD = WI_DENSE / WCH;
struct QState { int sk; unsigned nxt; bool have; };
__device__ __forceinline__ unsigned q_fetch(unsigned* head, int shard, int limit, bool check) {
    unsigned c = 0x0fffffffu;
    if (lane_id() == 0) { if (!(check && (int)ld_relaxed(head) * 8 + shard >= limit)) c = atomicAdd(head, 1u); }
    return c;
}
__device__ __forceinline__ bool mix_weight_step(const Params& p, int l, lds_u8* wl, int shard0, QState& q) {
    unsigned* wbase = (unsigned*)(p.ws + WS_CTL) + CTL_WQ + 64 * (l * 8);
    const int lane = lane_id();
    const int nch = NWCH + (l + 1 < DEPTH ? NWCHD : 0);
#pragma unroll 1
    while (q.sk < 8) {
        const int shard = (shard0 + q.sk) & 7;
        unsigned* head = wbase + 64 * shard;
        if (!q.have) q.nxt = q_fetch(head, shard, nch, q.sk > 0);
        const int chunk = uni((int)__shfl(q.nxt, 0)) * 8 + shard;
        if (chunk >= nch) { ++q.sk; q.have = false; continue; }
        q.nxt = q_fetch(head, shard, nch, false); q.have = true;
        static_assert(WCH == 2 && (NE * WI_EXPERT) % 2 == 0 && WI_DENSE % 2 == 0, "two tiles per dequeue");
        { const bool own = chunk < NWCH; const int ll = own ? l : l + 1, ra = own ? WI_DENSE + chunk * 2 : (chunk - NWCH) * 2; weight_item2(p, ll, ra, ra + 1, wl, lane); }
        return true;
    }
    return false;
}
__device__ __forceinline__ int mix_head_ranks(const Params& p, int l) {
    const float* bfg = p.b_forget + l * NFOX;
    int hrank = 0;
    float bf[NFOX];
#pragma unroll
    for (int c = 0; c < NFOX; ++c) bf[c] = bfg[c];
#pragma unroll
    for (int c = 0; c < NFOX; ++c) { int rk = 0;
#pragma unroll
        for (int o = 0; o < NFOX; ++o) rk += (bf[o] > bf[c] || (bf[o] == bf[c] && o < c)) ? 1 : 0;
        hrank |= c << (4 * rk); }
    static_assert(NFOX <= 8, "head ranks packed in 4-bit fields");
    return uni(hrank);
}
constexpr int NMIX_ITEMS = NRET * 4096 / 64 + NFOX * (S / 32) + NSB * (S / 32);
__device__ __forceinline__ void mix_prefetch(const Params& p, int l, int& hrank, int& first) {
    hrank = mix_head_ranks(p, l);
    const int shard0 = xcc_shard();
    unsigned* qbase = (unsigned*)(p.ws + WS_CTL) + CTL_MQ + 64 * (l * 8);
    first = uni((int)__shfl(q_fetch(qbase + 64 * shard0, shard0, NMIX_ITEMS, false), 0));
}
__device__ __forceinline__ void phase_mix(const Params& p, int l, float* ldsf, int pre_hrank, int pre_first) {
    constexpr int NSCANW = NRET * 4096 / 64, NFXI = NFOX * NQ32, NSBI = NSB * NQ32;
    const int wave = p.wid;
    lds_u8* wl = (lds_u8*)ldsf + wave * RET_WAVE_LDS;
    static_assert(MIX_WAVE_LDS <= RET_WAVE_LDS, "per-wave LDS region");
    const int shard0 = xcc_shard();
    QState wq; wq.sk = 0; wq.nxt = 0u; wq.have = false;
    unsigned* qbase = (unsigned*)(p.ws + WS_CTL) + CTL_MQ + 64 * (l * 8);
    const float* bfg = p.b_forget + l * NFOX;
    constexpr int NMIX = NSCANW + NFXI + NSBI;
    static_assert(NMIX == NMIX_ITEMS, "queue length");
    const int hrank = pre_first >= 0 ? pre_hrank : mix_head_ranks(p, l);
    int nitems_done = 0; constexpr int MIX_SKIP = 2;
#pragma unroll 1
    for (int sk = 0; sk < 8; ++sk) {
      const int shard = (shard0 + sk) & 7;
      unsigned* qhead = qbase + 64 * shard;
      unsigned nxt = (sk == 0 && pre_first >= 0) ? (unsigned)pre_first : q_fetch(qhead, shard, NMIX, sk > 0);
#pragma unroll 1
      for (;;) {
        const int it = uni((int)__shfl(nxt, 0)) * 8 + shard;
        if (it >= NMIX) break;
        nxt = q_fetch(qhead, shard, NMIX, false);
        if (it < NSCANW) ret_scan_wave(p, it);
        else if (it < NSCANW + NFXI) {
            const int j = it - NSCANW, rank = j / NQ32;
            attn_item<true>(p, l, (hrank >> (4 * rank)) & 15, NQ32 - 1 - j % NQ32, wl);
        }
        else { const int j = it - NSCANW - NFXI; attn_item<false>(p, l, j % NSB, NQ32 - 1 - j / NSB, wl); }
        if (nitems_done >= MIX_SKIP) (void)mix_weight_step(p, l, wl, shard0, wq);
        ++nitems_done;
      }
    }
    while (mix_weight_step(p, l, wl, shard0, wq)) {}
}

__device__ __forceinline__ void ret_out_item(const Params& p, int l, int h, int n, int cb, lds_u8* wl) {
    const bf16_t* P = (const bf16_t*)(p.ws + WS_PROJ);
    const bf16_t* SPT = (const bf16_t*)(p.ws + WS_SP) + (size_t)(h * NCHUNK + n) * 4096;
    bf16_t* MG = (bf16_t*)(p.ws + WS_MERGED);
    const int lane = lane_id(), r32 = lane & 31, hi = lane >> 5;
    const float lg = ret_log_gamma(h);
    const size_t rowb = (size_t)(n * CH) * PW + h * HD;
    const int c = 32 * cb + r32;
    wave_barrier();
    u32x4 kv[8];
    lds_u8* img1 = wl + IMG64;
    {
        u32x4 vv[8], sv[8];
#pragma unroll
        for (int i = 0; i < 8; ++i) { const int q = lane + 64 * i; vv[i] = *(const u32x4*)(P + rowb + (size_t)(q >> 3) * PW + OVR + 8 * (q & 7)); sv[i] = *(const u32x4*)(SPT + (size_t)q * 8);
            kv[i] = *(const u32x4*)(P + rowb + (size_t)(q >> 3) * PW + OKR + 8 * (q & 7)); }
#pragma unroll
        for (int i = 0; i < 8; ++i) { const int q = lane + 64 * i; *(LAS u32x4*)(wl + (q >> 3) * VROWB + (q & 7) * 16) = vv[i]; *(LAS u32x4*)(img1 + (q >> 3) * VROWB + (q & 7) * 16) = sv[i]; }
    }
    sched_fence();
    bf16x8 qf[4];
#pragma unroll
    for (int ks = 0; ks < 4; ++ks) qf[ks] = *(const bf16x8*)(P + rowb + (size_t)c * PW + OQR + 16 * ks + 8 * hi);
    u32x4 gv[4];
#pragma unroll
    for (int i = 0; i < 4; ++i) { const int q = lane + 64 * i; gv[i] = *(const u32x4*)(P + rowb + (size_t)(32 * cb + (q >> 3)) * PW + OGR + 8 * (q & 7)); }
    wave_barrier();
    f32x16 o[2];
#pragma unroll
    for (int a = 0; a < 2; ++a)
#pragma unroll
        for (int r = 0; r < 16; ++r) o[a][r] = 0.f;
#pragma unroll
    for (int ks = 0; ks < 4; ++ks)
#pragma unroll
        for (int eb = 0; eb < 2; ++eb) { const bf16x8 sf = *(const LAS bf16x8*)(img1 + (32 * eb + r32) * VROWB + 32 * ks + 16 * hi); o[eb] = mfma32(sf, qf[ks], o[eb]); }
    { const float qd = fast_exp(lg * (float)(c + 1));
#pragma unroll
      for (int eb = 0; eb < 2; ++eb)
#pragma unroll
          for (int r = 0; r < 16; ++r) o[eb][r] *= qd; }
    wave_barrier();
#pragma unroll
    for (int i = 0; i < 8; ++i) { const int q = lane + 64 * i; *(LAS u32x4*)(img1 + (q >> 3) * VROWB + (q & 7) * 16) = kv[i]; }
    wave_barrier();
    const lds_u8* vb = wl + (4 * hi + ((lane & 15) >> 2)) * VROWB + (16 * ((lane >> 4) & 1) + 4 * (lane & 3)) * 2;
#pragma unroll
    for (int kb = 0; kb < 2; ++kb) {
        f32x16 st;
#pragma unroll
        for (int r = 0; r < 16; ++r) st[r] = 0.f;
#pragma unroll
        for (int ks = 0; ks < 4; ++ks) { const bf16x8 kf = *(const LAS bf16x8*)(img1 + (32 * kb + r32) * VROWB + 32 * ks + 16 * hi); st = mfma32(kf, qf[ks], st); }
        bf16x8 pf[2];
#pragma unroll
        for (int r = 0; r < 16; ++r) { const int dist = c - (32 * kb + crow(r, hi)); st[r] *= fast_exp(lg * fabsf((float)dist)); }
        { u32x4 w0, w1;
#pragma unroll
          for (int j = 0; j < 4; ++j) { w0[j] = pk2(st[2 * j], st[2 * j + 1]); w1[j] = pk2(st[8 + 2 * j], st[9 + 2 * j]); }
          pf[0] = __builtin_bit_cast(bf16x8, w0); pf[1] = __builtin_bit_cast(bf16x8, w1); }
#pragma unroll
        for (int s = 0; s < 2; ++s)
#pragma unroll
            for (int eb = 0; eb < 2; ++eb) o[eb] = mfma32(tr_frag(vb, 32 * kb + 16 * s, 32 * kb + 16 * s + 8, eb * 64), pf[s], o[eb]);
    }
    wave_barrier();
#pragma unroll
    for (int i = 0; i < 4; ++i) { const int q = lane + 64 * i; *(LAS u32x4*)(img1 + (q >> 3) * VROWB + (q & 7) * 16) = gv[i]; }
    wave_barrier();
    float sm = 0.f;
#pragma unroll
    for (int eb = 0; eb < 2; ++eb)
#pragma unroll
        for (int r = 0; r < 16; ++r) sm += o[eb][r];
    sm += __shfl_xor(sm, 32);
    const float mu = sm * (1.0f / HD);
    float vs = 0.f;
#pragma unroll
    for (int eb = 0; eb < 2; ++eb)
#pragma unroll
        for (int r = 0; r < 16; ++r) { const float dlt = o[eb][r] - mu; o[eb][r] = dlt; vs += dlt * dlt; }
    vs += __shfl_xor(vs, 32);
    const float ri = 1.0f / sqrtf(vs * (1.0f / HD) + EPS);
    const int row = n * CH + c;
    f32x4 ggv[2][4];
#pragma unroll
    for (int eb = 0; eb < 2; ++eb)
#pragma unroll
        for (int g4 = 0; g4 < 4; ++g4) ggv[eb][g4] = *(const f32x4*)(p.g_ret + l * WRET + h * HD + 32 * eb + 8 * g4 + 4 * hi);
#pragma unroll
    for (int eb = 0; eb < 2; ++eb)
#pragma unroll
        for (int g4 = 0; g4 < 4; ++g4) {
            const int e0 = 32 * eb + 8 * g4 + 4 * hi;
            const f32x4 gg = ggv[eb][g4];
            const u32x2 gt = *(const LAS u32x2*)(img1 + r32 * VROWB + e0 * 2);
            const float ga[4] = {u2f(gt[0] << 16), u2f(gt[0] & 0xffff0000u), u2f(gt[1] << 16), u2f(gt[1] & 0xffff0000u)};
            float v[4];
#pragma unroll
            for (int i = 0; i < 4; ++i) v[i] = o[eb][4 * g4 + i] * ri * gg[i] * ga[i];
            u32x2 ov; ov[0] = pk2(v[0], v[1]); ov[1] = pk2(v[2], v[3]);
            *(LAS u32x2*)(wl + r32 * VROWB + e0 * 2) = ov;
        }
    wave_barrier();
#pragma unroll
    for (int i = 0; i < 4; ++i) { const int q = lane + 64 * i;
        *(u32x4*)(MG + (size_t)(n * CH + 32 * cb + (q >> 3)) * MIXW + h * HD + 8 * (q & 7)) = *(const LAS u32x4*)(wl + (q >> 3) * VROWB + (q & 7) * 16); }
    wave_barrier();
}
__device__ __forceinline__ void phase_retout(const Params& p, int l, float* ldsf) {
    const int wave = p.wid;
    lds_u8* wl = (lds_u8*)ldsf + wave * RET_WAVE_LDS;
    for (int it = wave * (int)gridDim.x + (int)blockIdx.x; it < NRET * NCHUNK * 2; it += gridDim.x * NW) ret_out_item(p, l, (it >> 1) / NCHUNK, (it >> 1) % NCHUNK, it & 1, wl);
}

struct OutprojSched {
    static constexpr bool GATHER = false;
    int wid;
    unsigned ao[4]; int vcu, G;
    static constexpr int NPM = S / GBM, NPN = D / GBM;
    __device__ __forceinline__ bool next(int i, GUnit& u) const {
        const int L = uni(i * G + vcu); if (L >= NPM * NPN) return false;
        const int pm = L / NPN, pn = L % NPN;
        u.A = (unsigned)(pm * GBM * MIXW * 2); u.B = (unsigned)(pn * GBM * MIXW * 2); u.ao[0] = u.ao[1] = u.ao[2] = u.ao[3] = 0u;
        u.i0 = pm; u.i1 = pn; u.i2 = 0; u.i3 = 0; return true;
    }
};
struct OutprojEpi {
    const float* xin32; const bf16_t* xin16; bf16_t* X;
    template <bool F32>
    __device__ __forceinline__ void run(f32x4 (&acc)[2][2][4][2], const GUnit& u, int wr, int wc, int fr, int fq) const {
        const size_t o0 = (size_t)(u.i0 * GBM + wr * 64 + fr) * D + u.i1 * GBM + wc * 32 + 8 * fq;
        constexpr int MB = F32 ? 2 : 4;
#pragma unroll
        for (int ai = 0; ai < 2; ++ai)
#pragma unroll
            for (int mh = 0; mh < 4 / MB; ++mh) {
                u32x4 r[MB][2][F32 ? 2 : 1];
#pragma unroll
                for (int mm = 0; mm < MB; ++mm)
#pragma unroll
                    for (int bj = 0; bj < 2; ++bj) { const size_t o = o0 + (size_t)(ai * 128 + (MB * mh + mm) * 16) * D + bj * 128;
                        if constexpr (F32) { r[mm][bj][0] = *(const u32x4*)(xin32 + o); r[mm][bj][1] = *(const u32x4*)(xin32 + o + 4); }
                        else r[mm][bj][0] = *(const u32x4*)(xin16 + o); }
#pragma unroll
                for (int mm = 0; mm < MB; ++mm)
#pragma unroll
                    for (int bj = 0; bj < 2; ++bj) { u32x4 ov;
#pragma unroll
                        for (int n = 0; n < 2; ++n) {
                            f32x4 x;
                            if constexpr (F32) { const u32x4 w = r[mm][bj][n]; x[0] = u2f(w[0]); x[1] = u2f(w[1]); x[2] = u2f(w[2]); x[3] = u2f(w[3]); }
                            else { const u32x4 w = r[mm][bj][0]; x[0] = u2f(w[2 * n] << 16); x[1] = u2f(w[2 * n] & 0xffff0000u); x[2] = u2f(w[2 * n + 1] << 16); x[3] = u2f(w[2 * n + 1] & 0xffff0000u); }
                            const f32x4 v = x + acc[ai][bj][MB * mh + mm][n]; ov[2 * n] = pk2(v[0], v[1]); ov[2 * n + 1] = pk2(v[2], v[3]); }
                        *(u32x4*)(X + o0 + (size_t)(ai * 128 + (MB * mh + mm) * 16) * D + bj * 128) = ov; }
                sched_fence();
            }
    }
    __device__ __forceinline__ void operator()(f32x4 (&acc)[2][2][4][2], const GUnit& u, int wr, int wc, int fr, int fq) const {
        if (xin32) run<true>(acc, u, wr, wc, fr, fq); else run<false>(acc, u, wr, wc, fr, fq);
    }
};
__device__ __forceinline__ void phase_outproj(const Params& p, int l, float* ldsf) {
    OutprojSched S; S.wid = p.wid; plain_ao(S.ao, MIXW, TIDX(p)); S.vcu = vcu_id(); S.G = gridDim.x;
    OutprojEpi E; E.X = (bf16_t*)(p.ws + WS_X); E.xin32 = l == 0 ? p.x : nullptr; E.xin16 = E.X;
    gemm_stream((lds_u8*)ldsf, (const char*)(p.ws + WS_MERGED), (const char*)(p.ws + WS_WOUT) + (size_t)l * D * MIXW * 2, MIXW, S, E);
}

constexpr int RT_ROWS = 64, RT_TT = RT_ROWS / 16, RT_NL = RT_MT * 16 + 4;
constexpr int RT_RECROWS = 1024;
constexpr int ROUTE_LDS = (NW + 1) * RT_ROWS * RT_NL * 4 + 2 * NE * 4 + 5 * RT_RECROWS * 4;
__device__ __forceinline__ void phase_route(const Params& p, int l, float* lds) {
    const bf16_t* X = (const bf16_t*)(p.ws + WS_X);
    unsigned* ctl = (unsigned*)(p.ws + WS_CTL);
    int* LIST = (int*)(p.ws + WS_LIST);
    float* RSL = (float*)(p.ws + WS_RSL); float* GSL = (float*)(p.ws + WS_GSL);
    const float* bg = p.b_group + l * NG; const float* br = p.b_router + l * NE;
    const int lane = lane_id(), wave = p.wid;
    const int tidx = TIDX(p);
    float* part = lds;
    float* red = lds + NW * RT_ROWS * RT_NL;
    unsigned* lcnt = (unsigned*)(red + RT_ROWS * RT_NL); unsigned* lbase = lcnt + NE; unsigned* lrec = lbase + NE; float* lrs = (float*)(lrec + 2 * RT_RECROWS); float* lgt = lrs + RT_RECROWS;
    __syncthreads();
    if (tidx < NE) lcnt[tidx] = 0u;
    bf16x8 af[RT_KS][RT_MT][2];
    {
        const u32x4* img = (const u32x4*)(p.ws + WS_RIMG) + (size_t)(l * NW + wave) * RT_KS * RT_MT * 2 * 64 + lane;
#pragma unroll
        for (int s = 0; s < RT_KS; ++s)
#pragma unroll
            for (int m = 0; m < RT_MT; ++m)
#pragma unroll
                for (int sp = 0; sp < 2; ++sp) af[s][m][sp] = __builtin_bit_cast(bf16x8, img[((s * RT_MT + m) * 2 + sp) * 64]);
    }
    const int ti = lane & 15, q = lane >> 4;
    int nloc = 0;
    for (int it = blockIdx.x; it < S / RT_ROWS; it += gridDim.x, ++nloc) {
        const int row0 = it * RT_ROWS;
        u32x4 xf[RT_TT][RT_KS];
#pragma unroll
        for (int tt = 0; tt < RT_TT; ++tt)
#pragma unroll
            for (int s = 0; s < RT_KS; ++s) xf[tt][s] = *(const u32x4*)(X + (size_t)(row0 + 16 * tt + ti) * D + wave * RT_KW + 32 * s + 8 * q);
#pragma unroll
        for (int tt = 0; tt < RT_TT; ++tt) {
            f32x4 acc[RT_MT]; float sq = 0.f;
#pragma unroll
            for (int m = 0; m < RT_MT; ++m) { acc[m][0] = 0.f; acc[m][1] = 0.f; acc[m][2] = 0.f; acc[m][3] = 0.f; }
#pragma unroll
            for (int s = 0; s < RT_KS; ++s) {
                const bf16x8 xb = __builtin_bit_cast(bf16x8, xf[tt][s]);
#pragma unroll
                for (int m = 0; m < RT_MT; ++m) { acc[m] = mfma16(af[s][m][0], xb, acc[m]); acc[m] = mfma16(af[s][m][1], xb, acc[m]); }
#pragma unroll
                for (int j = 0; j < 4; ++j) { const float a = u2f(xf[tt][s][j] << 16), b = u2f(xf[tt][s][j] & 0xffff0000u); sq += a * a + b * b; }
            }
            float* dst = part + (size_t)(wave * RT_ROWS + 16 * tt + ti) * RT_NL;
#pragma unroll
            for (int m = 0; m < RT_MT; ++m) *(f32x4*)(dst + 16 * m + 4 * q) = acc[m];
            dst[RT_MT * 16 + q] = sq;
        }
        __syncthreads();
        for (int i = tidx; i < RT_ROWS * RT_NL; i += NT) { float sm = 0.f;
#pragma unroll
            for (int w = 0; w < NW; ++w) sm += part[w * RT_ROWS * RT_NL + i];
            red[i] = sm; }
        __syncthreads();
        if (tidx < RT_ROWS) {
            const float* rr = red + tidx * RT_NL;
            const int r = row0 + tidx;
            const float ss = (rr[RT_MT * 16] + rr[RT_MT * 16 + 1]) + (rr[RT_MT * 16 + 2] + rr[RT_MT * 16 + 3]);
            const float ri = 1.0f / sqrtf(ss * (1.0f / D) + EPS);
            float gl[NG];
#pragma unroll
            for (int g = 0; g < NG; ++g) gl[g] = rr[g] * ri + bg[g];
            int grp = 0; float gm = gl[0];
#pragma unroll
            for (int g = 1; g < NG; ++g) if (gl[g] > gm) { gm = gl[g]; grp = g; }
            float den = 0.f;
#pragma unroll
            for (int g = 0; g < NG; ++g) den += fast_exp(gl[g] - gm);
            const float pg = 1.0f / den;
            int i1 = 0; float v1 = -INFINITY; int i2 = 0; float v2 = -INFINITY;
#pragma unroll
            for (int e = 0; e < EPG; ++e) { const float x = rr[NG + grp * EPG + e] * ri + br[grp * EPG + e];
                if (x > v1) { v2 = v1; i2 = i1; v1 = x; i1 = e; } else if (x > v2) { v2 = x; i2 = e; } }
            const float e2 = fast_exp(v2 - v1), g1 = pg / (1.f + e2), g2 = pg * e2 / (1.f + e2);
            const int ea = grp * EPG + i1, eb = grp * EPG + i2;
            const int li = nloc * RT_ROWS + tidx;
            const unsigned ra = atomicAdd(lcnt + ea, 1u), rb = atomicAdd(lcnt + eb, 1u);
            lrec[2 * li] = (unsigned)ea | (ra << 8); lrec[2 * li + 1] = (unsigned)eb | (rb << 8); lrs[li] = ri; lgt[2 * li] = g1; lgt[2 * li + 1] = g2;
        }
    }
    {
        __syncthreads();
        if (tidx < NE) lbase[tidx] = atomicAdd(ctl + CTL_CNT + l * NE + tidx, lcnt[tidx]);
        __syncthreads();
        for (int i = tidx; i < 2 * nloc * RT_ROWS; i += NT) {
            const int li = i >> 1, r = (blockIdx.x + (li / RT_ROWS) * gridDim.x) * RT_ROWS + (li % RT_ROWS);
            const unsigned rec = lrec[i]; const int e = rec & 255u; const size_t at = (size_t)e * S + lbase[e] + (rec >> 8);
            LIST[at] = r * 2 + (i & 1); RSL[at] = lrs[li]; GSL[at] = lgt[i];
        }
    }
}

__device__ __forceinline__ void moe_table(const unsigned* cnt, volatile LAS unsigned* tab, int tid, int npn, int G) {
    __syncthreads();
    if (tid < 64) {
        const unsigned c = tid < NE ? cnt[tid] : 0u;
        const unsigned r = c % GBM;
        unsigned fsum = c / GBM, npos = r > 0u ? 1u : 0u;
#pragma unroll
        for (int d = 1; d < 64; d <<= 1) { fsum += (unsigned)__shfl_xor((int)fsum, d); npos += (unsigned)__shfl_xor((int)npos, d); }
        const unsigned rounds = fsum * (unsigned)npn <= (unsigned)G ? 1u : (fsum * (unsigned)npn + (unsigned)G - 1u) / (unsigned)G;
        const unsigned nkeep = rounds * (unsigned)G / (unsigned)npn - fsum;
        unsigned rank = 0u;
#pragma unroll 1
        for (int j = 0; j < NE; ++j) { const unsigned rj = (unsigned)__shfl((int)r, j); rank += (rj > r || (rj == r && j < tid)) ? 1u : 0u; }
        const bool keep = r > 0u && (nkeep >= npos || rank < nkeep), rem = r > 0u && !keep;
        unsigned inc = c / GBM + (keep ? 1u : 0u), incp = (c + GBM - 1) / GBM, incr = rem ? (r + 31u) / 32u : 0u;
#pragma unroll
        for (int d = 1; d < 64; d <<= 1) { const unsigned o = (unsigned)__shfl_up((int)inc, d), op = (unsigned)__shfl_up((int)incp, d), orr = (unsigned)__shfl_up((int)incr, d);
            if ((tid & 63) >= d) { inc += o; incp += op; incr += orr; } }
        if (tid < NE) { tab[tid + 1] = inc; tab[64 + tid] = c | (rem ? 0x80000000u : 0u); tab[128 + tid + 1] = incp; tab[192 + tid + 1] = incr; }
        if (tid == 0) { tab[0] = 0u; tab[128] = 0u; tab[192] = 0u; }
    }
    __syncthreads();
}
__device__ __forceinline__ bool moe_unit(volatile LAS unsigned* tab, int u, int npn, int& e, int& rt, int& pn, int& base, int& count) {
    const int tile = uni(u / npn); pn = uni(u % npn);
    if (tile >= (int)tab[NE]) return false;
    int lo = 0;
#pragma unroll
    for (int s = NE / 2; s >= 1; s >>= 1) if ((int)tab[lo + s] <= tile) lo += s;
    e = uni(lo); rt = tile - (int)tab[e]; base = (int)tab[128 + e] * GBM; count = (int)(tab[64 + e] & 0x7fffffffu);
    rt = uni(rt); base = uni(base); count = uni(count);
    return true;
}
__device__ __forceinline__ bool moe_rem_item(volatile LAS unsigned* tab, int it, int nsl, int& e, int& rt, int& grp, int& nvalid, int& base, int& sl) {
    if (it >= (int)tab[192 + NE] * nsl) return false;
    int lo = 0;
#pragma unroll
    for (int s = NE / 2; s >= 1; s >>= 1) if ((int)tab[192 + lo + s] * nsl <= it) lo += s;
    e = uni(lo);
    const int g0 = (int)tab[192 + e], nge = (int)tab[192 + e + 1] - g0, loc = it - g0 * nsl;
    sl = uni(loc / nge); grp = uni(loc % nge);
    const int c = (int)(tab[64 + e] & 0x7fffffffu); rt = uni(c / GBM); nvalid = uni(c % GBM); base = uni((int)tab[128 + e] * GBM);
    return true;
}
struct RemWalk {
    int first, step, end;
    __device__ __forceinline__ RemWalk(volatile LAS unsigned* tab, int nsl, int wid, int vcu, int G) {
        const int total = (int)tab[192 + NE] * nsl;
        if (G % 8 == 0) { const int cpx = G / 8, x = vcu / cpx, c = vcu % cpx, chunk = (total + 7) / 8; first = x * chunk + wid * cpx + c; step = NW * cpx; end = imin(total, (x + 1) * chunk); }
        else { first = wid * G + vcu; step = NW * G; end = total; }
    }
};
constexpr int REM_WAVE_LDS = 64 * VROWB;
template <int KT>
__device__ __forceinline__ void slice_gemm(lds_u8* wl, const char* const (&ap)[4], const char* const (&bp)[4], f32x4 (&acc)[2][2]) {
    static_assert(KT == 2 || KT % 4 == 0, "chunks of two K tiles, two buffers");
    const int lane = lane_id();
    lds_u8* wp = wl + (lane >> 3) * VROWB + (lane & 7) * 16;
    const lds_u8* rp = wl + (lane & 15) * VROWB + (lane >> 4) * 16;
    u32x4 bufA[2][8], bufB[2][8];
#define SG_LOAD(buf, kt0) do { _Pragma("unroll") for (int t_ = 0; t_ < 2; ++t_) _Pragma("unroll") for (int j_ = 0; j_ < 4; ++j_) { \
        buf[t_][j_] = *(const u32x4*)(ap[j_] + ((kt0) + t_) * 128); buf[t_][4 + j_] = *(const u32x4*)(bp[j_] + ((kt0) + t_) * 128); } } while (0)
#define SG_MMA(buf) do { _Pragma("unroll") for (int t_ = 0; t_ < 2; ++t_) { wave_barrier(); \
        _Pragma("unroll") for (int j_ = 0; j_ < 4; ++j_) { *(LAS u32x4*)(wp + (8 * j_) * VROWB) = buf[t_][j_]; *(LAS u32x4*)(wp + (32 + 8 * j_) * VROWB) = buf[t_][4 + j_]; } \
        wave_barrier(); \
        _Pragma("unroll") for (int k_ = 0; k_ < 2; ++k_) { \
            const bf16x8 a0_ = *(const LAS bf16x8*)(rp + k_ * 64), a1_ = *(const LAS bf16x8*)(rp + 16 * VROWB + k_ * 64); \
            const bf16x8 b0_ = *(const LAS bf16x8*)(rp + 32 * VROWB + k_ * 64), b1_ = *(const LAS bf16x8*)(rp + 48 * VROWB + k_ * 64); \
            acc[0][0] = mfma16(b0_, a0_, acc[0][0]); acc[0][1] = mfma16(b1_, a0_, acc[0][1]); acc[1][0] = mfma16(b0_, a1_, acc[1][0]); acc[1][1] = mfma16(b1_, a1_, acc[1][1]); } } } while (0)
#pragma unroll
    for (int g = 0; g < 2; ++g)
#pragma unroll
        for (int j = 0; j < 2; ++j) acc[g][j] = (f32x4){0.f, 0.f, 0.f, 0.f};
    SG_LOAD(bufA, 0);
    if constexpr (KT >= 4) {
        SG_LOAD(bufB, 2); sched_fence();
#pragma unroll 1
        for (int kt = 0; kt + 4 < KT; kt += 4) {
            SG_MMA(bufA); sched_fence(); SG_LOAD(bufA, kt + 4); sched_fence();
            SG_MMA(bufB); sched_fence(); SG_LOAD(bufB, kt + 6); sched_fence();
        }
        SG_MMA(bufA); sched_fence(); SG_MMA(bufB);
    } else SG_MMA(bufA);
#undef SG_LOAD
#undef SG_MMA
    wave_barrier();
}
struct Moe1Sched {
    static constexpr bool GATHER = true;
    int wid;
    unsigned ao[4];
    volatile LAS unsigned* tab; const int* LIST; int vcu, G;
    lds_u8* lbuf;
    static constexpr int NPN = 2 * DE / GBM;
    __device__ __forceinline__ bool next(int i, GUnit& u) const {
        int e, rt, pn, base, count; if (!moe_unit(tab, i * G + vcu, NPN, e, rt, pn, base, count)) return false;
        const int nvalid = count - rt * GBM;
        u.A = 0u; u.B = (unsigned)((e * 2 * DE + pn * GBM) * D * 2);
#pragma unroll
        for (int k = 0; k < 4; ++k) { int R, C; stage_rc(((wid << 6) | lane_id()) * 16 + (k & 1) * 8192, R, C); const int r = R + 128 * (k >> 1);
            glds4(LIST + (size_t)e * S + rt * GBM + (r < nvalid ? r : 0), lbuf + k * 256); }
        u.i0 = base + rt * GBM; u.i1 = pn; u.i2 = nvalid; u.i3 = e * S + rt * GBM; return true;
    }
    __device__ __forceinline__ void finish(GUnit& u) const {
#pragma unroll
        for (int k = 0; k < 4; ++k) { int R, C; stage_rc(((wid << 6) | lane_id()) * 16 + (k & 1) * 8192, R, C);
            const int tok = *(const LAS int*)(lbuf + k * 256 + lane_id() * 4) >> 1; u.ao[k] = (unsigned)((tok * D + C) * 2); }
    }
};
struct Moe1Epi {
    bf16_t* HID; const float* RSL;
    __device__ __forceinline__ void operator()(f32x4 (&acc)[2][2][4][2], const GUnit& u, int wr, int wc, int fr, int fq) const {
        float rs[2][4];
#pragma unroll
        for (int ai = 0; ai < 2; ++ai)
#pragma unroll
            for (int m = 0; m < 4; ++m) { const int r = ai * 128 + wr * 64 + m * 16 + fr; rs[ai][m] = r < u.i2 ? RSL[(size_t)u.i3 + r] : 0.f; }
#pragma unroll
        for (int ai = 0; ai < 2; ++ai)
#pragma unroll
            for (int m = 0; m < 4; ++m)
{ u32x4 o;
#pragma unroll
                for (int n = 0; n < 2; ++n) { f32x4 v;
#pragma unroll
                    for (int j = 0; j < 4; ++j) v[j] = silu(acc[ai][0][m][n][j] * rs[ai][m]) * (acc[ai][1][m][n][j] * rs[ai][m]);
                    o[2 * n] = pk2(v[0], v[1]); o[2 * n + 1] = pk2(v[2], v[3]); }
                *(u32x4*)(HID + (size_t)(u.i0 + ai * 128 + wr * 64 + m * 16 + fr) * DE + u.i1 * 128 + wc * 32 + 8 * fq) = o; }
    }
};
__device__ __forceinline__ void phase_moe1(const Params& p, int l, float* ldsf) {
    Moe1Sched S; S.wid = p.wid; S.tab = (volatile LAS unsigned*)((LAS unsigned char*)ldsf + GEMM_LDS);
    moe_table((const unsigned*)(p.ws + WS_CTL) + CTL_CNT + l * NE, S.tab, TIDX(p), Moe1Sched::NPN, (int)gridDim.x);
    S.LIST = (const int*)(p.ws + WS_LIST); S.vcu = vcu_id(); S.G = gridDim.x;
    S.lbuf = (lds_u8*)ldsf + GEMM_LDS + 1024 + p.wid * 1024;
    Moe1Epi E; E.HID = (bf16_t*)(p.ws + WS_HID); E.RSL = (const float*)(p.ws + WS_RSL);
    gemm_stream((lds_u8*)ldsf, (const char*)(p.ws + WS_X), (const char*)(p.ws + WS_WGU) + (size_t)l * NE * 2 * DE * D * 2, D, S, E);
    const int lane = lane_id(), fr = lane & 15, fq = lane >> 4;
    const char* Xb = (const char*)(p.ws + WS_X); const char* Wb = (const char*)(p.ws + WS_WGU) + (size_t)l * NE * 2 * DE * D * 2;
    const float* RSL = (const float*)(p.ws + WS_RSL);
    const RemWalk rw(S.tab, 8 * Moe1Sched::NPN, p.wid, S.vcu, S.G);
#pragma unroll 1
    for (int it = rw.first; it < rw.end; it += rw.step) {
        int e, rt, grp, nvalid, base, sl; if (!moe_rem_item(S.tab, it, 8 * Moe1Sched::NPN, e, rt, grp, nvalid, base, sl)) break;
        const int pn = sl >> 3, wc = (sl >> 1) & 3, n = sl & 1;
        const int r0 = grp * 32 + fr, r1 = r0 + 16, lo = e * ::S + rt * GBM;
        const float rs0 = r0 < nvalid ? RSL[lo + r0] : 0.f, rs1 = r1 < nvalid ? RSL[lo + r1] : 0.f;
        const size_t brow = (size_t)(e * 2 * DE + pn * GBM + wc * 32 + n * 16);
        const char* ap[4]; const char* bp[4];
#pragma unroll
        for (int j = 0; j < 4; ++j) { const int R = 8 * j + (lane >> 3), rr = grp * 32 + R; const int tok = rr < nvalid ? (S.LIST[lo + rr] >> 1) : 0;
            ap[j] = Xb + ((size_t)tok * D + 8 * (lane & 7)) * 2; bp[j] = Wb + ((brow + (R < 16 ? R : 128 + R - 16)) * D + 8 * (lane & 7)) * 2; }
        f32x4 acc[2][2];
        slice_gemm<D / GBK>((lds_u8*)ldsf + p.wid * REM_WAVE_LDS, ap, bp, acc);
#pragma unroll
        for (int g = 0; g < 2; ++g) { const int r = g ? r1 : r0; const float rs = g ? rs1 : rs0;
            if (r < nvalid) { f32x4 v;
#pragma unroll
                for (int j = 0; j < 4; ++j) v[j] = silu(acc[g][0][j] * rs) * (acc[g][1][j] * rs);
                u32x2 o; o[0] = pk2(v[0], v[1]); o[1] = pk2(v[2], v[3]);
                *(u32x2*)(E.HID + (size_t)(base + rt * GBM + r) * DE + pn * 128 + wc * 32 + 8 * fq + 4 * n) = o; } }
    }
}
struct Moe2Sched {
    static constexpr bool GATHER = false;
    int wid;
    volatile LAS unsigned* tab; unsigned ao[4]; int vcu, G;
    static constexpr int NPN = D / GBM;
    __device__ __forceinline__ bool next(int i, GUnit& u) const {
        int e, rt, pn, base, count; if (!moe_unit(tab, i * G + vcu, NPN, e, rt, pn, base, count)) return false;
        u.A = (unsigned)((base + rt * GBM) * DE * 2); u.B = (unsigned)((e * D + pn * GBM) * DE * 2); u.ao[0] = u.ao[1] = u.ao[2] = u.ao[3] = 0u;
        u.i0 = 0; u.i1 = pn; u.i2 = count - rt * GBM; u.i3 = e * S + rt * GBM; return true;
    }
};
struct Moe2Epi {
    bf16_t* Y; const int* LIST; const float* GATE;
    __device__ __forceinline__ void operator()(f32x4 (&acc)[2][2][4][2], const GUnit& u, int wr, int wc, int fr, int fq) const {
        int a[2][4]; float g[2][4];
#pragma unroll
        for (int ai = 0; ai < 2; ++ai)
#pragma unroll
            for (int m = 0; m < 4; ++m) { const int r = ai * 128 + wr * 64 + m * 16 + fr; a[ai][m] = r < u.i2 ? LIST[(size_t)u.i3 + r] : -1; }
#pragma unroll
        for (int ai = 0; ai < 2; ++ai)
#pragma unroll
            for (int m = 0; m < 4; ++m) { const int r = ai * 128 + wr * 64 + m * 16 + fr; g[ai][m] = r < u.i2 ? GATE[(size_t)u.i3 + r] : 0.f; }
#pragma unroll
        for (int ai = 0; ai < 2; ++ai)
#pragma unroll
            for (int m = 0; m < 4; ++m) {
                if (a[ai][m] >= 0) {
#pragma unroll
                    for (int bj = 0; bj < 2; ++bj) { u32x4 o;
#pragma unroll
                        for (int n = 0; n < 2; ++n) { const f32x4 v = acc[ai][bj][m][n] * g[ai][m]; o[2 * n] = pk2(v[0], v[1]); o[2 * n + 1] = pk2(v[2], v[3]); }
                        *(u32x4*)(Y + (size_t)a[ai][m] * D + u.i1 * GBM + bj * 128 + wc * 32 + 8 * fq) = o; }
                }
            }
    }
};
__device__ __forceinline__ void phase_moe2(const Params& p, int l, float* ldsf) {
    Moe2Sched S; S.wid = p.wid; S.tab = (volatile LAS unsigned*)((LAS unsigned char*)ldsf + GEMM_LDS);
#ifdef CPU_EMU
    constexpr bool REBUILD = true;
#else
    constexpr bool REBUILD = (Moe1Sched::NPN != Moe2Sched::NPN);
#endif
    if constexpr (REBUILD) moe_table((const unsigned*)(p.ws + WS_CTL) + CTL_CNT + l * NE, S.tab, TIDX(p), Moe2Sched::NPN, (int)gridDim.x);
    else __syncthreads();
    plain_ao(S.ao, DE, TIDX(p)); S.vcu = vcu_id(); S.G = gridDim.x;
    Moe2Epi E; E.Y = (bf16_t*)(p.ws + WS_Y); E.LIST = (const int*)(p.ws + WS_LIST); E.GATE = (const float*)(p.ws + WS_GSL);
    gemm_stream((lds_u8*)ldsf, (const char*)(p.ws + WS_HID), (const char*)(p.ws + WS_WDN) + (size_t)l * NE * D * DE * 2, DE, S, E);
    const int lane = lane_id(), fr = lane & 15, fq = lane >> 4;
    const char* Hb = (const char*)(p.ws + WS_HID); const char* Wb = (const char*)(p.ws + WS_WDN) + (size_t)l * NE * D * DE * 2;
    const RemWalk rw(S.tab, 8 * Moe2Sched::NPN, p.wid, S.vcu, S.G);
#pragma unroll 1
    for (int it = rw.first; it < rw.end; it += rw.step) {
        int e, rt, grp, nvalid, base, sl; if (!moe_rem_item(S.tab, it, 8 * Moe2Sched::NPN, e, rt, grp, nvalid, base, sl)) break;
        const int pn = sl >> 3, wc = (sl >> 1) & 3, n = sl & 1;
        const int r0 = grp * 32 + fr, r1 = r0 + 16, lo = e * ::S + rt * GBM;
        const int a0 = r0 < nvalid ? E.LIST[lo + r0] : -1, a1 = r1 < nvalid ? E.LIST[lo + r1] : -1;
        const float g0 = r0 < nvalid ? E.GATE[lo + r0] : 0.f, g1 = r1 < nvalid ? E.GATE[lo + r1] : 0.f;
        const size_t hrow = (size_t)(base + rt * GBM), brow = (size_t)(e * D + pn * GBM + wc * 32 + n * 16);
        const char* ap[4]; const char* bp[4];
#pragma unroll
        for (int j = 0; j < 4; ++j) { const int R = 8 * j + (lane >> 3), rr = grp * 32 + R;
            ap[j] = Hb + ((hrow + (rr < nvalid ? rr : 0)) * DE + 8 * (lane & 7)) * 2; bp[j] = Wb + ((brow + (R < 16 ? R : 128 + R - 16)) * DE + 8 * (lane & 7)) * 2; }
        f32x4 acc[2][2];
        slice_gemm<DE / GBK>((lds_u8*)ldsf + p.wid * REM_WAVE_LDS, ap, bp, acc);
#pragma unroll
        for (int g = 0; g < 2; ++g) { const int a = g ? a1 : a0; const float gt = g ? g1 : g0;
            if (a >= 0) {
#pragma unroll
                for (int bj = 0; bj < 2; ++bj) { const f32x4 v = acc[g][bj] * gt; u32x2 o; o[0] = pk2(v[0], v[1]); o[1] = pk2(v[2], v[3]);
                    *(u32x2*)(E.Y + (size_t)a * D + pn * GBM + bj * 128 + wc * 32 + 8 * fq + 4 * n) = o; } } }
    }
}

__device__ __forceinline__ void phase_combine(const Params& p, int l) {
    bf16_t* X = (bf16_t*)(p.ws + WS_X);
    const bf16_t* Y = (const bf16_t*)(p.ws + WS_Y);
    bf16_t* H = (bf16_t*)(p.ws + WS_H);
    const bool last = (l == DEPTH - 1);
    const float* gn = last ? p.norm_final : p.norm_mix + (l + 1) * D;
    const int lane = lane_id(), wave = p.wid;
    for (int r = blockIdx.x * NW + wave; r < S; r += gridDim.x * NW) {
        f32x4 v[RJ]; row_load_bf16(X + (size_t)r * D, v, lane);
#pragma unroll
        for (int j = 0; j < RJ; ++j) {
            const u32x2 a = *(const u32x2*)(Y + (size_t)(2 * r) * D + 256 * j + lane * 4), b = *(const u32x2*)(Y + (size_t)(2 * r + 1) * D + 256 * j + lane * 4);
            v[j][0] += u2f(a[0] << 16) + u2f(b[0] << 16); v[j][1] += u2f(a[0] & 0xffff0000u) + u2f(b[0] & 0xffff0000u);
            v[j][2] += u2f(a[1] << 16) + u2f(b[1] << 16); v[j][3] += u2f(a[1] & 0xffff0000u) + u2f(b[1] & 0xffff0000u);
        }
        const float ri = row_rinv(v);
#pragma unroll
        for (int j = 0; j < RJ; ++j) {
            const f32x4 g = *(const f32x4*)(gn + 256 * j + lane * 4);
            if (last) *(f32x4*)(p.out + (size_t)r * D + 256 * j + lane * 4) = v[j] * ri * g;
            else {
                { u32x2 xo; xo[0] = pk2(v[j][0], v[j][1]); xo[1] = pk2(v[j][2], v[j][3]); *(u32x2*)(X + (size_t)r * D + 256 * j + lane * 4) = xo; }
                u32x2 o; o[0] = pk2(v[j][0] * ri * g[0], v[j][1] * ri * g[1]); o[1] = pk2(v[j][2] * ri * g[2], v[j][3] * ri * g[3]);
                *(u32x2*)(H + (size_t)r * D + 256 * j + lane * 4) = o;
            }
        }
    }
}

__device__ __forceinline__ void warm_rows(const char* base, int tid) {
#ifndef CPU_EMU
    u32x4 a = {0u, 0u, 0u, 0u};
#pragma unroll
    for (int k = 0; k < 8; ++k) { const u32x4 v = *(const u32x4*)(base + (size_t)(k * NT + tid) * 16); a[0] ^= v[0]; a[1] ^= v[1]; a[2] ^= v[2]; a[3] ^= v[3]; }
    asm volatile("" :: "v"(a[0]), "v"(a[1]), "v"(a[2]), "v"(a[3]));
#endif
}
__device__ __forceinline__ void warm_outproj(const Params& p, int l) {
    OutprojSched S; S.wid = p.wid; S.vcu = vcu_id(); S.G = gridDim.x; GUnit u;
    if (!S.next(0, u)) return;
    warm_rows((const char*)(p.ws + WS_WOUT) + ((size_t)l * D + (size_t)(u.i1 * GBM + (u.i0 & 7) * 32)) * MIXW * 2, TIDX(p));
}
__device__ __forceinline__ void warm_inproj(const Params& p, int l) {
    if (l >= DEPTH) return;
    InprojSched S; S.wid = p.wid; S.vcu = vcu_id(); S.G = gridDim.x; GUnit u;
    if (!S.next(0, u)) return;
    warm_rows((const char*)(p.ws + WS_WIN) + ((size_t)l * PW + (size_t)(u.i1 * GBM + (u.i0 & 7) * 32)) * D * 2, TIDX(p));
}

constexpr int PH_PER_LAYER = 9, NPHASE = 1 + DEPTH * PH_PER_LAYER;
constexpr int imax_c(int a, int b) { return a > b ? a : b; }
constexpr int LDS_MAIN = imax_c(imax_c(GEMM_LDS + 1024 + NW * 1024, ROUTE_LDS), imax_c(NW * RET_WAVE_LDS, NW * MIX_WAVE_LDS));
constexpr int LDS_MISC = (LDS_MAIN + 255) / 256 * 256;
constexpr int LDS_BYTES = LDS_MISC + 256;

__device__ __forceinline__ void run_phase(const Params& p, int ph, float* lds) {
    if (ph == 0) { phase_init(p, lds); return; }
    const int l = (ph - 1) / PH_PER_LAYER, q = (ph - 1) % PH_PER_LAYER;
    switch (q) {
        case 0: phase_inproj(p, l, lds); break;
        case 1: phase_prep(p, l, lds); break;
        case 2: phase_mix(p, l, lds, 0, -1); break;
        case 3: phase_retout(p, l, lds); break;
        case 4: phase_outproj(p, l, lds); break;
        case 5: phase_route(p, l, lds); break;
        case 6: phase_moe1(p, l, lds); break;
        case 7: phase_moe2(p, l, lds); break;
        default: phase_combine(p, l); break;
    }
}

#ifndef CPU_EMU
#define XB_TMO      128
#define XB_XCNT(j)  (256  + 64 * (j))
#define XB_XSUB(j)  (1280 + 64 * (j))
#define XB_XGEN(j)  (2304 + 64 * (j))
#define XB_TOP      3328
#define XB_TOPGEN   3392
#define XCD_BAR_WORDS 3456
#define XB_SPIN_CAP (1u << 22)
__device__ __forceinline__ unsigned xb_ld(unsigned* p)              { return __hip_atomic_load(p, __ATOMIC_RELAXED, __HIP_MEMORY_SCOPE_AGENT); }
__device__ __forceinline__ unsigned xb_add(unsigned* p, unsigned v) { return __hip_atomic_fetch_add(p, v, __ATOMIC_RELAXED, __HIP_MEMORY_SCOPE_AGENT); }
__device__ __forceinline__ unsigned xb_xcc_id() { return (unsigned)__builtin_amdgcn_s_getreg((3 << 11) | 20) & 0xFu; }
#define XB_SPIN(cond, bar) do { unsigned _sp = 0; while (cond) { __builtin_amdgcn_s_sleep(1); \
    if ((++_sp & 255u) == 0u) { if (xb_ld(&(bar)[XB_TMO])) break; if (_sp > XB_SPIN_CAP) { atomicAdd(&(bar)[XB_TMO], 1u); break; } } } } while (0)
struct XcdBarrier { unsigned* bar; unsigned x; volatile LAS unsigned* st; };
__device__ __forceinline__ XcdBarrier xcd_barrier_post(unsigned* bar, volatile LAS unsigned* st, bool t0) {
    XcdBarrier b; b.bar = bar; b.x = xb_xcc_id(); b.st = st;
    if (t0) (void)xb_add(&bar[XB_XCNT(b.x)], 1u);
    return b;
}
__device__ __forceinline__ void xcd_barrier_complete(unsigned* bar, unsigned x, unsigned& nloc, unsigned& nx) {
    const unsigned G = gridDim.x * gridDim.y * gridDim.z;
    unsigned sum, cnt, mine, sp = 0u;
    for (;;) {
        sum = 0u; cnt = 0u; mine = 0u;
#pragma unroll
        for (unsigned j = 0; j < 16; ++j) { const unsigned c = xb_ld(&bar[XB_XCNT(j)]); sum += c; cnt += (c > 0u) ? 1u : 0u; mine = (j == x) ? c : mine; }
        if (sum == G) break;
        __builtin_amdgcn_s_sleep(1);
        if ((++sp & 255u) == 0u) { if (xb_ld(&bar[XB_TMO])) break; if (sp > XB_SPIN_CAP) { atomicAdd(&bar[XB_TMO], 1u); break; } }
    }
    nloc = mine > 0u ? mine : 1u; nx = cnt > 0u ? cnt : 1u;
}
__device__ __forceinline__ void xcd_barrier(const XcdBarrier& b, bool t0) {
    asm volatile("s_waitcnt vmcnt(0)" ::: "memory");
    __syncthreads();
    if (t0) {
        unsigned* bar = b.bar;
        __builtin_amdgcn_s_waitcnt(0);
        unsigned nloc = b.st[0], nx = b.st[1];
        if (nloc == 0u) { xcd_barrier_complete(bar, b.x, nloc, nx); b.st[0] = nloc; b.st[1] = nx; }
        const unsigned old = xb_add(&bar[XB_XSUB(b.x)], 1u);
        const unsigned gen = old / nloc;
        if (old + 1u == (gen + 1u) * nloc) {
            __builtin_amdgcn_fence(__ATOMIC_RELEASE, "agent");
            asm volatile("s_waitcnt vmcnt(0)" ::: "memory");
            const unsigned og = xb_add(&bar[XB_TOP], 1u);
            const unsigned tg = og / nx;
            if (og + 1u == (tg + 1u) * nx) xb_add(&bar[XB_TOPGEN], 1u);
            else XB_SPIN(xb_ld(&bar[XB_TOPGEN]) == tg, bar);
            __builtin_amdgcn_fence(__ATOMIC_ACQUIRE, "agent");
            xb_add(&bar[XB_XGEN(b.x)], 1u);
            asm volatile("s_waitcnt vmcnt(0)" ::: "memory");
        } else {
            XB_SPIN(xb_ld(&bar[XB_XGEN(b.x)]) == gen, bar);
            __builtin_amdgcn_fence(__ATOMIC_ACQUIRE, "agent");
            asm volatile("s_waitcnt vmcnt(0)" ::: "memory");
        }
    }
    __syncthreads();
}
#endif
#ifndef CPU_EMU
__global__ void __launch_bounds__(NT) fwd_kernel(Params pin, int ph_lo, int ph_hi) {
    extern __shared__ __attribute__((aligned(16))) float lds[];
    Params p = pin; p.wid = uni((int)(threadIdx.x >> 6));
    volatile LAS unsigned* misc = (volatile LAS unsigned*)((LAS unsigned char*)lds + LDS_MISC);
    if (p.wid == 0) misc[lane_id()] = 0u;
    __syncthreads();
    XcdBarrier xb; xb.bar = (unsigned*)(p.ws + WS_CTL) + CTL_BAR; xb.x = 0; xb.st = misc;
#define T0() (p.wid == 0 && lane_id() == 0)
    xb = xcd_barrier_post((unsigned*)(p.ws + WS_CTL) + CTL_BAR, misc, T0());
#define SEAM(k) xcd_barrier(xb, T0())
#define PHASE(k, call) do { if (ph_lo <= (k) && (k) < ph_hi) { call; if ((k) + 1 < ph_hi) SEAM(k); } } while (0)
#define LAYER(l) do { const int b_ = 1 + (l) * PH_PER_LAYER; \
        PHASE(b_ + 0, phase_inproj(p, l, lds)); PHASE(b_ + 1, (phase_prep(p, l, lds), mix_prefetch(p, l, mixr, mixf))); PHASE(b_ + 2, phase_mix(p, l, lds, mixr, mixf)); \
        PHASE(b_ + 3, (phase_retout(p, l, lds), warm_outproj(p, l))); PHASE(b_ + 4, phase_outproj(p, l, lds)); PHASE(b_ + 5, phase_route(p, l, lds)); \
        PHASE(b_ + 6, phase_moe1(p, l, lds)); PHASE(b_ + 7, phase_moe2(p, l, lds)); PHASE(b_ + 8, (phase_combine(p, l), warm_inproj(p, (l) + 1))); } while (0)
    int mixr = 0, mixf = -1;
    PHASE(0, phase_init(p, lds));
    LAYER(0);
    LAYER(1);
    static_assert(DEPTH == 2, "phase program written for two layers");
#undef LAYER
#undef PHASE
#undef SEAM
}

#ifndef N_LAUNCH_PER_PHASE
#define N_LAUNCH_PER_PHASE 0
#endif
extern "C" void kernel_launch(void* const* d_in, const int* in_sizes, int n_in, void* d_out, int out_size, void* d_ws, size_t ws_size, hipStream_t stream) {
    static int grid = 0;
    if (grid == 0) {
        if (ws_size < WS_END) { fprintf(stderr, "kernel_launch: workspace too small (%zu < %zu)\n", ws_size, (size_t)WS_END); grid = -1; return; }
        int dev = 0, cus = 0, per_cu = 0;
        hipGetDevice(&dev);
        hipDeviceGetAttribute(&cus, hipDeviceAttributeMultiprocessorCount, dev);
        hipFuncSetAttribute((const void*)fwd_kernel, hipFuncAttributeMaxDynamicSharedMemorySize, LDS_BYTES);
        hipOccupancyMaxActiveBlocksPerMultiprocessor(&per_cu, (const void*)fwd_kernel, NT, LDS_BYTES);
        if (per_cu < 1) { fprintf(stderr, "kernel_launch: occupancy query says %d blocks per CU\n", per_cu); grid = -1; return; }
        grid = cus;
    }
    if (grid < 0) return;
    Params p{};
    p.x = (const float*)d_in[0]; p.norm_mix = (const float*)d_in[1]; p.w_in = (const float*)d_in[2]; p.b_forget = (const float*)d_in[3];
    p.g_ret = (const float*)d_in[4]; p.g_sb = (const float*)d_in[5]; p.g_fox = (const float*)d_in[6]; p.w_out = (const float*)d_in[7];
    p.norm_ffn = (const float*)d_in[8]; p.w_group = (const float*)d_in[9]; p.b_group = (const float*)d_in[10]; p.w_router = (const float*)d_in[11];
    p.b_router = (const float*)d_in[12]; p.w_gate = (const float*)d_in[13]; p.w_up = (const float*)d_in[14]; p.w_down = (const float*)d_in[15];
    p.norm_final = (const float*)d_in[16]; p.out = (float*)d_out; p.ws = (unsigned char*)d_ws;
#if N_LAUNCH_PER_PHASE
    for (int ph = 0; ph < NPHASE; ++ph) {
        int lo = ph, hi = ph + 1; void* args[] = {&p, &lo, &hi};
        hipLaunchCooperativeKernel((const void*)fwd_kernel, dim3(grid), dim3(NT), args, LDS_BYTES, stream);
    }
#else
    (void)hipMemsetAsync((char*)d_ws + WS_CTL + (size_t)CTL_BAR * 4, 0, 3456 * 4, stream);
    int lo = 0, hi = NPHASE; void* args[] = {&p, &lo, &hi};
    hipError_t e = hipLaunchCooperativeKernel((const void*)fwd_kernel, dim3(grid), dim3(NT), args, LDS_BYTES, stream);
    if (e != hipSuccess) fprintf(stderr, "cooperative launch failed: %s (grid %d)\n", hipGetErrorString(e), grid);
#endif
}
#endif
```
